# Optimizing an MI355X kernel written in HIP

```python
import jax, jax.numpy as jnp
from jax import lax
import numpy as np


D_MODEL = 2048
BATCH = 4
SEQ = 2048
DEPTH = 4

EPS = 1e-6
LRU_HEADS = 12
LRU_HEAD_DIM = 128
LRU_WIDTH = LRU_HEADS * LRU_HEAD_DIM
CONV_WIDTH = 4
LRU_C = 8.0
DIL_PATTERNS = ((128, 1), (512, 4), (2048, 16))
N_DIL = 3
ATT_HEADS_PER_GROUP = 4
ATT_HEAD_DIM = 128
ATT_HEADS = N_DIL * ATT_HEADS_PER_GROUP
ATT_WIDTH = ATT_HEADS * ATT_HEAD_DIM
ATT_OUT = ATT_HEADS_PER_GROUP * ATT_HEAD_DIM
EVEN_SIZES = (LRU_WIDTH, LRU_WIDTH, ATT_WIDTH, ATT_WIDTH, ATT_WIDTH, ATT_OUT)
EVEN_IN = 2 * LRU_WIDTH + 3 * ATT_WIDTH + ATT_OUT
EVEN_OUT = LRU_WIDTH + ATT_OUT
GLA_HEADS = 4
GLA_DK = 128
GLA_DV = 256
GLA_KW = GLA_HEADS * GLA_DK
GLA_VW = GLA_HEADS * GLA_DV
GLA_RANK = 16
GLA_TAU = 16.0
GLA_CHUNK = 64
SG_GROUPS = 4
SG_GROUP_DIM = 256
SG_WIDTH = SG_GROUPS * SG_GROUP_DIM
SG_CHUNK = 128
ODD_SIZES = (GLA_KW, GLA_KW, GLA_VW, GLA_RANK, GLA_VW, SG_WIDTH, SG_WIDTH, SG_WIDTH)
ODD_IN = 2 * GLA_KW + 2 * GLA_VW + GLA_RANK + 3 * SG_WIDTH
ODD_OUT = GLA_VW + SG_WIDTH

kernel_name = 'hybrid_lru_dilattn_gla_sgu_trunk'

F32 = jnp.float32


def split_points(sizes):
    pts, acc = [], 0
    for s in sizes[:-1]:
        acc += s
        pts.append(acc)
    return pts


def rms_norm(x, g):
    xf = x.astype(F32)
    y = xf * lax.rsqrt(jnp.mean(xf * xf, axis=-1, keepdims=True) + EPS)
    return (y * g.astype(F32)).astype(x.dtype)


def causal_conv(x, w, b):
    k_w = w.shape[0]
    seq = x.shape[1]
    xp = jnp.pad(x, ((0, 0), (k_w - 1, 0), (0, 0)))
    return sum(xp[:, j:j + seq] * w[j] for j in range(k_w)) + b


def _lru_combine(left, right):
    a_l, h_l = left
    a_r, h_r = right
    return a_l * a_r, a_r * h_l + h_r


def rg_lru(x, w_a, b_a, w_i, b_i, lam):
    bsz, seq, width = x.shape
    xf = x.astype(F32)
    xh = xf.reshape(bsz, seq, LRU_HEADS, LRU_HEAD_DIM)
    r = jax.nn.sigmoid(jnp.einsum('bshi,hij->bshj', xh, w_a.astype(F32)) + b_a.astype(F32))
    i = jax.nn.sigmoid(jnp.einsum('bshi,hij->bshj', xh, w_i.astype(F32)) + b_i.astype(F32))
    r = r.reshape(bsz, seq, width)
    i = i.reshape(bsz, seq, width)
    log_a = -LRU_C * r * jax.nn.softplus(-lam.astype(F32))
    a = jnp.exp(log_a)
    u = jnp.sqrt(-jnp.expm1(2.0 * log_a)) * (i * xf)
    _, hs = lax.associative_scan(_lru_combine, (a, u), axis=1)
    return hs.astype(x.dtype)


def alibi_slopes():
    g = np.arange(N_DIL)[:, None]
    j = np.arange(ATT_HEADS_PER_GROUP)[None, :]
    return jnp.asarray(2.0 ** (-8.0 * (g + N_DIL * j + 1) / ATT_HEADS), F32)


def dilated_group(q, k, v, dil, sub_w, slopes):
    bsz, seq, nh, dh = q.shape
    L = seq // dil
    nb = -(-L // sub_w)
    Lp = nb * sub_w

    def strided(t):
        t = t.reshape(bsz, L, dil, nh, dh).transpose(0, 2, 3, 1, 4)
        return jnp.pad(t, ((0, 0), (0, 0), (0, 0), (0, Lp - L), (0, 0)))

    def banded(t):
        t = jnp.pad(t, ((0, 0), (0, 0), (0, 0), (sub_w, 0), (0, 0)))
        t = t.reshape(bsz, dil, nh, nb + 1, sub_w, dh)
        return jnp.concatenate([t[:, :, :, :-1], t[:, :, :, 1:]], axis=-2)

    qb = strided(q).reshape(bsz, dil, nh, nb, sub_w, dh)
    kb = banded(strided(k))
    vb = banded(strided(v))
    s = jnp.einsum('brhnqe,brhnke->brhnqk', qb, kb) * (dh ** -0.5)
    qi = jnp.arange(sub_w)[:, None]
    ki = jnp.arange(2 * sub_w)[None, :]
    delta = sub_w + qi - ki
    blk = jnp.arange(nb)[:, None, None]
    valid = (delta >= 0) & (delta <= sub_w) & (blk * sub_w - sub_w + ki >= 0)
    dist = (delta * dil).astype(F32)
    s = s - slopes[None, None, :, None, None, None] * dist
    s = jnp.where(valid, s, -jnp.inf)
    m = jnp.max(s, axis=-1, keepdims=True)
    p = jnp.exp(s - m)
    den = jnp.sum(p, axis=-1, keepdims=True)
    o = jnp.einsum('brhnqk,brhnke->brhnqe', p, vb) / den
    lse = (m + jnp.log(den))[..., 0]

    def unstrided(t):
        t = t.reshape(bsz, dil, nh, Lp, *t.shape[5:])[:, :, :, :L]
        t = jnp.moveaxis(t, 3, 1)
        return t.reshape(bsz, seq, nh, *t.shape[4:])

    return unstrided(o), unstrided(lse)


def dilated_attention(q, k, v):
    bsz, seq, _ = q.shape
    shape = (bsz, seq, N_DIL, ATT_HEADS_PER_GROUP, ATT_HEAD_DIM)
    qh, kh, vh = (t.astype(F32).reshape(shape) for t in (q, k, v))
    slopes = alibi_slopes()
    outs, lses = [], []
    for g, (win, dil) in enumerate(DIL_PATTERNS):
        o, l = dilated_group(qh[:, :, g], kh[:, :, g], vh[:, :, g], dil, win // dil, slopes[g])
        outs.append(o)
        lses.append(l)
    wts = jax.nn.softmax(jnp.stack(lses, axis=0), axis=0)
    y = jnp.einsum('gbsh,gbshe->bshe', wts, jnp.stack(outs, axis=0))
    return y.reshape(bsz, seq, ATT_OUT).astype(q.dtype)


def gla_chunked(q, k, v, log_a):
    bsz, seq, nh, dk = q.shape
    dv = v.shape[-1]
    nc = seq // GLA_CHUNK

    def chunks(t):
        return t.astype(F32).reshape(bsz, nc, GLA_CHUNK, nh, t.shape[-1]).transpose(0, 3, 1, 2, 4)

    q, k, v, log_a = chunks(q), chunks(k), chunks(v), chunks(log_a)
    q = q * (dk ** -0.5)
    b = jnp.cumsum(log_a, axis=3)
    b_last = b[:, :, :, -1:, :]
    qt = q * jnp.exp(b)
    kt = k * jnp.exp(-b)
    causal = jnp.tril(jnp.ones((GLA_CHUNK, GLA_CHUNK), bool))
    att = jnp.where(causal, jnp.einsum('bhnie,bhnje->bhnij', qt, kt), 0.0)
    o_intra = jnp.einsum('bhnij,bhnjv->bhniv', att, v)
    upd = jnp.einsum('bhnje,bhnjv->bhnev', k * jnp.exp(b_last - b), v)
    decay = jnp.exp(b_last[:, :, :, 0, :])

    def step(state, inp):
        dec, u = inp
        return dec[..., None] * state + u, state

    init = jnp.zeros((bsz, nh, dk, dv), F32)
    _, s_prev = lax.scan(step, init, (jnp.moveaxis(decay, 2, 0), jnp.moveaxis(upd, 2, 0)))
    o_inter = jnp.einsum('bhnie,nbhev->bhniv', qt, s_prev)
    o = o_intra + o_inter
    return o.transpose(0, 2, 3, 1, 4).reshape(bsz, seq, nh, dv)


def spatial_gating(u, v, w_s, b_s, v_norm):
    bsz, seq, _ = u.shape
    nc = seq // SG_CHUNK
    vf = v.astype(F32).reshape(bsz, nc, SG_CHUNK, SG_GROUPS, SG_GROUP_DIM)
    mu = jnp.mean(vf, axis=-1, keepdims=True)
    var = jnp.mean(jnp.square(vf - mu), axis=-1, keepdims=True)
    vf = (vf - mu) * lax.rsqrt(var + EPS) * v_norm.astype(F32)
    mask = jnp.tril(jnp.ones((SG_CHUNK, SG_CHUNK), bool))
    w = jnp.where(mask, w_s.astype(F32), 0.0)
    s = jnp.einsum('gts,bcsge->bctge', w, vf) + b_s.astype(F32).T[:, :, None]
    return (u.astype(F32) * s.reshape(bsz, seq, SG_WIDTH)).astype(u.dtype)


def even_layer(x, norm, w_in, conv_w, conv_b, w_a, b_a, w_i, b_i, lam, w_out):
    h = rms_norm(x, norm)
    z = h @ w_in
    xa, ga, q, k, v, gb = jnp.split(z, split_points(EVEN_SIZES), axis=-1)
    ya = rg_lru(causal_conv(xa, conv_w, conv_b), w_a, b_a, w_i, b_i, lam) * jax.nn.silu(ga)
    yb = dilated_attention(q, k, v) * jax.nn.silu(gb)
    return jnp.concatenate([ya.astype(x.dtype), yb.astype(x.dtype)], axis=-1) @ w_out


def odd_layer(x, norm, w_in, w_alpha, b_alpha, head_norm, v_norm, w_s, b_s, w_out):
    bsz, seq, _ = x.shape
    h = rms_norm(x, norm)
    z = h @ w_in
    q, k, v, a_lr, gc, u, vd, gd = jnp.split(z, split_points(ODD_SIZES), axis=-1)
    log_a = jax.nn.log_sigmoid((a_lr @ w_alpha + b_alpha).astype(F32)) / GLA_TAU

    def heads(t, e):
        return t.reshape(bsz, seq, GLA_HEADS, e)

    o = gla_chunked(heads(q, GLA_DK), heads(k, GLA_DK), heads(v, GLA_DV), heads(log_a, GLA_DK))
    yc = rms_norm(o, head_norm).reshape(bsz, seq, GLA_VW).astype(x.dtype) * jax.nn.silu(gc)
    yd = spatial_gating(jax.nn.gelu(u), jax.nn.gelu(vd), w_s, b_s, v_norm) * jax.nn.silu(gd)
    return jnp.concatenate([yc.astype(x.dtype), yd.astype(x.dtype)], axis=-1) @ w_out


def setup_inputs(seed: int = 0) -> dict:
    key = jax.random.key(seed)
    ks = jax.random.split(key, 21)
    ne, no = (DEPTH + 1) // 2, DEPTH // 2

    def nrm(k, shape, scale):
        return scale * jax.random.normal(k, shape, F32)

    def gain(k, shape):
        return 1.0 + 0.02 * jax.random.normal(k, shape, F32)

    s_lru = jax.random.uniform(ks[9], (ne, LRU_WIDTH), F32, minval=0.9, maxval=0.999) ** (1.0 / LRU_C)
    return {
        'x': nrm(ks[0], (BATCH, SEQ, D_MODEL), 1.0),
        'ev_norm': gain(ks[1], (ne, D_MODEL)),
        'ev_w_in': nrm(ks[2], (ne, D_MODEL, EVEN_IN), D_MODEL ** -0.5),
        'ev_conv_w': nrm(ks[3], (ne, CONV_WIDTH, LRU_WIDTH), CONV_WIDTH ** -0.5),
        'ev_conv_b': nrm(ks[4], (ne, LRU_WIDTH), 0.01),
        'ev_w_a': nrm(ks[5], (ne, LRU_HEADS, LRU_HEAD_DIM, LRU_HEAD_DIM), LRU_HEAD_DIM ** -0.5),
        'ev_b_a': nrm(ks[6], (ne, LRU_HEADS, LRU_HEAD_DIM), 0.01),
        'ev_w_i': nrm(ks[7], (ne, LRU_HEADS, LRU_HEAD_DIM, LRU_HEAD_DIM), LRU_HEAD_DIM ** -0.5),
        'ev_b_i': nrm(ks[8], (ne, LRU_HEADS, LRU_HEAD_DIM), 0.01),
        'ev_lam': jnp.log(s_lru) - jnp.log1p(-s_lru),
        'ev_w_out': nrm(ks[10], (ne, EVEN_OUT, D_MODEL), EVEN_OUT ** -0.5),
        'od_norm': gain(ks[11], (no, D_MODEL)),
        'od_w_in': nrm(ks[12], (no, D_MODEL, ODD_IN), D_MODEL ** -0.5),
        'od_w_alpha': nrm(ks[13], (no, GLA_RANK, GLA_KW), GLA_RANK ** -0.5),
        'od_b_alpha': nrm(ks[14], (no, GLA_KW), 0.01),
        'od_head_norm': gain(ks[15], (no, GLA_HEADS, GLA_DV)),
        'od_v_norm': gain(ks[16], (no, SG_GROUPS, SG_GROUP_DIM)),
        'od_w_s': nrm(ks[17], (no, SG_GROUPS, SG_CHUNK, SG_CHUNK), SG_CHUNK ** -0.5),
        'od_b_s': 1.0 + nrm(ks[18], (no, SG_GROUPS, SG_CHUNK), 0.01),
        'od_w_out': nrm(ks[19], (no, ODD_OUT, D_MODEL), ODD_OUT ** -0.5),
        'final_norm': gain(ks[20], (D_MODEL,)),
    }


def reference(x, ev_norm, ev_w_in, ev_conv_w, ev_conv_b, ev_w_a, ev_b_a, ev_w_i, ev_b_i, ev_lam,
              ev_w_out, od_norm, od_w_in, od_w_alpha, od_b_alpha, od_head_norm, od_v_norm,
              od_w_s, od_b_s, od_w_out, final_norm):
    for layer in range(DEPTH):
        i = layer // 2
        if layer % 2 == 0:
            x = x + even_layer(x, ev_norm[i], ev_w_in[i], ev_conv_w[i], ev_conv_b[i], ev_w_a[i],
                               ev_b_a[i], ev_w_i[i], ev_b_i[i], ev_lam[i], ev_w_out[i])
        else:
            x = x + odd_layer(x, od_norm[i], od_w_in[i], od_w_alpha[i], od_b_alpha[i],
                              od_head_norm[i], od_v_norm[i], od_w_s[i], od_b_s[i], od_w_out[i])
    return rms_norm(x, final_norm)
```

```cpp
#include <hip/hip_runtime.h>
#include <cstdio>
#include <cstdint>

constexpr int DM = 2048, NB = 4, SEQ = 2048, MTOK = NB * SEQ;
constexpr int LRU_W = 1536, EV_IN = 8192;
constexpr int OD_IN = 6160, OD_Z = 6144;
constexpr float EPS = 1e-6f;

typedef unsigned short bf16;
typedef bf16 AT;

__device__ __forceinline__ float bf2f(bf16 v) { return __uint_as_float((unsigned)v << 16); }
__device__ __forceinline__ unsigned f2bf(float f) { unsigned u = __builtin_bit_cast(unsigned, f); return (u + 0x7fffu + ((u >> 16) & 1u)) >> 16; }
__device__ __forceinline__ unsigned pk2(float lo, float hi) { return f2bf(lo) | (f2bf(hi) << 16); }
__device__ __forceinline__ float ldA(const bf16* p, size_t i) { return bf2f(p[i]); }
__device__ __forceinline__ void stA(bf16* p, size_t i, float v) { p[i] = (bf16)f2bf(v); }

__device__ __forceinline__ float sigmoidf_(float x) { return 1.f / (1.f + __expf(-x)); }
__device__ __forceinline__ float siluf_(float x) { return x * sigmoidf_(x); }
__device__ __forceinline__ float geluf_(float x) { return 0.5f * x * (1.f + tanhf(0.7978845608028654f * (x + 0.044715f * x * x * x))); }
__device__ __forceinline__ float softplusf_(float x) { return x > 20.f ? x : log1pf(__expf(x)); }
__device__ __forceinline__ float logsigmoidf_(float x) { return -softplusf_(-x); }

__device__ __forceinline__ float block_sum(float v, float* red) {
#pragma unroll
    for (int o = 32; o > 0; o >>= 1) v += __shfl_xor(v, o);
    const int w = threadIdx.x >> 6, nw = blockDim.x >> 6;
    __syncthreads();
    if ((threadIdx.x & 63) == 0) red[w] = v;
    __syncthreads();
    float s = 0.f;
    for (int i = 0; i < nw; ++i) s += red[i];
    return s;
}
__device__ __forceinline__ float block_max(float v, float* red) {
#pragma unroll
    for (int o = 32; o > 0; o >>= 1) v = fmaxf(v, __shfl_xor(v, o));
    const int w = threadIdx.x >> 6, nw = blockDim.x >> 6;
    __syncthreads();
    if ((threadIdx.x & 63) == 0) red[w] = v;
    __syncthreads();
    float s = -INFINITY;
    for (int i = 0; i < nw; ++i) s = fmaxf(s, red[i]);
    return s;
}

__global__ void __launch_bounds__(128) nv_lru_gates(const AT* z, const float* conv_w, const float* conv_b, const float* w_a, const float* b_a, const float* w_i, const float* b_i,
                                                    const float* lam, float* a_out, float* u_out) {
    __shared__ float xc[128];
    const int tok = blockIdx.x, h = blockIdx.y, j = threadIdx.x, t = tok % SEQ, ch = h * 128 + j;
    float v = conv_b[ch];
    for (int q = 0; q < 4; ++q) { const int tt = t + q - 3; if (tt >= 0) v += ldA(z, (size_t)(tok + q - 3) * EV_IN + ch) * conv_w[q * LRU_W + ch]; }
    xc[j] = v; __syncthreads();
    float ra = b_a[ch], ri = b_i[ch];
    const float* wa = w_a + (size_t)h * 128 * 128; const float* wi = w_i + (size_t)h * 128 * 128;
    for (int i = 0; i < 128; ++i) { ra += xc[i] * wa[i * 128 + j]; ri += xc[i] * wi[i * 128 + j]; }
    const float r = sigmoidf_(ra), ig = sigmoidf_(ri);
    const float log_a = -8.0f * r * softplusf_(-lam[ch]);
    const float a = __expf(log_a);
    const float u = sqrtf(-expm1f(2.f * log_a)) * (ig * v);
    a_out[(size_t)tok * LRU_W + ch] = a; u_out[(size_t)tok * LRU_W + ch] = u;
}
__global__ void __launch_bounds__(256) nv_lru_scan(const float* a, const float* u, const AT* z, AT* y) {
    const int idx = blockIdx.x * 256 + threadIdx.x; if (idx >= NB * LRU_W) return;
    const int b = idx / LRU_W, ch = idx % LRU_W; float h = 0.f;
    for (int t = 0; t < SEQ; ++t) { const size_t tok = (size_t)b * SEQ + t; h = a[tok * LRU_W + ch] * h + u[tok * LRU_W + ch];
        stA(y, tok * DM + ch, h * siluf_(ldA(z, tok * EV_IN + LRU_W + ch))); }
}
__global__ void __launch_bounds__(256) nv_attn(const AT* z, AT* y) {
    __shared__ float qs[128], ps[132], red[16], og[3][128], lse[3];
    const int tok = blockIdx.x, j = blockIdx.y, t = tok % SEQ, tid = threadIdx.x;
    for (int g = 0; g < 3; ++g) {
        const int d = 1 << (2 * g);
        const float slope = exp2f(-8.0f * (float)(g + 3 * j + 1) / 12.0f);
        const size_t qoff = 3072 + g * 512 + j * 128, koff = 4608 + g * 512 + j * 128, voff = 6144 + g * 512 + j * 128;
        __syncthreads();
        if (tid < 128) qs[tid] = ldA(z, (size_t)tok * EV_IN + qoff + tid);
        __syncthreads();
        float s = -INFINITY;
        if (tid <= 128 && t - tid * d >= 0) {
            const AT* kr = z + (size_t)(tok - tid * d) * EV_IN + koff; float acc = 0.f;
            for (int e = 0; e < 128; ++e) acc += qs[e] * ldA(kr, e);
            s = acc * 0.08838834764831845f - slope * (float)(tid * d);
        }
        const float m = block_max(s, red);
        const float p = (s == -INFINITY) ? 0.f : __expf(s - m);
        if (tid <= 128) ps[tid] = p;
        const float den = block_sum(p, red);
        __syncthreads();
        if (tid < 128) { float o = 0.f;
            for (int i = 0; i <= 128; ++i) { if (t - i * d < 0) break; o += ps[i] * ldA(z, (size_t)(tok - i * d) * EV_IN + voff + tid); }
            og[g][tid] = o / den; }
        if (tid == 0) lse[g] = m + __logf(den);
    }
    __syncthreads();
    if (tid < 128) {
        const float mm = fmaxf(lse[0], fmaxf(lse[1], lse[2]));
        const float w0 = __expf(lse[0] - mm), w1 = __expf(lse[1] - mm), w2 = __expf(lse[2] - mm);
        const float yv = (w0 * og[0][tid] + w1 * og[1][tid] + w2 * og[2][tid]) / (w0 + w1 + w2);
        stA(y, (size_t)tok * DM + LRU_W + j * 128 + tid, yv * siluf_(ldA(z, (size_t)tok * EV_IN + 7680 + j * 128 + tid)));
    }
}

__global__ void __launch_bounds__(256) nv_gla(const AT* z, const float* alr, const float* w_alpha, const float* b_alpha, const float* head_norm, AT* y) {
    __shared__ float qs[128], ks[128], al[128], ar[16], red[16];
    const int b = blockIdx.x >> 2, h = blockIdx.x & 3, v = threadIdx.x;
    float S[128];
#pragma unroll
    for (int e = 0; e < 128; ++e) S[e] = 0.f;
    for (int t = 0; t < SEQ; ++t) {
        const size_t tok = (size_t)b * SEQ + t;
        __syncthreads();
        if (v < 16) ar[v] = alr[tok * 16 + v];
        if (v < 128) { qs[v] = ldA(z, tok * OD_Z + h * 128 + v) * 0.08838834764831845f; ks[v] = ldA(z, tok * OD_Z + 512 + h * 128 + v); }
        __syncthreads();
        if (v < 128) { float s = b_alpha[h * 128 + v];
            for (int r = 0; r < 16; ++r) s += ar[r] * w_alpha[r * 512 + h * 128 + v];
            al[v] = __expf(logsigmoidf_(s) * (1.f / 16.f)); }
        __syncthreads();
        const float vv = ldA(z, tok * OD_Z + 1024 + h * 256 + v);
        float o = 0.f;
#pragma unroll
        for (int e = 0; e < 128; ++e) { S[e] = al[e] * S[e] + ks[e] * vv; o += qs[e] * S[e]; }
        const float ss = block_sum(o * o, red);
        const float r = rsqrtf(ss / 256.f + EPS);
        stA(y, tok * DM + h * 256 + v, o * r * head_norm[h * 256 + v] * siluf_(ldA(z, tok * OD_Z + 2048 + h * 256 + v)));
    }
}
__global__ void __launch_bounds__(256) nv_sgu_ln(const AT* z, const float* v_norm, float* vf) {
    __shared__ float red[16];
    const int tok = blockIdx.x, g = blockIdx.y, e = threadIdx.x;
    const float val = geluf_(ldA(z, (size_t)tok * OD_Z + 4096 + g * 256 + e));
    const float mu = block_sum(val, red) / 256.f;
    const float dv = val - mu;
    const float var = block_sum(dv * dv, red) / 256.f;
    vf[(size_t)tok * 1024 + g * 256 + e] = dv * rsqrtf(var + EPS) * v_norm[g * 256 + e];
}
__global__ void __launch_bounds__(256) nv_sgu_mix(const AT* z, const float* vf, const float* w_s, const float* b_s, AT* y) {
    const int tok = blockIdx.x, g = blockIdx.y, e = threadIdx.x, t = tok % 128, base = tok - t;
    float acc = b_s[g * 128 + t];
    const float* w = w_s + ((size_t)g * 128 + t) * 128;
    for (int s = 0; s <= t; ++s) acc += w[s] * vf[(size_t)(base + s) * 1024 + g * 256 + e];
    const float u = geluf_(ldA(z, (size_t)tok * OD_Z + 3072 + g * 256 + e));
    stA(y, (size_t)tok * DM + 1024 + g * 256 + e, u * acc * siluf_(ldA(z, (size_t)tok * OD_Z + 5120 + g * 256 + e)));
}
namespace pg8 {
#define PG8_LAS __attribute__((address_space(3)))
typedef unsigned short bf16_t;
typedef short bf16x8 __attribute__((ext_vector_type(8)));
typedef float f32x4 __attribute__((ext_vector_type(4)));
typedef unsigned u32x4 __attribute__((ext_vector_type(4)));
constexpr int BM = 256, BK = 64, HALF = 128, HTB = HALF * BK * 2  , STAGE_BYTES = 8 * HTB, NXCD = 8, WGM = 8;

__host__ __device__ __forceinline__ int lds_byte(int r, int c) { const int st = (r >> 4) * 2 + (c >> 5), rr = r & 15, cc = c & 31, ob = rr * 64 + cc * 2; return st * 1024 + (ob ^ (((ob >> 9) & 1) << 5)); }
__host__ __device__ __forceinline__ void stage_rc(int b, int& R, int& C) { const int st = b / 1024, sb = b % 1024, swz = sb ^ (((sb >> 9) & 1) << 5); R = (st >> 1) * 16 + swz / 64; C = (st & 1) * 32 + (swz % 64) / 2; }
__host__ __device__ __forceinline__ int perm32(int rho) { const int n = rho >> 4, i = rho & 15; return 8 * (i >> 2) + 4 * n + (i & 3); }

struct Unit { int pm, pn; };
struct Gemm { const bf16_t* A; const bf16_t* Bt; int M, N, K; };

struct StaticOrder {
    int nM, nN, nwg, G, c;
    __host__ __device__ void init(int M, int N, int G_, int c_) { nM = M / BM; nN = N / BM; nwg = nM * nN; G = G_; c = c_; }
    __host__ __device__ bool next(int i, Unit& u) const {
        const long L = (long)i * G + c; if (L >= nwg) return false;
        int wgid = (int)L; { const int q = nwg / NXCD, r = nwg % NXCD, xcd = wgid % NXCD, off = wgid / NXCD; wgid = (xcd < r ? xcd * (q + 1) : r * (q + 1) + (xcd - r) * q) + off; }
        const int nig = WGM * nN, gid = wgid / nig, fm = gid * WGM, gsz = (nM - fm) < WGM ? (nM - fm) : WGM;
        u.pm = fm + ((wgid % nig) % gsz); u.pn = (wgid % nig) / gsz; return true;
    }
    __device__ __forceinline__ void a_ready(const Unit&) const {}
    __device__ __forceinline__ void done(const Unit&) const {}
};

__device__ __forceinline__ unsigned cvt_pk_bf16(float lo, float hi) { unsigned r; asm volatile("v_cvt_pk_bf16_f32 %0, %1, %2" : "=v"(r) : "v"(lo), "v"(hi)); return r; }
struct EpiIn {
    static constexpr bool PERM = true, AFTER_DRAIN = false;
    bf16_t* O; int ldc; const float* sumsq;
    __device__ __forceinline__ void operator()(const f32x4 (&acc)[2][2][4][2], const Unit& u, int wr, int wc, int fr, int fq) const {
        const int row0 = u.pm * BM + wr * 64 + fr, col0 = u.pn * BM + wc * 32 + 8 * fq;
#pragma unroll
        for (int ai = 0; ai < 2; ++ai)
#pragma unroll
            for (int m = 0; m < 4; ++m) { const int row = row0 + ai * HALF + m * 16;
                const float rs = __builtin_amdgcn_rsqf(sumsq[row] * (1.0f / 2048.0f) + 1e-6f);
                bf16_t* rowp = O + (size_t)row * ldc + col0;
#pragma unroll
                for (int bj = 0; bj < 2; ++bj) { const f32x4 v0 = acc[ai][bj][m][0] * rs, v1 = acc[ai][bj][m][1] * rs;
                    u32x4 w; w.x = cvt_pk_bf16(v0[0], v0[1]); w.y = cvt_pk_bf16(v0[2], v0[3]); w.z = cvt_pk_bf16(v1[0], v1[1]); w.w = cvt_pk_bf16(v1[2], v1[3]);
                    *(u32x4*)(rowp + bj * HALF) = w; } }
    }
};
struct EpiOut {
    static constexpr bool PERM = true, AFTER_DRAIN = false;
    const float* xold; float* xnew; bf16_t* xg; const float* g; float* sumsq_next; int write_xg;
    __device__ __forceinline__ void operator()(const f32x4 (&acc)[2][2][4][2], const Unit& u, int wr, int wc, int fr, int fq) const {
        const int row0 = u.pm * BM + wr * 64 + fr, col0 = u.pn * BM + wc * 32 + 8 * fq;
        f32x4 gv[2][2];
#pragma unroll
        for (int bj = 0; bj < 2; ++bj) { gv[bj][0] = *(const f32x4*)(g + col0 + bj * HALF); gv[bj][1] = *(const f32x4*)(g + col0 + bj * HALF + 4); }
#pragma unroll
        for (int ai = 0; ai < 2; ++ai)
#pragma unroll
            for (int m = 0; m < 4; ++m) { const int row = row0 + ai * HALF + m * 16; const size_t off = (size_t)row * 2048 + col0; float ss = 0.f;
#pragma unroll
                for (int bj = 0; bj < 2; ++bj) {
                    const f32x4 v0 = acc[ai][bj][m][0] + *(const f32x4*)(xold + off + bj * HALF), v1 = acc[ai][bj][m][1] + *(const f32x4*)(xold + off + bj * HALF + 4);
                    *(f32x4*)(xnew + off + bj * HALF) = v0; *(f32x4*)(xnew + off + bj * HALF + 4) = v1;
                    ss += (v0[0] * v0[0] + v0[1] * v0[1]) + (v0[2] * v0[2] + v0[3] * v0[3]) + (v1[0] * v1[0] + v1[1] * v1[1]) + (v1[2] * v1[2] + v1[3] * v1[3]);
                    if (write_xg) { const f32x4 a = v0 * gv[bj][0], b = v1 * gv[bj][1];
                        u32x4 w; w.x = cvt_pk_bf16(a[0], a[1]); w.y = cvt_pk_bf16(a[2], a[3]); w.z = cvt_pk_bf16(b[0], b[1]); w.w = cvt_pk_bf16(b[2], b[3]);
                        *(u32x4*)(xg + off + bj * HALF) = w; } }
                ss += __shfl_xor(ss, 16); ss += __shfl_xor(ss, 32);
                if (fq == 0) atomicAdd(sumsq_next + row, ss); }
    }
};
template <class Epi, class Sched, bool ALIGN_EPI = false, bool SP2 = false>
__device__ __forceinline__ void gemm_phase(PG8_LAS unsigned char* lds, const Gemm g, const Sched& S, const Epi& E) {
    int tid_op = threadIdx.x; asm volatile("" : "+v"(tid_op));
    const int tid = tid_op, wid = __builtin_amdgcn_readfirstlane(tid >> 6), lane = tid & 63, wr = wid >> 2, wc = wid & 3, fr = lane & 15, fq = lane >> 4;
    const int K = g.K, nt = K / BK;
    unsigned voffA[2], voffB[2];
#pragma unroll
    for (int i = 0; i < 2; ++i) { int R, C; stage_rc(tid * 16 + i * 8192, R, C); const int Rb = Epi::PERM ? ((R & ~31) + perm32(R & 31)) : R;
        voffA[i] = (unsigned)(R * K + C) * 2u; voffB[i] = (unsigned)(Rb * K + C) * 2u; }
    const size_t kstep = (size_t)(BK * 2);
    const size_t hstep = (size_t)HALF * K * 2;
    const size_t tstep = 2 * hstep;
    const unsigned ldsw = (unsigned)wid * 1024u;
    const int aoff = lds_byte(wr * 64 + fr, fq * 8), boff = lds_byte(wc * 32 + fr, fq * 8);
#define PG8_SA(b, h) (((b) * 2 + (h)) * HTB)
#define PG8_SB(b, h) ((4 + (b) * 2 + (h)) * HTB)
#define PG8_STAGE(bufoff, gbase, voff) do { _Pragma("unroll") for (int _i = 0; _i < 2; ++_i) \
        __builtin_amdgcn_global_load_lds((const unsigned*)((const char*)(gbase) + (voff)[_i]), (PG8_LAS unsigned*)(lds + (bufoff) + ldsw + _i * 8192), 16, 0, 0); } while (0)
#define PG8_LDA(dst, b, h) do { _Pragma("unroll") for (int m = 0; m < 4; ++m) _Pragma("unroll") for (int k = 0; k < 2; ++k) dst[m][k] = *(const PG8_LAS bf16x8*)(lds + PG8_SA(b, h) + aoff + m * 2048 + k * 1024); } while (0)
#define PG8_LDB(dst, b, h) do { _Pragma("unroll") for (int n = 0; n < 2; ++n) _Pragma("unroll") for (int k = 0; k < 2; ++k) dst[n][k] = *(const PG8_LAS bf16x8*)(lds + PG8_SB(b, h) + boff + n * 2048 + k * 1024); } while (0)
#define PG8_MMA(ai, bj, At, Bt) do { __builtin_amdgcn_s_setprio(1); _Pragma("unroll") for (int m = 0; m < 4; ++m) _Pragma("unroll") for (int n = 0; n < 2; ++n) _Pragma("unroll") for (int k = 0; k < 2; ++k) \
        acc[ai][bj][m][n] = __builtin_amdgcn_mfma_f32_16x16x32_bf16(Bt[n][k], At[m][k], acc[ai][bj][m][n], 0, 0, 0); __builtin_amdgcn_s_setprio(0); } while (0)
#define PG8_WAIT_V(n) asm volatile("s_waitcnt vmcnt(" #n ")" ::: "memory")
#define PG8_WAIT_L(n) asm volatile("s_waitcnt lgkmcnt(" #n ")" ::: "memory")
#define PG8_BAR __builtin_amdgcn_s_barrier()
#define PG8_SCHED __builtin_amdgcn_sched_barrier(0)
    Unit cur, nxt; int ui = 0;
    if (!S.next(0, cur)) return;
    f32x4 acc[2][2][4][2];
#pragma unroll
    for (int a = 0; a < 2; ++a)
#pragma unroll
        for (int b = 0; b < 2; ++b)
#pragma unroll
            for (int m = 0; m < 4; ++m)
#pragma unroll
                for (int n = 0; n < 2; ++n) acc[a][b][m][n] = (f32x4){0.f, 0.f, 0.f, 0.f};
    bf16x8 At[4][2], B0[2][2], B1[2][2];
    const char* cA = (const char*)g.A + (size_t)cur.pm * tstep; const char* cB = (const char*)g.Bt + (size_t)cur.pn * tstep;
    S.a_ready(cur);
    if constexpr (SP2) {
        PG8_STAGE(PG8_SB(0, 0), cB, voffB); PG8_STAGE(PG8_SB(0, 1), cB + hstep, voffB); PG8_STAGE(PG8_SA(0, 0), cA, voffA); PG8_STAGE(PG8_SA(0, 1), cA + hstep, voffA);
        if (wr == 1) PG8_BAR;
        PG8_WAIT_V(2); PG8_BAR;
        PG8_STAGE(PG8_SB(1, 0), cB + kstep, voffB); PG8_STAGE(PG8_SA(1, 0), cA + kstep, voffA); PG8_STAGE(PG8_SB(1, 1), cB + hstep + kstep, voffB);
        PG8_WAIT_V(6); PG8_BAR;
    } else {
        PG8_STAGE(PG8_SB(0, 0), cB, voffB); PG8_STAGE(PG8_SA(0, 0), cA, voffA); PG8_STAGE(PG8_SB(0, 1), cB + hstep, voffB); PG8_STAGE(PG8_SA(0, 1), cA + hstep, voffA);
        if (wr == 1) PG8_BAR;
        PG8_WAIT_V(4); PG8_BAR;
        PG8_STAGE(PG8_SB(1, 0), cB + kstep, voffB); PG8_STAGE(PG8_SA(1, 0), cA + kstep, voffA); PG8_STAGE(PG8_SB(1, 1), cB + hstep + kstep, voffB);
        PG8_WAIT_V(6); PG8_BAR;
    }
    for (;;) {
        const bool has_next = S.next(ui + 1, nxt);
        const char* nA = has_next ? (const char*)g.A + (size_t)nxt.pm * tstep : cA; const char* nB = has_next ? (const char*)g.Bt + (size_t)nxt.pn * tstep : cB;
        for (int t = 0; t < nt; t += 2) {
            const bool last = (t == nt - 2);
            const char* a1 = cA + (size_t)(t + 1) * kstep;
            const char* a2 = last ? nA : cA + (size_t)(t + 2) * kstep; const char* b2 = last ? nB : cB + (size_t)(t + 2) * kstep;
            const char* a3 = a2 + kstep; const char* b3 = b2 + kstep;
            if (last && has_next) S.a_ready(nxt);
            if constexpr (SP2) {
            PG8_LDB(B0, 0, 0); PG8_LDB(B1, 0, 1); PG8_SCHED; PG8_LDA(At, 0, 0); PG8_STAGE(PG8_SA(1, 1), a1 + hstep, voffA);
            PG8_WAIT_V(8); PG8_WAIT_L(0); PG8_BAR; PG8_MMA(0, 0, At, B0); PG8_MMA(0, 1, At, B1); PG8_BAR; PG8_SCHED;
            PG8_LDA(At, 0, 1); PG8_STAGE(PG8_SB(0, 0), b2, voffB); PG8_STAGE(PG8_SB(0, 1), b2 + hstep, voffB); PG8_STAGE(PG8_SA(0, 0), a2, voffA);
            PG8_WAIT_V(8); PG8_WAIT_L(0); PG8_BAR; PG8_MMA(1, 0, At, B0); PG8_MMA(1, 1, At, B1); PG8_BAR; PG8_SCHED;
            PG8_LDB(B0, 1, 0); PG8_LDB(B1, 1, 1); PG8_SCHED; PG8_LDA(At, 1, 0); PG8_STAGE(PG8_SA(0, 1), a2 + hstep, voffA);
            PG8_WAIT_V(8); PG8_WAIT_L(0); PG8_BAR; PG8_MMA(0, 0, At, B0); PG8_MMA(0, 1, At, B1); PG8_BAR; PG8_SCHED;
            PG8_LDA(At, 1, 1); PG8_STAGE(PG8_SB(1, 0), b3, voffB); PG8_STAGE(PG8_SB(1, 1), b3 + hstep, voffB); PG8_STAGE(PG8_SA(1, 0), a3, voffA);
            PG8_WAIT_V(8); PG8_WAIT_L(0); PG8_BAR; PG8_MMA(1, 0, At, B0); PG8_MMA(1, 1, At, B1); PG8_BAR; PG8_SCHED;
            } else {
            PG8_LDB(B0, 0, 0); PG8_SCHED; PG8_LDA(At, 0, 0); PG8_STAGE(PG8_SA(1, 1), a1 + hstep, voffA);
            PG8_WAIT_L(8); PG8_BAR; PG8_WAIT_L(0); PG8_MMA(0, 0, At, B0); PG8_BAR; PG8_SCHED;
            PG8_LDB(B1, 0, 1); PG8_STAGE(PG8_SB(0, 0), b2, voffB);
            PG8_BAR; PG8_WAIT_L(0); PG8_MMA(0, 1, At, B1); PG8_BAR;
            PG8_LDA(At, 0, 1); PG8_STAGE(PG8_SA(0, 0), a2, voffA);
            PG8_BAR; PG8_WAIT_L(0); PG8_MMA(1, 0, At, B0); PG8_BAR; PG8_SCHED;
            PG8_STAGE(PG8_SB(0, 1), b2 + hstep, voffB);
            PG8_WAIT_V(6); PG8_BAR; PG8_MMA(1, 1, At, B1); PG8_BAR;
            PG8_LDB(B0, 1, 0); PG8_SCHED; PG8_LDA(At, 1, 0); PG8_STAGE(PG8_SA(0, 1), a2 + hstep, voffA);
            PG8_WAIT_L(8); PG8_BAR; PG8_WAIT_L(0); PG8_MMA(0, 0, At, B0); PG8_BAR; PG8_SCHED;
            PG8_LDB(B1, 1, 1); PG8_STAGE(PG8_SB(1, 0), b3, voffB);
            PG8_BAR; PG8_WAIT_L(0); PG8_MMA(0, 1, At, B1); PG8_BAR;
            PG8_LDA(At, 1, 1); PG8_STAGE(PG8_SA(1, 0), a3, voffA);
            PG8_BAR; PG8_WAIT_L(0); PG8_MMA(1, 0, At, B0); PG8_BAR; PG8_SCHED;
            PG8_STAGE(PG8_SB(1, 1), b3 + hstep, voffB);
            PG8_WAIT_V(6); PG8_BAR; PG8_MMA(1, 1, At, B1); PG8_BAR;
            }
        }
        if constexpr (ALIGN_EPI) { if (wr == 0) PG8_BAR; }
        if constexpr (!Epi::AFTER_DRAIN) { E(acc, cur, wr, wc, fr, fq); S.done(cur); }
        if (!has_next) break;
#pragma unroll
        for (int a = 0; a < 2; ++a)
#pragma unroll
            for (int b = 0; b < 2; ++b)
#pragma unroll
                for (int m = 0; m < 4; ++m)
#pragma unroll
                    for (int n = 0; n < 2; ++n) acc[a][b][m][n] = (f32x4){0.f, 0.f, 0.f, 0.f};
        cur = nxt; cA = nA; cB = nB; ++ui;
        if constexpr (ALIGN_EPI) { if (wr == 1) PG8_BAR; }
    }
    PG8_WAIT_V(0);
    if constexpr (!ALIGN_EPI) { if (wr == 0) PG8_BAR; }
    PG8_BAR;
    if constexpr (Epi::AFTER_DRAIN) { E.fused(acc, cur, wr, wc, fr, fq, lds, wid, lane); S.done(cur); }
#undef PG8_SA
#undef PG8_SB
#undef PG8_STAGE
#undef PG8_LDA
#undef PG8_LDB
#undef PG8_MMA
#undef PG8_WAIT_V
#undef PG8_WAIT_L
#undef PG8_BAR
#undef PG8_SCHED
}
}
#define GAS __attribute__((address_space(1)))
#define LAS __attribute__((address_space(3)))
typedef unsigned v4u __attribute__((ext_vector_type(4)));
typedef float f32x4 __attribute__((ext_vector_type(4)));
typedef short bf16x8 __attribute__((ext_vector_type(8)));
typedef GAS unsigned gu32;
#define RLX_AGENT __ATOMIC_RELAXED, __HIP_MEMORY_SCOPE_AGENT
#define LDS_WAIT() asm volatile("s_waitcnt lgkmcnt(0)" ::: "memory")
#define VM_WAIT() asm volatile("s_waitcnt vmcnt(0)" ::: "memory")
#define XB_TMO      128
#define XB_XCNT(j)  (256  + 64 * (j))
#define XB_XSUB(j)  (1280 + 64 * (j))
#define XB_XGEN(j)  (2304 + 64 * (j))
#define XB_TOP      3328
#define XB_TOPGEN   3392
#define XCD_BAR_WORDS 3456
#define XB_SPIN_CAP (1u << 18)

__device__ __forceinline__ unsigned xb_ld(unsigned* p)              { return __hip_atomic_load(p, __ATOMIC_RELAXED, __HIP_MEMORY_SCOPE_AGENT); }
__device__ __forceinline__ unsigned xb_add(unsigned* p, unsigned v) { return __hip_atomic_fetch_add(p, v, __ATOMIC_RELAXED, __HIP_MEMORY_SCOPE_AGENT); }
__device__ __forceinline__ unsigned xb_xcc_id() { return (unsigned)__builtin_amdgcn_s_getreg((3 << 11) | 20) & 0xFu; }
#define XB_SPIN(cond, bar) do { unsigned _sp = 0; while (cond) { __builtin_amdgcn_s_sleep(1); \
    if ((++_sp & 255u) == 0u) { if (xb_ld(&(bar)[XB_TMO])) break; if (_sp > XB_SPIN_CAP) { atomicAdd(&(bar)[XB_TMO], 1u); break; } } } } while (0)

struct XcdBarrier {
    unsigned* bar; unsigned x;
    volatile LAS unsigned* st;
};

__device__ __forceinline__ XcdBarrier xcd_barrier_post(unsigned* bar, volatile LAS unsigned* st) {
    XcdBarrier b; b.bar = bar; b.x = xb_xcc_id(); b.st = st;
    if (threadIdx.x == 0) (void)xb_add(&bar[XB_XCNT(b.x)], 1u);
    return b;
}
__device__ __forceinline__ void xcd_barrier_complete(unsigned* bar, unsigned x, unsigned& nloc, unsigned& nx) {
    const unsigned G = gridDim.x * gridDim.y * gridDim.z;
    unsigned sum, cnt, mine, sp = 0u;
    for (;;) {
        sum = 0u; cnt = 0u; mine = 0u;
#pragma unroll
        for (unsigned j = 0; j < 16; ++j) { const unsigned c = xb_ld(&bar[XB_XCNT(j)]); sum += c; cnt += (c > 0u) ? 1u : 0u; mine = (j == x) ? c : mine; }
        if (sum == G) break;
        __builtin_amdgcn_s_sleep(1);
        if ((++sp & 255u) == 0u) { if (xb_ld(&bar[XB_TMO])) break; if (sp > XB_SPIN_CAP) { atomicAdd(&bar[XB_TMO], 1u); break; } }
    }
    nloc = mine > 0u ? mine : 1u; nx = cnt > 0u ? cnt : 1u;
}

__device__ __forceinline__ void xcd_barrier(const XcdBarrier& b) {
    asm volatile("s_waitcnt vmcnt(0)" ::: "memory");
    __syncthreads();
    if (threadIdx.x == 0) {
        unsigned* bar = b.bar;
        __builtin_amdgcn_s_waitcnt(0);
        unsigned nloc = b.st[0], nx = b.st[1];
        if (nloc == 0u) { xcd_barrier_complete(bar, b.x, nloc, nx); b.st[0] = nloc; b.st[1] = nx; }
        const unsigned old = xb_add(&bar[XB_XSUB(b.x)], 1u);
        const unsigned gen = old / nloc;
        if (old + 1u == (gen + 1u) * nloc) {
            __builtin_amdgcn_fence(__ATOMIC_RELEASE, "agent");
            asm volatile("s_waitcnt vmcnt(0)" ::: "memory");
            const unsigned og = xb_add(&bar[XB_TOP], 1u);
            const unsigned tg = og / nx;
            if (og + 1u == (tg + 1u) * nx) xb_add(&bar[XB_TOPGEN], 1u);
            else XB_SPIN(xb_ld(&bar[XB_TOPGEN]) == tg, bar);
            __builtin_amdgcn_fence(__ATOMIC_ACQUIRE, "agent");
            xb_add(&bar[XB_XGEN(b.x)], 1u);
            asm volatile("s_waitcnt vmcnt(0)" ::: "memory");
        } else {
            XB_SPIN(xb_ld(&bar[XB_XGEN(b.x)]) == gen, bar);
            __builtin_amdgcn_fence(__ATOMIC_ACQUIRE, "agent");
            asm volatile("s_waitcnt vmcnt(0)" ::: "memory");
        }
    }
    __syncthreads();
}

constexpr int NWAVES = 8;
constexpr size_t MiB = 1u << 20;
constexpr size_t WS_CTL = 0, CTL_ZERO_BYTES = 1 * MiB;
constexpr size_t WS_WEVIN = 2 * MiB;
constexpr size_t WS_WEVOUT = 66 * MiB;
constexpr size_t WS_WODIN = 82 * MiB;
constexpr size_t WS_WODOUT = 130 * MiB;
constexpr size_t WS_WALR = 146 * MiB;
constexpr size_t WS_WGATE = 147 * MiB;
constexpr size_t WS_X = 150 * MiB;
constexpr size_t WS_XG = 214 * MiB;
constexpr size_t WS_Z = 246 * MiB;
constexpr size_t WS_Y = 374 * MiB;
constexpr size_t WS_ALR = 406 * MiB;
constexpr size_t WS_T0 = 408 * MiB;
constexpr size_t WS_T1 = 456 * MiB;
constexpr size_t WS_END = 504 * MiB;
constexpr int CW_BAR = 4096;
constexpr int MAX_LAUNCH = 8;
constexpr int CW_SUMSQ = 65536;
static_assert((CW_BAR + MAX_LAUNCH * XCD_BAR_WORDS) <= CW_SUMSQ && (CW_SUMSQ + 5 * 8192) * 4 <= (int)CTL_ZERO_BYTES, "ctl map");
constexpr int RING_OFF = 0, RING_BYTES = 131072;
constexpr int LDSCTL_OFF = RING_BYTES, MISC_OFF = LDSCTL_OFF + 320;
constexpr int LDS_BYTES = 147456;

constexpr int PH_PROLOGUE = 0, PH_FINAL = 17, N_PHASES = 18;

struct Args {
    const float* in[21]; float* out; unsigned char* ws;
    const float* gn[4];
    const float* xold[4];
    int ph_lo, ph_hi, li, pad;
};
#define CAS __attribute__((address_space(4)))
template <class T> __device__ __forceinline__ T* karg(const CAS char* ka, int byte_off) { T* p = *(T* const CAS*)(ka + byte_off); return (T*)(__attribute__((address_space(1))) T*)p; }
#define KIN(k) karg<const float>(ka_, 8 * (k))

__device__ __forceinline__ float wave_sum(float v) {
#pragma unroll
    for (int o = 1; o < 64; o <<= 1) v += __shfl_xor(v, o);
    return v;
}
__device__ __forceinline__ void p0_transpose_item(const float* W, int K, int ldw, int nblk, bf16* WT, int skip_at, int skip, LAS float* scr, int item, int lane) {
    const int kb = item / nblk, nb = item % nblk, k0 = 64 * kb, n0 = 32 * nb, s0 = n0 + (n0 >= skip_at ? skip : 0);
#pragma unroll 8
    for (int i = 0; i < 32; ++i) { const int kk = 2 * i + (lane >> 5); scr[kk * 33 + (lane & 31)] = W[(size_t)(k0 + kk) * ldw + s0 + (lane & 31)]; }
    LDS_WAIT(); asm volatile("" ::: "memory");
    const int c = lane & 7;
#pragma unroll
    for (int j = 0; j < 4; ++j) { const int n = (lane >> 3) + 8 * j; const LAS float* s = scr + (8 * c) * 33 + n;
        v4u o; o.x = pk2(s[0 * 33], s[1 * 33]); o.y = pk2(s[2 * 33], s[3 * 33]); o.z = pk2(s[4 * 33], s[5 * 33]); o.w = pk2(s[6 * 33], s[7 * 33]);
        *(GAS v4u*)(WT + (size_t)(n0 + n) * K + k0 + 8 * c) = o; }
    LDS_WAIT(); asm volatile("" ::: "memory");
}

__global__ void __launch_bounds__(NWAVES * 64, 2) mk_fwd(Args args) {
    extern __shared__ __attribute__((aligned(16))) unsigned char lds_raw[];
    LAS unsigned char* lds = (LAS unsigned char*)lds_raw;
    volatile LAS unsigned* MISC = (volatile LAS unsigned*)(lds + MISC_OFF);
    const int G = gridDim.x;
    unsigned char* ws = args.ws;
    unsigned* ctl = (unsigned*)(ws + WS_CTL);
    float* SUMSQ = (float*)(ctl + CW_SUMSQ);
    for (int u = threadIdx.x; u < (LDS_BYTES - LDSCTL_OFF) / 4; u += NWAVES * 64) ((LAS unsigned*)(lds + LDSCTL_OFF))[u] = 0u;
    __syncthreads();
    XcdBarrier bar = xcd_barrier_post(ctl + CW_BAR + args.li * XCD_BAR_WORDS, MISC + 8);

    float* X = (float*)(ws + WS_X); bf16* XG = (bf16*)(ws + WS_XG); bf16* Z = (bf16*)(ws + WS_Z); bf16* Y = (bf16*)(ws + WS_Y);
    float* ALR = (float*)(ws + WS_ALR);

    for (int ph = args.ph_lo; ph < args.ph_hi; ++ph) {
        if (ph > args.ph_lo) xcd_barrier(bar);
        int tid = threadIdx.x; asm volatile("" : "+v"(tid));
        const int lane = tid & 63, wave = __builtin_amdgcn_readfirstlane(tid >> 6);
        const CAS char* ka_ = (const CAS char*)__builtin_amdgcn_kernarg_segment_ptr(); asm volatile("" : "+s"(ka_));
        const float* x_in = KIN(0);
        if (ph == PH_PROLOGUE) {
            LAS float* scr = (LAS float*)(lds + RING_OFF + wave * 16384);
            const int gw = blockIdx.x * NWAVES + wave, NGW = G * NWAVES;
            constexpr int I_EVIN = 32 * 256, I_EVOUT = 32 * 64, I_ODIN = 32 * 192, I_ODOUT = 32 * 64, I_GATE = 2 * 4;
            constexpr int NITEMS = 2 * (I_EVIN + I_EVOUT + I_ODIN + I_ODOUT) + 2 * 12 * 2 * I_GATE;
            for (int it = gw; it < NITEMS; it += NGW) {
                int r = it;
                if (r < 2 * I_EVIN) { const int i = r / I_EVIN; p0_transpose_item(KIN(2) + (size_t)i * DM * EV_IN, DM, EV_IN, 256, (bf16*)(ws + WS_WEVIN) + (size_t)i * EV_IN * DM, 1 << 30, 0, scr, r % I_EVIN, lane); continue; } r -= 2 * I_EVIN;
                if (r < 2 * I_EVOUT) { const int i = r / I_EVOUT; p0_transpose_item(KIN(10) + (size_t)i * DM * DM, DM, DM, 64, (bf16*)(ws + WS_WEVOUT) + (size_t)i * DM * DM, 1 << 30, 0, scr, r % I_EVOUT, lane); continue; } r -= 2 * I_EVOUT;
                if (r < 2 * I_ODIN) { const int i = r / I_ODIN; p0_transpose_item(KIN(12) + (size_t)i * DM * OD_IN, DM, OD_IN, 192, (bf16*)(ws + WS_WODIN) + (size_t)i * OD_Z * DM, 2048, 16, scr, r % I_ODIN, lane); continue; } r -= 2 * I_ODIN;
                if (r < 2 * I_ODOUT) { const int i = r / I_ODOUT; p0_transpose_item(KIN(19) + (size_t)i * DM * DM, DM, DM, 64, (bf16*)(ws + WS_WODOUT) + (size_t)i * DM * DM, 1 << 30, 0, scr, r % I_ODOUT, lane); continue; } r -= 2 * I_ODOUT;
                { const int mat = r / I_GATE, li2 = mat / 24, h = (mat % 24) >> 1, gate = mat & 1;
                  const float* src = KIN(gate ? 7 : 5) + ((size_t)li2 * 12 + h) * 128 * 128;
                  p0_transpose_item(src, 128, 128, 4, (bf16*)(ws + WS_WGATE) + (size_t)mat * 128 * 128, 1 << 30, 0, scr, r % I_GATE, lane); }
            }
            for (int e = blockIdx.x * 512 + tid; e < 2 * 16 * 2048; e += G * 512) { const int i = e >> 15, j = (e >> 11) & 15, k = e & 2047;
                ((bf16*)(ws + WS_WALR))[e] = (bf16)f2bf(KIN(12)[(size_t)i * DM * OD_IN + (size_t)k * OD_IN + 2048 + j]); }
            const float* g0 = KIN(1);
            for (int m = gw; m < MTOK; m += NGW) {
                const f32x4* xr = (const f32x4*)(x_in + (size_t)m * DM) + lane; float s = 0.f;
                unsigned long long* o8 = (unsigned long long*)(XG + (size_t)m * DM) + lane;
#pragma unroll
                for (int j = 0; j < 8; ++j) { const f32x4 v = xr[64 * j]; const f32x4 gg = ((const f32x4*)g0)[lane + 64 * j];
                    s += (v[0] * v[0] + v[1] * v[1]) + (v[2] * v[2] + v[3] * v[3]);
                    o8[64 * j] = (unsigned long long)pk2(v[0] * gg[0], v[1] * gg[1]) | ((unsigned long long)pk2(v[2] * gg[2], v[3] * gg[3]) << 32); }
                s = wave_sum(s);
                if (lane == 0) SUMSQ[m] = s;
            }
        } else if (ph == PH_FINAL) {
            const int gw = blockIdx.x * NWAVES + wave, NGW = G * NWAVES;
            const float* gf = KIN(20);
            for (int m = gw; m < MTOK; m += NGW) {
                const float rs = __builtin_amdgcn_rsqf(SUMSQ[4 * 8192 + m] * (1.0f / 2048.0f) + 1e-6f);
                const f32x4* xr = (const f32x4*)(X + (size_t)m * DM) + lane; f32x4* o = (f32x4*)(args.out + (size_t)m * DM) + lane;
#pragma unroll
                for (int j = 0; j < 8; ++j) { const f32x4 v = xr[64 * j]; const f32x4 gg = ((const f32x4*)gf)[lane + 64 * j]; o[64 * j] = v * gg * rs; }
            }
        } else {
            const int L = (ph - 1) >> 2, sub = (ph - 1) & 3, i = L >> 1, odd = L & 1;
            if (sub == 0) {
                const int N = odd ? OD_Z : EV_IN;
                const bf16* Wt = (const bf16*)(ws + (odd ? WS_WODIN : WS_WEVIN)) + (size_t)i * N * DM;
                pg8::Gemm g{XG, Wt, MTOK, N, DM}; pg8::StaticOrder S; S.init(MTOK, N, G, (int)blockIdx.x);
                pg8::EpiIn E{Z, N, SUMSQ + L * 8192};
                pg8::gemm_phase<pg8::EpiIn, pg8::StaticOrder, true, true>(lds + RING_OFF, g, S, E);
                if (odd) {
                    const bf16* WA = (const bf16*)(ws + WS_WALR) + (size_t)i * 16 * 2048;
                    for (int rb0 = blockIdx.x * 32; rb0 < MTOK; rb0 += G * 32) {
                        const int rb = wave & 1, kq = wave >> 1, fr = lane & 15, fq = lane >> 4;
                        const bf16* ap = XG + (size_t)(rb0 + 16 * rb + fr) * DM + kq * 512 + 8 * fq;
                        const bf16* bp = WA + (size_t)fr * DM + kq * 512 + 8 * fq;
                        f32x4 acc = {0.f, 0.f, 0.f, 0.f};
#pragma unroll 8
                        for (int ks = 0; ks < 16; ++ks) { const bf16x8 a = *(const bf16x8*)(ap + ks * 32), b = *(const bf16x8*)(bp + ks * 32);
                            acc = __builtin_amdgcn_mfma_f32_16x16x32_bf16(a, b, acc, 0, 0, 0); }
                        LAS float* part = (LAS float*)(lds + RING_OFF);
#pragma unroll
                        for (int r = 0; r < 4; ++r) part[(kq * 32 + 16 * rb + 4 * fq + r) * 16 + fr] = acc[r];
                        __syncthreads();
                        { const int row = tid >> 4, j = tid & 15;
                          const float s = (part[(0 * 32 + row) * 16 + j] + part[(1 * 32 + row) * 16 + j]) + (part[(2 * 32 + row) * 16 + j] + part[(3 * 32 + row) * 16 + j]);
                          const float rs = __builtin_amdgcn_rsqf(SUMSQ[L * 8192 + rb0 + row] * (1.0f / 2048.0f) + 1e-6f);
                          ALR[(size_t)(rb0 + row) * 16 + j] = s * rs; }
                        __syncthreads();
                    }
                }
            } else if (sub == 3) {
                const bf16* Wt = (const bf16*)(ws + (odd ? WS_WODOUT : WS_WEVOUT)) + (size_t)i * DM * DM;
                const float* gn = karg<const float>(ka_, (int)offsetof(Args, gn) + 8 * L);
                const float* xo = karg<const float>(ka_, (int)offsetof(Args, xold) + 8 * L);
                pg8::Gemm g{Y, Wt, MTOK, DM, DM}; pg8::StaticOrder S; S.init(MTOK, DM, G, (int)blockIdx.x);
                pg8::EpiOut E{xo, X, XG, gn, SUMSQ + (L + 1) * 8192, L < 3 ? 1 : 0};
                pg8::gemm_phase<pg8::EpiOut, pg8::StaticOrder, true, true>(lds + RING_OFF, g, S, E);
            }
        }
    }
}

static void launch_mk(Args& a, int lo, int hi, int li, int grid, hipStream_t stream) {
    a.ph_lo = lo; a.ph_hi = hi; a.li = li;
    hipLaunchKernelGGL(mk_fwd, dim3(grid), dim3(NWAVES * 64), LDS_BYTES, stream, a);
}
extern "C" void kernel_launch(void* const* d_in, const int* in_sizes, int n_in, void* d_out, int out_size, void* d_ws, size_t ws_size, hipStream_t stream) {
    static int grid = 0;
    if (grid == 0) {
        if (n_in != 21 || ws_size < WS_END) { fprintf(stderr, "kernel_launch: unexpected n_in %d / ws_size %zu\n", n_in, ws_size); grid = -1; return; }
        int dev = 0, cus = 0, per_cu = 0;
        if (hipGetDevice(&dev) != hipSuccess || hipDeviceGetAttribute(&cus, hipDeviceAttributeMultiprocessorCount, dev) != hipSuccess) { grid = -1; return; }
        if (hipFuncSetAttribute((const void*)mk_fwd, hipFuncAttributeMaxDynamicSharedMemorySize, LDS_BYTES) != hipSuccess) { fprintf(stderr, "kernel_launch: hipFuncSetAttribute failed\n"); grid = -1; return; }
        if (hipOccupancyMaxActiveBlocksPerMultiprocessor(&per_cu, (const void*)mk_fwd, NWAVES * 64, LDS_BYTES) != hipSuccess || per_cu < 1) { fprintf(stderr, "kernel_launch: occupancy query says %d\n", per_cu); }
        (void)hipGetLastError();
        grid = cus;
    }
    if (grid < 0) return;
    hipMemsetAsync((char*)d_ws + WS_CTL, 0, CTL_ZERO_BYTES, stream);
    Args a{};
    for (int i = 0; i < 21; ++i) a.in[i] = (const float*)d_in[i];
    a.out = (float*)d_out; a.ws = (unsigned char*)d_ws;
    a.gn[0] = a.in[11]; a.gn[1] = a.in[1] + DM; a.gn[2] = a.in[11] + DM; a.gn[3] = a.in[20];
    a.xold[0] = a.in[0]; a.xold[1] = a.xold[2] = a.xold[3] = (const float*)((char*)d_ws + WS_X);
    const float *ev_conv_w = a.in[3], *ev_conv_b = a.in[4], *ev_w_a = a.in[5], *ev_b_a = a.in[6], *ev_w_i = a.in[7], *ev_b_i = a.in[8], *ev_lam = a.in[9];
    const float *od_w_alpha = a.in[13], *od_b_alpha = a.in[14], *od_head_norm = a.in[15], *od_v_norm = a.in[16], *od_w_s = a.in[17], *od_b_s = a.in[18];
    char* ws = (char*)d_ws;
    bf16* Z = (bf16*)(ws + WS_Z); bf16* Y = (bf16*)(ws + WS_Y); float* ALR = (float*)(ws + WS_ALR); float* T0 = (float*)(ws + WS_T0); float* T1 = (float*)(ws + WS_T1);
    int li = 0;
#ifdef BISECT_PROLOGUE_ONLY
    launch_mk(a, 0, 1, li++, grid, stream); return;
#endif
    launch_mk(a, 0, 2, li++, grid, stream);
#ifdef BISECT_P01
    return;
#endif
    for (int L = 0; L < 4; ++L) {
        const int i = L >> 1;
        if ((L & 1) == 0) {
            nv_lru_gates<<<dim3(MTOK, 12), 128, 0, stream>>>(Z, ev_conv_w + (size_t)i * 4 * LRU_W, ev_conv_b + (size_t)i * LRU_W, ev_w_a + (size_t)i * 12 * 128 * 128, ev_b_a + (size_t)i * LRU_W,
                                                             ev_w_i + (size_t)i * 12 * 128 * 128, ev_b_i + (size_t)i * LRU_W, ev_lam + (size_t)i * LRU_W, T0, T1);
            nv_lru_scan<<<(NB * LRU_W + 255) / 256, 256, 0, stream>>>(T0, T1, Z, Y);
            nv_attn<<<dim3(MTOK, 4), 256, 0, stream>>>(Z, Y);
        } else {
            nv_gla<<<16, 256, 0, stream>>>(Z, ALR, od_w_alpha + (size_t)i * 16 * 512, od_b_alpha + (size_t)i * 512, od_head_norm + (size_t)i * 1024, Y);
            nv_sgu_ln<<<dim3(MTOK, 4), 256, 0, stream>>>(Z, od_v_norm + (size_t)i * 1024, T0);
            nv_sgu_mix<<<dim3(MTOK, 4), 256, 0, stream>>>(Z, T0, od_w_s + (size_t)i * 4 * 128 * 128, od_b_s + (size_t)i * 4 * 128, Y);
        }
#ifdef BISECT_STOP_MIX
        if (L == BISECT_STOP_MIX) return;
#endif
        launch_mk(a, 4 + 4 * L, (L < 3) ? 6 + 4 * L : 18, li++, grid, stream);
#ifdef BISECT_STOP_MK
        if (L == BISECT_STOP_MK) return;
#endif
    }
}
```

```cpp
#include <hip/hip_runtime.h>
#include <cstdio>
#include <cstdint>

constexpr int DM = 2048, NB = 4, SEQ = 2048, MTOK = NB * SEQ;
constexpr int LRU_W = 1536, EV_IN = 8192;
constexpr int OD_IN = 6160, OD_Z = 6144;
constexpr float EPS = 1e-6f;

typedef unsigned short bf16;
typedef bf16 AT;

__device__ __forceinline__ float bf2f(bf16 v) { return __uint_as_float((unsigned)v << 16); }
__device__ __forceinline__ unsigned f2bf(float f) { unsigned u = __builtin_bit_cast(unsigned, f); return (u + 0x7fffu + ((u >> 16) & 1u)) >> 16; }
__device__ __forceinline__ unsigned pk2(float lo, float hi) { return f2bf(lo) | (f2bf(hi) << 16); }
__device__ __forceinline__ float ldA(const bf16* p, size_t i) { return bf2f(p[i]); }
__device__ __forceinline__ void stA(bf16* p, size_t i, float v) { p[i] = (bf16)f2bf(v); }

__device__ __forceinline__ float sigmoidf_(float x) { return 1.f / (1.f + __expf(-x)); }
__device__ __forceinline__ float siluf_(float x) { return x * sigmoidf_(x); }
__device__ __forceinline__ float geluf_(float x) { return 0.5f * x * (1.f + tanhf(0.7978845608028654f * (x + 0.044715f * x * x * x))); }
__device__ __forceinline__ float softplusf_(float x) { return x > 20.f ? x : log1pf(__expf(x)); }
__device__ __forceinline__ float logsigmoidf_(float x) { return -softplusf_(-x); }

__device__ __forceinline__ float block_sum(float v, float* red) {
#pragma unroll
    for (int o = 32; o > 0; o >>= 1) v += __shfl_xor(v, o);
    const int w = threadIdx.x >> 6, nw = blockDim.x >> 6;
    __syncthreads();
    if ((threadIdx.x & 63) == 0) red[w] = v;
    __syncthreads();
    float s = 0.f;
    for (int i = 0; i < nw; ++i) s += red[i];
    return s;
}
__device__ __forceinline__ float block_max(float v, float* red) {
#pragma unroll
    for (int o = 32; o > 0; o >>= 1) v = fmaxf(v, __shfl_xor(v, o));
    const int w = threadIdx.x >> 6, nw = blockDim.x >> 6;
    __syncthreads();
    if ((threadIdx.x & 63) == 0) red[w] = v;
    __syncthreads();
    float s = -INFINITY;
    for (int i = 0; i < nw; ++i) s = fmaxf(s, red[i]);
    return s;
}

__global__ void __launch_bounds__(128) nv_lru_gates(const AT* z, const float* conv_w, const float* conv_b, const float* w_a, const float* b_a, const float* w_i, const float* b_i,
                                                    const float* lam, float* a_out, float* u_out) {
    __shared__ float xc[128];
    const int tok = blockIdx.x, h = blockIdx.y, j = threadIdx.x, t = tok % SEQ, ch = h * 128 + j;
    float v = conv_b[ch];
    for (int q = 0; q < 4; ++q) { const int tt = t + q - 3; if (tt >= 0) v += ldA(z, (size_t)(tok + q - 3) * EV_IN + ch) * conv_w[q * LRU_W + ch]; }
    xc[j] = v; __syncthreads();
    float ra = b_a[ch], ri = b_i[ch];
    const float* wa = w_a + (size_t)h * 128 * 128; const float* wi = w_i + (size_t)h * 128 * 128;
    for (int i = 0; i < 128; ++i) { ra += xc[i] * wa[i * 128 + j]; ri += xc[i] * wi[i * 128 + j]; }
    const float r = sigmoidf_(ra), ig = sigmoidf_(ri);
    const float log_a = -8.0f * r * softplusf_(-lam[ch]);
    const float a = __expf(log_a);
    const float u = sqrtf(-expm1f(2.f * log_a)) * (ig * v);
    a_out[(size_t)tok * LRU_W + ch] = a; u_out[(size_t)tok * LRU_W + ch] = u;
}
__global__ void __launch_bounds__(256) nv_lru_scan(const float* a, const float* u, const AT* z, AT* y) {
    const int idx = blockIdx.x * 256 + threadIdx.x; if (idx >= NB * LRU_W) return;
    const int b = idx / LRU_W, ch = idx % LRU_W; float h = 0.f;
    for (int t = 0; t < SEQ; ++t) { const size_t tok = (size_t)b * SEQ + t; h = a[tok * LRU_W + ch] * h + u[tok * LRU_W + ch];
        stA(y, tok * DM + ch, h * siluf_(ldA(z, tok * EV_IN + LRU_W + ch))); }
}
__global__ void __launch_bounds__(256) nv_attn(const AT* z, AT* y) {
    __shared__ float qs[128], ps[132], red[16], og[3][128], lse[3];
    const int tok = blockIdx.x, j = blockIdx.y, t = tok % SEQ, tid = threadIdx.x;
    for (int g = 0; g < 3; ++g) {
        const int d = 1 << (2 * g);
        const float slope = exp2f(-8.0f * (float)(g + 3 * j + 1) / 12.0f);
        const size_t qoff = 3072 + g * 512 + j * 128, koff = 4608 + g * 512 + j * 128, voff = 6144 + g * 512 + j * 128;
        __syncthreads();
        if (tid < 128) qs[tid] = ldA(z, (size_t)tok * EV_IN + qoff + tid);
        __syncthreads();
        float s = -INFINITY;
        if (tid <= 128 && t - tid * d >= 0) {
            const AT* kr = z + (size_t)(tok - tid * d) * EV_IN + koff; float acc = 0.f;
            for (int e = 0; e < 128; ++e) acc += qs[e] * ldA(kr, e);
            s = acc * 0.08838834764831845f - slope * (float)(tid * d);
        }
        const float m = block_max(s, red);
        const float p = (s == -INFINITY) ? 0.f : __expf(s - m);
        if (tid <= 128) ps[tid] = p;
        const float den = block_sum(p, red);
        __syncthreads();
        if (tid < 128) { float o = 0.f;
            for (int i = 0; i <= 128; ++i) { if (t - i * d < 0) break; o += ps[i] * ldA(z, (size_t)(tok - i * d) * EV_IN + voff + tid); }
            og[g][tid] = o / den; }
        if (tid == 0) lse[g] = m + __logf(den);
    }
    __syncthreads();
    if (tid < 128) {
        const float mm = fmaxf(lse[0], fmaxf(lse[1], lse[2]));
        const float w0 = __expf(lse[0] - mm), w1 = __expf(lse[1] - mm), w2 = __expf(lse[2] - mm);
        const float yv = (w0 * og[0][tid] + w1 * og[1][tid] + w2 * og[2][tid]) / (w0 + w1 + w2);
        stA(y, (size_t)tok * DM + LRU_W + j * 128 + tid, yv * siluf_(ldA(z, (size_t)tok * EV_IN + 7680 + j * 128 + tid)));
    }
}

__global__ void __launch_bounds__(256) nv_gla(const AT* z, const float* alr, const float* w_alpha, const float* b_alpha, const float* head_norm, AT* y) {
    __shared__ float qs[128], ks[128], al[128], ar[16], red[16];
    const int b = blockIdx.x >> 2, h = blockIdx.x & 3, v = threadIdx.x;
    float S[128];
#pragma unroll
    for (int e = 0; e < 128; ++e) S[e] = 0.f;
    for (int t = 0; t < SEQ; ++t) {
        const size_t tok = (size_t)b * SEQ + t;
        __syncthreads();
        if (v < 16) ar[v] = alr[tok * 16 + v];
        if (v < 128) { qs[v] = ldA(z, tok * OD_Z + h * 128 + v) * 0.08838834764831845f; ks[v] = ldA(z, tok * OD_Z + 512 + h * 128 + v); }
        __syncthreads();
        if (v < 128) { float s = b_alpha[h * 128 + v];
            for (int r = 0; r < 16; ++r) s += ar[r] * w_alpha[r * 512 + h * 128 + v];
            al[v] = __expf(logsigmoidf_(s) * (1.f / 16.f)); }
        __syncthreads();
        const float vv = ldA(z, tok * OD_Z + 1024 + h * 256 + v);
        float o = 0.f;
#pragma unroll
        for (int e = 0; e < 128; ++e) { S[e] = al[e] * S[e] + ks[e] * vv; o += qs[e] * S[e]; }
        const float ss = block_sum(o * o, red);
        const float r = rsqrtf(ss / 256.f + EPS);
        stA(y, tok * DM + h * 256 + v, o * r * head_norm[h * 256 + v] * siluf_(ldA(z, tok * OD_Z + 2048 + h * 256 + v)));
    }
}
__global__ void __launch_bounds__(256) nv_sgu_ln(const AT* z, const float* v_norm, float* vf) {
    __shared__ float red[16];
    const int tok = blockIdx.x, g = blockIdx.y, e = threadIdx.x;
    const float val = geluf_(ldA(z, (size_t)tok * OD_Z + 4096 + g * 256 + e));
    const float mu = block_sum(val, red) / 256.f;
    const float dv = val - mu;
    const float var = block_sum(dv * dv, red) / 256.f;
    vf[(size_t)tok * 1024 + g * 256 + e] = dv * rsqrtf(var + EPS) * v_norm[g * 256 + e];
}
__global__ void __launch_bounds__(256) nv_sgu_mix(const AT* z, const float* vf, const float* w_s, const float* b_s, AT* y) {
    const int tok = blockIdx.x, g = blockIdx.y, e = threadIdx.x, t = tok % 128, base = tok - t;
    float acc = b_s[g * 128 + t];
    const float* w = w_s + ((size_t)g * 128 + t) * 128;
    for (int s = 0; s <= t; ++s) acc += w[s] * vf[(size_t)(base + s) * 1024 + g * 256 + e];
    const float u = geluf_(ldA(z, (size_t)tok * OD_Z + 3072 + g * 256 + e));
    stA(y, (size_t)tok * DM + 1024 + g * 256 + e, u * acc * siluf_(ldA(z, (size_t)tok * OD_Z + 5120 + g * 256 + e)));
}
namespace pg8 {
#define PG8_LAS __attribute__((address_space(3)))
typedef unsigned short bf16_t;
typedef short bf16x8 __attribute__((ext_vector_type(8)));
typedef float f32x4 __attribute__((ext_vector_type(4)));
typedef unsigned u32x4 __attribute__((ext_vector_type(4)));
constexpr int BM = 256, BK = 64, HALF = 128, HTB = HALF * BK * 2  , STAGE_BYTES = 8 * HTB, NXCD = 8, WGM = 8;

__host__ __device__ __forceinline__ int lds_byte(int r, int c) { const int st = (r >> 4) * 2 + (c >> 5), rr = r & 15, cc = c & 31, ob = rr * 64 + cc * 2; return st * 1024 + (ob ^ (((ob >> 9) & 1) << 5)); }
__host__ __device__ __forceinline__ void stage_rc(int b, int& R, int& C) { const int st = b / 1024, sb = b % 1024, swz = sb ^ (((sb >> 9) & 1) << 5); R = (st >> 1) * 16 + swz / 64; C = (st & 1) * 32 + (swz % 64) / 2; }
__host__ __device__ __forceinline__ int perm32(int rho) { const int n = rho >> 4, i = rho & 15; return 8 * (i >> 2) + 4 * n + (i & 3); }

struct Unit { int pm, pn; };
struct Gemm { const bf16_t* A; const bf16_t* Bt; int M, N, K; };

struct StaticOrder {
    int nM, nN, nwg, G, c;
    __host__ __device__ void init(int M, int N, int G_, int c_) { nM = M / BM; nN = N / BM; nwg = nM * nN; G = G_; c = c_; }
    __host__ __device__ bool next(int i, Unit& u) const {
        const long L = (long)i * G + c; if (L >= nwg) return false;
        int wgid = (int)L; { const int q = nwg / NXCD, r = nwg % NXCD, xcd = wgid % NXCD, off = wgid / NXCD; wgid = (xcd < r ? xcd * (q + 1) : r * (q + 1) + (xcd - r) * q) + off; }
        const int nig = WGM * nN, gid = wgid / nig, fm = gid * WGM, gsz = (nM - fm) < WGM ? (nM - fm) : WGM;
        u.pm = fm + ((wgid % nig) % gsz); u.pn = (wgid % nig) / gsz; return true;
    }
    __device__ __forceinline__ void a_ready(const Unit&) const {}
    __device__ __forceinline__ void done(const Unit&) const {}
};

__device__ __forceinline__ unsigned cvt_pk_bf16(float lo, float hi) { unsigned r; asm volatile("v_cvt_pk_bf16_f32 %0, %1, %2" : "=v"(r) : "v"(lo), "v"(hi)); return r; }
struct EpiIn {
    static constexpr bool PERM = true, AFTER_DRAIN = false;
    bf16_t* O; int ldc; const float* sump;
    __device__ __forceinline__ void operator()(const f32x4 (&acc)[2][2][4][2], const Unit& u, int wr, int wc, int fr, int fq) const {
        const int row0 = u.pm * BM + wr * 64 + fr, col0 = u.pn * BM + wc * 32 + 8 * fq;
#pragma unroll
        for (int ai = 0; ai < 2; ++ai)
#pragma unroll
            for (int m = 0; m < 4; ++m) { const int row = row0 + ai * HALF + m * 16;
                const f32x4 p0 = *(const f32x4*)(sump + (size_t)row * 8), p1 = *(const f32x4*)(sump + (size_t)row * 8 + 4);
                const float rs = __builtin_amdgcn_rsqf((((p0[0] + p0[1]) + (p0[2] + p0[3])) + ((p1[0] + p1[1]) + (p1[2] + p1[3]))) * (1.0f / 2048.0f) + 1e-6f);
                bf16_t* rowp = O + (size_t)row * ldc + col0;
#pragma unroll
                for (int bj = 0; bj < 2; ++bj) { const f32x4 v0 = acc[ai][bj][m][0] * rs, v1 = acc[ai][bj][m][1] * rs;
                    u32x4 w; w.x = cvt_pk_bf16(v0[0], v0[1]); w.y = cvt_pk_bf16(v0[2], v0[3]); w.z = cvt_pk_bf16(v1[0], v1[1]); w.w = cvt_pk_bf16(v1[2], v1[3]);
                    *(u32x4*)(rowp + bj * HALF) = w; } }
    }
};
struct EpiOut {
    static constexpr bool PERM = true, AFTER_DRAIN = false;
    const float* xold; float* xnew; bf16_t* xg; const float* g; float* sump_next; int write_xg; PG8_LAS float* xs;
    __device__ __forceinline__ void operator()(const f32x4 (&acc)[2][2][4][2], const Unit& u, int wr, int wc, int fr, int fq) const {
        const int row0 = u.pm * BM + wr * 64 + fr, col0 = u.pn * BM + wc * 32 + 8 * fq;
        f32x4 gv[2][2];
#pragma unroll
        for (int bj = 0; bj < 2; ++bj) { gv[bj][0] = *(const f32x4*)(g + col0 + bj * HALF); gv[bj][1] = *(const f32x4*)(g + col0 + bj * HALF + 4); }
#pragma unroll
        for (int ai = 0; ai < 2; ++ai)
#pragma unroll
            for (int m = 0; m < 4; ++m) { const int row = row0 + ai * HALF + m * 16; const size_t off = (size_t)row * 2048 + col0; float ss = 0.f;
#pragma unroll
                for (int bj = 0; bj < 2; ++bj) {
                    const f32x4 v0 = acc[ai][bj][m][0] + *(const f32x4*)(xold + off + bj * HALF), v1 = acc[ai][bj][m][1] + *(const f32x4*)(xold + off + bj * HALF + 4);
                    *(f32x4*)(xnew + off + bj * HALF) = v0; *(f32x4*)(xnew + off + bj * HALF + 4) = v1;
                    ss += (v0[0] * v0[0] + v0[1] * v0[1]) + (v0[2] * v0[2] + v0[3] * v0[3]) + (v1[0] * v1[0] + v1[1] * v1[1]) + (v1[2] * v1[2] + v1[3] * v1[3]);
                    if (write_xg) { const f32x4 a = v0 * gv[bj][0], b = v1 * gv[bj][1];
                        u32x4 w; w.x = cvt_pk_bf16(a[0], a[1]); w.y = cvt_pk_bf16(a[2], a[3]); w.z = cvt_pk_bf16(b[0], b[1]); w.w = cvt_pk_bf16(b[2], b[3]);
                        *(u32x4*)(xg + off + bj * HALF) = w; } }
                ss += __shfl_xor(ss, 16); ss += __shfl_xor(ss, 32);
                if (fq == 0) xs[(ai * HALF + wr * 64 + m * 16 + fr) * 4 + wc] = ss; }
        asm volatile("s_waitcnt lgkmcnt(0)" ::: "memory"); __builtin_amdgcn_s_barrier(); asm volatile("" ::: "memory");
        { const int t = threadIdx.x; if (t < 256) { const f32x4 p = *(const PG8_LAS f32x4*)(xs + 4 * t); sump_next[(size_t)(u.pm * BM + t) * 8 + u.pn] = (p[0] + p[1]) + (p[2] + p[3]); } }
    }
};
template <class Epi, class Sched, bool ALIGN_EPI = false, bool SP2 = false>
__device__ __forceinline__ void gemm_phase(PG8_LAS unsigned char* lds, const Gemm g, const Sched& S, const Epi& E) {
    int tid_op = threadIdx.x; asm volatile("" : "+v"(tid_op));
    const int tid = tid_op, wid = __builtin_amdgcn_readfirstlane(tid >> 6), lane = tid & 63, wr = wid >> 2, wc = wid & 3, fr = lane & 15, fq = lane >> 4;
    const int K = g.K, nt = K / BK;
    unsigned voffA[2], voffB[2];
#pragma unroll
    for (int i = 0; i < 2; ++i) { int R, C; stage_rc(tid * 16 + i * 8192, R, C); const int Rb = Epi::PERM ? ((R & ~31) + perm32(R & 31)) : R;
        voffA[i] = (unsigned)(R * K + C) * 2u; voffB[i] = (unsigned)(Rb * K + C) * 2u; }
    const size_t kstep = (size_t)(BK * 2);
    const size_t hstep = (size_t)HALF * K * 2;
    const size_t tstep = 2 * hstep;
    const unsigned ldsw = (unsigned)wid * 1024u;
    const int aoff = lds_byte(wr * 64 + fr, fq * 8), boff = lds_byte(wc * 32 + fr, fq * 8);
#define PG8_SA(b, h) (((b) * 2 + (h)) * HTB)
#define PG8_SB(b, h) ((4 + (b) * 2 + (h)) * HTB)
#define PG8_STAGE(bufoff, gbase, voff) do { _Pragma("unroll") for (int _i = 0; _i < 2; ++_i) \
        __builtin_amdgcn_global_load_lds((const unsigned*)((const char*)(gbase) + (voff)[_i]), (PG8_LAS unsigned*)(lds + (bufoff) + ldsw + _i * 8192), 16, 0, 0); } while (0)
#define PG8_LDA(dst, b, h) do { _Pragma("unroll") for (int m = 0; m < 4; ++m) _Pragma("unroll") for (int k = 0; k < 2; ++k) dst[m][k] = *(const PG8_LAS bf16x8*)(lds + PG8_SA(b, h) + aoff + m * 2048 + k * 1024); } while (0)
#define PG8_LDB(dst, b, h) do { _Pragma("unroll") for (int n = 0; n < 2; ++n) _Pragma("unroll") for (int k = 0; k < 2; ++k) dst[n][k] = *(const PG8_LAS bf16x8*)(lds + PG8_SB(b, h) + boff + n * 2048 + k * 1024); } while (0)
#define PG8_MMA(ai, bj, At, Bt) do { __builtin_amdgcn_s_setprio(1); _Pragma("unroll") for (int m = 0; m < 4; ++m) _Pragma("unroll") for (int n = 0; n < 2; ++n) _Pragma("unroll") for (int k = 0; k < 2; ++k) \
        acc[ai][bj][m][n] = __builtin_amdgcn_mfma_f32_16x16x32_bf16(Bt[n][k], At[m][k], acc[ai][bj][m][n], 0, 0, 0); __builtin_amdgcn_s_setprio(0); } while (0)
#define PG8_WAIT_V(n) asm volatile("s_waitcnt vmcnt(" #n ")" ::: "memory")
#define PG8_WAIT_L(n) asm volatile("s_waitcnt lgkmcnt(" #n ")" ::: "memory")
#define PG8_BAR __builtin_amdgcn_s_barrier()
#define PG8_SCHED __builtin_amdgcn_sched_barrier(0)
    Unit cur, nxt; int ui = 0;
    if (!S.next(0, cur)) return;
    f32x4 acc[2][2][4][2];
#pragma unroll
    for (int a = 0; a < 2; ++a)
#pragma unroll
        for (int b = 0; b < 2; ++b)
#pragma unroll
            for (int m = 0; m < 4; ++m)
#pragma unroll
                for (int n = 0; n < 2; ++n) acc[a][b][m][n] = (f32x4){0.f, 0.f, 0.f, 0.f};
    bf16x8 At[4][2], B0[2][2], B1[2][2];
    const char* cA = (const char*)g.A + (size_t)cur.pm * tstep; const char* cB = (const char*)g.Bt + (size_t)cur.pn * tstep;
    S.a_ready(cur);
    if constexpr (SP2) {
        PG8_STAGE(PG8_SB(0, 0), cB, voffB); PG8_STAGE(PG8_SB(0, 1), cB + hstep, voffB); PG8_STAGE(PG8_SA(0, 0), cA, voffA); PG8_STAGE(PG8_SA(0, 1), cA + hstep, voffA);
        if (wr == 1) PG8_BAR;
        PG8_WAIT_V(2); PG8_BAR;
        PG8_STAGE(PG8_SB(1, 0), cB + kstep, voffB); PG8_STAGE(PG8_SA(1, 0), cA + kstep, voffA); PG8_STAGE(PG8_SB(1, 1), cB + hstep + kstep, voffB);
        PG8_WAIT_V(6); PG8_BAR;
    } else {
        PG8_STAGE(PG8_SB(0, 0), cB, voffB); PG8_STAGE(PG8_SA(0, 0), cA, voffA); PG8_STAGE(PG8_SB(0, 1), cB + hstep, voffB); PG8_STAGE(PG8_SA(0, 1), cA + hstep, voffA);
        if (wr == 1) PG8_BAR;
        PG8_WAIT_V(4); PG8_BAR;
        PG8_STAGE(PG8_SB(1, 0), cB + kstep, voffB); PG8_STAGE(PG8_SA(1, 0), cA + kstep, voffA); PG8_STAGE(PG8_SB(1, 1), cB + hstep + kstep, voffB);
        PG8_WAIT_V(6); PG8_BAR;
    }
    for (;;) {
        const bool has_next = S.next(ui + 1, nxt);
        const char* nA = has_next ? (const char*)g.A + (size_t)nxt.pm * tstep : cA; const char* nB = has_next ? (const char*)g.Bt + (size_t)nxt.pn * tstep : cB;
        for (int t = 0; t < nt; t += 2) {
            const bool last = (t == nt - 2);
            const char* a1 = cA + (size_t)(t + 1) * kstep;
            const char* a2 = last ? nA : cA + (size_t)(t + 2) * kstep; const char* b2 = last ? nB : cB + (size_t)(t + 2) * kstep;
            const char* a3 = a2 + kstep; const char* b3 = b2 + kstep;
            if (last && has_next) S.a_ready(nxt);
            if constexpr (SP2) {
            PG8_LDB(B0, 0, 0); PG8_LDB(B1, 0, 1); PG8_SCHED; PG8_LDA(At, 0, 0); PG8_STAGE(PG8_SA(1, 1), a1 + hstep, voffA);
            PG8_WAIT_V(8); PG8_WAIT_L(0); PG8_BAR; PG8_MMA(0, 0, At, B0); PG8_MMA(0, 1, At, B1); PG8_BAR; PG8_SCHED;
            PG8_LDA(At, 0, 1); PG8_STAGE(PG8_SB(0, 0), b2, voffB); PG8_STAGE(PG8_SB(0, 1), b2 + hstep, voffB); PG8_STAGE(PG8_SA(0, 0), a2, voffA);
            PG8_WAIT_V(8); PG8_WAIT_L(0); PG8_BAR; PG8_MMA(1, 0, At, B0); PG8_MMA(1, 1, At, B1); PG8_BAR; PG8_SCHED;
            PG8_LDB(B0, 1, 0); PG8_LDB(B1, 1, 1); PG8_SCHED; PG8_LDA(At, 1, 0); PG8_STAGE(PG8_SA(0, 1), a2 + hstep, voffA);
            PG8_WAIT_V(8); PG8_WAIT_L(0); PG8_BAR; PG8_MMA(0, 0, At, B0); PG8_MMA(0, 1, At, B1); PG8_BAR; PG8_SCHED;
            PG8_LDA(At, 1, 1); PG8_STAGE(PG8_SB(1, 0), b3, voffB); PG8_STAGE(PG8_SB(1, 1), b3 + hstep, voffB); PG8_STAGE(PG8_SA(1, 0), a3, voffA);
            PG8_WAIT_V(8); PG8_WAIT_L(0); PG8_BAR; PG8_MMA(1, 0, At, B0); PG8_MMA(1, 1, At, B1); PG8_BAR; PG8_SCHED;
            } else {
            PG8_LDB(B0, 0, 0); PG8_SCHED; PG8_LDA(At, 0, 0); PG8_STAGE(PG8_SA(1, 1), a1 + hstep, voffA);
            PG8_WAIT_L(8); PG8_BAR; PG8_WAIT_L(0); PG8_MMA(0, 0, At, B0); PG8_BAR; PG8_SCHED;
            PG8_LDB(B1, 0, 1); PG8_STAGE(PG8_SB(0, 0), b2, voffB);
            PG8_BAR; PG8_WAIT_L(0); PG8_MMA(0, 1, At, B1); PG8_BAR;
            PG8_LDA(At, 0, 1); PG8_STAGE(PG8_SA(0, 0), a2, voffA);
            PG8_BAR; PG8_WAIT_L(0); PG8_MMA(1, 0, At, B0); PG8_BAR; PG8_SCHED;
            PG8_STAGE(PG8_SB(0, 1), b2 + hstep, voffB);
            PG8_WAIT_V(6); PG8_BAR; PG8_MMA(1, 1, At, B1); PG8_BAR;
            PG8_LDB(B0, 1, 0); PG8_SCHED; PG8_LDA(At, 1, 0); PG8_STAGE(PG8_SA(0, 1), a2 + hstep, voffA);
            PG8_WAIT_L(8); PG8_BAR; PG8_WAIT_L(0); PG8_MMA(0, 0, At, B0); PG8_BAR; PG8_SCHED;
            PG8_LDB(B1, 1, 1); PG8_STAGE(PG8_SB(1, 0), b3, voffB);
            PG8_BAR; PG8_WAIT_L(0); PG8_MMA(0, 1, At, B1); PG8_BAR;
            PG8_LDA(At, 1, 1); PG8_STAGE(PG8_SA(1, 0), a3, voffA);
            PG8_BAR; PG8_WAIT_L(0); PG8_MMA(1, 0, At, B0); PG8_BAR; PG8_SCHED;
            PG8_STAGE(PG8_SB(1, 1), b3 + hstep, voffB);
            PG8_WAIT_V(6); PG8_BAR; PG8_MMA(1, 1, At, B1); PG8_BAR;
            }
        }
        if constexpr (ALIGN_EPI) { if (wr == 0) PG8_BAR; }
        if constexpr (!Epi::AFTER_DRAIN) { E(acc, cur, wr, wc, fr, fq); S.done(cur); }
        if (!has_next) break;
#pragma unroll
        for (int a = 0; a < 2; ++a)
#pragma unroll
            for (int b = 0; b < 2; ++b)
#pragma unroll
                for (int m = 0; m < 4; ++m)
#pragma unroll
                    for (int n = 0; n < 2; ++n) acc[a][b][m][n] = (f32x4){0.f, 0.f, 0.f, 0.f};
        cur = nxt; cA = nA; cB = nB; ++ui;
        if constexpr (ALIGN_EPI) { if (wr == 1) PG8_BAR; }
    }
    PG8_WAIT_V(0);
    if constexpr (!ALIGN_EPI) { if (wr == 0) PG8_BAR; }
    PG8_BAR;
    if constexpr (Epi::AFTER_DRAIN) { E.fused(acc, cur, wr, wc, fr, fq, lds, wid, lane); S.done(cur); }
#undef PG8_SA
#undef PG8_SB
#undef PG8_STAGE
#undef PG8_LDA
#undef PG8_LDB
#undef PG8_MMA
#undef PG8_WAIT_V
#undef PG8_WAIT_L
#undef PG8_BAR
#undef PG8_SCHED
}
}
#define GAS __attribute__((address_space(1)))
#define LAS __attribute__((address_space(3)))
typedef unsigned v4u __attribute__((ext_vector_type(4)));
typedef float f32x4 __attribute__((ext_vector_type(4)));
typedef short bf16x8 __attribute__((ext_vector_type(8)));
typedef GAS unsigned gu32;
#define RLX_AGENT __ATOMIC_RELAXED, __HIP_MEMORY_SCOPE_AGENT
#define LDS_WAIT() asm volatile("s_waitcnt lgkmcnt(0)" ::: "memory")
#define VM_WAIT() asm volatile("s_waitcnt vmcnt(0)" ::: "memory")
#define XB_TMO      128
#define XB_XCNT(j)  (256  + 64 * (j))
#define XB_XSUB(j)  (1280 + 64 * (j))
#define XB_XGEN(j)  (2304 + 64 * (j))
#define XB_TOP      3328
#define XB_TOPGEN   3392
#define XCD_BAR_WORDS 3456
#define XB_SPIN_CAP (1u << 18)

__device__ __forceinline__ unsigned xb_ld(unsigned* p)              { return __hip_atomic_load(p, __ATOMIC_RELAXED, __HIP_MEMORY_SCOPE_AGENT); }
__device__ __forceinline__ unsigned xb_add(unsigned* p, unsigned v) { return __hip_atomic_fetch_add(p, v, __ATOMIC_RELAXED, __HIP_MEMORY_SCOPE_AGENT); }
__device__ __forceinline__ unsigned xb_xcc_id() { return (unsigned)__builtin_amdgcn_s_getreg((3 << 11) | 20) & 0xFu; }
#define XB_SPIN(cond, bar) do { unsigned _sp = 0; while (cond) { __builtin_amdgcn_s_sleep(1); \
    if ((++_sp & 255u) == 0u) { if (xb_ld(&(bar)[XB_TMO])) break; if (_sp > XB_SPIN_CAP) { atomicAdd(&(bar)[XB_TMO], 1u); break; } } } } while (0)

struct XcdBarrier {
    unsigned* bar; unsigned x;
    volatile LAS unsigned* st;
};

__device__ __forceinline__ XcdBarrier xcd_barrier_post(unsigned* bar, volatile LAS unsigned* st) {
    XcdBarrier b; b.bar = bar; b.x = xb_xcc_id(); b.st = st;
    if (threadIdx.x == 0) (void)xb_add(&bar[XB_XCNT(b.x)], 1u);
    return b;
}
__device__ __forceinline__ void xcd_barrier_complete(unsigned* bar, unsigned x, unsigned& nloc, unsigned& nx) {
    const unsigned G = gridDim.x * gridDim.y * gridDim.z;
    unsigned sum, cnt, mine, sp = 0u;
    for (;;) {
        sum = 0u; cnt = 0u; mine = 0u;
#pragma unroll
        for (unsigned j = 0; j < 16; ++j) { const unsigned c = xb_ld(&bar[XB_XCNT(j)]); sum += c; cnt += (c > 0u) ? 1u : 0u; mine = (j == x) ? c : mine; }
        if (sum == G) break;
        __builtin_amdgcn_s_sleep(1);
        if ((++sp & 255u) == 0u) { if (xb_ld(&bar[XB_TMO])) break; if (sp > XB_SPIN_CAP) { atomicAdd(&bar[XB_TMO], 1u); break; } }
    }
    nloc = mine > 0u ? mine : 1u; nx = cnt > 0u ? cnt : 1u;
}

__device__ __forceinline__ void xcd_barrier(const XcdBarrier& b) {
    asm volatile("s_waitcnt vmcnt(0)" ::: "memory");
    __syncthreads();
    if (threadIdx.x == 0) {
        unsigned* bar = b.bar;
        __builtin_amdgcn_s_waitcnt(0);
        unsigned nloc = b.st[0], nx = b.st[1];
        if (nloc == 0u) { xcd_barrier_complete(bar, b.x, nloc, nx); b.st[0] = nloc; b.st[1] = nx; }
        const unsigned old = xb_add(&bar[XB_XSUB(b.x)], 1u);
        const unsigned gen = old / nloc;
        if (old + 1u == (gen + 1u) * nloc) {
            __builtin_amdgcn_fence(__ATOMIC_RELEASE, "agent");
            asm volatile("s_waitcnt vmcnt(0)" ::: "memory");
            const unsigned og = xb_add(&bar[XB_TOP], 1u);
            const unsigned tg = og / nx;
            if (og + 1u == (tg + 1u) * nx) xb_add(&bar[XB_TOPGEN], 1u);
            else XB_SPIN(xb_ld(&bar[XB_TOPGEN]) == tg, bar);
            __builtin_amdgcn_fence(__ATOMIC_ACQUIRE, "agent");
            xb_add(&bar[XB_XGEN(b.x)], 1u);
            asm volatile("s_waitcnt vmcnt(0)" ::: "memory");
        } else {
            XB_SPIN(xb_ld(&bar[XB_XGEN(b.x)]) == gen, bar);
            __builtin_amdgcn_fence(__ATOMIC_ACQUIRE, "agent");
            asm volatile("s_waitcnt vmcnt(0)" ::: "memory");
        }
    }
    __syncthreads();
}

typedef short s16x4 __attribute__((ext_vector_type(4)));
typedef unsigned u32x2 __attribute__((ext_vector_type(2)));
__device__ __forceinline__ float fast_sigmoid(float x) { return __builtin_amdgcn_rcpf(1.f + __builtin_amdgcn_exp2f(-1.4426950408889634f * x)); }
__device__ __forceinline__ float fast_silu(float x) { return x * fast_sigmoid(x); }
__device__ __forceinline__ float fast_gelu(float x) { return x * fast_sigmoid(x * (1.5957691216057308f + 0.0713548162726f * x * x)); }
__device__ __forceinline__ float bflo(unsigned w) { return __uint_as_float(w << 16); }
__device__ __forceinline__ float bfhi(unsigned w) { return __uint_as_float(w & 0xffff0000u); }
typedef float f32x2_t __attribute__((ext_vector_type(2))); typedef __bf16 bf16x2_t __attribute__((ext_vector_type(2)));
__device__ __forceinline__ unsigned cvtpk(float lo, float hi) { const f32x2_t v = {lo, hi}; const bf16x2_t b = __builtin_convertvector(v, bf16x2_t); return __builtin_bit_cast(unsigned, b); }
__device__ __forceinline__ s16x4 tr_read(const LAS unsigned char* p) { return __builtin_bit_cast(s16x4, __builtin_amdgcn_ds_read_tr16_b64_v4i16((LAS s16x4*)p)); }
__device__ __forceinline__ bf16x8 frag_tr(const LAS unsigned char* base, int stride, int lane) {
    const int G = lane >> 4, q = (lane >> 2) & 3, p = lane & 3;
    const LAS unsigned char* a = base + (4 * G + q) * stride + 8 * p;
    const s16x4 lo = tr_read(a), hi = tr_read(a + 16 * stride);
    return (bf16x8){lo[0], lo[1], lo[2], lo[3], hi[0], hi[1], hi[2], hi[3]};
}
__device__ __forceinline__ bf16x8 frag_perm_row(const LAS unsigned char* rowbase, int stride, int lane) {
    const LAS unsigned char* a = rowbase + (lane & 15) * stride + 8 * (lane >> 4);
    const s16x4 lo = *(const LAS s16x4*)a, hi = *(const LAS s16x4*)(a + 32);
    return (bf16x8){lo[0], lo[1], lo[2], lo[3], hi[0], hi[1], hi[2], hi[3]};
}

constexpr int SGU_VF_STRIDE = 544, SGU_W_STRIDE = 272, SGU_VF_OFF = 0, SGU_W_OFF = 128 * SGU_VF_STRIDE;
__device__ __forceinline__ void sgu_item(LAS unsigned char* lds, int item, const bf16* Z, const float* v_norm, const float* w_s, const float* b_s, bf16* Y, int tid) {
    const int lane = tid & 63, wave = __builtin_amdgcn_readfirstlane(tid >> 6);
    const int g = item & 3, c = (item >> 2) & 15, b = item >> 6;
    const size_t tok0 = (size_t)b * SEQ + 128 * c;
    LAS unsigned char* VF = lds + SGU_VF_OFF; LAS unsigned char* WS = lds + SGU_W_OFF;
    {
        const int sub = lane >> 4, cl = lane & 15;
        float vn[16];
#pragma unroll
        for (int j = 0; j < 4; ++j) { const f32x4 t = *(const f32x4*)(v_norm + g * 256 + 16 * cl + 4 * j); vn[4 * j] = t[0]; vn[4 * j + 1] = t[1]; vn[4 * j + 2] = t[2]; vn[4 * j + 3] = t[3]; }
#pragma unroll
        for (int ps = 0; ps < 4; ++ps) {
            const int row = 16 * wave + 4 * ps + sub;
            const v4u* src = (const v4u*)(Z + (tok0 + row) * OD_Z + 4096 + 256 * g + 16 * cl);
            const v4u w0 = src[0], w1 = src[1];
            float x[16];
#pragma unroll
            for (int j = 0; j < 4; ++j) { x[2 * j] = fast_gelu(bflo(w0[j])); x[2 * j + 1] = fast_gelu(bfhi(w0[j])); x[8 + 2 * j] = fast_gelu(bflo(w1[j])); x[9 + 2 * j] = fast_gelu(bfhi(w1[j])); }
            float s = 0.f;
#pragma unroll
            for (int j = 0; j < 16; ++j) s += x[j];
            s += __shfl_xor(s, 1); s += __shfl_xor(s, 2); s += __shfl_xor(s, 4); s += __shfl_xor(s, 8);
            const float mu = s * (1.f / 256.f);
            float q = 0.f;
#pragma unroll
            for (int j = 0; j < 16; ++j) { x[j] -= mu; q += x[j] * x[j]; }
            q += __shfl_xor(q, 1); q += __shfl_xor(q, 2); q += __shfl_xor(q, 4); q += __shfl_xor(q, 8);
            const float rstd = __builtin_amdgcn_rsqf(q * (1.f / 256.f) + 1e-6f);
            v4u o0, o1;
#pragma unroll
            for (int j = 0; j < 4; ++j) { o0[j] = cvtpk(x[2 * j] * rstd * vn[2 * j], x[2 * j + 1] * rstd * vn[2 * j + 1]); o1[j] = cvtpk(x[8 + 2 * j] * rstd * vn[8 + 2 * j], x[9 + 2 * j] * rstd * vn[9 + 2 * j]); }
            LAS v4u* dst = (LAS v4u*)(VF + row * SGU_VF_STRIDE + 32 * cl);
            dst[0] = o0; dst[1] = o1;
        }
    }
    {
        const int t = tid >> 2, s0 = (tid & 3) * 32;
        const f32x4* src = (const f32x4*)(w_s + ((size_t)g * 128 + t) * 128 + s0);
#pragma unroll
        for (int j = 0; j < 4; ++j) { const f32x4 a = src[2 * j], bb = src[2 * j + 1]; const int s = s0 + 8 * j;
            v4u o; o[0] = cvtpk(s + 0 <= t ? a[0] : 0.f, s + 1 <= t ? a[1] : 0.f); o[1] = cvtpk(s + 2 <= t ? a[2] : 0.f, s + 3 <= t ? a[3] : 0.f);
            o[2] = cvtpk(s + 4 <= t ? bb[0] : 0.f, s + 5 <= t ? bb[1] : 0.f); o[3] = cvtpk(s + 6 <= t ? bb[2] : 0.f, s + 7 <= t ? bb[3] : 0.f);
            *(LAS v4u*)(WS + t * SGU_W_STRIDE + 2 * s) = o; }
    }
    __syncthreads();
    f32x4 acc[2][8];
#pragma unroll
    for (int eb = 0; eb < 2; ++eb)
#pragma unroll
        for (int tb = 0; tb < 8; ++tb) acc[eb][tb] = (f32x4){0.f, 0.f, 0.f, 0.f};
#pragma unroll
    for (int ks = 0; ks < 4; ++ks) {
        bf16x8 af[2];
#pragma unroll
        for (int eb = 0; eb < 2; ++eb) af[eb] = frag_tr(VF + (32 * ks) * SGU_VF_STRIDE + (16 * (2 * wave + eb)) * 2, SGU_VF_STRIDE, lane);
#pragma unroll
        for (int tb = 2 * ks; tb < 8; ++tb) {
            const bf16x8 bfr = frag_perm_row(WS + (16 * tb) * SGU_W_STRIDE + (32 * ks) * 2, SGU_W_STRIDE, lane);
#pragma unroll
            for (int eb = 0; eb < 2; ++eb) acc[eb][tb] = __builtin_amdgcn_mfma_f32_16x16x32_bf16(af[eb], bfr, acc[eb][tb], 0, 0, 0);
        }
    }
    {
        const int G = lane >> 4, tl = lane & 15;
#pragma unroll
        for (int tb = 0; tb < 8; ++tb) {
            const int t = 16 * tb + tl; const float bs = b_s[g * 128 + t];
            const bf16* zr = Z + (tok0 + t) * OD_Z + 256 * g;
            bf16* yr = Y + (tok0 + t) * DM + 1024 + 256 * g;
#pragma unroll
            for (int eb = 0; eb < 2; ++eb) {
                const int e = 16 * (2 * wave + eb) + 4 * G;
                const u32x2 uu = *(const u32x2*)(zr + 3072 + e), gg = *(const u32x2*)(zr + 5120 + e);
                const f32x4 a = acc[eb][tb];
                const float y0 = fast_gelu(bflo(uu[0])) * (a[0] + bs) * fast_silu(bflo(gg[0])), y1 = fast_gelu(bfhi(uu[0])) * (a[1] + bs) * fast_silu(bfhi(gg[0]));
                const float y2 = fast_gelu(bflo(uu[1])) * (a[2] + bs) * fast_silu(bflo(gg[1])), y3 = fast_gelu(bfhi(uu[1])) * (a[3] + bs) * fast_silu(bfhi(gg[1]));
                u32x2 o; o[0] = cvtpk(y0, y1); o[1] = cvtpk(y2, y3);
                *(u32x2*)(yr + e) = o;
            }
        }
    }
    __syncthreads();
}

constexpr int AT_STRIDE = 288, AT_K_OFF = 0, AT_V_OFF = 256 * AT_STRIDE, AT_V_ROWS = 272, AT_LDS_END = AT_V_OFF + AT_V_ROWS * AT_STRIDE;
__device__ __forceinline__ void attn_item(LAS unsigned char* lds, int item, const bf16* Z, bf16* OG, float* LSE, int tid) {
    const int lane = tid & 63, wave = __builtin_amdgcn_readfirstlane(tid >> 6), G = lane >> 4, ql = lane & 15;
    const int g = item >> 8, rem = item & 255, j = rem & 3, rn = (rem >> 2) & 15, b = rem >> 6;
    const int d = 1 << (2 * g), nb = 16 >> (2 * g), n = rn % nb, r = rn / nb;
    const size_t tokb = (size_t)b * SEQ;
    LAS unsigned char* KT = lds + AT_K_OFF; LAS unsigned char* VT = lds + AT_V_OFF;
    const int q0 = 16 * wave;
    const size_t qtok = tokb + (size_t)(128 * n + q0 + ql) * d + r;
    bf16x8 qf[4];
    { const bf16* qp = Z + qtok * EV_IN + 3072 + g * 512 + j * 128 + 8 * G;
#pragma unroll
      for (int ks = 0; ks < 4; ++ks) qf[ks] = *(const bf16x8*)(qp + 32 * ks); }
    {
        const int c16 = tid & 15, rw = tid >> 4;
        const bf16* kb = Z + 4608 + g * 512 + j * 128 + 8 * c16;
#pragma unroll
        for (int ps = 0; ps < 8; ++ps) {
            const int kk = 32 * ps + rw; const int l = 128 * (n - 1) + kk;
            v4u kv = (v4u){0u, 0u, 0u, 0u}, vv = (v4u){0u, 0u, 0u, 0u};
            if (l >= 0) { const bf16* p = kb + (tokb + (size_t)l * d + r) * EV_IN; kv = *(const v4u*)p; vv = *(const v4u*)(p + 1536); }
            *(LAS v4u*)(KT + kk * AT_STRIDE + 16 * c16) = kv; *(LAS v4u*)(VT + kk * AT_STRIDE + 16 * c16) = vv;
        }
        if (tid < 16 * 18) *(LAS v4u*)(VT + 256 * AT_STRIDE + 16 * tid) = (v4u){0u, 0u, 0u, 0u};
    }
    __syncthreads();
    f32x4 sc[9];
#pragma unroll
    for (int t = 0; t < 9; ++t) {
        sc[t] = (f32x4){0.f, 0.f, 0.f, 0.f};
        const LAS unsigned char* kp = KT + (16 * wave + 16 * t + ql) * AT_STRIDE + 16 * G;
#pragma unroll
        for (int ks = 0; ks < 4; ++ks) sc[t] = __builtin_amdgcn_mfma_f32_16x16x32_bf16(*(const LAS bf16x8*)(kp + 64 * ks), qf[ks], sc[t], 0, 0, 0);
    }
    const float slope2 = exp2f(-8.0f * (float)(g + 3 * j + 1) / 12.0f) * (float)d * 1.4426950408889634f;
    const float scale2 = 0.08838834764831845f * 1.4426950408889634f;
    float mx = -INFINITY;
#pragma unroll
    for (int t = 0; t < 9; ++t)
#pragma unroll
        for (int rg = 0; rg < 4; ++rg) {
            const int rel = 16 * t + 4 * G + rg - ql;
            const bool ok = (rel >= 0) && (rel <= 128) && (n > 0 || (q0 + ql + rel) >= 128);
            const float s = sc[t][rg] * scale2 - slope2 * (float)(128 - rel);
            sc[t][rg] = ok ? s : -INFINITY;
            mx = fmaxf(mx, sc[t][rg]);
        }
    mx = fmaxf(mx, __shfl_xor(mx, 16)); mx = fmaxf(mx, __shfl_xor(mx, 32));
    float den = 0.f;
#pragma unroll
    for (int t = 0; t < 9; ++t)
#pragma unroll
        for (int rg = 0; rg < 4; ++rg) { const float p = __builtin_amdgcn_exp2f(sc[t][rg] - mx); sc[t][rg] = p; den += p; }
    den += __shfl_xor(den, 16); den += __shfl_xor(den, 32);
    f32x4 oc[8];
#pragma unroll
    for (int dvb = 0; dvb < 8; ++dvb) oc[dvb] = (f32x4){0.f, 0.f, 0.f, 0.f};
#pragma unroll
    for (int s = 0; s < 5; ++s) {
        const f32x4 plo = sc[2 * s], phi = (s < 4) ? sc[2 * s + 1] : (f32x4){0.f, 0.f, 0.f, 0.f};
        const unsigned w0 = cvtpk(plo[0], plo[1]), w1 = cvtpk(plo[2], plo[3]), w2 = cvtpk(phi[0], phi[1]), w3 = cvtpk(phi[2], phi[3]);
        const bf16x8 pf = __builtin_bit_cast(bf16x8, (v4u){w0, w1, w2, w3});
#pragma unroll
        for (int dvb = 0; dvb < 8; ++dvb) {
            const bf16x8 vf = frag_tr(VT + (16 * wave + 32 * s) * AT_STRIDE + (16 * dvb) * 2, AT_STRIDE, lane);
            oc[dvb] = __builtin_amdgcn_mfma_f32_16x16x32_bf16(vf, pf, oc[dvb], 0, 0, 0);
        }
    }
    const float rden = __builtin_amdgcn_rcpf(den);
    bf16* op = OG + ((size_t)g * MTOK + qtok) * 512 + j * 128 + 4 * G;
#pragma unroll
    for (int dvb = 0; dvb < 8; ++dvb) { u32x2 o; o[0] = cvtpk(oc[dvb][0] * rden, oc[dvb][1] * rden); o[1] = cvtpk(oc[dvb][2] * rden, oc[dvb][3] * rden); *(u32x2*)(op + 16 * dvb) = o; }
    if (G == 0) LSE[((size_t)g * MTOK + qtok) * 4 + j] = mx + __builtin_amdgcn_logf(den);
    __syncthreads();
}
__device__ __forceinline__ void attn_merge(const bf16* Z, const bf16* OG, const float* LSE, bf16* Y, int gtid, int gthreads) {
    for (int it = gtid; it < MTOK * 64; it += gthreads) {
        const int tok = it >> 6, c8 = it & 63, j = c8 >> 4;
        const float l0 = LSE[((size_t)0 * MTOK + tok) * 4 + j], l1 = LSE[((size_t)1 * MTOK + tok) * 4 + j], l2 = LSE[((size_t)2 * MTOK + tok) * 4 + j];
        const float m = fmaxf(l0, fmaxf(l1, l2));
        float w0 = __builtin_amdgcn_exp2f(l0 - m), w1 = __builtin_amdgcn_exp2f(l1 - m), w2 = __builtin_amdgcn_exp2f(l2 - m);
        const float rs = __builtin_amdgcn_rcpf(w0 + w1 + w2); w0 *= rs; w1 *= rs; w2 *= rs;
        const v4u a = *(const v4u*)(OG + ((size_t)0 * MTOK + tok) * 512 + 8 * c8), bb = *(const v4u*)(OG + ((size_t)1 * MTOK + tok) * 512 + 8 * c8), cc = *(const v4u*)(OG + ((size_t)2 * MTOK + tok) * 512 + 8 * c8);
        const v4u gt = *(const v4u*)(Z + (size_t)tok * EV_IN + 7680 + 8 * c8);
        v4u o;
#pragma unroll
        for (int k = 0; k < 4; ++k) {
            const float ylo = (w0 * bflo(a[k]) + w1 * bflo(bb[k]) + w2 * bflo(cc[k])) * fast_silu(bflo(gt[k]));
            const float yhi = (w0 * bfhi(a[k]) + w1 * bfhi(bb[k]) + w2 * bfhi(cc[k])) * fast_silu(bfhi(gt[k]));
            o[k] = cvtpk(ylo, yhi);
        }
        *(v4u*)(Y + (size_t)tok * DM + 1536 + 8 * c8) = o;
    }
}

constexpr int LR_XC_STRIDE = 272, LR_XC_OFF = 0, LR_F_STRIDE = 528  , LR_XCF_OFF = 128 * LR_XC_STRIDE, LR_A_OFF = LR_XCF_OFF + 32 * LR_F_STRIDE, LR_U_OFF = LR_A_OFF + 32 * LR_F_STRIDE, LR_LDS_END = LR_U_OFF + 32 * LR_F_STRIDE;
struct LruParams { const float *conv_w, *conv_b, *b_a, *b_i, *lam; const bf16* wg; };
__device__ __forceinline__ void lru_load_tile(v4u (&xa)[7], v4u& ga, const bf16* Z, size_t tokb, int t0, int h, int c4, int tid) {
    const int co = tid & 15, rg = tid >> 4;
#pragma unroll
    for (int k = 0; k < 7; ++k) { const int t = t0 + 4 * rg + k - 3;
        xa[k] = (t >= 0) ? *(const v4u*)(Z + (tokb + t) * EV_IN + h * 128 + 8 * co) : (v4u){0u, 0u, 0u, 0u}; }
    ga = *(const v4u*)(Z + (tokb + t0 + (tid >> 2)) * EV_IN + 1536 + h * 128 + 32 * c4 + 8 * (tid & 3));
}
__device__ __forceinline__ void lru_item(LAS unsigned char* lds, int item, const bf16* Z, const LruParams& P, bf16* Y, int tid) {
    const int lane = tid & 63, wave = __builtin_amdgcn_readfirstlane(tid >> 6), G = lane >> 4, ql = lane & 15;
    const int c4 = item & 3, h = (item >> 2) % 12, b = item / 48;
    const size_t tokb = (size_t)b * SEQ;
    LAS unsigned char* XC = lds + LR_XC_OFF; LAS unsigned char* XCF = lds + LR_XCF_OFF; LAS unsigned char* AL = lds + LR_A_OFF; LAS unsigned char* UL = lds + LR_U_OFF;
    bf16x8 wf[2][2][4];
#pragma unroll
    for (int gate = 0; gate < 2; ++gate)
#pragma unroll
        for (int cb = 0; cb < 2; ++cb)
#pragma unroll
            for (int ks = 0; ks < 4; ++ks) wf[gate][cb][ks] = *(const bf16x8*)(P.wg + ((size_t)(h * 2 + gate) * 128 + 32 * c4 + 16 * cb + ql) * 128 + 32 * ks + 8 * G);
    float ba[2], bi[2], sp8[2];
#pragma unroll
    for (int cb = 0; cb < 2; ++cb) { const int ch = h * 128 + 32 * c4 + 16 * cb + ql; ba[cb] = P.b_a[ch]; bi[cb] = P.b_i[ch];
        const float nl = -P.lam[ch]; sp8[cb] = 8.0f * (nl > 20.f ? nl : log1pf(__expf(nl))); }
    float hc = 0.f;
    v4u xa[7], ga;
    lru_load_tile(xa, ga, Z, tokb, 0, h, c4, tid);
    for (int sc = 0; sc < 16; ++sc) {
        const int t0 = 128 * sc;
        {
            const int co = tid & 15, rg = tid >> 4;
            v4u orow[4];
            const bool mine = (co >> 2) == c4;
#pragma unroll
            for (int e = 0; e < 4; ++e) {
                typedef float f32x2 __attribute__((ext_vector_type(2)));
                const int chn = h * 128 + 8 * co + 2 * e;
                const f32x2 w0 = *(const f32x2*)(P.conv_w + 0 * LRU_W + chn), w1 = *(const f32x2*)(P.conv_w + 1 * LRU_W + chn), w2 = *(const f32x2*)(P.conv_w + 2 * LRU_W + chn), w3 = *(const f32x2*)(P.conv_w + 3 * LRU_W + chn);
                const f32x2 cb2 = *(const f32x2*)(P.conv_b + chn);
                float lo[7], hi[7];
#pragma unroll
                for (int k = 0; k < 7; ++k) { lo[k] = bflo(xa[k][e]); hi[k] = bfhi(xa[k][e]); }
                f32x4 xlo, xhi;
#pragma unroll
                for (int r = 0; r < 4; ++r) { xlo[r] = cb2[0] + w0[0] * lo[r] + w1[0] * lo[r + 1] + w2[0] * lo[r + 2] + w3[0] * lo[r + 3];
                                              xhi[r] = cb2[1] + w0[1] * hi[r] + w1[1] * hi[r + 1] + w2[1] * hi[r + 2] + w3[1] * hi[r + 3]; orow[r][e] = cvtpk(xlo[r], xhi[r]); }
                if (mine) { *(LAS f32x4*)(XCF + (8 * (co & 3) + 2 * e) * LR_F_STRIDE + 16 * rg) = xlo; *(LAS f32x4*)(XCF + (8 * (co & 3) + 2 * e + 1) * LR_F_STRIDE + 16 * rg) = xhi; }
            }
#pragma unroll
            for (int r = 0; r < 4; ++r) *(LAS v4u*)(XC + (4 * rg + r) * LR_XC_STRIDE + 16 * co) = orow[r];
        }
        const v4u ga_cur = ga;
        if (sc < 15) lru_load_tile(xa, ga, Z, tokb, t0 + 128, h, c4, tid);
        __syncthreads();
        f32x4 acc[2][2];
#pragma unroll
        for (int gate = 0; gate < 2; ++gate)
#pragma unroll
            for (int cb = 0; cb < 2; ++cb) acc[gate][cb] = (f32x4){0.f, 0.f, 0.f, 0.f};
#pragma unroll
        for (int ks = 0; ks < 4; ++ks) {
            const bf16x8 af = *(const LAS bf16x8*)(XC + (16 * wave + ql) * LR_XC_STRIDE + 64 * ks + 16 * G);
#pragma unroll
            for (int gate = 0; gate < 2; ++gate)
#pragma unroll
                for (int cb = 0; cb < 2; ++cb) acc[gate][cb] = __builtin_amdgcn_mfma_f32_16x16x32_bf16(af, wf[gate][cb][ks], acc[gate][cb], 0, 0, 0);
        }
#pragma unroll
        for (int cb = 0; cb < 2; ++cb) {
            const int off = (16 * cb + ql) * LR_F_STRIDE + (16 * wave + 4 * G) * 4;
            const f32x4 xcv = *(const LAS f32x4*)(XCF + off);
            f32x4 av, uv;
#pragma unroll
            for (int rg2 = 0; rg2 < 4; ++rg2) {
                const float r = fast_sigmoid(acc[0][cb][rg2] + ba[cb]), ig = fast_sigmoid(acc[1][cb][rg2] + bi[cb]);
                const float la = -r * sp8[cb];
                const float a = __builtin_amdgcn_exp2f(la * 1.4426950408889634f);
                const float x2 = 2.f * la;
                const float om = (x2 > -0.05f) ? -x2 * (1.f + x2 * (0.5f + x2 * (0.16666667f + x2 * 0.041666667f))) : 1.f - a * a;
                av[rg2] = a; uv[rg2] = __builtin_amdgcn_sqrtf(om) * ig * xcv[rg2];
            }
            *(LAS f32x4*)(AL + off) = av; *(LAS f32x4*)(UL + off) = uv;
        }
        __syncthreads();
        {
            const int seg = ql, off = (4 * wave + G) * LR_F_STRIDE + 32 * seg;
            const f32x4 a0 = *(const LAS f32x4*)(AL + off), a1 = *(const LAS f32x4*)(AL + off + 16), u0 = *(const LAS f32x4*)(UL + off), u1 = *(const LAS f32x4*)(UL + off + 16);
            float Pp = 1.f, Hh = 0.f;
#pragma unroll
            for (int k = 0; k < 4; ++k) { Hh = a0[k] * Hh + u0[k]; Pp *= a0[k]; }
#pragma unroll
            for (int k = 0; k < 4; ++k) { Hh = a1[k] * Hh + u1[k]; Pp *= a1[k]; }
#pragma unroll
            for (int o = 1; o < 16; o <<= 1) { const float Pl = __shfl_up(Pp, o, 16), Hl = __shfl_up(Hh, o, 16); if (seg >= o) { Hh = Pp * Hl + Hh; Pp = Pp * Pl; } }
            float Pe = __shfl_up(Pp, 1, 16), He = __shfl_up(Hh, 1, 16);
            if (seg == 0) { Pe = 1.f; He = 0.f; }
            float hh = Pe * hc + He;
            f32x4 h0, h1;
#pragma unroll
            for (int k = 0; k < 4; ++k) { hh = a0[k] * hh + u0[k]; h0[k] = hh; }
#pragma unroll
            for (int k = 0; k < 4; ++k) { hh = a1[k] * hh + u1[k]; h1[k] = hh; }
            *(LAS f32x4*)(UL + off) = h0; *(LAS f32x4*)(UL + off + 16) = h1;
            hc = __shfl(hh, (lane & 48) + 15);
        }
        __syncthreads();
        {
            const int tk = tid >> 2, oc = tid & 3;
            float hv[8];
#pragma unroll
            for (int e = 0; e < 8; ++e) hv[e] = *(const LAS float*)(UL + (8 * oc + e) * LR_F_STRIDE + 4 * tk);
            v4u o;
#pragma unroll
            for (int e = 0; e < 4; ++e) o[e] = cvtpk(hv[2 * e] * fast_silu(bflo(ga_cur[e])), hv[2 * e + 1] * fast_silu(bfhi(ga_cur[e])));
            *(v4u*)(Y + (tokb + t0 + tk) * DM + h * 128 + 32 * c4 + 8 * oc) = o;
        }
    }
    __syncthreads();
}

constexpr int G1_ALR_OFF = 0, G1_TOT_OFF = 4096, G1_QT_OFF = 8192, G1_QK_STRIDE = 272, G1_KT_OFF = G1_QT_OFF + 64 * G1_QK_STRIDE, G1_V_OFF = G1_KT_OFF + 64 * G1_QK_STRIDE, G1_V_STRIDE = 544,
              G1_LDS_END = G1_V_OFF + 64 * G1_V_STRIDE;
__device__ __forceinline__ void gla1_item(LAS unsigned char* lds, int item, const bf16* Z, const float* ALR, const float* w_alpha, const float* b_alpha, bf16* QT, bf16* KD, bf16* OI, float* DEC, int tid) {
    const int lane = tid & 63, wave = __builtin_amdgcn_readfirstlane(tid >> 6), G = lane >> 4, ql = lane & 15;
    const int c = item & 31, h = (item >> 5) & 3, b = item >> 7;
    const size_t tok0 = (size_t)b * SEQ + 64 * c;
    LAS float* ALRs = (LAS float*)(lds + G1_ALR_OFF); LAS float* TOT = (LAS float*)(lds + G1_TOT_OFF);
    LAS unsigned char* QTl = lds + G1_QT_OFF; LAS unsigned char* KTl = lds + G1_KT_OFF; LAS unsigned char* Vl = lds + G1_V_OFF;
    if (tid < 256) *(LAS f32x4*)(ALRs + 4 * tid) = *(const f32x4*)(ALR + tok0 * 16 + 4 * tid);
    { const int rw = tid >> 5, c16 = tid & 31;
#pragma unroll
      for (int ps = 0; ps < 4; ++ps) { const int row = 16 * ps + rw;
          *(LAS v4u*)(Vl + row * G1_V_STRIDE + 16 * c16) = *(const v4u*)(Z + (tok0 + row) * OD_Z + 1024 + h * 256 + 8 * c16); } }
    const int e = tid & 127, tq = tid >> 7;
    float wa[16];
#pragma unroll
    for (int r = 0; r < 16; ++r) wa[r] = w_alpha[r * 512 + h * 128 + e];
    const float bal = b_alpha[h * 128 + e];
    float qv[16], kv[16];
#pragma unroll
    for (int t = 0; t < 16; ++t) { const bf16* zr = Z + (tok0 + 16 * tq + t) * OD_Z + h * 128 + e; qv[t] = bf2f(zr[0]); kv[t] = bf2f(zr[512]); }
    __syncthreads();
    float bc[16]; float run = 0.f;
#pragma unroll
    for (int t = 0; t < 16; ++t) {
        float s = bal;
#pragma unroll
        for (int r = 0; r < 16; ++r) s += ALRs[(16 * tq + t) * 16 + r] * wa[r];
        const float sp = (s < -20.f) ? -s : __builtin_amdgcn_logf(1.f + __builtin_amdgcn_exp2f(-s * 1.4426950408889634f)) * 0.6931471805599453f;
        run -= sp * 0.0625f; bc[t] = run;
    }
    TOT[tq * 128 + e] = run;
    __syncthreads();
    const float t0s = TOT[e], t1s = TOT[128 + e], t2s = TOT[256 + e], t3s = TOT[384 + e];
    const float offs = (tq > 0 ? t0s : 0.f) + (tq > 1 ? t1s : 0.f) + (tq > 2 ? t2s : 0.f), blast = (t0s + t1s) + (t2s + t3s);
    if (tq == 0) DEC[(size_t)item * 128 + e] = __builtin_amdgcn_exp2f(blast * 1.4426950408889634f);
#pragma unroll
    for (int t = 0; t < 16; ++t) {
        const float bb = bc[t] + offs;
        const float eb = __builtin_amdgcn_exp2f(bb * 1.4426950408889634f), enb = __builtin_amdgcn_exp2f(-bb * 1.4426950408889634f), edl = __builtin_amdgcn_exp2f((blast - bb) * 1.4426950408889634f);
        const float qt = qv[t] * 0.08838834764831845f * eb, kt = kv[t] * enb, kd = kv[t] * edl;
        const int row = 16 * tq + t;
        const bf16 qtb = (bf16)f2bf(qt);
        *(LAS bf16*)(QTl + row * G1_QK_STRIDE + 2 * e) = qtb; *(LAS bf16*)(KTl + row * G1_QK_STRIDE + 2 * e) = (bf16)f2bf(kt);
        QT[(tok0 + row) * 512 + h * 128 + e] = qtb; KD[(tok0 + row) * 512 + h * 128 + e] = (bf16)f2bf(kd);
    }
    __syncthreads();
    const int ib = wave >> 1, dh = wave & 1;
    bf16x8 qf[4];
#pragma unroll
    for (int ks = 0; ks < 4; ++ks) qf[ks] = *(const LAS bf16x8*)(QTl + (16 * ib + ql) * G1_QK_STRIDE + 64 * ks + 16 * G);
    f32x4 at[4];
#pragma unroll
    for (int jb = 0; jb < 4; ++jb) {
        at[jb] = (f32x4){0.f, 0.f, 0.f, 0.f};
        if (jb <= ib) {
#pragma unroll
            for (int ks = 0; ks < 4; ++ks) at[jb] = __builtin_amdgcn_mfma_f32_16x16x32_bf16(*(const LAS bf16x8*)(KTl + (16 * jb + ql) * G1_QK_STRIDE + 64 * ks + 16 * G), qf[ks], at[jb], 0, 0, 0);
#pragma unroll
            for (int rg = 0; rg < 4; ++rg) if (16 * jb + 4 * G + rg > 16 * ib + ql) at[jb][rg] = 0.f;
        }
    }
    f32x4 oc[8];
#pragma unroll
    for (int dvb = 0; dvb < 8; ++dvb) oc[dvb] = (f32x4){0.f, 0.f, 0.f, 0.f};
#pragma unroll
    for (int s = 0; s < 2; ++s) {
        if (2 * s <= ib) {
            const bf16x8 pf = __builtin_bit_cast(bf16x8, (v4u){cvtpk(at[2 * s][0], at[2 * s][1]), cvtpk(at[2 * s][2], at[2 * s][3]), cvtpk(at[2 * s + 1][0], at[2 * s + 1][1]), cvtpk(at[2 * s + 1][2], at[2 * s + 1][3])});
#pragma unroll
            for (int dvb = 0; dvb < 8; ++dvb) {
                const bf16x8 vf = frag_tr(Vl + (32 * s) * G1_V_STRIDE + (128 * dh + 16 * dvb) * 2, G1_V_STRIDE, lane);
                oc[dvb] = __builtin_amdgcn_mfma_f32_16x16x32_bf16(vf, pf, oc[dvb], 0, 0, 0);
            }
        }
    }
    bf16* op = OI + (tok0 + 16 * ib + ql) * 1024 + h * 256 + 128 * dh + 4 * G;
#pragma unroll
    for (int dvb = 0; dvb < 8; ++dvb) { u32x2 o; o[0] = cvtpk(oc[dvb][0], oc[dvb][1]); o[1] = cvtpk(oc[dvb][2], oc[dvb][3]); *(u32x2*)(op + 16 * dvb) = o; }
    __syncthreads();
}

constexpr int G2_QT_STRIDE = 272, G2_KD_STRIDE = 288, G2_V_STRIDE = 544;
constexpr int G2_QT_OFF = 0, G2_KD_OFF = G2_QT_OFF + 64 * G2_QT_STRIDE, G2_V_OFF = G2_KD_OFF + 64 * G2_KD_STRIDE, G2_BUF = G2_V_OFF + 64 * G2_V_STRIDE;
constexpr int G2_DEC_OFF = 2 * G2_BUF  , G2_PART_OFF = G2_DEC_OFF + 32 * 128 * 4, G2_LDS_END = G2_PART_OFF + 8 * 64 * 4;
struct Gla2StageA { v4u qt[2], kd[2]; };
struct Gla2StageB { v4u v[4]; };
__device__ __forceinline__ void gla2_loadA(Gla2StageA& st, const bf16* QT, const bf16* KD, size_t tok0, int h, int tid) {
    const int rw = tid >> 4, c16 = tid & 15;
#pragma unroll
    for (int ps = 0; ps < 2; ++ps) { st.qt[ps] = *(const v4u*)(QT + (tok0 + 32 * ps + rw) * 512 + h * 128 + 8 * c16); st.kd[ps] = *(const v4u*)(KD + (tok0 + 32 * ps + rw) * 512 + h * 128 + 8 * c16); }
}
__device__ __forceinline__ void gla2_loadB(Gla2StageB& st, const bf16* Z, size_t tok0, int h, int tid) {
    const int rv = tid >> 5, c32 = tid & 31;
#pragma unroll
    for (int ps = 0; ps < 4; ++ps) st.v[ps] = *(const v4u*)(Z + (tok0 + 16 * ps + rv) * OD_Z + 1024 + h * 256 + 8 * c32);
}
__device__ __forceinline__ void gla2_storeA(const Gla2StageA& st, LAS unsigned char* buf, int tid) {
    const int rw = tid >> 4, c16 = tid & 15;
#pragma unroll
    for (int ps = 0; ps < 2; ++ps) { *(LAS v4u*)(buf + G2_QT_OFF + (32 * ps + rw) * G2_QT_STRIDE + 16 * c16) = st.qt[ps]; *(LAS v4u*)(buf + G2_KD_OFF + (32 * ps + rw) * G2_KD_STRIDE + 16 * c16) = st.kd[ps]; }
}
__device__ __forceinline__ void gla2_storeB(const Gla2StageB& st, LAS unsigned char* buf, int tid) {

    const int rv = tid >> 5, c32 = tid & 31;
#pragma unroll
    for (int ps = 0; ps < 4; ++ps) *(LAS v4u*)(buf + G2_V_OFF + (16 * ps + rv) * G2_V_STRIDE + 16 * c32) = st.v[ps];
}
__device__ __forceinline__ void gla2_item(LAS unsigned char* lds, int item, const bf16* Z, const bf16* QT, const bf16* KD, const bf16* OI, const float* DEC, const float* head_norm, bf16* Y, int tid) {
    const int lane = tid & 63, wave = __builtin_amdgcn_readfirstlane(tid >> 6), G = lane >> 4, ql = lane & 15;
    const int h = item & 3, b = item >> 2;
    const size_t tokb = (size_t)b * SEQ;
    LAS float* PART = (LAS float*)(lds + G2_PART_OFF);
    f32x4 sacc[8][2];
#pragma unroll
    for (int dkb = 0; dkb < 8; ++dkb) { sacc[dkb][0] = (f32x4){0.f, 0.f, 0.f, 0.f}; sacc[dkb][1] = (f32x4){0.f, 0.f, 0.f, 0.f}; }
    { Gla2StageA sa; Gla2StageB sb;
      gla2_loadA(sa, QT, KD, tokb, h, tid); gla2_loadB(sb, Z, tokb, h, tid);
#pragma unroll
      for (int k = 0; k < 2; ++k) *(LAS f32x4*)(lds + G2_DEC_OFF + 16 * (tid + 512 * k)) = *(const f32x4*)(DEC + (size_t)(item * 32) * 128 + 4 * (tid + 512 * k));
      gla2_storeA(sa, lds, tid); gla2_storeB(sb, lds, tid); }
    __syncthreads();
    for (int c = 0; c < 32; ++c) {
        LAS unsigned char* buf = lds + (c & 1) * G2_BUF;
        const size_t tok0 = tokb + 64 * c;
        LAS unsigned char* nbuf = lds + ((c + 1) & 1) * G2_BUF;
        Gla2StageA sa;
        if (c < 31) gla2_loadA(sa, QT, KD, tok0 + 64, h, tid);
        f32x4 oacc[2][4];
#pragma unroll
        for (int db = 0; db < 2; ++db)
#pragma unroll
            for (int tb = 0; tb < 4; ++tb) oacc[db][tb] = (f32x4){0.f, 0.f, 0.f, 0.f};
#pragma unroll
        for (int s = 0; s < 4; ++s) {
            bf16x8 sf[2];
#pragma unroll
            for (int db = 0; db < 2; ++db) sf[db] = __builtin_bit_cast(bf16x8, (v4u){cvtpk(sacc[2 * s][db][0], sacc[2 * s][db][1]), cvtpk(sacc[2 * s][db][2], sacc[2 * s][db][3]),
                                                                                   cvtpk(sacc[2 * s + 1][db][0], sacc[2 * s + 1][db][1]), cvtpk(sacc[2 * s + 1][db][2], sacc[2 * s + 1][db][3])});
#pragma unroll
            for (int tb = 0; tb < 4; ++tb) {
                const bf16x8 qf = frag_perm_row(buf + G2_QT_OFF + (16 * tb) * G2_QT_STRIDE + (32 * s) * 2, G2_QT_STRIDE, lane);
#pragma unroll
                for (int db = 0; db < 2; ++db) oacc[db][tb] = __builtin_amdgcn_mfma_f32_16x16x32_bf16(sf[db], qf, oacc[db][tb], 0, 0, 0);
            }
        }
        if (c < 31) gla2_storeA(sa, nbuf, tid);
#pragma unroll
        for (int dkb = 0; dkb < 8; ++dkb) { const f32x4 dec = *(const LAS f32x4*)(lds + G2_DEC_OFF + (128 * c + 16 * dkb + 4 * G) * 4); sacc[dkb][0] *= dec; sacc[dkb][1] *= dec; }
#pragma unroll
        for (int s = 0; s < 2; ++s) {
            bf16x8 vf[2];
#pragma unroll
            for (int db = 0; db < 2; ++db) vf[db] = frag_tr(buf + G2_V_OFF + (32 * s) * G2_V_STRIDE + (16 * (2 * wave + db)) * 2, G2_V_STRIDE, lane);
#pragma unroll
            for (int dkb = 0; dkb < 8; ++dkb) {
                const bf16x8 kf = frag_tr(buf + G2_KD_OFF + (32 * s) * G2_KD_STRIDE + (16 * dkb) * 2, G2_KD_STRIDE, lane);
#pragma unroll
                for (int db = 0; db < 2; ++db) sacc[dkb][db] = __builtin_amdgcn_mfma_f32_16x16x32_bf16(kf, vf[db], sacc[dkb][db], 0, 0, 0);
            }
        }
#pragma unroll
        for (int tb = 0; tb < 4; ++tb) {
            float ss = 0.f;
#pragma unroll
            for (int db = 0; db < 2; ++db) {
                const u32x2 oi = *(const u32x2*)(OI + (tok0 + 16 * tb + ql) * 1024 + h * 256 + 16 * (2 * wave + db) + 4 * G);
                f32x4 o = oacc[db][tb]; o[0] += bflo(oi[0]); o[1] += bfhi(oi[0]); o[2] += bflo(oi[1]); o[3] += bfhi(oi[1]);
                oacc[db][tb] = o; ss += (o[0] * o[0] + o[1] * o[1]) + (o[2] * o[2] + o[3] * o[3]);
            }
            ss += __shfl_xor(ss, 16); ss += __shfl_xor(ss, 32);
            if (G == 0) PART[wave * 64 + 16 * tb + ql] = ss;
        }
        __syncthreads();
        Gla2StageB sb;
        if (c < 31) gla2_loadB(sb, Z, tok0 + 64, h, tid);
#pragma unroll
        for (int tb = 0; tb < 4; ++tb) {
            float tot = 0.f;
#pragma unroll
            for (int w = 0; w < 8; ++w) tot += PART[w * 64 + 16 * tb + ql];
            const float rs = __builtin_amdgcn_rsqf(tot * (1.f / 256.f) + 1e-6f);
#pragma unroll
            for (int db = 0; db < 2; ++db) {
                const int col = h * 256 + 16 * (2 * wave + db) + 4 * G;
                const u32x2 gc = *(const u32x2*)(Z + (tok0 + 16 * tb + ql) * OD_Z + 2048 + col);
                const f32x4 o = oacc[db][tb];
                const f32x4 hn = *(const f32x4*)(head_norm + col);
                u32x2 y; y[0] = cvtpk(o[0] * rs * hn[0] * fast_silu(bflo(gc[0])), o[1] * rs * hn[1] * fast_silu(bfhi(gc[0])));
                y[1] = cvtpk(o[2] * rs * hn[2] * fast_silu(bflo(gc[1])), o[3] * rs * hn[3] * fast_silu(bfhi(gc[1])));
                *(u32x2*)(Y + (tok0 + 16 * tb + ql) * DM + col) = y;
            }
        }
        if (c < 31) gla2_storeB(sb, nbuf, tid);
        __syncthreads();
    }
}
#define OPT_ATTN 1
#define OPT_LRU 1
#define OPT_GLA 1
constexpr int NWAVES = 8;
constexpr size_t MiB = 1u << 20;
constexpr size_t WS_CTL = 0, CTL_ZERO_BYTES = 1 * MiB;
constexpr size_t WS_WEVIN = 2 * MiB;
constexpr size_t WS_WEVOUT = 66 * MiB;
constexpr size_t WS_WODIN = 82 * MiB;
constexpr size_t WS_WODOUT = 130 * MiB;
constexpr size_t WS_WALR = 146 * MiB;
constexpr size_t WS_WGATE = 147 * MiB;
constexpr size_t WS_X = 150 * MiB;
constexpr size_t WS_XG = 214 * MiB;
constexpr size_t WS_Z = 246 * MiB;
constexpr size_t WS_Y = 374 * MiB;
constexpr size_t WS_ALR = 406 * MiB;
constexpr size_t WS_SUMP = 406 * MiB + 512 * 1024;
constexpr size_t WS_T0 = 408 * MiB;
constexpr size_t WS_T1 = 456 * MiB;
constexpr size_t WS_END = 504 * MiB;
constexpr int CW_BAR = 4096;
constexpr int MAX_LAUNCH = 8;
static_assert((CW_BAR + MAX_LAUNCH * XCD_BAR_WORDS) * 4 <= (int)CTL_ZERO_BYTES, "ctl map");
constexpr int RING_OFF = 0, RING_BYTES = 131072;
constexpr int LDSCTL_OFF = 159744, MISC_OFF = LDSCTL_OFF + 320;
constexpr int LDS_BYTES = 163840;
static_assert(G1_LDS_END <= LDSCTL_OFF && G2_LDS_END <= LDSCTL_OFF && AT_LDS_END <= LDSCTL_OFF && LR_LDS_END <= LDSCTL_OFF && SGU_W_OFF + 128 * SGU_W_STRIDE <= LDSCTL_OFF, "LDS map");

constexpr int PH_PROLOGUE = 0, PH_FINAL = 17, N_PHASES = 18;

struct Args {
    const float* in[21]; float* out; unsigned char* ws;
    const float* gn[4];
    const float* xold[4];
    int ph_lo, ph_hi, li, pad;
};
#define CAS __attribute__((address_space(4)))
template <class T> __device__ __forceinline__ T* karg(const CAS char* ka, int byte_off) { T* p = *(T* const CAS*)(ka + byte_off); return (T*)(__attribute__((address_space(1))) T*)p; }
#define KIN(k) karg<const float>(ka_, 8 * (k))

__device__ __forceinline__ float wave_sum(float v) {
#pragma unroll
    for (int o = 1; o < 64; o <<= 1) v += __shfl_xor(v, o);
    return v;
}
__device__ __forceinline__ void p0_transpose_item(const float* W, int K, int ldw, int nblk, bf16* WT, int skip_at, int skip, LAS float* scr, int item, int lane) {
    const int kb = item / nblk, nb = item % nblk, k0 = 64 * kb, n0 = 32 * nb, s0 = n0 + (n0 >= skip_at ? skip : 0);
#pragma unroll 8
    for (int i = 0; i < 32; ++i) { const int kk = 2 * i + (lane >> 5); scr[kk * 33 + (lane & 31)] = W[(size_t)(k0 + kk) * ldw + s0 + (lane & 31)]; }
    LDS_WAIT(); asm volatile("" ::: "memory");
    const int c = lane & 7;
#pragma unroll
    for (int j = 0; j < 4; ++j) { const int n = (lane >> 3) + 8 * j; const LAS float* s = scr + (8 * c) * 33 + n;
        v4u o; o.x = pk2(s[0 * 33], s[1 * 33]); o.y = pk2(s[2 * 33], s[3 * 33]); o.z = pk2(s[4 * 33], s[5 * 33]); o.w = pk2(s[6 * 33], s[7 * 33]);
        *(GAS v4u*)(WT + (size_t)(n0 + n) * K + k0 + 8 * c) = o; }
    LDS_WAIT(); asm volatile("" ::: "memory");
}

__global__ void __launch_bounds__(NWAVES * 64, 2) mk_fwd(Args args) {
    extern __shared__ __attribute__((aligned(16))) unsigned char lds_raw[];
    LAS unsigned char* lds = (LAS unsigned char*)lds_raw;
    volatile LAS unsigned* MISC = (volatile LAS unsigned*)(lds + MISC_OFF);
    const int G0 = gridDim.x;
    unsigned char* ws = args.ws;
    unsigned* ctl = (unsigned*)(ws + WS_CTL);
    float* SUMP = (float*)(ws + WS_SUMP);
    for (int u = threadIdx.x; u < (LDS_BYTES - LDSCTL_OFF) / 4; u += NWAVES * 64) ((LAS unsigned*)(lds + LDSCTL_OFF))[u] = 0u;
    __syncthreads();
    XcdBarrier bar = xcd_barrier_post(ctl + CW_BAR + args.li * XCD_BAR_WORDS, MISC + 8);

    float* X = (float*)(ws + WS_X); bf16* XG = (bf16*)(ws + WS_XG); bf16* Z = (bf16*)(ws + WS_Z); bf16* Y = (bf16*)(ws + WS_Y);
    float* ALR = (float*)(ws + WS_ALR);

    for (int ph = args.ph_lo; ph < args.ph_hi; ++ph) {
        if (ph > args.ph_lo) xcd_barrier(bar);
        int tid = threadIdx.x; asm volatile("" : "+v"(tid));
        int G = G0; asm volatile("" : "+s"(G));
        const int lane = tid & 63, wave = __builtin_amdgcn_readfirstlane(tid >> 6);
        const CAS char* ka_ = (const CAS char*)__builtin_amdgcn_kernarg_segment_ptr(); asm volatile("" : "+s"(ka_));
        const float* x_in = KIN(0);
        if (ph == PH_PROLOGUE) {
            LAS float* scr = (LAS float*)(lds + RING_OFF + wave * 16384);
            const int gw = blockIdx.x * NWAVES + wave, NGW = G * NWAVES;
            constexpr int I_EVIN = 32 * 256, I_EVOUT = 32 * 64, I_ODIN = 32 * 192, I_ODOUT = 32 * 64, I_GATE = 2 * 4;
            constexpr int NITEMS = 2 * (I_EVIN + I_EVOUT + I_ODIN + I_ODOUT) + 2 * 12 * 2 * I_GATE;
            for (int it = gw; it < NITEMS; it += NGW) {
                int r = it;
                if (r < 2 * I_EVIN) { const int i = r / I_EVIN; p0_transpose_item(KIN(2) + (size_t)i * DM * EV_IN, DM, EV_IN, 256, (bf16*)(ws + WS_WEVIN) + (size_t)i * EV_IN * DM, 1 << 30, 0, scr, r % I_EVIN, lane); continue; } r -= 2 * I_EVIN;
                if (r < 2 * I_EVOUT) { const int i = r / I_EVOUT; p0_transpose_item(KIN(10) + (size_t)i * DM * DM, DM, DM, 64, (bf16*)(ws + WS_WEVOUT) + (size_t)i * DM * DM, 1 << 30, 0, scr, r % I_EVOUT, lane); continue; } r -= 2 * I_EVOUT;
                if (r < 2 * I_ODIN) { const int i = r / I_ODIN; p0_transpose_item(KIN(12) + (size_t)i * DM * OD_IN, DM, OD_IN, 192, (bf16*)(ws + WS_WODIN) + (size_t)i * OD_Z * DM, 2048, 16, scr, r % I_ODIN, lane); continue; } r -= 2 * I_ODIN;
                if (r < 2 * I_ODOUT) { const int i = r / I_ODOUT; p0_transpose_item(KIN(19) + (size_t)i * DM * DM, DM, DM, 64, (bf16*)(ws + WS_WODOUT) + (size_t)i * DM * DM, 1 << 30, 0, scr, r % I_ODOUT, lane); continue; } r -= 2 * I_ODOUT;
                { const int mat = r / I_GATE, li2 = mat / 24, h = (mat % 24) >> 1, gate = mat & 1;
                  const float* src = KIN(gate ? 7 : 5) + ((size_t)li2 * 12 + h) * 128 * 128;
                  p0_transpose_item(src, 128, 128, 4, (bf16*)(ws + WS_WGATE) + (size_t)mat * 128 * 128, 1 << 30, 0, scr, r % I_GATE, lane); }
            }
            for (int e = blockIdx.x * 512 + tid; e < 2 * 16 * 2048; e += G * 512) { const int i = e >> 15, j = (e >> 11) & 15, k = e & 2047;
                ((bf16*)(ws + WS_WALR))[e] = (bf16)f2bf(KIN(12)[(size_t)i * DM * OD_IN + (size_t)k * OD_IN + 2048 + j]); }
            const float* g0 = KIN(1);
            for (int m = gw; m < MTOK; m += NGW) {
                const f32x4* xr = (const f32x4*)(x_in + (size_t)m * DM) + lane; float s = 0.f;
                unsigned long long* o8 = (unsigned long long*)(XG + (size_t)m * DM) + lane;
#pragma unroll
                for (int j = 0; j < 8; ++j) { const f32x4 v = xr[64 * j]; const f32x4 gg = ((const f32x4*)g0)[lane + 64 * j];
                    s += (v[0] * v[0] + v[1] * v[1]) + (v[2] * v[2] + v[3] * v[3]);
                    o8[64 * j] = (unsigned long long)pk2(v[0] * gg[0], v[1] * gg[1]) | ((unsigned long long)pk2(v[2] * gg[2], v[3] * gg[3]) << 32); }
                s = wave_sum(s);
                if (lane < 8) SUMP[(size_t)m * 8 + lane] = (lane == 0) ? s : 0.f;
            }
        } else if (ph == PH_FINAL) {
            const int gw = blockIdx.x * NWAVES + wave, NGW = G * NWAVES;
            const float* gf = KIN(20);
            for (int m = gw; m < MTOK; m += NGW) {
                const f32x4 p0 = *(const f32x4*)(SUMP + ((size_t)4 * 8192 + m) * 8), p1 = *(const f32x4*)(SUMP + ((size_t)4 * 8192 + m) * 8 + 4);
                const float rs = __builtin_amdgcn_rsqf((((p0[0] + p0[1]) + (p0[2] + p0[3])) + ((p1[0] + p1[1]) + (p1[2] + p1[3]))) * (1.0f / 2048.0f) + 1e-6f);
                const f32x4* xr = (const f32x4*)(X + (size_t)m * DM) + lane; f32x4* o = (f32x4*)(args.out + (size_t)m * DM) + lane;
#pragma unroll
                for (int j = 0; j < 8; ++j) { const f32x4 v = xr[64 * j]; const f32x4 gg = ((const f32x4*)gf)[lane + 64 * j]; o[64 * j] = v * gg * rs; }
            }
        } else {
            const int L = (ph - 1) >> 2, sub = (ph - 1) & 3, i = L >> 1, odd = L & 1;
            if (sub == 0) {
                const int N = odd ? OD_Z : EV_IN;
                const bf16* Wt = (const bf16*)(ws + (odd ? WS_WODIN : WS_WEVIN)) + (size_t)i * N * DM;
                pg8::Gemm g{XG, Wt, MTOK, N, DM}; pg8::StaticOrder S; S.init(MTOK, N, G, (int)blockIdx.x);
                pg8::EpiIn E{Z, N, SUMP + (size_t)L * 8192 * 8};
                pg8::gemm_phase<pg8::EpiIn, pg8::StaticOrder, true, true>(lds + RING_OFF, g, S, E);
                if (odd) {
                    const bf16* WA = (const bf16*)(ws + WS_WALR) + (size_t)i * 16 * 2048;
                    for (int rb0 = blockIdx.x * 32; rb0 < MTOK; rb0 += G * 32) {
                        const int rb = wave & 1, kq = wave >> 1, fr = lane & 15, fq = lane >> 4;
                        const bf16* ap = XG + (size_t)(rb0 + 16 * rb + fr) * DM + kq * 512 + 8 * fq;
                        const bf16* bp = WA + (size_t)fr * DM + kq * 512 + 8 * fq;
                        f32x4 acc = {0.f, 0.f, 0.f, 0.f};
#pragma unroll 8
                        for (int ks = 0; ks < 16; ++ks) { const bf16x8 a = *(const bf16x8*)(ap + ks * 32), b = *(const bf16x8*)(bp + ks * 32);
                            acc = __builtin_amdgcn_mfma_f32_16x16x32_bf16(a, b, acc, 0, 0, 0); }
                        LAS float* part = (LAS float*)(lds + RING_OFF);
#pragma unroll
                        for (int r = 0; r < 4; ++r) part[(kq * 32 + 16 * rb + 4 * fq + r) * 16 + fr] = acc[r];
                        __syncthreads();
                        { const int row = tid >> 4, j = tid & 15;
                          const float s = (part[(0 * 32 + row) * 16 + j] + part[(1 * 32 + row) * 16 + j]) + (part[(2 * 32 + row) * 16 + j] + part[(3 * 32 + row) * 16 + j]);
                          const float* sp_ = SUMP + ((size_t)L * 8192 + rb0 + row) * 8; const f32x4 p0 = *(const f32x4*)sp_, p1 = *(const f32x4*)(sp_ + 4);
                          const float rs = __builtin_amdgcn_rsqf((((p0[0] + p0[1]) + (p0[2] + p0[3])) + ((p1[0] + p1[1]) + (p1[2] + p1[3]))) * (1.0f / 2048.0f) + 1e-6f);
                          ALR[(size_t)(rb0 + row) * 16 + j] = s * rs; }
                        __syncthreads();
                    }
                }
            } else if (sub == 3) {
                const bf16* Wt = (const bf16*)(ws + (odd ? WS_WODOUT : WS_WEVOUT)) + (size_t)i * DM * DM;
                const float* gn = karg<const float>(ka_, (int)offsetof(Args, gn) + 8 * L);
                const float* xo = karg<const float>(ka_, (int)offsetof(Args, xold) + 8 * L);
                pg8::Gemm g{Y, Wt, MTOK, DM, DM}; pg8::StaticOrder S; S.init(MTOK, DM, G, (int)blockIdx.x);
                pg8::EpiOut E{xo, X, XG, gn, SUMP + (size_t)(L + 1) * 8192 * 8, L < 3 ? 1 : 0, (LAS float*)(lds + RING_BYTES)};
                pg8::gemm_phase<pg8::EpiOut, pg8::StaticOrder, true, true>(lds + RING_OFF, g, S, E);
            }
            else if (sub == 1 && !odd) {
#ifdef OPT_LRU
                { LruParams P{KIN(3) + (size_t)i * 4 * LRU_W, KIN(4) + (size_t)i * LRU_W, KIN(6) + (size_t)i * LRU_W, KIN(8) + (size_t)i * LRU_W, KIN(9) + (size_t)i * LRU_W,
                              (const bf16*)(ws + WS_WGATE) + (size_t)i * 12 * 2 * 128 * 128};
                  for (int item = blockIdx.x; item < 192; item += G) lru_item(lds, item, Z, P, Y, tid); }
#endif
#ifdef OPT_ATTN
                for (int item = blockIdx.x; item < 768; item += G) attn_item(lds, item, Z, (bf16*)(ws + WS_T0), (float*)(ws + WS_T1), tid);
#endif
            } else if (sub == 2 && !odd) {
#ifdef OPT_ATTN
                attn_merge(Z, (const bf16*)(ws + WS_T0), (const float*)(ws + WS_T1), Y, blockIdx.x * 512 + tid, G * 512);
#endif
            }
            else if (sub == 1 && odd) {
#ifdef OPT_GLA
                const float* wal = KIN(13) + (size_t)i * 16 * 512; const float* bal = KIN(14) + (size_t)i * 512;
                for (int item = blockIdx.x; item < 512; item += G)
                    gla1_item(lds, item, Z, ALR, wal, bal, (bf16*)(ws + WS_T0), (bf16*)(ws + WS_T0 + 8 * MiB), (bf16*)(ws + WS_T0 + 16 * MiB), (float*)(ws + WS_T0 + 32 * MiB), tid);
#endif
            }
            else if (sub == 2 && odd) {
#ifdef OPT_GLA
                if (blockIdx.x < 16) {
                    gla2_item(lds, blockIdx.x, Z, (const bf16*)(ws + WS_T0), (const bf16*)(ws + WS_T0 + 8 * MiB), (const bf16*)(ws + WS_T0 + 16 * MiB), (const float*)(ws + WS_T0 + 32 * MiB),
                              KIN(15) + (size_t)i * 1024, Y, tid);
                } else {
                    const float* vn = KIN(16) + (size_t)i * 1024; const float* wsg = KIN(17) + (size_t)i * 4 * 128 * 128; const float* bsg = KIN(18) + (size_t)i * 4 * 128;
                    for (int item = blockIdx.x - 16; item < 256; item += G - 16) sgu_item(lds, item, Z, vn, wsg, bsg, Y, tid);
                }
            }
            else if (sub == 2 && odd && false) {
#endif
                const float* vn = KIN(16) + (size_t)i * 1024; const float* wsg = KIN(17) + (size_t)i * 4 * 128 * 128; const float* bsg = KIN(18) + (size_t)i * 4 * 128;
                for (int item = blockIdx.x; item < 256; item += G) sgu_item(lds, item, Z, vn, wsg, bsg, Y, tid);
            }
        }
    }
}

#define OPT_SGU 1
constexpr int OPT_EVEN_LO = 2, OPT_ODD_LO = 2;
static void launch_mk(Args& a, int lo, int hi, int li, int grid, hipStream_t stream) {
    a.ph_lo = lo; a.ph_hi = hi; a.li = li;
    hipLaunchKernelGGL(mk_fwd, dim3(grid), dim3(NWAVES * 64), LDS_BYTES, stream, a);
}
extern "C" void kernel_launch(void* const* d_in, const int* in_sizes, int n_in, void* d_out, int out_size, void* d_ws, size_t ws_size, hipStream_t stream) {
    static int grid = 0;
    if (grid == 0) {
        if (n_in != 21 || ws_size < WS_END) { fprintf(stderr, "kernel_launch: unexpected n_in %d / ws_size %zu\n", n_in, ws_size); grid = -1; return; }
        int dev = 0, cus = 0, per_cu = 0;
        if (hipGetDevice(&dev) != hipSuccess || hipDeviceGetAttribute(&cus, hipDeviceAttributeMultiprocessorCount, dev) != hipSuccess) { grid = -1; return; }
        if (hipFuncSetAttribute((const void*)mk_fwd, hipFuncAttributeMaxDynamicSharedMemorySize, LDS_BYTES) != hipSuccess) { fprintf(stderr, "kernel_launch: hipFuncSetAttribute failed\n"); grid = -1; return; }
        if (hipOccupancyMaxActiveBlocksPerMultiprocessor(&per_cu, (const void*)mk_fwd, NWAVES * 64, LDS_BYTES) != hipSuccess || per_cu < 1) { fprintf(stderr, "kernel_launch: occupancy query says %d\n", per_cu); }
        (void)hipGetLastError();
        grid = cus;
    }
    if (grid < 0) return;
    hipMemsetAsync((char*)d_ws + WS_CTL, 0, CTL_ZERO_BYTES, stream);
    Args a{};
    for (int i = 0; i < 21; ++i) a.in[i] = (const float*)d_in[i];
    a.out = (float*)d_out; a.ws = (unsigned char*)d_ws;
    a.gn[0] = a.in[11]; a.gn[1] = a.in[1] + DM; a.gn[2] = a.in[11] + DM; a.gn[3] = a.in[20];
    a.xold[0] = a.in[0]; a.xold[1] = a.xold[2] = a.xold[3] = (const float*)((char*)d_ws + WS_X);
    const float *ev_conv_w = a.in[3], *ev_conv_b = a.in[4], *ev_w_a = a.in[5], *ev_b_a = a.in[6], *ev_w_i = a.in[7], *ev_b_i = a.in[8], *ev_lam = a.in[9];
    const float *od_w_alpha = a.in[13], *od_b_alpha = a.in[14], *od_head_norm = a.in[15], *od_v_norm = a.in[16], *od_w_s = a.in[17], *od_b_s = a.in[18];
    char* ws = (char*)d_ws;
    bf16* Z = (bf16*)(ws + WS_Z); bf16* Y = (bf16*)(ws + WS_Y); float* ALR = (float*)(ws + WS_ALR); float* T0 = (float*)(ws + WS_T0); float* T1 = (float*)(ws + WS_T1);
    int li = 0;
#ifdef BISECT_PROLOGUE_ONLY
    launch_mk(a, 0, 1, li++, grid, stream); return;
#endif
    launch_mk(a, 0, 2, li++, grid, stream);
#ifdef BISECT_P01
    return;
#endif
    for (int L = 0; L < 4; ++L) {
        const int i = L >> 1;
        if ((L & 1) == 0) {
#ifndef OPT_LRU
            nv_lru_gates<<<dim3(MTOK, 12), 128, 0, stream>>>(Z, ev_conv_w + (size_t)i * 4 * LRU_W, ev_conv_b + (size_t)i * LRU_W, ev_w_a + (size_t)i * 12 * 128 * 128, ev_b_a + (size_t)i * LRU_W,
                                                             ev_w_i + (size_t)i * 12 * 128 * 128, ev_b_i + (size_t)i * LRU_W, ev_lam + (size_t)i * LRU_W, T0, T1);
            nv_lru_scan<<<(NB * LRU_W + 255) / 256, 256, 0, stream>>>(T0, T1, Z, Y);
#endif
#ifndef OPT_ATTN
            nv_attn<<<dim3(MTOK, 4), 256, 0, stream>>>(Z, Y);
#endif
        } else {
#ifndef OPT_GLA
            nv_gla<<<16, 256, 0, stream>>>(Z, ALR, od_w_alpha + (size_t)i * 16 * 512, od_b_alpha + (size_t)i * 512, od_head_norm + (size_t)i * 1024, Y);
#endif
#ifndef OPT_SGU
            nv_sgu_ln<<<dim3(MTOK, 4), 256, 0, stream>>>(Z, od_v_norm + (size_t)i * 1024, T0);
            nv_sgu_mix<<<dim3(MTOK, 4), 256, 0, stream>>>(Z, T0, od_w_s + (size_t)i * 4 * 128 * 128, od_b_s + (size_t)i * 4 * 128, Y);
#endif
        }
#ifdef BISECT_STOP_MIX
        if (L == BISECT_STOP_MIX) return;
#endif
        launch_mk(a, ((L & 1) ? OPT_ODD_LO : OPT_EVEN_LO) + 4 * L, (L < 3) ? 6 + 4 * L : 18, li++, grid, stream);
#ifdef BISECT_STOP_MK
        if (L == BISECT_STOP_MK) return;
#endif
    }
}
```

```cpp
#include <hip/hip_runtime.h>
#include <cstdio>
#include <cstdint>

constexpr int DM = 2048, NB = 4, SEQ = 2048, MTOK = NB * SEQ;
constexpr int LRU_W = 1536, EV_IN = 8192;
constexpr int OD_IN = 6160, OD_Z = 6144;
constexpr float EPS = 1e-6f;

typedef unsigned short bf16;
typedef bf16 AT;

__device__ __forceinline__ float bf2f(bf16 v) { return __uint_as_float((unsigned)v << 16); }
__device__ __forceinline__ unsigned f2bf(float f) { unsigned u = __builtin_bit_cast(unsigned, f); return (u + 0x7fffu + ((u >> 16) & 1u)) >> 16; }
__device__ __forceinline__ unsigned pk2(float lo, float hi) { return f2bf(lo) | (f2bf(hi) << 16); }
__device__ __forceinline__ float ldA(const bf16* p, size_t i) { return bf2f(p[i]); }
__device__ __forceinline__ void stA(bf16* p, size_t i, float v) { p[i] = (bf16)f2bf(v); }

__device__ __forceinline__ float sigmoidf_(float x) { return 1.f / (1.f + __expf(-x)); }
__device__ __forceinline__ float siluf_(float x) { return x * sigmoidf_(x); }
__device__ __forceinline__ float geluf_(float x) { return 0.5f * x * (1.f + tanhf(0.7978845608028654f * (x + 0.044715f * x * x * x))); }
__device__ __forceinline__ float softplusf_(float x) { return x > 20.f ? x : log1pf(__expf(x)); }
__device__ __forceinline__ float logsigmoidf_(float x) { return -softplusf_(-x); }

__device__ __forceinline__ float block_sum(float v, float* red) {
#pragma unroll
    for (int o = 32; o > 0; o >>= 1) v += __shfl_xor(v, o);
    const int w = threadIdx.x >> 6, nw = blockDim.x >> 6;
    __syncthreads();
    if ((threadIdx.x & 63) == 0) red[w] = v;
    __syncthreads();
    float s = 0.f;
    for (int i = 0; i < nw; ++i) s += red[i];
    return s;
}
__device__ __forceinline__ float block_max(float v, float* red) {
#pragma unroll
    for (int o = 32; o > 0; o >>= 1) v = fmaxf(v, __shfl_xor(v, o));
    const int w = threadIdx.x >> 6, nw = blockDim.x >> 6;
    __syncthreads();
    if ((threadIdx.x & 63) == 0) red[w] = v;
    __syncthreads();
    float s = -INFINITY;
    for (int i = 0; i < nw; ++i) s = fmaxf(s, red[i]);
    return s;
}

__global__ void __launch_bounds__(128) nv_lru_gates(const AT* z, const float* conv_w, const float* conv_b, const float* w_a, const float* b_a, const float* w_i, const float* b_i,
                                                    const float* lam, float* a_out, float* u_out) {
    __shared__ float xc[128];
    const int tok = blockIdx.x, h = blockIdx.y, j = threadIdx.x, t = tok % SEQ, ch = h * 128 + j;
    float v = conv_b[ch];
    for (int q = 0; q < 4; ++q) { const int tt = t + q - 3; if (tt >= 0) v += ldA(z, (size_t)(tok + q - 3) * EV_IN + ch) * conv_w[q * LRU_W + ch]; }
    xc[j] = v; __syncthreads();
    float ra = b_a[ch], ri = b_i[ch];
    const float* wa = w_a + (size_t)h * 128 * 128; const float* wi = w_i + (size_t)h * 128 * 128;
    for (int i = 0; i < 128; ++i) { ra += xc[i] * wa[i * 128 + j]; ri += xc[i] * wi[i * 128 + j]; }
    const float r = sigmoidf_(ra), ig = sigmoidf_(ri);
    const float log_a = -8.0f * r * softplusf_(-lam[ch]);
    const float a = __expf(log_a);
    const float u = sqrtf(-expm1f(2.f * log_a)) * (ig * v);
    a_out[(size_t)tok * LRU_W + ch] = a; u_out[(size_t)tok * LRU_W + ch] = u;
}
__global__ void __launch_bounds__(256) nv_lru_scan(const float* a, const float* u, const AT* z, AT* y) {
    const int idx = blockIdx.x * 256 + threadIdx.x; if (idx >= NB * LRU_W) return;
    const int b = idx / LRU_W, ch = idx % LRU_W; float h = 0.f;
    for (int t = 0; t < SEQ; ++t) { const size_t tok = (size_t)b * SEQ + t; h = a[tok * LRU_W + ch] * h + u[tok * LRU_W + ch];
        stA(y, tok * DM + ch, h * siluf_(ldA(z, tok * EV_IN + LRU_W + ch))); }
}
__global__ void __launch_bounds__(256) nv_attn(const AT* z, AT* y) {
    __shared__ float qs[128], ps[132], red[16], og[3][128], lse[3];
    const int tok = blockIdx.x, j = blockIdx.y, t = tok % SEQ, tid = threadIdx.x;
    for (int g = 0; g < 3; ++g) {
        const int d = 1 << (2 * g);
        const float slope = exp2f(-8.0f * (float)(g + 3 * j + 1) / 12.0f);
        const size_t qoff = 3072 + g * 512 + j * 128, koff = 4608 + g * 512 + j * 128, voff = 6144 + g * 512 + j * 128;
        __syncthreads();
        if (tid < 128) qs[tid] = ldA(z, (size_t)tok * EV_IN + qoff + tid);
        __syncthreads();
        float s = -INFINITY;
        if (tid <= 128 && t - tid * d >= 0) {
            const AT* kr = z + (size_t)(tok - tid * d) * EV_IN + koff; float acc = 0.f;
            for (int e = 0; e < 128; ++e) acc += qs[e] * ldA(kr, e);
            s = acc * 0.08838834764831845f - slope * (float)(tid * d);
        }
        const float m = block_max(s, red);
        const float p = (s == -INFINITY) ? 0.f : __expf(s - m);
        if (tid <= 128) ps[tid] = p;
        const float den = block_sum(p, red);
        __syncthreads();
        if (tid < 128) { float o = 0.f;
            for (int i = 0; i <= 128; ++i) { if (t - i * d < 0) break; o += ps[i] * ldA(z, (size_t)(tok - i * d) * EV_IN + voff + tid); }
            og[g][tid] = o / den; }
        if (tid == 0) lse[g] = m + __logf(den);
    }
    __syncthreads();
    if (tid < 128) {
        const float mm = fmaxf(lse[0], fmaxf(lse[1], lse[2]));
        const float w0 = __expf(lse[0] - mm), w1 = __expf(lse[1] - mm), w2 = __expf(lse[2] - mm);
        const float yv = (w0 * og[0][tid] + w1 * og[1][tid] + w2 * og[2][tid]) / (w0 + w1 + w2);
        stA(y, (size_t)tok * DM + LRU_W + j * 128 + tid, yv * siluf_(ldA(z, (size_t)tok * EV_IN + 7680 + j * 128 + tid)));
    }
}

__global__ void __launch_bounds__(256) nv_gla(const AT* z, const float* alr, const float* w_alpha, const float* b_alpha, const float* head_norm, AT* y) {
    __shared__ float qs[128], ks[128], al[128], ar[16], red[16];
    const int b = blockIdx.x >> 2, h = blockIdx.x & 3, v = threadIdx.x;
    float S[128];
#pragma unroll
    for (int e = 0; e < 128; ++e) S[e] = 0.f;
    for (int t = 0; t < SEQ; ++t) {
        const size_t tok = (size_t)b * SEQ + t;
        __syncthreads();
        if (v < 16) ar[v] = alr[tok * 16 + v];
        if (v < 128) { qs[v] = ldA(z, tok * OD_Z + h * 128 + v) * 0.08838834764831845f; ks[v] = ldA(z, tok * OD_Z + 512 + h * 128 + v); }
        __syncthreads();
        if (v < 128) { float s = b_alpha[h * 128 + v];
            for (int r = 0; r < 16; ++r) s += ar[r] * w_alpha[r * 512 + h * 128 + v];
            al[v] = __expf(logsigmoidf_(s) * (1.f / 16.f)); }
        __syncthreads();
        const float vv = ldA(z, tok * OD_Z + 1024 + h * 256 + v);
        float o = 0.f;
#pragma unroll
        for (int e = 0; e < 128; ++e) { S[e] = al[e] * S[e] + ks[e] * vv; o += qs[e] * S[e]; }
        const float ss = block_sum(o * o, red);
        const float r = rsqrtf(ss / 256.f + EPS);
        stA(y, tok * DM + h * 256 + v, o * r * head_norm[h * 256 + v] * siluf_(ldA(z, tok * OD_Z + 2048 + h * 256 + v)));
    }
}
__global__ void __launch_bounds__(256) nv_sgu_ln(const AT* z, const float* v_norm, float* vf) {
    __shared__ float red[16];
    const int tok = blockIdx.x, g = blockIdx.y, e = threadIdx.x;
    const float val = geluf_(ldA(z, (size_t)tok * OD_Z + 4096 + g * 256 + e));
    const float mu = block_sum(val, red) / 256.f;
    const float dv = val - mu;
    const float var = block_sum(dv * dv, red) / 256.f;
    vf[(size_t)tok * 1024 + g * 256 + e] = dv * rsqrtf(var + EPS) * v_norm[g * 256 + e];
}
__global__ void __launch_bounds__(256) nv_sgu_mix(const AT* z, const float* vf, const float* w_s, const float* b_s, AT* y) {
    const int tok = blockIdx.x, g = blockIdx.y, e = threadIdx.x, t = tok % 128, base = tok - t;
    float acc = b_s[g * 128 + t];
    const float* w = w_s + ((size_t)g * 128 + t) * 128;
    for (int s = 0; s <= t; ++s) acc += w[s] * vf[(size_t)(base + s) * 1024 + g * 256 + e];
    const float u = geluf_(ldA(z, (size_t)tok * OD_Z + 3072 + g * 256 + e));
    stA(y, (size_t)tok * DM + 1024 + g * 256 + e, u * acc * siluf_(ldA(z, (size_t)tok * OD_Z + 5120 + g * 256 + e)));
}
namespace pg8 {
#define PG8_LAS __attribute__((address_space(3)))
typedef unsigned short bf16_t;
typedef short bf16x8 __attribute__((ext_vector_type(8)));
typedef float f32x4 __attribute__((ext_vector_type(4)));
typedef unsigned u32x4 __attribute__((ext_vector_type(4)));
constexpr int BM = 256, BK = 64, HALF = 128, HTB = HALF * BK * 2  , STAGE_BYTES = 8 * HTB, NXCD = 8, WGM = 8;

__host__ __device__ __forceinline__ int lds_byte(int r, int c) { const int st = (r >> 4) * 2 + (c >> 5), rr = r & 15, cc = c & 31, ob = rr * 64 + cc * 2; return st * 1024 + (ob ^ (((ob >> 9) & 1) << 5)); }
__host__ __device__ __forceinline__ void stage_rc(int b, int& R, int& C) { const int st = b / 1024, sb = b % 1024, swz = sb ^ (((sb >> 9) & 1) << 5); R = (st >> 1) * 16 + swz / 64; C = (st & 1) * 32 + (swz % 64) / 2; }
__host__ __device__ __forceinline__ int perm32(int rho) { const int n = rho >> 4, i = rho & 15; return 8 * (i >> 2) + 4 * n + (i & 3); }

struct Unit { int pm, pn; };
struct Gemm { const bf16_t* A; const bf16_t* Bt; int M, N, K; };

struct StaticOrder {
    int nM, nN, nwg, G, c;
    __host__ __device__ void init(int M, int N, int G_, int c_) { nM = M / BM; nN = N / BM; nwg = nM * nN; G = G_; c = c_; }
    __host__ __device__ bool next(int i, Unit& u) const {
        const long L = (long)i * G + c; if (L >= nwg) return false;
        int wgid = (int)L; { const int q = nwg / NXCD, r = nwg % NXCD, xcd = wgid % NXCD, off = wgid / NXCD; wgid = (xcd < r ? xcd * (q + 1) : r * (q + 1) + (xcd - r) * q) + off; }
        const int nig = WGM * nN, gid = wgid / nig, fm = gid * WGM, gsz = (nM - fm) < WGM ? (nM - fm) : WGM;
        u.pm = fm + ((wgid % nig) % gsz); u.pn = (wgid % nig) / gsz; return true;
    }
    __device__ __forceinline__ void a_ready(const Unit&) const {}
    __device__ __forceinline__ void done(const Unit&) const {}
};

__device__ __forceinline__ unsigned cvt_pk_bf16(float lo, float hi) { unsigned r; asm volatile("v_cvt_pk_bf16_f32 %0, %1, %2" : "=v"(r) : "v"(lo), "v"(hi)); return r; }
struct EpiIn {
    static constexpr bool PERM = true, AFTER_DRAIN = false;
    bf16_t* O; int ldc; const float* sump;
    __device__ __forceinline__ void operator()(const f32x4 (&acc)[2][2][4][2], const Unit& u, int wr, int wc, int fr, int fq) const {
        const int row0 = u.pm * BM + wr * 64 + fr, col0 = u.pn * BM + wc * 32 + 8 * fq;
#pragma unroll
        for (int ai = 0; ai < 2; ++ai)
#pragma unroll
            for (int m = 0; m < 4; ++m) { const int row = row0 + ai * HALF + m * 16;
                const f32x4 p0 = *(const f32x4*)(sump + (size_t)row * 8), p1 = *(const f32x4*)(sump + (size_t)row * 8 + 4);
                const float rs = __builtin_amdgcn_rsqf((((p0[0] + p0[1]) + (p0[2] + p0[3])) + ((p1[0] + p1[1]) + (p1[2] + p1[3]))) * (1.0f / 2048.0f) + 1e-6f);
                bf16_t* rowp = O + (size_t)row * ldc + col0;
#pragma unroll
                for (int bj = 0; bj < 2; ++bj) { const f32x4 v0 = acc[ai][bj][m][0] * rs, v1 = acc[ai][bj][m][1] * rs;
                    u32x4 w; w.x = cvt_pk_bf16(v0[0], v0[1]); w.y = cvt_pk_bf16(v0[2], v0[3]); w.z = cvt_pk_bf16(v1[0], v1[1]); w.w = cvt_pk_bf16(v1[2], v1[3]);
                    *(u32x4*)(rowp + bj * HALF) = w; } }
    }
};
struct EpiOut {
    static constexpr bool PERM = true, AFTER_DRAIN = false;
    const float* xold; float* xnew; bf16_t* xg; const float* g; float* sump_next; int write_xg; PG8_LAS float* xs;
    __device__ __forceinline__ void operator()(const f32x4 (&acc)[2][2][4][2], const Unit& u, int wr, int wc, int fr, int fq) const {
        const int row0 = u.pm * BM + wr * 64 + fr, col0 = u.pn * BM + wc * 32 + 8 * fq;
        f32x4 gv[2][2];
#pragma unroll
        for (int bj = 0; bj < 2; ++bj) { gv[bj][0] = *(const f32x4*)(g + col0 + bj * HALF); gv[bj][1] = *(const f32x4*)(g + col0 + bj * HALF + 4); }
#pragma unroll
        for (int ai = 0; ai < 2; ++ai)
#pragma unroll
            for (int m = 0; m < 4; ++m) { const int row = row0 + ai * HALF + m * 16; const size_t off = (size_t)row * 2048 + col0; float ss = 0.f;
#pragma unroll
                for (int bj = 0; bj < 2; ++bj) {
                    const f32x4 v0 = acc[ai][bj][m][0] + *(const f32x4*)(xold + off + bj * HALF), v1 = acc[ai][bj][m][1] + *(const f32x4*)(xold + off + bj * HALF + 4);
                    *(f32x4*)(xnew + off + bj * HALF) = v0; *(f32x4*)(xnew + off + bj * HALF + 4) = v1;
                    ss += (v0[0] * v0[0] + v0[1] * v0[1]) + (v0[2] * v0[2] + v0[3] * v0[3]) + (v1[0] * v1[0] + v1[1] * v1[1]) + (v1[2] * v1[2] + v1[3] * v1[3]);
                    if (write_xg) { const f32x4 a = v0 * gv[bj][0], b = v1 * gv[bj][1];
                        u32x4 w; w.x = cvt_pk_bf16(a[0], a[1]); w.y = cvt_pk_bf16(a[2], a[3]); w.z = cvt_pk_bf16(b[0], b[1]); w.w = cvt_pk_bf16(b[2], b[3]);
                        *(u32x4*)(xg + off + bj * HALF) = w; } }
                ss += __shfl_xor(ss, 16); ss += __shfl_xor(ss, 32);
                if (fq == 0) xs[(ai * HALF + wr * 64 + m * 16 + fr) * 4 + wc] = ss; }
        asm volatile("s_waitcnt lgkmcnt(0)" ::: "memory"); __builtin_amdgcn_s_barrier(); asm volatile("" ::: "memory");
        { const int t = threadIdx.x; if (t < 256) { const f32x4 p = *(const PG8_LAS f32x4*)(xs + 4 * t); sump_next[(size_t)(u.pm * BM + t) * 8 + u.pn] = (p[0] + p[1]) + (p[2] + p[3]); } }
    }
};
template <class Epi, class Sched, bool ALIGN_EPI = false, bool SP2 = false>
__device__ __forceinline__ void gemm_phase(PG8_LAS unsigned char* lds, const Gemm g, const Sched& S, const Epi& E) {
    int tid_op = threadIdx.x; asm volatile("" : "+v"(tid_op));
    const int tid = tid_op, wid = __builtin_amdgcn_readfirstlane(tid >> 6), lane = tid & 63, wr = wid >> 2, wc = wid & 3, fr = lane & 15, fq = lane >> 4;
    const int K = g.K, nt = K / BK;
    unsigned voffA[2], voffB[2];
#pragma unroll
    for (int i = 0; i < 2; ++i) { int R, C; stage_rc(tid * 16 + i * 8192, R, C); const int Rb = Epi::PERM ? ((R & ~31) + perm32(R & 31)) : R;
        voffA[i] = (unsigned)(R * K + C) * 2u; voffB[i] = (unsigned)(Rb * K + C) * 2u; }
    const size_t kstep = (size_t)(BK * 2);
    const size_t hstep = (size_t)HALF * K * 2;
    const size_t tstep = 2 * hstep;
    const unsigned ldsw = (unsigned)wid * 1024u;
    const int aoff = lds_byte(wr * 64 + fr, fq * 8), boff = lds_byte(wc * 32 + fr, fq * 8);
#define PG8_SA(b, h) (((b) * 2 + (h)) * HTB)
#define PG8_SB(b, h) ((4 + (b) * 2 + (h)) * HTB)
#define PG8_STAGE(bufoff, gbase, voff) do { _Pragma("unroll") for (int _i = 0; _i < 2; ++_i) \
        __builtin_amdgcn_global_load_lds((const unsigned*)((const char*)(gbase) + (voff)[_i]), (PG8_LAS unsigned*)(lds + (bufoff) + ldsw + _i * 8192), 16, 0, 0); } while (0)
#define PG8_LDA(dst, b, h) do { _Pragma("unroll") for (int m = 0; m < 4; ++m) _Pragma("unroll") for (int k = 0; k < 2; ++k) dst[m][k] = *(const PG8_LAS bf16x8*)(lds + PG8_SA(b, h) + aoff + m * 2048 + k * 1024); } while (0)
#define PG8_LDB(dst, b, h) do { _Pragma("unroll") for (int n = 0; n < 2; ++n) _Pragma("unroll") for (int k = 0; k < 2; ++k) dst[n][k] = *(const PG8_LAS bf16x8*)(lds + PG8_SB(b, h) + boff + n * 2048 + k * 1024); } while (0)
#define PG8_MMA(ai, bj, At, Bt) do { __builtin_amdgcn_s_setprio(1); _Pragma("unroll") for (int m = 0; m < 4; ++m) _Pragma("unroll") for (int n = 0; n < 2; ++n) _Pragma("unroll") for (int k = 0; k < 2; ++k) \
        acc[ai][bj][m][n] = __builtin_amdgcn_mfma_f32_16x16x32_bf16(Bt[n][k], At[m][k], acc[ai][bj][m][n], 0, 0, 0); __builtin_amdgcn_s_setprio(0); } while (0)
#define PG8_WAIT_V(n) asm volatile("s_waitcnt vmcnt(" #n ")" ::: "memory")
#define PG8_WAIT_L(n) asm volatile("s_waitcnt lgkmcnt(" #n ")" ::: "memory")
#define PG8_BAR __builtin_amdgcn_s_barrier()
#define PG8_SCHED __builtin_amdgcn_sched_barrier(0)
    Unit cur, nxt; int ui = 0;
    if (!S.next(0, cur)) return;
    f32x4 acc[2][2][4][2];
#pragma unroll
    for (int a = 0; a < 2; ++a)
#pragma unroll
        for (int b = 0; b < 2; ++b)
#pragma unroll
            for (int m = 0; m < 4; ++m)
#pragma unroll
                for (int n = 0; n < 2; ++n) acc[a][b][m][n] = (f32x4){0.f, 0.f, 0.f, 0.f};
    bf16x8 At[4][2], B0[2][2], B1[2][2];
    const char* cA = (const char*)g.A + (size_t)cur.pm * tstep; const char* cB = (const char*)g.Bt + (size_t)cur.pn * tstep;
    S.a_ready(cur);
    if constexpr (SP2) {
        PG8_STAGE(PG8_SB(0, 0), cB, voffB); PG8_STAGE(PG8_SB(0, 1), cB + hstep, voffB); PG8_STAGE(PG8_SA(0, 0), cA, voffA); PG8_STAGE(PG8_SA(0, 1), cA + hstep, voffA);
        if (wr == 1) PG8_BAR;
        PG8_WAIT_V(2); PG8_BAR;
        PG8_STAGE(PG8_SB(1, 0), cB + kstep, voffB); PG8_STAGE(PG8_SA(1, 0), cA + kstep, voffA); PG8_STAGE(PG8_SB(1, 1), cB + hstep + kstep, voffB);
        PG8_WAIT_V(6); PG8_BAR;
    } else {
        PG8_STAGE(PG8_SB(0, 0), cB, voffB); PG8_STAGE(PG8_SA(0, 0), cA, voffA); PG8_STAGE(PG8_SB(0, 1), cB + hstep, voffB); PG8_STAGE(PG8_SA(0, 1), cA + hstep, voffA);
        if (wr == 1) PG8_BAR;
        PG8_WAIT_V(4); PG8_BAR;
        PG8_STAGE(PG8_SB(1, 0), cB + kstep, voffB); PG8_STAGE(PG8_SA(1, 0), cA + kstep, voffA); PG8_STAGE(PG8_SB(1, 1), cB + hstep + kstep, voffB);
        PG8_WAIT_V(6); PG8_BAR;
    }
    for (;;) {
        const bool has_next = S.next(ui + 1, nxt);
        const char* nA = has_next ? (const char*)g.A + (size_t)nxt.pm * tstep : cA; const char* nB = has_next ? (const char*)g.Bt + (size_t)nxt.pn * tstep : cB;
        for (int t = 0; t < nt; t += 2) {
            const bool last = (t == nt - 2);
            const char* a1 = cA + (size_t)(t + 1) * kstep;
            const char* a2 = last ? nA : cA + (size_t)(t + 2) * kstep; const char* b2 = last ? nB : cB + (size_t)(t + 2) * kstep;
            const char* a3 = a2 + kstep; const char* b3 = b2 + kstep;
            if (last && has_next) S.a_ready(nxt);
            if constexpr (SP2) {
            PG8_LDB(B0, 0, 0); PG8_LDB(B1, 0, 1); PG8_SCHED; PG8_LDA(At, 0, 0); PG8_STAGE(PG8_SA(1, 1), a1 + hstep, voffA);
            PG8_WAIT_V(8); PG8_WAIT_L(0); PG8_BAR; PG8_MMA(0, 0, At, B0); PG8_MMA(0, 1, At, B1); PG8_BAR; PG8_SCHED;
            PG8_LDA(At, 0, 1); PG8_STAGE(PG8_SB(0, 0), b2, voffB); PG8_STAGE(PG8_SB(0, 1), b2 + hstep, voffB); PG8_STAGE(PG8_SA(0, 0), a2, voffA);
            PG8_WAIT_V(8); PG8_WAIT_L(0); PG8_BAR; PG8_MMA(1, 0, At, B0); PG8_MMA(1, 1, At, B1); PG8_BAR; PG8_SCHED;
            PG8_LDB(B0, 1, 0); PG8_LDB(B1, 1, 1); PG8_SCHED; PG8_LDA(At, 1, 0); PG8_STAGE(PG8_SA(0, 1), a2 + hstep, voffA);
            PG8_WAIT_V(8); PG8_WAIT_L(0); PG8_BAR; PG8_MMA(0, 0, At, B0); PG8_MMA(0, 1, At, B1); PG8_BAR; PG8_SCHED;
            PG8_LDA(At, 1, 1); PG8_STAGE(PG8_SB(1, 0), b3, voffB); PG8_STAGE(PG8_SB(1, 1), b3 + hstep, voffB); PG8_STAGE(PG8_SA(1, 0), a3, voffA);
            PG8_WAIT_V(8); PG8_WAIT_L(0); PG8_BAR; PG8_MMA(1, 0, At, B0); PG8_MMA(1, 1, At, B1); PG8_BAR; PG8_SCHED;
            } else {
            PG8_LDB(B0, 0, 0); PG8_SCHED; PG8_LDA(At, 0, 0); PG8_STAGE(PG8_SA(1, 1), a1 + hstep, voffA);
            PG8_WAIT_L(8); PG8_BAR; PG8_WAIT_L(0); PG8_MMA(0, 0, At, B0); PG8_BAR; PG8_SCHED;
            PG8_LDB(B1, 0, 1); PG8_STAGE(PG8_SB(0, 0), b2, voffB);
            PG8_BAR; PG8_WAIT_L(0); PG8_MMA(0, 1, At, B1); PG8_BAR;
            PG8_LDA(At, 0, 1); PG8_STAGE(PG8_SA(0, 0), a2, voffA);
            PG8_BAR; PG8_WAIT_L(0); PG8_MMA(1, 0, At, B0); PG8_BAR; PG8_SCHED;
            PG8_STAGE(PG8_SB(0, 1), b2 + hstep, voffB);
            PG8_WAIT_V(6); PG8_BAR; PG8_MMA(1, 1, At, B1); PG8_BAR;
            PG8_LDB(B0, 1, 0); PG8_SCHED; PG8_LDA(At, 1, 0); PG8_STAGE(PG8_SA(0, 1), a2 + hstep, voffA);
            PG8_WAIT_L(8); PG8_BAR; PG8_WAIT_L(0); PG8_MMA(0, 0, At, B0); PG8_BAR; PG8_SCHED;
            PG8_LDB(B1, 1, 1); PG8_STAGE(PG8_SB(1, 0), b3, voffB);
            PG8_BAR; PG8_WAIT_L(0); PG8_MMA(0, 1, At, B1); PG8_BAR;
            PG8_LDA(At, 1, 1); PG8_STAGE(PG8_SA(1, 0), a3, voffA);
            PG8_BAR; PG8_WAIT_L(0); PG8_MMA(1, 0, At, B0); PG8_BAR; PG8_SCHED;
            PG8_STAGE(PG8_SB(1, 1), b3 + hstep, voffB);
            PG8_WAIT_V(6); PG8_BAR; PG8_MMA(1, 1, At, B1); PG8_BAR;
            }
        }
        if constexpr (ALIGN_EPI) { if (wr == 0) PG8_BAR; }
        if constexpr (!Epi::AFTER_DRAIN) { E(acc, cur, wr, wc, fr, fq); S.done(cur); }
        if (!has_next) break;
#pragma unroll
        for (int a = 0; a < 2; ++a)
#pragma unroll
            for (int b = 0; b < 2; ++b)
#pragma unroll
                for (int m = 0; m < 4; ++m)
#pragma unroll
                    for (int n = 0; n < 2; ++n) acc[a][b][m][n] = (f32x4){0.f, 0.f, 0.f, 0.f};
        cur = nxt; cA = nA; cB = nB; ++ui;
        if constexpr (ALIGN_EPI) { if (wr == 1) PG8_BAR; }
    }
    PG8_WAIT_V(0);
    if constexpr (!ALIGN_EPI) { if (wr == 0) PG8_BAR; }
    PG8_BAR;
    if constexpr (Epi::AFTER_DRAIN) { E.fused(acc, cur, wr, wc, fr, fq, lds, wid, lane); S.done(cur); }
#undef PG8_SA
#undef PG8_SB
#undef PG8_STAGE
#undef PG8_LDA
#undef PG8_LDB
#undef PG8_MMA
#undef PG8_WAIT_V
#undef PG8_WAIT_L
#undef PG8_BAR
#undef PG8_SCHED
}
}
#define GAS __attribute__((address_space(1)))
#define LAS __attribute__((address_space(3)))
typedef unsigned v4u __attribute__((ext_vector_type(4)));
typedef float f32x4 __attribute__((ext_vector_type(4)));
typedef short bf16x8 __attribute__((ext_vector_type(8)));
typedef GAS unsigned gu32;
#define RLX_AGENT __ATOMIC_RELAXED, __HIP_MEMORY_SCOPE_AGENT
#define LDS_WAIT() asm volatile("s_waitcnt lgkmcnt(0)" ::: "memory")
#define VM_WAIT() asm volatile("s_waitcnt vmcnt(0)" ::: "memory")
#define XB_TMO      128
#define XB_XCNT(j)  (256  + 64 * (j))
#define XB_XSUB(j)  (1280 + 64 * (j))
#define XB_XGEN(j)  (2304 + 64 * (j))
#define XB_TOP      3328
#define XB_TOPGEN   3392
#define XCD_BAR_WORDS 3456
#define XB_SPIN_CAP (1u << 18)

__device__ __forceinline__ unsigned xb_ld(unsigned* p)              { return __hip_atomic_load(p, __ATOMIC_RELAXED, __HIP_MEMORY_SCOPE_AGENT); }
__device__ __forceinline__ unsigned xb_add(unsigned* p, unsigned v) { return __hip_atomic_fetch_add(p, v, __ATOMIC_RELAXED, __HIP_MEMORY_SCOPE_AGENT); }
__device__ __forceinline__ unsigned xb_xcc_id() { return (unsigned)__builtin_amdgcn_s_getreg((3 << 11) | 20) & 0xFu; }
#define XB_SPIN(cond, bar) do { unsigned _sp = 0; while (cond) { __builtin_amdgcn_s_sleep(1); \
    if ((++_sp & 255u) == 0u) { if (xb_ld(&(bar)[XB_TMO])) break; if (_sp > XB_SPIN_CAP) { atomicAdd(&(bar)[XB_TMO], 1u); break; } } } } while (0)

struct XcdBarrier {
    unsigned* bar; unsigned x;
    volatile LAS unsigned* st;
};

__device__ __forceinline__ XcdBarrier xcd_barrier_post(unsigned* bar, volatile LAS unsigned* st) {
    XcdBarrier b; b.bar = bar; b.x = xb_xcc_id(); b.st = st;
    if (threadIdx.x == 0) (void)xb_add(&bar[XB_XCNT(b.x)], 1u);
    return b;
}
__device__ __forceinline__ void xcd_barrier_complete(unsigned* bar, unsigned x, unsigned& nloc, unsigned& nx) {
    const unsigned G = gridDim.x * gridDim.y * gridDim.z;
    unsigned sum, cnt, mine, sp = 0u;
    for (;;) {
        sum = 0u; cnt = 0u; mine = 0u;
#pragma unroll
        for (unsigned j = 0; j < 16; ++j) { const unsigned c = xb_ld(&bar[XB_XCNT(j)]); sum += c; cnt += (c > 0u) ? 1u : 0u; mine = (j == x) ? c : mine; }
        if (sum == G) break;
        __builtin_amdgcn_s_sleep(1);
        if ((++sp & 255u) == 0u) { if (xb_ld(&bar[XB_TMO])) break; if (sp > XB_SPIN_CAP) { atomicAdd(&bar[XB_TMO], 1u); break; } }
    }
    nloc = mine > 0u ? mine : 1u; nx = cnt > 0u ? cnt : 1u;
}

__device__ __forceinline__ void xcd_barrier(const XcdBarrier& b) {
    asm volatile("s_waitcnt vmcnt(0)" ::: "memory");
    __syncthreads();
    if (threadIdx.x == 0) {
        unsigned* bar = b.bar;
        __builtin_amdgcn_s_waitcnt(0);
        unsigned nloc = b.st[0], nx = b.st[1];
        if (nloc == 0u) { xcd_barrier_complete(bar, b.x, nloc, nx); b.st[0] = nloc; b.st[1] = nx; }
        const unsigned old = xb_add(&bar[XB_XSUB(b.x)], 1u);
        const unsigned gen = old / nloc;
        if (old + 1u == (gen + 1u) * nloc) {
            __builtin_amdgcn_fence(__ATOMIC_RELEASE, "agent");
            asm volatile("s_waitcnt vmcnt(0)" ::: "memory");
            const unsigned og = xb_add(&bar[XB_TOP], 1u);
            const unsigned tg = og / nx;
            if (og + 1u == (tg + 1u) * nx) xb_add(&bar[XB_TOPGEN], 1u);
            else XB_SPIN(xb_ld(&bar[XB_TOPGEN]) == tg, bar);
            __builtin_amdgcn_fence(__ATOMIC_ACQUIRE, "agent");
            xb_add(&bar[XB_XGEN(b.x)], 1u);
            asm volatile("s_waitcnt vmcnt(0)" ::: "memory");
        } else {
            XB_SPIN(xb_ld(&bar[XB_XGEN(b.x)]) == gen, bar);
            __builtin_amdgcn_fence(__ATOMIC_ACQUIRE, "agent");
            asm volatile("s_waitcnt vmcnt(0)" ::: "memory");
        }
    }
    __syncthreads();
}

typedef short s16x4 __attribute__((ext_vector_type(4)));
typedef unsigned u32x2 __attribute__((ext_vector_type(2)));
__device__ __forceinline__ float fast_sigmoid(float x) { return __builtin_amdgcn_rcpf(1.f + __builtin_amdgcn_exp2f(-1.4426950408889634f * x)); }
__device__ __forceinline__ float fast_silu(float x) { return x * fast_sigmoid(x); }
__device__ __forceinline__ float fast_gelu(float x) { return x * fast_sigmoid(x * (1.5957691216057308f + 0.0713548162726f * x * x)); }
__device__ __forceinline__ float bflo(unsigned w) { return __uint_as_float(w << 16); }
__device__ __forceinline__ float bfhi(unsigned w) { return __uint_as_float(w & 0xffff0000u); }
typedef float f32x2_t __attribute__((ext_vector_type(2))); typedef __bf16 bf16x2_t __attribute__((ext_vector_type(2)));
__device__ __forceinline__ unsigned cvtpk(float lo, float hi) { const f32x2_t v = {lo, hi}; const bf16x2_t b = __builtin_convertvector(v, bf16x2_t); return __builtin_bit_cast(unsigned, b); }
__device__ __forceinline__ s16x4 tr_read(const LAS unsigned char* p) { return __builtin_bit_cast(s16x4, __builtin_amdgcn_ds_read_tr16_b64_v4i16((LAS s16x4*)p)); }
__device__ __forceinline__ bf16x8 frag_tr(const LAS unsigned char* base, int stride, int lane) {
    const int G = lane >> 4, q = (lane >> 2) & 3, p = lane & 3;
    const LAS unsigned char* a = base + (4 * G + q) * stride + 8 * p;
    const s16x4 lo = tr_read(a), hi = tr_read(a + 16 * stride);
    return (bf16x8){lo[0], lo[1], lo[2], lo[3], hi[0], hi[1], hi[2], hi[3]};
}
__device__ __forceinline__ bf16x8 frag_perm_row(const LAS unsigned char* rowbase, int stride, int lane) {
    const LAS unsigned char* a = rowbase + (lane & 15) * stride + 8 * (lane >> 4);
    const s16x4 lo = *(const LAS s16x4*)a, hi = *(const LAS s16x4*)(a + 32);
    return (bf16x8){lo[0], lo[1], lo[2], lo[3], hi[0], hi[1], hi[2], hi[3]};
}

constexpr int SGU_VF_STRIDE = 544, SGU_W_STRIDE = 272, SGU_VF_OFF = 0, SGU_W_OFF = 128 * SGU_VF_STRIDE;
__device__ __forceinline__ void sgu_item(LAS unsigned char* lds, int item, const bf16* Z, const float* v_norm, const float* w_s, const float* b_s, bf16* Y, int tid) {
    const int lane = tid & 63, wave = __builtin_amdgcn_readfirstlane(tid >> 6);
    const int g = item & 3, c = (item >> 2) & 15, b = item >> 6;
    const size_t tok0 = (size_t)b * SEQ + 128 * c;
    LAS unsigned char* VF = lds + SGU_VF_OFF; LAS unsigned char* WS = lds + SGU_W_OFF;
    {
        const int sub = lane >> 4, cl = lane & 15;
        float vn[16];
#pragma unroll
        for (int j = 0; j < 4; ++j) { const f32x4 t = *(const f32x4*)(v_norm + g * 256 + 16 * cl + 4 * j); vn[4 * j] = t[0]; vn[4 * j + 1] = t[1]; vn[4 * j + 2] = t[2]; vn[4 * j + 3] = t[3]; }
#pragma unroll
        for (int ps = 0; ps < 4; ++ps) {
            const int row = 16 * wave + 4 * ps + sub;
            const v4u* src = (const v4u*)(Z + (tok0 + row) * OD_Z + 4096 + 256 * g + 16 * cl);
            const v4u w0 = src[0], w1 = src[1];
            float x[16];
#pragma unroll
            for (int j = 0; j < 4; ++j) { x[2 * j] = fast_gelu(bflo(w0[j])); x[2 * j + 1] = fast_gelu(bfhi(w0[j])); x[8 + 2 * j] = fast_gelu(bflo(w1[j])); x[9 + 2 * j] = fast_gelu(bfhi(w1[j])); }
            float s = 0.f;
#pragma unroll
            for (int j = 0; j < 16; ++j) s += x[j];
            s += __shfl_xor(s, 1); s += __shfl_xor(s, 2); s += __shfl_xor(s, 4); s += __shfl_xor(s, 8);
            const float mu = s * (1.f / 256.f);
            float q = 0.f;
#pragma unroll
            for (int j = 0; j < 16; ++j) { x[j] -= mu; q += x[j] * x[j]; }
            q += __shfl_xor(q, 1); q += __shfl_xor(q, 2); q += __shfl_xor(q, 4); q += __shfl_xor(q, 8);
            const float rstd = __builtin_amdgcn_rsqf(q * (1.f / 256.f) + 1e-6f);
            v4u o0, o1;
#pragma unroll
            for (int j = 0; j < 4; ++j) { o0[j] = cvtpk(x[2 * j] * rstd * vn[2 * j], x[2 * j + 1] * rstd * vn[2 * j + 1]); o1[j] = cvtpk(x[8 + 2 * j] * rstd * vn[8 + 2 * j], x[9 + 2 * j] * rstd * vn[9 + 2 * j]); }
            LAS v4u* dst = (LAS v4u*)(VF + row * SGU_VF_STRIDE + 32 * cl);
            dst[0] = o0; dst[1] = o1;
        }
    }
    {
        const int t = tid >> 2, s0 = (tid & 3) * 32;
        const f32x4* src = (const f32x4*)(w_s + ((size_t)g * 128 + t) * 128 + s0);
#pragma unroll
        for (int j = 0; j < 4; ++j) { const f32x4 a = src[2 * j], bb = src[2 * j + 1]; const int s = s0 + 8 * j;
            v4u o; o[0] = cvtpk(s + 0 <= t ? a[0] : 0.f, s + 1 <= t ? a[1] : 0.f); o[1] = cvtpk(s + 2 <= t ? a[2] : 0.f, s + 3 <= t ? a[3] : 0.f);
            o[2] = cvtpk(s + 4 <= t ? bb[0] : 0.f, s + 5 <= t ? bb[1] : 0.f); o[3] = cvtpk(s + 6 <= t ? bb[2] : 0.f, s + 7 <= t ? bb[3] : 0.f);
            *(LAS v4u*)(WS + t * SGU_W_STRIDE + 2 * s) = o; }
    }
    __syncthreads();
    f32x4 acc[2][8];
#pragma unroll
    for (int eb = 0; eb < 2; ++eb)
#pragma unroll
        for (int tb = 0; tb < 8; ++tb) acc[eb][tb] = (f32x4){0.f, 0.f, 0.f, 0.f};
#pragma unroll
    for (int ks = 0; ks < 4; ++ks) {
        bf16x8 af[2];
#pragma unroll
        for (int eb = 0; eb < 2; ++eb) af[eb] = frag_tr(VF + (32 * ks) * SGU_VF_STRIDE + (16 * (2 * wave + eb)) * 2, SGU_VF_STRIDE, lane);
#pragma unroll
        for (int tb = 2 * ks; tb < 8; ++tb) {
            const bf16x8 bfr = frag_perm_row(WS + (16 * tb) * SGU_W_STRIDE + (32 * ks) * 2, SGU_W_STRIDE, lane);
#pragma unroll
            for (int eb = 0; eb < 2; ++eb) acc[eb][tb] = __builtin_amdgcn_mfma_f32_16x16x32_bf16(af[eb], bfr, acc[eb][tb], 0, 0, 0);
        }
    }
    {
        const int G = lane >> 4, tl = lane & 15;
#pragma unroll
        for (int tb = 0; tb < 8; ++tb) {
            const int t = 16 * tb + tl; const float bs = b_s[g * 128 + t];
            const bf16* zr = Z + (tok0 + t) * OD_Z + 256 * g;
            bf16* yr = Y + (tok0 + t) * DM + 1024 + 256 * g;
#pragma unroll
            for (int eb = 0; eb < 2; ++eb) {
                const int e = 16 * (2 * wave + eb) + 4 * G;
                const u32x2 uu = *(const u32x2*)(zr + 3072 + e), gg = *(const u32x2*)(zr + 5120 + e);
                const f32x4 a = acc[eb][tb];
                const float y0 = fast_gelu(bflo(uu[0])) * (a[0] + bs) * fast_silu(bflo(gg[0])), y1 = fast_gelu(bfhi(uu[0])) * (a[1] + bs) * fast_silu(bfhi(gg[0]));
                const float y2 = fast_gelu(bflo(uu[1])) * (a[2] + bs) * fast_silu(bflo(gg[1])), y3 = fast_gelu(bfhi(uu[1])) * (a[3] + bs) * fast_silu(bfhi(gg[1]));
                u32x2 o; o[0] = cvtpk(y0, y1); o[1] = cvtpk(y2, y3);
                *(u32x2*)(yr + e) = o;
            }
        }
    }
    __syncthreads();
}

constexpr int AT_STRIDE = 288, AT_K_OFF = 0, AT_V_OFF = 256 * AT_STRIDE, AT_V_ROWS = 272, AT_LDS_END = AT_V_OFF + AT_V_ROWS * AT_STRIDE;
__device__ __forceinline__ void attn_item(LAS unsigned char* lds, int item, const bf16* Z, bf16* OG, float* LSE, int tid) {
    const int lane = tid & 63, wave = __builtin_amdgcn_readfirstlane(tid >> 6), G = lane >> 4, ql = lane & 15;
    const int g = item >> 8, rem = item & 255, j = rem & 3, rn = (rem >> 2) & 15, b = rem >> 6;
    const int d = 1 << (2 * g), nb = 16 >> (2 * g), n = rn % nb, r = rn / nb;
    const size_t tokb = (size_t)b * SEQ;
    LAS unsigned char* KT = lds + AT_K_OFF; LAS unsigned char* VT = lds + AT_V_OFF;
    const int q0 = 16 * wave;
    const size_t qtok = tokb + (size_t)(128 * n + q0 + ql) * d + r;
    bf16x8 qf[4];
    { const bf16* qp = Z + qtok * EV_IN + 3072 + g * 512 + j * 128 + 8 * G;
#pragma unroll
      for (int ks = 0; ks < 4; ++ks) qf[ks] = *(const bf16x8*)(qp + 32 * ks); }
    {
        const int c16 = tid & 15, rw = tid >> 4;
        const bf16* kb = Z + 4608 + g * 512 + j * 128 + 8 * c16;
#pragma unroll
        for (int ps = 0; ps < 8; ++ps) {
            const int kk = 32 * ps + rw; const int l = 128 * (n - 1) + kk;
            v4u kv = (v4u){0u, 0u, 0u, 0u}, vv = (v4u){0u, 0u, 0u, 0u};
            if (l >= 0) { const bf16* p = kb + (tokb + (size_t)l * d + r) * EV_IN; kv = *(const v4u*)p; vv = *(const v4u*)(p + 1536); }
            *(LAS v4u*)(KT + kk * AT_STRIDE + 16 * c16) = kv; *(LAS v4u*)(VT + kk * AT_STRIDE + 16 * c16) = vv;
        }
        if (tid < 16 * 18) *(LAS v4u*)(VT + 256 * AT_STRIDE + 16 * tid) = (v4u){0u, 0u, 0u, 0u};
    }
    __syncthreads();
    f32x4 sc[9];
#pragma unroll
    for (int t = 0; t < 9; ++t) {
        sc[t] = (f32x4){0.f, 0.f, 0.f, 0.f};
        const LAS unsigned char* kp = KT + (16 * wave + 16 * t + ql) * AT_STRIDE + 16 * G;
#pragma unroll
        for (int ks = 0; ks < 4; ++ks) sc[t] = __builtin_amdgcn_mfma_f32_16x16x32_bf16(*(const LAS bf16x8*)(kp + 64 * ks), qf[ks], sc[t], 0, 0, 0);
    }
    const float slope2 = exp2f(-8.0f * (float)(g + 3 * j + 1) / 12.0f) * (float)d * 1.4426950408889634f;
    const float scale2 = 0.08838834764831845f * 1.4426950408889634f;
    float mx = -INFINITY;
#pragma unroll
    for (int t = 0; t < 9; ++t)
#pragma unroll
        for (int rg = 0; rg < 4; ++rg) {
            const int rel = 16 * t + 4 * G + rg - ql;
            const bool ok = (rel >= 0) && (rel <= 128) && (n > 0 || (q0 + ql + rel) >= 128);
            const float s = sc[t][rg] * scale2 - slope2 * (float)(128 - rel);
            sc[t][rg] = ok ? s : -INFINITY;
            mx = fmaxf(mx, sc[t][rg]);
        }
    mx = fmaxf(mx, __shfl_xor(mx, 16)); mx = fmaxf(mx, __shfl_xor(mx, 32));
    float den = 0.f;
#pragma unroll
    for (int t = 0; t < 9; ++t)
#pragma unroll
        for (int rg = 0; rg < 4; ++rg) { const float p = __builtin_amdgcn_exp2f(sc[t][rg] - mx); sc[t][rg] = p; den += p; }
    den += __shfl_xor(den, 16); den += __shfl_xor(den, 32);
    f32x4 oc[8];
#pragma unroll
    for (int dvb = 0; dvb < 8; ++dvb) oc[dvb] = (f32x4){0.f, 0.f, 0.f, 0.f};
#pragma unroll
    for (int s = 0; s < 5; ++s) {
        const f32x4 plo = sc[2 * s], phi = (s < 4) ? sc[2 * s + 1] : (f32x4){0.f, 0.f, 0.f, 0.f};
        const unsigned w0 = cvtpk(plo[0], plo[1]), w1 = cvtpk(plo[2], plo[3]), w2 = cvtpk(phi[0], phi[1]), w3 = cvtpk(phi[2], phi[3]);
        const bf16x8 pf = __builtin_bit_cast(bf16x8, (v4u){w0, w1, w2, w3});
#pragma unroll
        for (int dvb = 0; dvb < 8; ++dvb) {
            const bf16x8 vf = frag_tr(VT + (16 * wave + 32 * s) * AT_STRIDE + (16 * dvb) * 2, AT_STRIDE, lane);
            oc[dvb] = __builtin_amdgcn_mfma_f32_16x16x32_bf16(vf, pf, oc[dvb], 0, 0, 0);
        }
    }
    const float rden = __builtin_amdgcn_rcpf(den);
    bf16* op = OG + ((size_t)g * MTOK + qtok) * 512 + j * 128 + 4 * G;
#pragma unroll
    for (int dvb = 0; dvb < 8; ++dvb) { u32x2 o; o[0] = cvtpk(oc[dvb][0] * rden, oc[dvb][1] * rden); o[1] = cvtpk(oc[dvb][2] * rden, oc[dvb][3] * rden); *(u32x2*)(op + 16 * dvb) = o; }
    if (G == 0) LSE[((size_t)g * MTOK + qtok) * 4 + j] = mx + __builtin_amdgcn_logf(den);
    __syncthreads();
}
__device__ __forceinline__ void attn_merge(const bf16* Z, const bf16* OG, const float* LSE, bf16* Y, int gtid, int gthreads) {
    for (int it = gtid; it < MTOK * 64; it += gthreads) {
        const int tok = it >> 6, c8 = it & 63, j = c8 >> 4;
        const float l0 = LSE[((size_t)0 * MTOK + tok) * 4 + j], l1 = LSE[((size_t)1 * MTOK + tok) * 4 + j], l2 = LSE[((size_t)2 * MTOK + tok) * 4 + j];
        const float m = fmaxf(l0, fmaxf(l1, l2));
        float w0 = __builtin_amdgcn_exp2f(l0 - m), w1 = __builtin_amdgcn_exp2f(l1 - m), w2 = __builtin_amdgcn_exp2f(l2 - m);
        const float rs = __builtin_amdgcn_rcpf(w0 + w1 + w2); w0 *= rs; w1 *= rs; w2 *= rs;
        const v4u a = *(const v4u*)(OG + ((size_t)0 * MTOK + tok) * 512 + 8 * c8), bb = *(const v4u*)(OG + ((size_t)1 * MTOK + tok) * 512 + 8 * c8), cc = *(const v4u*)(OG + ((size_t)2 * MTOK + tok) * 512 + 8 * c8);
        const v4u gt = *(const v4u*)(Z + (size_t)tok * EV_IN + 7680 + 8 * c8);
        v4u o;
#pragma unroll
        for (int k = 0; k < 4; ++k) {
            const float ylo = (w0 * bflo(a[k]) + w1 * bflo(bb[k]) + w2 * bflo(cc[k])) * fast_silu(bflo(gt[k]));
            const float yhi = (w0 * bfhi(a[k]) + w1 * bfhi(bb[k]) + w2 * bfhi(cc[k])) * fast_silu(bfhi(gt[k]));
            o[k] = cvtpk(ylo, yhi);
        }
        *(v4u*)(Y + (size_t)tok * DM + 1536 + 8 * c8) = o;
    }
}

constexpr int LR_XC_STRIDE = 272, LR_XC_OFF = 0, LR_F_STRIDE = 528  , LR_XCF_OFF = 128 * LR_XC_STRIDE, LR_A_OFF = LR_XCF_OFF + 32 * LR_F_STRIDE, LR_U_OFF = LR_A_OFF + 32 * LR_F_STRIDE, LR_LDS_END = LR_U_OFF + 32 * LR_F_STRIDE;
struct LruParams { const float *conv_w, *conv_b, *b_a, *b_i, *lam; const bf16* wg; };
__device__ __forceinline__ void lru_load_tile(v4u (&xa)[7], v4u& ga, const bf16* Z, size_t tokb, int t0, int h, int c4, int tid) {
    const int co = tid & 15, rg = tid >> 4;
#pragma unroll
    for (int k = 0; k < 7; ++k) { const int t = t0 + 4 * rg + k - 3;
        xa[k] = (t >= 0) ? *(const v4u*)(Z + (tokb + t) * EV_IN + h * 128 + 8 * co) : (v4u){0u, 0u, 0u, 0u}; }
    ga = *(const v4u*)(Z + (tokb + t0 + (tid >> 2)) * EV_IN + 1536 + h * 128 + 32 * c4 + 8 * (tid & 3));
}
__device__ __forceinline__ void lru_item(LAS unsigned char* lds, int item, const bf16* Z, const LruParams& P, bf16* Y, int tid) {
    const int lane = tid & 63, wave = __builtin_amdgcn_readfirstlane(tid >> 6), G = lane >> 4, ql = lane & 15;
    const int c4 = item & 3, h = (item >> 2) % 12, b = item / 48;
    const size_t tokb = (size_t)b * SEQ;
    LAS unsigned char* XC = lds + LR_XC_OFF; LAS unsigned char* XCF = lds + LR_XCF_OFF; LAS unsigned char* AL = lds + LR_A_OFF; LAS unsigned char* UL = lds + LR_U_OFF;
    bf16x8 wf[2][2][4];
#pragma unroll
    for (int gate = 0; gate < 2; ++gate)
#pragma unroll
        for (int cb = 0; cb < 2; ++cb)
#pragma unroll
            for (int ks = 0; ks < 4; ++ks) wf[gate][cb][ks] = *(const bf16x8*)(P.wg + ((size_t)(h * 2 + gate) * 128 + 32 * c4 + 16 * cb + ql) * 128 + 32 * ks + 8 * G);
    float ba[2], bi[2], sp8[2];
#pragma unroll
    for (int cb = 0; cb < 2; ++cb) { const int ch = h * 128 + 32 * c4 + 16 * cb + ql; ba[cb] = P.b_a[ch]; bi[cb] = P.b_i[ch];
        const float nl = -P.lam[ch]; sp8[cb] = 8.0f * (nl > 20.f ? nl : log1pf(__expf(nl))); }
    float hc = 0.f;
    v4u xa[7], ga;
    lru_load_tile(xa, ga, Z, tokb, 0, h, c4, tid);
    for (int sc = 0; sc < 16; ++sc) {
        const int t0 = 128 * sc;
        {
            const int co = tid & 15, rg = tid >> 4;
            v4u orow[4];
            const bool mine = (co >> 2) == c4;
#pragma unroll
            for (int e = 0; e < 4; ++e) {
                typedef float f32x2 __attribute__((ext_vector_type(2)));
                const int chn = h * 128 + 8 * co + 2 * e;
                const f32x2 w0 = *(const f32x2*)(P.conv_w + 0 * LRU_W + chn), w1 = *(const f32x2*)(P.conv_w + 1 * LRU_W + chn), w2 = *(const f32x2*)(P.conv_w + 2 * LRU_W + chn), w3 = *(const f32x2*)(P.conv_w + 3 * LRU_W + chn);
                const f32x2 cb2 = *(const f32x2*)(P.conv_b + chn);
                float lo[7], hi[7];
#pragma unroll
                for (int k = 0; k < 7; ++k) { lo[k] = bflo(xa[k][e]); hi[k] = bfhi(xa[k][e]); }
                f32x4 xlo, xhi;
#pragma unroll
                for (int r = 0; r < 4; ++r) { xlo[r] = cb2[0] + w0[0] * lo[r] + w1[0] * lo[r + 1] + w2[0] * lo[r + 2] + w3[0] * lo[r + 3];
                                              xhi[r] = cb2[1] + w0[1] * hi[r] + w1[1] * hi[r + 1] + w2[1] * hi[r + 2] + w3[1] * hi[r + 3]; orow[r][e] = cvtpk(xlo[r], xhi[r]); }
                if (mine) { *(LAS f32x4*)(XCF + (8 * (co & 3) + 2 * e) * LR_F_STRIDE + 16 * rg) = xlo; *(LAS f32x4*)(XCF + (8 * (co & 3) + 2 * e + 1) * LR_F_STRIDE + 16 * rg) = xhi; }
            }
#pragma unroll
            for (int r = 0; r < 4; ++r) *(LAS v4u*)(XC + (4 * rg + r) * LR_XC_STRIDE + 16 * co) = orow[r];
        }
        const v4u ga_cur = ga;
        if (sc < 15) lru_load_tile(xa, ga, Z, tokb, t0 + 128, h, c4, tid);
        __syncthreads();
        f32x4 acc[2][2];
#pragma unroll
        for (int gate = 0; gate < 2; ++gate)
#pragma unroll
            for (int cb = 0; cb < 2; ++cb) acc[gate][cb] = (f32x4){0.f, 0.f, 0.f, 0.f};
#pragma unroll
        for (int ks = 0; ks < 4; ++ks) {
            const bf16x8 af = *(const LAS bf16x8*)(XC + (16 * wave + ql) * LR_XC_STRIDE + 64 * ks + 16 * G);
#pragma unroll
            for (int gate = 0; gate < 2; ++gate)
#pragma unroll
                for (int cb = 0; cb < 2; ++cb) acc[gate][cb] = __builtin_amdgcn_mfma_f32_16x16x32_bf16(af, wf[gate][cb][ks], acc[gate][cb], 0, 0, 0);
        }
#pragma unroll
        for (int cb = 0; cb < 2; ++cb) {
            const int off = (16 * cb + ql) * LR_F_STRIDE + (16 * wave + 4 * G) * 4;
            const f32x4 xcv = *(const LAS f32x4*)(XCF + off);
            f32x4 av, uv;
#pragma unroll
            for (int rg2 = 0; rg2 < 4; ++rg2) {
                const float r = fast_sigmoid(acc[0][cb][rg2] + ba[cb]), ig = fast_sigmoid(acc[1][cb][rg2] + bi[cb]);
                const float la = -r * sp8[cb];
                const float a = __builtin_amdgcn_exp2f(la * 1.4426950408889634f);
                const float x2 = 2.f * la;
                const float om = (x2 > -0.05f) ? -x2 * (1.f + x2 * (0.5f + x2 * (0.16666667f + x2 * 0.041666667f))) : 1.f - a * a;
                av[rg2] = a; uv[rg2] = __builtin_amdgcn_sqrtf(om) * ig * xcv[rg2];
            }
            *(LAS f32x4*)(AL + off) = av; *(LAS f32x4*)(UL + off) = uv;
        }
        __syncthreads();
        {
            const int seg = ql, off = (4 * wave + G) * LR_F_STRIDE + 32 * seg;
            const f32x4 a0 = *(const LAS f32x4*)(AL + off), a1 = *(const LAS f32x4*)(AL + off + 16), u0 = *(const LAS f32x4*)(UL + off), u1 = *(const LAS f32x4*)(UL + off + 16);
            float Pp = 1.f, Hh = 0.f;
#pragma unroll
            for (int k = 0; k < 4; ++k) { Hh = a0[k] * Hh + u0[k]; Pp *= a0[k]; }
#pragma unroll
            for (int k = 0; k < 4; ++k) { Hh = a1[k] * Hh + u1[k]; Pp *= a1[k]; }
#pragma unroll
            for (int o = 1; o < 16; o <<= 1) { const float Pl = __shfl_up(Pp, o, 16), Hl = __shfl_up(Hh, o, 16); if (seg >= o) { Hh = Pp * Hl + Hh; Pp = Pp * Pl; } }
            float Pe = __shfl_up(Pp, 1, 16), He = __shfl_up(Hh, 1, 16);
            if (seg == 0) { Pe = 1.f; He = 0.f; }
            float hh = Pe * hc + He;
            f32x4 h0, h1;
#pragma unroll
            for (int k = 0; k < 4; ++k) { hh = a0[k] * hh + u0[k]; h0[k] = hh; }
#pragma unroll
            for (int k = 0; k < 4; ++k) { hh = a1[k] * hh + u1[k]; h1[k] = hh; }
            *(LAS f32x4*)(UL + off) = h0; *(LAS f32x4*)(UL + off + 16) = h1;
            hc = __shfl(hh, (lane & 48) + 15);
        }
        __syncthreads();
        {
            const int tk = tid >> 2, oc = tid & 3;
            float hv[8];
#pragma unroll
            for (int e = 0; e < 8; ++e) hv[e] = *(const LAS float*)(UL + (8 * oc + e) * LR_F_STRIDE + 4 * tk);
            v4u o;
#pragma unroll
            for (int e = 0; e < 4; ++e) o[e] = cvtpk(hv[2 * e] * fast_silu(bflo(ga_cur[e])), hv[2 * e + 1] * fast_silu(bfhi(ga_cur[e])));
            *(v4u*)(Y + (tokb + t0 + tk) * DM + h * 128 + 32 * c4 + 8 * oc) = o;
        }
    }
    __syncthreads();
}

constexpr int G1_ALR_OFF = 0, G1_TOT_OFF = 4096, G1_QT_OFF = 8192, G1_QK_STRIDE = 272, G1_KT_OFF = G1_QT_OFF + 64 * G1_QK_STRIDE, G1_V_OFF = G1_KT_OFF + 64 * G1_QK_STRIDE, G1_V_STRIDE = 544,
              G1_LDS_END = G1_V_OFF + 64 * G1_V_STRIDE;
__device__ __forceinline__ void gla1_item(LAS unsigned char* lds, int item, const bf16* Z, const float* ALR, const float* w_alpha, const float* b_alpha, bf16* QT, bf16* KD, bf16* OI, float* DEC, int tid) {
    const int lane = tid & 63, wave = __builtin_amdgcn_readfirstlane(tid >> 6), G = lane >> 4, ql = lane & 15;
    const int c = item & 31, h = (item >> 5) & 3, b = item >> 7;
    const size_t tok0 = (size_t)b * SEQ + 64 * c;
    LAS float* ALRs = (LAS float*)(lds + G1_ALR_OFF); LAS float* TOT = (LAS float*)(lds + G1_TOT_OFF);
    LAS unsigned char* QTl = lds + G1_QT_OFF; LAS unsigned char* KTl = lds + G1_KT_OFF; LAS unsigned char* Vl = lds + G1_V_OFF;
    if (tid < 256) *(LAS f32x4*)(ALRs + 4 * tid) = *(const f32x4*)(ALR + tok0 * 16 + 4 * tid);
    { const int rw = tid >> 5, c16 = tid & 31;
#pragma unroll
      for (int ps = 0; ps < 4; ++ps) { const int row = 16 * ps + rw;
          *(LAS v4u*)(Vl + row * G1_V_STRIDE + 16 * c16) = *(const v4u*)(Z + (tok0 + row) * OD_Z + 1024 + h * 256 + 8 * c16); } }
    const int e = tid & 127, tq = tid >> 7;
    float wa[16];
#pragma unroll
    for (int r = 0; r < 16; ++r) wa[r] = w_alpha[r * 512 + h * 128 + e];
    const float bal = b_alpha[h * 128 + e];
    float qv[16], kv[16];
#pragma unroll
    for (int t = 0; t < 16; ++t) { const bf16* zr = Z + (tok0 + 16 * tq + t) * OD_Z + h * 128 + e; qv[t] = bf2f(zr[0]); kv[t] = bf2f(zr[512]); }
    __syncthreads();
    float bc[16]; float run = 0.f;
#pragma unroll
    for (int t = 0; t < 16; ++t) {
        float s = bal;
#pragma unroll
        for (int r = 0; r < 16; ++r) s += ALRs[(16 * tq + t) * 16 + r] * wa[r];
        const float sp = (s < -20.f) ? -s : __builtin_amdgcn_logf(1.f + __builtin_amdgcn_exp2f(-s * 1.4426950408889634f)) * 0.6931471805599453f;
        run -= sp * 0.0625f; bc[t] = run;
    }
    TOT[tq * 128 + e] = run;
    __syncthreads();
    const float t0s = TOT[e], t1s = TOT[128 + e], t2s = TOT[256 + e], t3s = TOT[384 + e];
    const float offs = (tq > 0 ? t0s : 0.f) + (tq > 1 ? t1s : 0.f) + (tq > 2 ? t2s : 0.f), blast = (t0s + t1s) + (t2s + t3s);
    if (tq == 0) DEC[(size_t)item * 128 + e] = __builtin_amdgcn_exp2f(blast * 1.4426950408889634f);
#pragma unroll
    for (int t = 0; t < 16; ++t) {
        const float bb = bc[t] + offs;
        const float eb = __builtin_amdgcn_exp2f(bb * 1.4426950408889634f), enb = __builtin_amdgcn_exp2f(-bb * 1.4426950408889634f), edl = __builtin_amdgcn_exp2f((blast - bb) * 1.4426950408889634f);
        const float qt = qv[t] * 0.08838834764831845f * eb, kt = kv[t] * enb, kd = kv[t] * edl;
        const int row = 16 * tq + t;
        const bf16 qtb = (bf16)f2bf(qt);
        *(LAS bf16*)(QTl + row * G1_QK_STRIDE + 2 * e) = qtb; *(LAS bf16*)(KTl + row * G1_QK_STRIDE + 2 * e) = (bf16)f2bf(kt);
        QT[(tok0 + row) * 512 + h * 128 + e] = qtb; KD[(tok0 + row) * 512 + h * 128 + e] = (bf16)f2bf(kd);
    }
    __syncthreads();
    const int ib = wave >> 1, dh = wave & 1;
    bf16x8 qf[4];
#pragma unroll
    for (int ks = 0; ks < 4; ++ks) qf[ks] = *(const LAS bf16x8*)(QTl + (16 * ib + ql) * G1_QK_STRIDE + 64 * ks + 16 * G);
    f32x4 at[4];
#pragma unroll
    for (int jb = 0; jb < 4; ++jb) {
        at[jb] = (f32x4){0.f, 0.f, 0.f, 0.f};
        if (jb <= ib) {
#pragma unroll
            for (int ks = 0; ks < 4; ++ks) at[jb] = __builtin_amdgcn_mfma_f32_16x16x32_bf16(*(const LAS bf16x8*)(KTl + (16 * jb + ql) * G1_QK_STRIDE + 64 * ks + 16 * G), qf[ks], at[jb], 0, 0, 0);
#pragma unroll
            for (int rg = 0; rg < 4; ++rg) if (16 * jb + 4 * G + rg > 16 * ib + ql) at[jb][rg] = 0.f;
        }
    }
    f32x4 oc[8];
#pragma unroll
    for (int dvb = 0; dvb < 8; ++dvb) oc[dvb] = (f32x4){0.f, 0.f, 0.f, 0.f};
#pragma unroll
    for (int s = 0; s < 2; ++s) {
        if (2 * s <= ib) {
            const bf16x8 pf = __builtin_bit_cast(bf16x8, (v4u){cvtpk(at[2 * s][0], at[2 * s][1]), cvtpk(at[2 * s][2], at[2 * s][3]), cvtpk(at[2 * s + 1][0], at[2 * s + 1][1]), cvtpk(at[2 * s + 1][2], at[2 * s + 1][3])});
#pragma unroll
            for (int dvb = 0; dvb < 8; ++dvb) {
                const bf16x8 vf = frag_tr(Vl + (32 * s) * G1_V_STRIDE + (128 * dh + 16 * dvb) * 2, G1_V_STRIDE, lane);
                oc[dvb] = __builtin_amdgcn_mfma_f32_16x16x32_bf16(vf, pf, oc[dvb], 0, 0, 0);
            }
        }
    }
    bf16* op = OI + (tok0 + 16 * ib + ql) * 1024 + h * 256 + 128 * dh + 4 * G;
#pragma unroll
    for (int dvb = 0; dvb < 8; ++dvb) { u32x2 o; o[0] = cvtpk(oc[dvb][0], oc[dvb][1]); o[1] = cvtpk(oc[dvb][2], oc[dvb][3]); *(u32x2*)(op + 16 * dvb) = o; }
    __syncthreads();
}

constexpr int G2_QT_STRIDE = 272, G2_KD_STRIDE = 288, G2_V_STRIDE = 544;
constexpr int G2_QT_OFF = 0, G2_KD_OFF = G2_QT_OFF + 64 * G2_QT_STRIDE, G2_V_OFF = G2_KD_OFF + 64 * G2_KD_STRIDE, G2_BUF = G2_V_OFF + 64 * G2_V_STRIDE;
constexpr int G2_DEC_OFF = 2 * G2_BUF  , G2_PART_OFF = G2_DEC_OFF + 32 * 128 * 4, G2_LDS_END = G2_PART_OFF + 8 * 64 * 4;
struct Gla2StageA { v4u qt[2], kd[2]; };
struct Gla2StageB { v4u v[4]; };
__device__ __forceinline__ void gla2_loadA(Gla2StageA& st, const bf16* QT, const bf16* KD, size_t tok0, int h, int tid) {
    const int rw = tid >> 4, c16 = tid & 15;
#pragma unroll
    for (int ps = 0; ps < 2; ++ps) { st.qt[ps] = *(const v4u*)(QT + (tok0 + 32 * ps + rw) * 512 + h * 128 + 8 * c16); st.kd[ps] = *(const v4u*)(KD + (tok0 + 32 * ps + rw) * 512 + h * 128 + 8 * c16); }
}
__device__ __forceinline__ void gla2_loadB(Gla2StageB& st, const bf16* Z, size_t tok0, int h, int tid) {
    const int rv = tid >> 5, c32 = tid & 31;
#pragma unroll
    for (int ps = 0; ps < 4; ++ps) st.v[ps] = *(const v4u*)(Z + (tok0 + 16 * ps + rv) * OD_Z + 1024 + h * 256 + 8 * c32);
}
__device__ __forceinline__ void gla2_storeA(const Gla2StageA& st, LAS unsigned char* buf, int tid) {
    const int rw = tid >> 4, c16 = tid & 15;
#pragma unroll
    for (int ps = 0; ps < 2; ++ps) { *(LAS v4u*)(buf + G2_QT_OFF + (32 * ps + rw) * G2_QT_STRIDE + 16 * c16) = st.qt[ps]; *(LAS v4u*)(buf + G2_KD_OFF + (32 * ps + rw) * G2_KD_STRIDE + 16 * c16) = st.kd[ps]; }
}
__device__ __forceinline__ void gla2_storeB(const Gla2StageB& st, LAS unsigned char* buf, int tid) {

    const int rv = tid >> 5, c32 = tid & 31;
#pragma unroll
    for (int ps = 0; ps < 4; ++ps) *(LAS v4u*)(buf + G2_V_OFF + (16 * ps + rv) * G2_V_STRIDE + 16 * c32) = st.v[ps];
}
__device__ __forceinline__ void gla2_item(LAS unsigned char* lds, int item, const bf16* Z, const bf16* QT, const bf16* KD, const bf16* OI, const float* DEC, const float* head_norm, bf16* Y, int tid) {
    const int lane = tid & 63, wave = __builtin_amdgcn_readfirstlane(tid >> 6), G = lane >> 4, ql = lane & 15;
    const int h = item & 3, b = item >> 2;
    const size_t tokb = (size_t)b * SEQ;
    LAS float* PART = (LAS float*)(lds + G2_PART_OFF);
    f32x4 sacc[8][2];
#pragma unroll
    for (int dkb = 0; dkb < 8; ++dkb) { sacc[dkb][0] = (f32x4){0.f, 0.f, 0.f, 0.f}; sacc[dkb][1] = (f32x4){0.f, 0.f, 0.f, 0.f}; }
    { Gla2StageA sa; Gla2StageB sb;
      gla2_loadA(sa, QT, KD, tokb, h, tid); gla2_loadB(sb, Z, tokb, h, tid);
#pragma unroll
      for (int k = 0; k < 2; ++k) *(LAS f32x4*)(lds + G2_DEC_OFF + 16 * (tid + 512 * k)) = *(const f32x4*)(DEC + (size_t)(item * 32) * 128 + 4 * (tid + 512 * k));
      gla2_storeA(sa, lds, tid); gla2_storeB(sb, lds, tid); }
    __syncthreads();
    for (int c = 0; c < 32; ++c) {
        LAS unsigned char* buf = lds + (c & 1) * G2_BUF;
        const size_t tok0 = tokb + 64 * c;
        LAS unsigned char* nbuf = lds + ((c + 1) & 1) * G2_BUF;
        Gla2StageA sa;
        if (c < 31) gla2_loadA(sa, QT, KD, tok0 + 64, h, tid);
        f32x4 oacc[2][4];
#pragma unroll
        for (int db = 0; db < 2; ++db)
#pragma unroll
            for (int tb = 0; tb < 4; ++tb) oacc[db][tb] = (f32x4){0.f, 0.f, 0.f, 0.f};
#pragma unroll
        for (int s = 0; s < 4; ++s) {
            bf16x8 sf[2];
#pragma unroll
            for (int db = 0; db < 2; ++db) sf[db] = __builtin_bit_cast(bf16x8, (v4u){cvtpk(sacc[2 * s][db][0], sacc[2 * s][db][1]), cvtpk(sacc[2 * s][db][2], sacc[2 * s][db][3]),
                                                                                   cvtpk(sacc[2 * s + 1][db][0], sacc[2 * s + 1][db][1]), cvtpk(sacc[2 * s + 1][db][2], sacc[2 * s + 1][db][3])});
#pragma unroll
            for (int tb = 0; tb < 4; ++tb) {
                const bf16x8 qf = frag_perm_row(buf + G2_QT_OFF + (16 * tb) * G2_QT_STRIDE + (32 * s) * 2, G2_QT_STRIDE, lane);
#pragma unroll
                for (int db = 0; db < 2; ++db) oacc[db][tb] = __builtin_amdgcn_mfma_f32_16x16x32_bf16(sf[db], qf, oacc[db][tb], 0, 0, 0);
            }
        }
        if (c < 31) gla2_storeA(sa, nbuf, tid);
#pragma unroll
        for (int dkb = 0; dkb < 8; ++dkb) { const f32x4 dec = *(const LAS f32x4*)(lds + G2_DEC_OFF + (128 * c + 16 * dkb + 4 * G) * 4); sacc[dkb][0] *= dec; sacc[dkb][1] *= dec; }
#pragma unroll
        for (int s = 0; s < 2; ++s) {
            bf16x8 vf[2];
#pragma unroll
            for (int db = 0; db < 2; ++db) vf[db] = frag_tr(buf + G2_V_OFF + (32 * s) * G2_V_STRIDE + (16 * (2 * wave + db)) * 2, G2_V_STRIDE, lane);
#pragma unroll
            for (int dkb = 0; dkb < 8; ++dkb) {
                const bf16x8 kf = frag_tr(buf + G2_KD_OFF + (32 * s) * G2_KD_STRIDE + (16 * dkb) * 2, G2_KD_STRIDE, lane);
#pragma unroll
                for (int db = 0; db < 2; ++db) sacc[dkb][db] = __builtin_amdgcn_mfma_f32_16x16x32_bf16(kf, vf[db], sacc[dkb][db], 0, 0, 0);
            }
        }
#pragma unroll
        for (int tb = 0; tb < 4; ++tb) {
            float ss = 0.f;
#pragma unroll
            for (int db = 0; db < 2; ++db) {
                const u32x2 oi = *(const u32x2*)(OI + (tok0 + 16 * tb + ql) * 1024 + h * 256 + 16 * (2 * wave + db) + 4 * G);
                f32x4 o = oacc[db][tb]; o[0] += bflo(oi[0]); o[1] += bfhi(oi[0]); o[2] += bflo(oi[1]); o[3] += bfhi(oi[1]);
                oacc[db][tb] = o; ss += (o[0] * o[0] + o[1] * o[1]) + (o[2] * o[2] + o[3] * o[3]);
            }
            ss += __shfl_xor(ss, 16); ss += __shfl_xor(ss, 32);
            if (G == 0) PART[wave * 64 + 16 * tb + ql] = ss;
        }
        __syncthreads();
        Gla2StageB sb;
        if (c < 31) gla2_loadB(sb, Z, tok0 + 64, h, tid);
#pragma unroll
        for (int tb = 0; tb < 4; ++tb) {
            float tot = 0.f;
#pragma unroll
            for (int w = 0; w < 8; ++w) tot += PART[w * 64 + 16 * tb + ql];
            const float rs = __builtin_amdgcn_rsqf(tot * (1.f / 256.f) + 1e-6f);
#pragma unroll
            for (int db = 0; db < 2; ++db) {
                const int col = h * 256 + 16 * (2 * wave + db) + 4 * G;
                const u32x2 gc = *(const u32x2*)(Z + (tok0 + 16 * tb + ql) * OD_Z + 2048 + col);
                const f32x4 o = oacc[db][tb];
                const f32x4 hn = *(const f32x4*)(head_norm + col);
                u32x2 y; y[0] = cvtpk(o[0] * rs * hn[0] * fast_silu(bflo(gc[0])), o[1] * rs * hn[1] * fast_silu(bfhi(gc[0])));
                y[1] = cvtpk(o[2] * rs * hn[2] * fast_silu(bflo(gc[1])), o[3] * rs * hn[3] * fast_silu(bfhi(gc[1])));
                *(u32x2*)(Y + (tok0 + 16 * tb + ql) * DM + col) = y;
            }
        }
        if (c < 31) gla2_storeB(sb, nbuf, tid);
        __syncthreads();
    }
}
#define OPT_ATTN 1
#define OPT_LRU 1
#define OPT_GLA 1
constexpr int NWAVES = 8;
constexpr size_t MiB = 1u << 20;
constexpr size_t WS_CTL = 0, CTL_ZERO_BYTES = 1 * MiB;
constexpr size_t WS_WEVIN = 2 * MiB;
constexpr size_t WS_WEVOUT = 66 * MiB;
constexpr size_t WS_WODIN = 82 * MiB;
constexpr size_t WS_WODOUT = 130 * MiB;
constexpr size_t WS_WALR = 146 * MiB;
constexpr size_t WS_WGATE = 147 * MiB;
constexpr size_t WS_X = 150 * MiB;
constexpr size_t WS_XG = 214 * MiB;
constexpr size_t WS_Z = 246 * MiB;
constexpr size_t WS_Y = 374 * MiB;
constexpr size_t WS_ALR = 406 * MiB;
constexpr size_t WS_SUMP = 406 * MiB + 512 * 1024;
constexpr size_t WS_T0 = 408 * MiB;
constexpr size_t WS_T1 = 456 * MiB;
constexpr size_t WS_END = 504 * MiB;
constexpr int CW_BAR = 4096;
constexpr int MAX_LAUNCH = 8;
static_assert((CW_BAR + MAX_LAUNCH * XCD_BAR_WORDS) * 4 <= (int)CTL_ZERO_BYTES, "ctl map");
constexpr int RING_OFF = 0, RING_BYTES = 131072;
constexpr int LDSCTL_OFF = 159744, MISC_OFF = LDSCTL_OFF + 320;
constexpr int LDS_BYTES = 163840;
static_assert(G1_LDS_END <= LDSCTL_OFF && G2_LDS_END <= LDSCTL_OFF && AT_LDS_END <= LDSCTL_OFF && LR_LDS_END <= LDSCTL_OFF && SGU_W_OFF + 128 * SGU_W_STRIDE <= LDSCTL_OFF, "LDS map");

constexpr int PH_PROLOGUE = 0, PH_FINAL = 17, N_PHASES = 18;

struct Args {
    const float* in[21]; float* out; unsigned char* ws;
    const float* gn[4];
    const float* xold[4];
    int ph_lo, ph_hi, li, pad;
};
#define CAS __attribute__((address_space(4)))
template <class T> __device__ __forceinline__ T* karg(const CAS char* ka, int byte_off) { T* p = *(T* const CAS*)(ka + byte_off); return (T*)(__attribute__((address_space(1))) T*)p; }
#define KIN(k) karg<const float>(ka_, 8 * (k))

__device__ __forceinline__ float wave_sum(float v) {
#pragma unroll
    for (int o = 1; o < 64; o <<= 1) v += __shfl_xor(v, o);
    return v;
}
__device__ __forceinline__ void p0_transpose_item(const float* W, int K, int ldw, int nblk, bf16* WT, int skip_at, int skip, LAS float* scr, int item, int lane) {
    const int kb = item / nblk, nb = item % nblk, k0 = 64 * kb, n0 = 32 * nb, s0 = n0 + (n0 >= skip_at ? skip : 0);
#pragma unroll 8
    for (int i = 0; i < 32; ++i) { const int kk = 2 * i + (lane >> 5); scr[kk * 33 + (lane & 31)] = W[(size_t)(k0 + kk) * ldw + s0 + (lane & 31)]; }
    LDS_WAIT(); asm volatile("" ::: "memory");
    const int c = lane & 7;
#pragma unroll
    for (int j = 0; j < 4; ++j) { const int n = (lane >> 3) + 8 * j; const LAS float* s = scr + (8 * c) * 33 + n;
        v4u o; o.x = pk2(s[0 * 33], s[1 * 33]); o.y = pk2(s[2 * 33], s[3 * 33]); o.z = pk2(s[4 * 33], s[5 * 33]); o.w = pk2(s[6 * 33], s[7 * 33]);
        *(GAS v4u*)(WT + (size_t)(n0 + n) * K + k0 + 8 * c) = o; }
    LDS_WAIT(); asm volatile("" ::: "memory");
}

__global__ void __launch_bounds__(NWAVES * 64, 2) mk_fwd(Args args) {
    extern __shared__ __attribute__((aligned(16))) unsigned char lds_raw[];
    LAS unsigned char* lds = (LAS unsigned char*)lds_raw;
    volatile LAS unsigned* MISC = (volatile LAS unsigned*)(lds + MISC_OFF);
    const int G0 = gridDim.x;
    unsigned char* ws = args.ws;
    unsigned* ctl = (unsigned*)(ws + WS_CTL);
    float* SUMP = (float*)(ws + WS_SUMP);
    for (int u = threadIdx.x; u < (LDS_BYTES - LDSCTL_OFF) / 4; u += NWAVES * 64) ((LAS unsigned*)(lds + LDSCTL_OFF))[u] = 0u;
    __syncthreads();
    XcdBarrier bar = xcd_barrier_post(ctl + CW_BAR + args.li * XCD_BAR_WORDS, MISC + 8);

    float* X = (float*)(ws + WS_X); bf16* XG = (bf16*)(ws + WS_XG); bf16* Z = (bf16*)(ws + WS_Z); bf16* Y = (bf16*)(ws + WS_Y);
    float* ALR = (float*)(ws + WS_ALR);

    for (int ph = args.ph_lo; ph < args.ph_hi; ++ph) {
        if (ph > args.ph_lo) xcd_barrier(bar);
        int tid = threadIdx.x; asm volatile("" : "+v"(tid));
        int G = G0; asm volatile("" : "+s"(G));
        const int lane = tid & 63, wave = __builtin_amdgcn_readfirstlane(tid >> 6);
        const CAS char* ka_ = (const CAS char*)__builtin_amdgcn_kernarg_segment_ptr(); asm volatile("" : "+s"(ka_));
        const float* x_in = KIN(0);
        if (ph == PH_PROLOGUE) {
            LAS float* scr = (LAS float*)(lds + RING_OFF + wave * 16384);
            const int gw = blockIdx.x * NWAVES + wave, NGW = G * NWAVES;
            constexpr int I_EVIN = 32 * 256, I_EVOUT = 32 * 64, I_ODIN = 32 * 192, I_ODOUT = 32 * 64, I_GATE = 2 * 4;
            constexpr int NITEMS = 2 * (I_EVIN + I_EVOUT + I_ODIN + I_ODOUT) + 2 * 12 * 2 * I_GATE;
            for (int it = gw; it < NITEMS; it += NGW) {
                int r = it;
                if (r < 2 * I_EVIN) { const int i = r / I_EVIN; p0_transpose_item(KIN(2) + (size_t)i * DM * EV_IN, DM, EV_IN, 256, (bf16*)(ws + WS_WEVIN) + (size_t)i * EV_IN * DM, 1 << 30, 0, scr, r % I_EVIN, lane); continue; } r -= 2 * I_EVIN;
                if (r < 2 * I_EVOUT) { const int i = r / I_EVOUT; p0_transpose_item(KIN(10) + (size_t)i * DM * DM, DM, DM, 64, (bf16*)(ws + WS_WEVOUT) + (size_t)i * DM * DM, 1 << 30, 0, scr, r % I_EVOUT, lane); continue; } r -= 2 * I_EVOUT;
                if (r < 2 * I_ODIN) { const int i = r / I_ODIN; p0_transpose_item(KIN(12) + (size_t)i * DM * OD_IN, DM, OD_IN, 192, (bf16*)(ws + WS_WODIN) + (size_t)i * OD_Z * DM, 2048, 16, scr, r % I_ODIN, lane); continue; } r -= 2 * I_ODIN;
                if (r < 2 * I_ODOUT) { const int i = r / I_ODOUT; p0_transpose_item(KIN(19) + (size_t)i * DM * DM, DM, DM, 64, (bf16*)(ws + WS_WODOUT) + (size_t)i * DM * DM, 1 << 30, 0, scr, r % I_ODOUT, lane); continue; } r -= 2 * I_ODOUT;
                { const int mat = r / I_GATE, li2 = mat / 24, h = (mat % 24) >> 1, gate = mat & 1;
                  const float* src = KIN(gate ? 7 : 5) + ((size_t)li2 * 12 + h) * 128 * 128;
                  p0_transpose_item(src, 128, 128, 4, (bf16*)(ws + WS_WGATE) + (size_t)mat * 128 * 128, 1 << 30, 0, scr, r % I_GATE, lane); }
            }
            for (int e = blockIdx.x * 512 + tid; e < 2 * 16 * 2048; e += G * 512) { const int i = e >> 15, j = (e >> 11) & 15, k = e & 2047;
                ((bf16*)(ws + WS_WALR))[e] = (bf16)f2bf(KIN(12)[(size_t)i * DM * OD_IN + (size_t)k * OD_IN + 2048 + j]); }
            const float* g0 = KIN(1);
            for (int m = gw; m < MTOK; m += NGW) {
                const f32x4* xr = (const f32x4*)(x_in + (size_t)m * DM) + lane; float s = 0.f;
                unsigned long long* o8 = (unsigned long long*)(XG + (size_t)m * DM) + lane;
#pragma unroll
                for (int j = 0; j < 8; ++j) { const f32x4 v = xr[64 * j]; const f32x4 gg = ((const f32x4*)g0)[lane + 64 * j];
                    s += (v[0] * v[0] + v[1] * v[1]) + (v[2] * v[2] + v[3] * v[3]);
                    o8[64 * j] = (unsigned long long)pk2(v[0] * gg[0], v[1] * gg[1]) | ((unsigned long long)pk2(v[2] * gg[2], v[3] * gg[3]) << 32); }
                s = wave_sum(s);
                if (lane < 8) SUMP[(size_t)m * 8 + lane] = (lane == 0) ? s : 0.f;
            }
        } else if (ph == PH_FINAL) {
            const int gw = blockIdx.x * NWAVES + wave, NGW = G * NWAVES;
            const float* gf = KIN(20);
            for (int m = gw; m < MTOK; m += NGW) {
                const f32x4 p0 = *(const f32x4*)(SUMP + ((size_t)4 * 8192 + m) * 8), p1 = *(const f32x4*)(SUMP + ((size_t)4 * 8192 + m) * 8 + 4);
                const float rs = __builtin_amdgcn_rsqf((((p0[0] + p0[1]) + (p0[2] + p0[3])) + ((p1[0] + p1[1]) + (p1[2] + p1[3]))) * (1.0f / 2048.0f) + 1e-6f);
                const f32x4* xr = (const f32x4*)(X + (size_t)m * DM) + lane; f32x4* o = (f32x4*)(args.out + (size_t)m * DM) + lane;
#pragma unroll
                for (int j = 0; j < 8; ++j) { const f32x4 v = xr[64 * j]; const f32x4 gg = ((const f32x4*)gf)[lane + 64 * j]; o[64 * j] = v * gg * rs; }
            }
        } else {
            const int L = (ph - 1) >> 2, sub = (ph - 1) & 3, i = L >> 1, odd = L & 1;
            if (sub == 0) {
                const int N = odd ? OD_Z : EV_IN;
                const bf16* Wt = (const bf16*)(ws + (odd ? WS_WODIN : WS_WEVIN)) + (size_t)i * N * DM;
                pg8::Gemm g{XG, Wt, MTOK, N, DM}; pg8::StaticOrder S; S.init(MTOK, N, G, (int)blockIdx.x);
                pg8::EpiIn E{Z, N, SUMP + (size_t)L * 8192 * 8};
                pg8::gemm_phase<pg8::EpiIn, pg8::StaticOrder, true, true>(lds + RING_OFF, g, S, E);
                if (odd) {
                    const bf16* WA = (const bf16*)(ws + WS_WALR) + (size_t)i * 16 * 2048;
                    for (int rb0 = blockIdx.x * 32; rb0 < MTOK; rb0 += G * 32) {
                        const int rb = wave & 1, kq = wave >> 1, fr = lane & 15, fq = lane >> 4;
                        const bf16* ap = XG + (size_t)(rb0 + 16 * rb + fr) * DM + kq * 512 + 8 * fq;
                        const bf16* bp = WA + (size_t)fr * DM + kq * 512 + 8 * fq;
                        f32x4 acc = {0.f, 0.f, 0.f, 0.f};
#pragma unroll 8
                        for (int ks = 0; ks < 16; ++ks) { const bf16x8 a = *(const bf16x8*)(ap + ks * 32), b = *(const bf16x8*)(bp + ks * 32);
                            acc = __builtin_amdgcn_mfma_f32_16x16x32_bf16(a, b, acc, 0, 0, 0); }
                        LAS float* part = (LAS float*)(lds + RING_OFF);
#pragma unroll
                        for (int r = 0; r < 4; ++r) part[(kq * 32 + 16 * rb + 4 * fq + r) * 16 + fr] = acc[r];
                        __syncthreads();
                        { const int row = tid >> 4, j = tid & 15;
                          const float s = (part[(0 * 32 + row) * 16 + j] + part[(1 * 32 + row) * 16 + j]) + (part[(2 * 32 + row) * 16 + j] + part[(3 * 32 + row) * 16 + j]);
                          const float* sp_ = SUMP + ((size_t)L * 8192 + rb0 + row) * 8; const f32x4 p0 = *(const f32x4*)sp_, p1 = *(const f32x4*)(sp_ + 4);
                          const float rs = __builtin_amdgcn_rsqf((((p0[0] + p0[1]) + (p0[2] + p0[3])) + ((p1[0] + p1[1]) + (p1[2] + p1[3]))) * (1.0f / 2048.0f) + 1e-6f);
                          ALR[(size_t)(rb0 + row) * 16 + j] = s * rs; }
                        __syncthreads();
                    }
                }
            } else if (sub == 3) {
                const bf16* Wt = (const bf16*)(ws + (odd ? WS_WODOUT : WS_WEVOUT)) + (size_t)i * DM * DM;
                const float* gn = karg<const float>(ka_, (int)offsetof(Args, gn) + 8 * L);
                const float* xo = karg<const float>(ka_, (int)offsetof(Args, xold) + 8 * L);
                pg8::Gemm g{Y, Wt, MTOK, DM, DM}; pg8::StaticOrder S; S.init(MTOK, DM, G, (int)blockIdx.x);
                pg8::EpiOut E{xo, X, XG, gn, SUMP + (size_t)(L + 1) * 8192 * 8, L < 3 ? 1 : 0, (LAS float*)(lds + RING_BYTES)};
                pg8::gemm_phase<pg8::EpiOut, pg8::StaticOrder, true, true>(lds + RING_OFF, g, S, E);
            }
            else if (sub == 1 && !odd) {
#ifdef OPT_LRU
                { LruParams P{KIN(3) + (size_t)i * 4 * LRU_W, KIN(4) + (size_t)i * LRU_W, KIN(6) + (size_t)i * LRU_W, KIN(8) + (size_t)i * LRU_W, KIN(9) + (size_t)i * LRU_W,
                              (const bf16*)(ws + WS_WGATE) + (size_t)i * 12 * 2 * 128 * 128};
                  for (int item = blockIdx.x; item < 192; item += G) lru_item(lds, item, Z, P, Y, tid); }
#endif
#ifdef OPT_ATTN
                for (int item = blockIdx.x; item < 768; item += G) attn_item(lds, item, Z, (bf16*)(ws + WS_T0), (float*)(ws + WS_T1), tid);
#endif
            } else if (sub == 2 && !odd) {
#ifdef OPT_ATTN
                attn_merge(Z, (const bf16*)(ws + WS_T0), (const float*)(ws + WS_T1), Y, blockIdx.x * 512 + tid, G * 512);
#endif
            }
            else if (sub == 1 && odd) {
#ifdef OPT_GLA
                const float* wal = KIN(13) + (size_t)i * 16 * 512; const float* bal = KIN(14) + (size_t)i * 512;
                for (int item = blockIdx.x; item < 512; item += G)
                    gla1_item(lds, item, Z, ALR, wal, bal, (bf16*)(ws + WS_T0), (bf16*)(ws + WS_T0 + 8 * MiB), (bf16*)(ws + WS_T0 + 16 * MiB), (float*)(ws + WS_T0 + 32 * MiB), tid);
#endif
            }
            else if (sub == 2 && odd) {
#ifdef OPT_GLA
                if (blockIdx.x < 16) {
                    gla2_item(lds, blockIdx.x, Z, (const bf16*)(ws + WS_T0), (const bf16*)(ws + WS_T0 + 8 * MiB), (const bf16*)(ws + WS_T0 + 16 * MiB), (const float*)(ws + WS_T0 + 32 * MiB),
                              KIN(15) + (size_t)i * 1024, Y, tid);
                } else {
                    const float* vn = KIN(16) + (size_t)i * 1024; const float* wsg = KIN(17) + (size_t)i * 4 * 128 * 128; const float* bsg = KIN(18) + (size_t)i * 4 * 128;
                    for (int item = blockIdx.x - 16; item < 256; item += G - 16) sgu_item(lds, item, Z, vn, wsg, bsg, Y, tid);
                }
            }
            else if (sub == 2 && odd && false) {
#endif
                const float* vn = KIN(16) + (size_t)i * 1024; const float* wsg = KIN(17) + (size_t)i * 4 * 128 * 128; const float* bsg = KIN(18) + (size_t)i * 4 * 128;
                for (int item = blockIdx.x; item < 256; item += G) sgu_item(lds, item, Z, vn, wsg, bsg, Y, tid);
            }
        }
    }
}

#define OPT_SGU 1
constexpr int OPT_EVEN_LO = 2, OPT_ODD_LO = 2;
static void launch_mk(Args& a, int lo, int hi, int li, int grid, hipStream_t stream) {
    a.ph_lo = lo; a.ph_hi = hi; a.li = li;
    hipLaunchKernelGGL(mk_fwd, dim3(grid), dim3(NWAVES * 64), LDS_BYTES, stream, a);
}
extern "C" void kernel_launch(void* const* d_in, const int* in_sizes, int n_in, void* d_out, int out_size, void* d_ws, size_t ws_size, hipStream_t stream) {
    static int grid = 0;
    if (grid == 0) {
        if (n_in != 21 || ws_size < WS_END) { fprintf(stderr, "kernel_launch: unexpected n_in %d / ws_size %zu\n", n_in, ws_size); grid = -1; return; }
        int dev = 0, cus = 0, per_cu = 0;
        if (hipGetDevice(&dev) != hipSuccess || hipDeviceGetAttribute(&cus, hipDeviceAttributeMultiprocessorCount, dev) != hipSuccess) { grid = -1; return; }
        if (hipFuncSetAttribute((const void*)mk_fwd, hipFuncAttributeMaxDynamicSharedMemorySize, LDS_BYTES) != hipSuccess) { fprintf(stderr, "kernel_launch: hipFuncSetAttribute failed\n"); grid = -1; return; }
        if (hipOccupancyMaxActiveBlocksPerMultiprocessor(&per_cu, (const void*)mk_fwd, NWAVES * 64, LDS_BYTES) != hipSuccess || per_cu < 1) { fprintf(stderr, "kernel_launch: occupancy query says %d\n", per_cu); }
        (void)hipGetLastError();
        grid = cus;
    }
    if (grid < 0) return;
    hipMemsetAsync((char*)d_ws + WS_CTL, 0, CTL_ZERO_BYTES, stream);
    Args a{};
    for (int i = 0; i < 21; ++i) a.in[i] = (const float*)d_in[i];
    a.out = (float*)d_out; a.ws = (unsigned char*)d_ws;
    a.gn[0] = a.in[11]; a.gn[1] = a.in[1] + DM; a.gn[2] = a.in[11] + DM; a.gn[3] = a.in[20];
    a.xold[0] = a.in[0]; a.xold[1] = a.xold[2] = a.xold[3] = (const float*)((char*)d_ws + WS_X);
    const float *ev_conv_w = a.in[3], *ev_conv_b = a.in[4], *ev_w_a = a.in[5], *ev_b_a = a.in[6], *ev_w_i = a.in[7], *ev_b_i = a.in[8], *ev_lam = a.in[9];
    const float *od_w_alpha = a.in[13], *od_b_alpha = a.in[14], *od_head_norm = a.in[15], *od_v_norm = a.in[16], *od_w_s = a.in[17], *od_b_s = a.in[18];
    char* ws = (char*)d_ws;
    bf16* Z = (bf16*)(ws + WS_Z); bf16* Y = (bf16*)(ws + WS_Y); float* ALR = (float*)(ws + WS_ALR); float* T0 = (float*)(ws + WS_T0); float* T1 = (float*)(ws + WS_T1);
    launch_mk(a, 0, N_PHASES, 0, grid, stream);
}
```

```cpp
#include <hip/hip_runtime.h>
#include <cstdio>
#include <cstdint>

constexpr int DM = 2048, NB = 4, SEQ = 2048, MTOK = NB * SEQ;
constexpr int LRU_W = 1536, EV_IN = 8192;
constexpr int OD_IN = 6160, OD_Z = 6144;
constexpr float EPS = 1e-6f;

typedef unsigned short bf16;
typedef bf16 AT;

__device__ __forceinline__ float bf2f(bf16 v) { return __uint_as_float((unsigned)v << 16); }
__device__ __forceinline__ unsigned f2bf(float f) { unsigned u = __builtin_bit_cast(unsigned, f); return (u + 0x7fffu + ((u >> 16) & 1u)) >> 16; }
__device__ __forceinline__ unsigned pk2(float lo, float hi) { return f2bf(lo) | (f2bf(hi) << 16); }
__device__ __forceinline__ float ldA(const bf16* p, size_t i) { return bf2f(p[i]); }
__device__ __forceinline__ void stA(bf16* p, size_t i, float v) { p[i] = (bf16)f2bf(v); }

__device__ __forceinline__ float sigmoidf_(float x) { return 1.f / (1.f + __expf(-x)); }
__device__ __forceinline__ float siluf_(float x) { return x * sigmoidf_(x); }
__device__ __forceinline__ float geluf_(float x) { return 0.5f * x * (1.f + tanhf(0.7978845608028654f * (x + 0.044715f * x * x * x))); }
__device__ __forceinline__ float softplusf_(float x) { return x > 20.f ? x : log1pf(__expf(x)); }
__device__ __forceinline__ float logsigmoidf_(float x) { return -softplusf_(-x); }

__device__ __forceinline__ float block_sum(float v, float* red) {
#pragma unroll
    for (int o = 32; o > 0; o >>= 1) v += __shfl_xor(v, o);
    const int w = threadIdx.x >> 6, nw = blockDim.x >> 6;
    __syncthreads();
    if ((threadIdx.x & 63) == 0) red[w] = v;
    __syncthreads();
    float s = 0.f;
    for (int i = 0; i < nw; ++i) s += red[i];
    return s;
}
__device__ __forceinline__ float block_max(float v, float* red) {
#pragma unroll
    for (int o = 32; o > 0; o >>= 1) v = fmaxf(v, __shfl_xor(v, o));
    const int w = threadIdx.x >> 6, nw = blockDim.x >> 6;
    __syncthreads();
    if ((threadIdx.x & 63) == 0) red[w] = v;
    __syncthreads();
    float s = -INFINITY;
    for (int i = 0; i < nw; ++i) s = fmaxf(s, red[i]);
    return s;
}

__global__ void __launch_bounds__(128) nv_lru_gates(const AT* z, const float* conv_w, const float* conv_b, const float* w_a, const float* b_a, const float* w_i, const float* b_i,
                                                    const float* lam, float* a_out, float* u_out) {
    __shared__ float xc[128];
    const int tok = blockIdx.x, h = blockIdx.y, j = threadIdx.x, t = tok % SEQ, ch = h * 128 + j;
    float v = conv_b[ch];
    for (int q = 0; q < 4; ++q) { const int tt = t + q - 3; if (tt >= 0) v += ldA(z, (size_t)(tok + q - 3) * EV_IN + ch) * conv_w[q * LRU_W + ch]; }
    xc[j] = v; __syncthreads();
    float ra = b_a[ch], ri = b_i[ch];
    const float* wa = w_a + (size_t)h * 128 * 128; const float* wi = w_i + (size_t)h * 128 * 128;
    for (int i = 0; i < 128; ++i) { ra += xc[i] * wa[i * 128 + j]; ri += xc[i] * wi[i * 128 + j]; }
    const float r = sigmoidf_(ra), ig = sigmoidf_(ri);
    const float log_a = -8.0f * r * softplusf_(-lam[ch]);
    const float a = __expf(log_a);
    const float u = sqrtf(-expm1f(2.f * log_a)) * (ig * v);
    a_out[(size_t)tok * LRU_W + ch] = a; u_out[(size_t)tok * LRU_W + ch] = u;
}
__global__ void __launch_bounds__(256) nv_lru_scan(const float* a, const float* u, const AT* z, AT* y) {
    const int idx = blockIdx.x * 256 + threadIdx.x; if (idx >= NB * LRU_W) return;
    const int b = idx / LRU_W, ch = idx % LRU_W; float h = 0.f;
    for (int t = 0; t < SEQ; ++t) { const size_t tok = (size_t)b * SEQ + t; h = a[tok * LRU_W + ch] * h + u[tok * LRU_W + ch];
        stA(y, tok * DM + ch, h * siluf_(ldA(z, tok * EV_IN + LRU_W + ch))); }
}
__global__ void __launch_bounds__(256) nv_attn(const AT* z, AT* y) {
    __shared__ float qs[128], ps[132], red[16], og[3][128], lse[3];
    const int tok = blockIdx.x, j = blockIdx.y, t = tok % SEQ, tid = threadIdx.x;
    for (int g = 0; g < 3; ++g) {
        const int d = 1 << (2 * g);
        const float slope = exp2f(-8.0f * (float)(g + 3 * j + 1) / 12.0f);
        const size_t qoff = 3072 + g * 512 + j * 128, koff = 4608 + g * 512 + j * 128, voff = 6144 + g * 512 + j * 128;
        __syncthreads();
        if (tid < 128) qs[tid] = ldA(z, (size_t)tok * EV_IN + qoff + tid);
        __syncthreads();
        float s = -INFINITY;
        if (tid <= 128 && t - tid * d >= 0) {
            const AT* kr = z + (size_t)(tok - tid * d) * EV_IN + koff; float acc = 0.f;
            for (int e = 0; e < 128; ++e) acc += qs[e] * ldA(kr, e);
            s = acc * 0.08838834764831845f - slope * (float)(tid * d);
        }
        const float m = block_max(s, red);
        const float p = (s == -INFINITY) ? 0.f : __expf(s - m);
        if (tid <= 128) ps[tid] = p;
        const float den = block_sum(p, red);
        __syncthreads();
        if (tid < 128) { float o = 0.f;
            for (int i = 0; i <= 128; ++i) { if (t - i * d < 0) break; o += ps[i] * ldA(z, (size_t)(tok - i * d) * EV_IN + voff + tid); }
            og[g][tid] = o / den; }
        if (tid == 0) lse[g] = m + __logf(den);
    }
    __syncthreads();
    if (tid < 128) {
        const float mm = fmaxf(lse[0], fmaxf(lse[1], lse[2]));
        const float w0 = __expf(lse[0] - mm), w1 = __expf(lse[1] - mm), w2 = __expf(lse[2] - mm);
        const float yv = (w0 * og[0][tid] + w1 * og[1][tid] + w2 * og[2][tid]) / (w0 + w1 + w2);
        stA(y, (size_t)tok * DM + LRU_W + j * 128 + tid, yv * siluf_(ldA(z, (size_t)tok * EV_IN + 7680 + j * 128 + tid)));
    }
}

__global__ void __launch_bounds__(256) nv_gla(const AT* z, const float* alr, const float* w_alpha, const float* b_alpha, const float* head_norm, AT* y) {
    __shared__ float qs[128], ks[128], al[128], ar[16], red[16];
    const int b = blockIdx.x >> 2, h = blockIdx.x & 3, v = threadIdx.x;
    float S[128];
#pragma unroll
    for (int e = 0; e < 128; ++e) S[e] = 0.f;
    for (int t = 0; t < SEQ; ++t) {
        const size_t tok = (size_t)b * SEQ + t;
        __syncthreads();
        if (v < 16) ar[v] = alr[tok * 16 + v];
        if (v < 128) { qs[v] = ldA(z, tok * OD_Z + h * 128 + v) * 0.08838834764831845f; ks[v] = ldA(z, tok * OD_Z + 512 + h * 128 + v); }
        __syncthreads();
        if (v < 128) { float s = b_alpha[h * 128 + v];
            for (int r = 0; r < 16; ++r) s += ar[r] * w_alpha[r * 512 + h * 128 + v];
            al[v] = __expf(logsigmoidf_(s) * (1.f / 16.f)); }
        __syncthreads();
        const float vv = ldA(z, tok * OD_Z + 1024 + h * 256 + v);
        float o = 0.f;
#pragma unroll
        for (int e = 0; e < 128; ++e) { S[e] = al[e] * S[e] + ks[e] * vv; o += qs[e] * S[e]; }
        const float ss = block_sum(o * o, red);
        const float r = rsqrtf(ss / 256.f + EPS);
        stA(y, tok * DM + h * 256 + v, o * r * head_norm[h * 256 + v] * siluf_(ldA(z, tok * OD_Z + 2048 + h * 256 + v)));
    }
}
__global__ void __launch_bounds__(256) nv_sgu_ln(const AT* z, const float* v_norm, float* vf) {
    __shared__ float red[16];
    const int tok = blockIdx.x, g = blockIdx.y, e = threadIdx.x;
    const float val = geluf_(ldA(z, (size_t)tok * OD_Z + 4096 + g * 256 + e));
    const float mu = block_sum(val, red) / 256.f;
    const float dv = val - mu;
    const float var = block_sum(dv * dv, red) / 256.f;
    vf[(size_t)tok * 1024 + g * 256 + e] = dv * rsqrtf(var + EPS) * v_norm[g * 256 + e];
}
__global__ void __launch_bounds__(256) nv_sgu_mix(const AT* z, const float* vf, const float* w_s, const float* b_s, AT* y) {
    const int tok = blockIdx.x, g = blockIdx.y, e = threadIdx.x, t = tok % 128, base = tok - t;
    float acc = b_s[g * 128 + t];
    const float* w = w_s + ((size_t)g * 128 + t) * 128;
    for (int s = 0; s <= t; ++s) acc += w[s] * vf[(size_t)(base + s) * 1024 + g * 256 + e];
    const float u = geluf_(ldA(z, (size_t)tok * OD_Z + 3072 + g * 256 + e));
    stA(y, (size_t)tok * DM + 1024 + g * 256 + e, u * acc * siluf_(ldA(z, (size_t)tok * OD_Z + 5120 + g * 256 + e)));
}
namespace pg8 {
#define PG8_LAS __attribute__((address_space(3)))
typedef unsigned short bf16_t;
typedef short bf16x8 __attribute__((ext_vector_type(8)));
typedef float f32x4 __attribute__((ext_vector_type(4)));
typedef unsigned u32x4 __attribute__((ext_vector_type(4)));
constexpr int BM = 256, BK = 64, HALF = 128, HTB = HALF * BK * 2  , STAGE_BYTES = 8 * HTB, NXCD = 8, WGM = 8;

__host__ __device__ __forceinline__ int lds_byte(int r, int c) { const int st = (r >> 4) * 2 + (c >> 5), rr = r & 15, cc = c & 31, ob = rr * 64 + cc * 2; return st * 1024 + (ob ^ (((ob >> 9) & 1) << 5)); }
__host__ __device__ __forceinline__ void stage_rc(int b, int& R, int& C) { const int st = b / 1024, sb = b % 1024, swz = sb ^ (((sb >> 9) & 1) << 5); R = (st >> 1) * 16 + swz / 64; C = (st & 1) * 32 + (swz % 64) / 2; }
__host__ __device__ __forceinline__ int perm32(int rho) { const int n = rho >> 4, i = rho & 15; return 8 * (i >> 2) + 4 * n + (i & 3); }

struct Unit { int pm, pn; };
struct Gemm { const bf16_t* A; const bf16_t* Bt; int M, N, K; };

struct StaticOrder {
    int nM, nN, nwg, G, c;
    __host__ __device__ void init(int M, int N, int G_, int c_) { nM = M / BM; nN = N / BM; nwg = nM * nN; G = G_; c = c_; }
    __host__ __device__ bool next(int i, Unit& u) const {
        const long L = (long)i * G + c; if (L >= nwg) return false;
        int wgid = (int)L; { const int q = nwg / NXCD, r = nwg % NXCD, xcd = wgid % NXCD, off = wgid / NXCD; wgid = (xcd < r ? xcd * (q + 1) : r * (q + 1) + (xcd - r) * q) + off; }
        const int nig = WGM * nN, gid = wgid / nig, fm = gid * WGM, gsz = (nM - fm) < WGM ? (nM - fm) : WGM;
        u.pm = fm + ((wgid % nig) % gsz); u.pn = (wgid % nig) / gsz; return true;
    }
    __device__ __forceinline__ void a_ready(const Unit&) const {}
    __device__ __forceinline__ void done(const Unit&) const {}
};

__device__ __forceinline__ unsigned cvt_pk_bf16(float lo, float hi) { unsigned r; asm volatile("v_cvt_pk_bf16_f32 %0, %1, %2" : "=v"(r) : "v"(lo), "v"(hi)); return r; }
struct EpiIn {
    static constexpr bool PERM = true, AFTER_DRAIN = false;
    bf16_t* O; int ldc; const float* sump;
    __device__ __forceinline__ void operator()(const f32x4 (&acc)[2][2][4][2], const Unit& u, int wr, int wc, int fr, int fq) const {
        const int row0 = u.pm * BM + wr * 64 + fr, col0 = u.pn * BM + wc * 32 + 8 * fq;
#pragma unroll
        for (int ai = 0; ai < 2; ++ai)
#pragma unroll
            for (int m = 0; m < 4; ++m) { const int row = row0 + ai * HALF + m * 16;
                const f32x4 p0 = *(const f32x4*)(sump + (size_t)row * 8), p1 = *(const f32x4*)(sump + (size_t)row * 8 + 4);
                const float rs = __builtin_amdgcn_rsqf((((p0[0] + p0[1]) + (p0[2] + p0[3])) + ((p1[0] + p1[1]) + (p1[2] + p1[3]))) * (1.0f / 2048.0f) + 1e-6f);
                bf16_t* rowp = O + (size_t)row * ldc + col0;
#pragma unroll
                for (int bj = 0; bj < 2; ++bj) { const f32x4 v0 = acc[ai][bj][m][0] * rs, v1 = acc[ai][bj][m][1] * rs;
                    u32x4 w; w.x = cvt_pk_bf16(v0[0], v0[1]); w.y = cvt_pk_bf16(v0[2], v0[3]); w.z = cvt_pk_bf16(v1[0], v1[1]); w.w = cvt_pk_bf16(v1[2], v1[3]);
                    *(u32x4*)(rowp + bj * HALF) = w; } }
    }
};
struct EpiOut {
    static constexpr bool PERM = true, AFTER_DRAIN = false;
    const float* xold; float* xnew; bf16_t* xg; const float* g; float* sump_next; int write_xg; PG8_LAS float* xs;
    __device__ __forceinline__ void operator()(const f32x4 (&acc)[2][2][4][2], const Unit& u, int wr, int wc, int fr, int fq) const {
        const int row0 = u.pm * BM + wr * 64 + fr, col0 = u.pn * BM + wc * 32 + 8 * fq;
        f32x4 gv[2][2];
#pragma unroll
        for (int bj = 0; bj < 2; ++bj) { gv[bj][0] = *(const f32x4*)(g + col0 + bj * HALF); gv[bj][1] = *(const f32x4*)(g + col0 + bj * HALF + 4); }
#pragma unroll
        for (int ai = 0; ai < 2; ++ai)
#pragma unroll
            for (int m = 0; m < 4; ++m) { const int row = row0 + ai * HALF + m * 16; const size_t off = (size_t)row * 2048 + col0; float ss = 0.f;
#pragma unroll
                for (int bj = 0; bj < 2; ++bj) {
                    const f32x4 v0 = acc[ai][bj][m][0] + *(const f32x4*)(xold + off + bj * HALF), v1 = acc[ai][bj][m][1] + *(const f32x4*)(xold + off + bj * HALF + 4);
                    *(f32x4*)(xnew + off + bj * HALF) = v0; *(f32x4*)(xnew + off + bj * HALF + 4) = v1;
                    ss += (v0[0] * v0[0] + v0[1] * v0[1]) + (v0[2] * v0[2] + v0[3] * v0[3]) + (v1[0] * v1[0] + v1[1] * v1[1]) + (v1[2] * v1[2] + v1[3] * v1[3]);
                    if (write_xg) { const f32x4 a = v0 * gv[bj][0], b = v1 * gv[bj][1];
                        u32x4 w; w.x = cvt_pk_bf16(a[0], a[1]); w.y = cvt_pk_bf16(a[2], a[3]); w.z = cvt_pk_bf16(b[0], b[1]); w.w = cvt_pk_bf16(b[2], b[3]);
                        *(u32x4*)(xg + off + bj * HALF) = w; } }
                ss += __shfl_xor(ss, 16); ss += __shfl_xor(ss, 32);
                if (fq == 0) xs[(ai * HALF + wr * 64 + m * 16 + fr) * 4 + wc] = ss; }
        asm volatile("s_waitcnt lgkmcnt(0)" ::: "memory"); __builtin_amdgcn_s_barrier(); asm volatile("" ::: "memory");
        { const int t = threadIdx.x; if (t < 256) { const f32x4 p = *(const PG8_LAS f32x4*)(xs + 4 * t); sump_next[(size_t)(u.pm * BM + t) * 8 + u.pn] = (p[0] + p[1]) + (p[2] + p[3]); } }
    }
};
template <class Epi, class Sched, bool ALIGN_EPI = false, bool SP2 = false>
__device__ __forceinline__ void gemm_phase(PG8_LAS unsigned char* lds, const Gemm g, const Sched& S, const Epi& E) {
    int tid_op = threadIdx.x; asm volatile("" : "+v"(tid_op));
    const int tid = tid_op, wid = __builtin_amdgcn_readfirstlane(tid >> 6), lane = tid & 63, wr = wid >> 2, wc = wid & 3, fr = lane & 15, fq = lane >> 4;
    const int K = g.K, nt = K / BK;
    unsigned voffA[2], voffB[2];
#pragma unroll
    for (int i = 0; i < 2; ++i) { int R, C; stage_rc(tid * 16 + i * 8192, R, C); const int Rb = Epi::PERM ? ((R & ~31) + perm32(R & 31)) : R;
        voffA[i] = (unsigned)(R * K + C) * 2u; voffB[i] = (unsigned)(Rb * K + C) * 2u; }
    const size_t kstep = (size_t)(BK * 2);
    const size_t hstep = (size_t)HALF * K * 2;
    const size_t tstep = 2 * hstep;
    const unsigned ldsw = (unsigned)wid * 1024u;
    const int aoff = lds_byte(wr * 64 + fr, fq * 8), boff = lds_byte(wc * 32 + fr, fq * 8);
#define PG8_SA(b, h) (((b) * 2 + (h)) * HTB)
#define PG8_SB(b, h) ((4 + (b) * 2 + (h)) * HTB)
#define PG8_STAGE(bufoff, gbase, voff) do { _Pragma("unroll") for (int _i = 0; _i < 2; ++_i) \
        __builtin_amdgcn_global_load_lds((const unsigned*)((const char*)(gbase) + (voff)[_i]), (PG8_LAS unsigned*)(lds + (bufoff) + ldsw + _i * 8192), 16, 0, 0); } while (0)
#define PG8_LDA(dst, b, h) do { _Pragma("unroll") for (int m = 0; m < 4; ++m) _Pragma("unroll") for (int k = 0; k < 2; ++k) dst[m][k] = *(const PG8_LAS bf16x8*)(lds + PG8_SA(b, h) + aoff + m * 2048 + k * 1024); } while (0)
#define PG8_LDB(dst, b, h) do { _Pragma("unroll") for (int n = 0; n < 2; ++n) _Pragma("unroll") for (int k = 0; k < 2; ++k) dst[n][k] = *(const PG8_LAS bf16x8*)(lds + PG8_SB(b, h) + boff + n * 2048 + k * 1024); } while (0)
#define PG8_MMA(ai, bj, At, Bt) do { __builtin_amdgcn_s_setprio(1); _Pragma("unroll") for (int m = 0; m < 4; ++m) _Pragma("unroll") for (int n = 0; n < 2; ++n) _Pragma("unroll") for (int k = 0; k < 2; ++k) \
        acc[ai][bj][m][n] = __builtin_amdgcn_mfma_f32_16x16x32_bf16(Bt[n][k], At[m][k], acc[ai][bj][m][n], 0, 0, 0); __builtin_amdgcn_s_setprio(0); } while (0)
#define PG8_WAIT_V(n) asm volatile("s_waitcnt vmcnt(" #n ")" ::: "memory")
#define PG8_WAIT_L(n) asm volatile("s_waitcnt lgkmcnt(" #n ")" ::: "memory")
#define PG8_BAR __builtin_amdgcn_s_barrier()
#define PG8_SCHED __builtin_amdgcn_sched_barrier(0)
    Unit cur, nxt; int ui = 0;
    if (!S.next(0, cur)) return;
    f32x4 acc[2][2][4][2];
#pragma unroll
    for (int a = 0; a < 2; ++a)
#pragma unroll
        for (int b = 0; b < 2; ++b)
#pragma unroll
            for (int m = 0; m < 4; ++m)
#pragma unroll
                for (int n = 0; n < 2; ++n) acc[a][b][m][n] = (f32x4){0.f, 0.f, 0.f, 0.f};
    bf16x8 At[4][2], B0[2][2], B1[2][2];
    const char* cA = (const char*)g.A + (size_t)cur.pm * tstep; const char* cB = (const char*)g.Bt + (size_t)cur.pn * tstep;
    S.a_ready(cur);
    if constexpr (SP2) {
        PG8_STAGE(PG8_SB(0, 0), cB, voffB); PG8_STAGE(PG8_SB(0, 1), cB + hstep, voffB); PG8_STAGE(PG8_SA(0, 0), cA, voffA); PG8_STAGE(PG8_SA(0, 1), cA + hstep, voffA);
        if (wr == 1) PG8_BAR;
        PG8_WAIT_V(2); PG8_BAR;
        PG8_STAGE(PG8_SB(1, 0), cB + kstep, voffB); PG8_STAGE(PG8_SA(1, 0), cA + kstep, voffA); PG8_STAGE(PG8_SB(1, 1), cB + hstep + kstep, voffB);
        PG8_WAIT_V(6); PG8_BAR;
    } else {
        PG8_STAGE(PG8_SB(0, 0), cB, voffB); PG8_STAGE(PG8_SA(0, 0), cA, voffA); PG8_STAGE(PG8_SB(0, 1), cB + hstep, voffB); PG8_STAGE(PG8_SA(0, 1), cA + hstep, voffA);
        if (wr == 1) PG8_BAR;
        PG8_WAIT_V(4); PG8_BAR;
        PG8_STAGE(PG8_SB(1, 0), cB + kstep, voffB); PG8_STAGE(PG8_SA(1, 0), cA + kstep, voffA); PG8_STAGE(PG8_SB(1, 1), cB + hstep + kstep, voffB);
        PG8_WAIT_V(6); PG8_BAR;
    }
    for (;;) {
        const bool has_next = S.next(ui + 1, nxt);
        const char* nA = has_next ? (const char*)g.A + (size_t)nxt.pm * tstep : cA; const char* nB = has_next ? (const char*)g.Bt + (size_t)nxt.pn * tstep : cB;
        for (int t = 0; t < nt; t += 2) {
            const bool last = (t == nt - 2);
            const char* a1 = cA + (size_t)(t + 1) * kstep;
            const char* a2 = last ? nA : cA + (size_t)(t + 2) * kstep; const char* b2 = last ? nB : cB + (size_t)(t + 2) * kstep;
            const char* a3 = a2 + kstep; const char* b3 = b2 + kstep;
            if (last && has_next) S.a_ready(nxt);
            if constexpr (SP2) {
            PG8_LDB(B0, 0, 0); PG8_LDB(B1, 0, 1); PG8_SCHED; PG8_LDA(At, 0, 0); PG8_STAGE(PG8_SA(1, 1), a1 + hstep, voffA);
            PG8_WAIT_V(8); PG8_WAIT_L(0); PG8_BAR; PG8_MMA(0, 0, At, B0); PG8_MMA(0, 1, At, B1); PG8_BAR; PG8_SCHED;
            PG8_LDA(At, 0, 1); PG8_STAGE(PG8_SB(0, 0), b2, voffB); PG8_STAGE(PG8_SB(0, 1), b2 + hstep, voffB); PG8_STAGE(PG8_SA(0, 0), a2, voffA);
            PG8_WAIT_V(8); PG8_WAIT_L(0); PG8_BAR; PG8_MMA(1, 0, At, B0); PG8_MMA(1, 1, At, B1); PG8_BAR; PG8_SCHED;
            PG8_LDB(B0, 1, 0); PG8_LDB(B1, 1, 1); PG8_SCHED; PG8_LDA(At, 1, 0); PG8_STAGE(PG8_SA(0, 1), a2 + hstep, voffA);
            PG8_WAIT_V(8); PG8_WAIT_L(0); PG8_BAR; PG8_MMA(0, 0, At, B0); PG8_MMA(0, 1, At, B1); PG8_BAR; PG8_SCHED;
            PG8_LDA(At, 1, 1); PG8_STAGE(PG8_SB(1, 0), b3, voffB); PG8_STAGE(PG8_SB(1, 1), b3 + hstep, voffB); PG8_STAGE(PG8_SA(1, 0), a3, voffA);
            PG8_WAIT_V(8); PG8_WAIT_L(0); PG8_BAR; PG8_MMA(1, 0, At, B0); PG8_MMA(1, 1, At, B1); PG8_BAR; PG8_SCHED;
            } else {
            PG8_LDB(B0, 0, 0); PG8_SCHED; PG8_LDA(At, 0, 0); PG8_STAGE(PG8_SA(1, 1), a1 + hstep, voffA);
            PG8_WAIT_L(8); PG8_BAR; PG8_WAIT_L(0); PG8_MMA(0, 0, At, B0); PG8_BAR; PG8_SCHED;
            PG8_LDB(B1, 0, 1); PG8_STAGE(PG8_SB(0, 0), b2, voffB);
            PG8_BAR; PG8_WAIT_L(0); PG8_MMA(0, 1, At, B1); PG8_BAR;
            PG8_LDA(At, 0, 1); PG8_STAGE(PG8_SA(0, 0), a2, voffA);
            PG8_BAR; PG8_WAIT_L(0); PG8_MMA(1, 0, At, B0); PG8_BAR; PG8_SCHED;
            PG8_STAGE(PG8_SB(0, 1), b2 + hstep, voffB);
            PG8_WAIT_V(6); PG8_BAR; PG8_MMA(1, 1, At, B1); PG8_BAR;
            PG8_LDB(B0, 1, 0); PG8_SCHED; PG8_LDA(At, 1, 0); PG8_STAGE(PG8_SA(0, 1), a2 + hstep, voffA);
            PG8_WAIT_L(8); PG8_BAR; PG8_WAIT_L(0); PG8_MMA(0, 0, At, B0); PG8_BAR; PG8_SCHED;
            PG8_LDB(B1, 1, 1); PG8_STAGE(PG8_SB(1, 0), b3, voffB);
            PG8_BAR; PG8_WAIT_L(0); PG8_MMA(0, 1, At, B1); PG8_BAR;
            PG8_LDA(At, 1, 1); PG8_STAGE(PG8_SA(1, 0), a3, voffA);
            PG8_BAR; PG8_WAIT_L(0); PG8_MMA(1, 0, At, B0); PG8_BAR; PG8_SCHED;
            PG8_STAGE(PG8_SB(1, 1), b3 + hstep, voffB);
            PG8_WAIT_V(6); PG8_BAR; PG8_MMA(1, 1, At, B1); PG8_BAR;
            }
        }
        if constexpr (ALIGN_EPI) { if (wr == 0) PG8_BAR; }
        if constexpr (!Epi::AFTER_DRAIN) { E(acc, cur, wr, wc, fr, fq); S.done(cur); }
        if (!has_next) break;
#pragma unroll
        for (int a = 0; a < 2; ++a)
#pragma unroll
            for (int b = 0; b < 2; ++b)
#pragma unroll
                for (int m = 0; m < 4; ++m)
#pragma unroll
                    for (int n = 0; n < 2; ++n) acc[a][b][m][n] = (f32x4){0.f, 0.f, 0.f, 0.f};
        cur = nxt; cA = nA; cB = nB; ++ui;
        if constexpr (ALIGN_EPI) { if (wr == 1) PG8_BAR; }
    }
    PG8_WAIT_V(0);
    if constexpr (!ALIGN_EPI) { if (wr == 0) PG8_BAR; }
    PG8_BAR;
    if constexpr (Epi::AFTER_DRAIN) { E.fused(acc, cur, wr, wc, fr, fq, lds, wid, lane); S.done(cur); }
#undef PG8_SA
#undef PG8_SB
#undef PG8_STAGE
#undef PG8_LDA
#undef PG8_LDB
#undef PG8_MMA
#undef PG8_WAIT_V
#undef PG8_WAIT_L
#undef PG8_BAR
#undef PG8_SCHED
}
}
#define GAS __attribute__((address_space(1)))
#define LAS __attribute__((address_space(3)))
typedef unsigned v4u __attribute__((ext_vector_type(4)));
typedef float f32x4 __attribute__((ext_vector_type(4)));
typedef short bf16x8 __attribute__((ext_vector_type(8)));
typedef GAS unsigned gu32;
#define RLX_AGENT __ATOMIC_RELAXED, __HIP_MEMORY_SCOPE_AGENT
#define LDS_WAIT() asm volatile("s_waitcnt lgkmcnt(0)" ::: "memory")
#define VM_WAIT() asm volatile("s_waitcnt vmcnt(0)" ::: "memory")
#define XB_TMO      128
#define XB_XCNT(j)  (256  + 64 * (j))
#define XB_XSUB(j)  (1280 + 64 * (j))
#define XB_XGEN(j)  (2304 + 64 * (j))
#define XB_TOP      3328
#define XB_TOPGEN   3392
#define XCD_BAR_WORDS 3456
#define XB_SPIN_CAP (1u << 18)

__device__ __forceinline__ unsigned xb_ld(unsigned* p)              { return __hip_atomic_load(p, __ATOMIC_RELAXED, __HIP_MEMORY_SCOPE_AGENT); }
__device__ __forceinline__ unsigned xb_add(unsigned* p, unsigned v) { return __hip_atomic_fetch_add(p, v, __ATOMIC_RELAXED, __HIP_MEMORY_SCOPE_AGENT); }
__device__ __forceinline__ unsigned xb_xcc_id() { return (unsigned)__builtin_amdgcn_s_getreg((3 << 11) | 20) & 0xFu; }
#define XB_SPIN(cond, bar) do { unsigned _sp = 0; while (cond) { __builtin_amdgcn_s_sleep(1); \
    if ((++_sp & 255u) == 0u) { if (xb_ld(&(bar)[XB_TMO])) break; if (_sp > XB_SPIN_CAP) { atomicAdd(&(bar)[XB_TMO], 1u); break; } } } } while (0)

struct XcdBarrier {
    unsigned* bar; unsigned x;
    volatile LAS unsigned* st;
};

__device__ __forceinline__ XcdBarrier xcd_barrier_post(unsigned* bar, volatile LAS unsigned* st) {
    XcdBarrier b; b.bar = bar; b.x = xb_xcc_id(); b.st = st;
    if (threadIdx.x == 0) (void)xb_add(&bar[XB_XCNT(b.x)], 1u);
    return b;
}
__device__ __forceinline__ void xcd_barrier_complete(unsigned* bar, unsigned x, unsigned& nloc, unsigned& nx) {
    const unsigned G = gridDim.x * gridDim.y * gridDim.z;
    unsigned sum, cnt, mine, sp = 0u;
    for (;;) {
        sum = 0u; cnt = 0u; mine = 0u;
#pragma unroll
        for (unsigned j = 0; j < 16; ++j) { const unsigned c = xb_ld(&bar[XB_XCNT(j)]); sum += c; cnt += (c > 0u) ? 1u : 0u; mine = (j == x) ? c : mine; }
        if (sum == G) break;
        __builtin_amdgcn_s_sleep(1);
        if ((++sp & 255u) == 0u) { if (xb_ld(&bar[XB_TMO])) break; if (sp > XB_SPIN_CAP) { atomicAdd(&bar[XB_TMO], 1u); break; } }
    }
    nloc = mine > 0u ? mine : 1u; nx = cnt > 0u ? cnt : 1u;
}

__device__ __forceinline__ void xcd_barrier(const XcdBarrier& b) {
    asm volatile("s_waitcnt vmcnt(0)" ::: "memory");
    __syncthreads();
    if (threadIdx.x == 0) {
        unsigned* bar = b.bar;
        __builtin_amdgcn_s_waitcnt(0);
        unsigned nloc = b.st[0], nx = b.st[1];
        if (nloc == 0u) { xcd_barrier_complete(bar, b.x, nloc, nx); b.st[0] = nloc; b.st[1] = nx; }
        const unsigned old = xb_add(&bar[XB_XSUB(b.x)], 1u);
        const unsigned gen = old / nloc;
        if (old + 1u == (gen + 1u) * nloc) {
            __builtin_amdgcn_fence(__ATOMIC_RELEASE, "agent");
            asm volatile("s_waitcnt vmcnt(0)" ::: "memory");
            const unsigned og = xb_add(&bar[XB_TOP], 1u);
            const unsigned tg = og / nx;
            if (og + 1u == (tg + 1u) * nx) xb_add(&bar[XB_TOPGEN], 1u);
            else XB_SPIN(xb_ld(&bar[XB_TOPGEN]) == tg, bar);
            __builtin_amdgcn_fence(__ATOMIC_ACQUIRE, "agent");
            xb_add(&bar[XB_XGEN(b.x)], 1u);
            asm volatile("s_waitcnt vmcnt(0)" ::: "memory");
        } else {
            XB_SPIN(xb_ld(&bar[XB_XGEN(b.x)]) == gen, bar);
            __builtin_amdgcn_fence(__ATOMIC_ACQUIRE, "agent");
            asm volatile("s_waitcnt vmcnt(0)" ::: "memory");
        }
    }
    __syncthreads();
}

typedef short s16x4 __attribute__((ext_vector_type(4)));
typedef unsigned u32x2 __attribute__((ext_vector_type(2)));
__device__ __forceinline__ float fast_sigmoid(float x) { return __builtin_amdgcn_rcpf(1.f + __builtin_amdgcn_exp2f(-1.4426950408889634f * x)); }
__device__ __forceinline__ float fast_silu(float x) { return x * fast_sigmoid(x); }
__device__ __forceinline__ float fast_gelu(float x) { return x * fast_sigmoid(x * (1.5957691216057308f + 0.0713548162726f * x * x)); }
__device__ __forceinline__ float bflo(unsigned w) { return __uint_as_float(w << 16); }
__device__ __forceinline__ float bfhi(unsigned w) { return __uint_as_float(w & 0xffff0000u); }
typedef float f32x2_t __attribute__((ext_vector_type(2))); typedef __bf16 bf16x2_t __attribute__((ext_vector_type(2)));
__device__ __forceinline__ unsigned cvtpk(float lo, float hi) { const f32x2_t v = {lo, hi}; const bf16x2_t b = __builtin_convertvector(v, bf16x2_t); return __builtin_bit_cast(unsigned, b); }
__device__ __forceinline__ s16x4 tr_read(const LAS unsigned char* p) { return __builtin_bit_cast(s16x4, __builtin_amdgcn_ds_read_tr16_b64_v4i16((LAS s16x4*)p)); }
__device__ __forceinline__ bf16x8 frag_tr(const LAS unsigned char* base, int stride, int lane) {
    const int G = lane >> 4, q = (lane >> 2) & 3, p = lane & 3;
    const LAS unsigned char* a = base + (4 * G + q) * stride + 8 * p;
    const s16x4 lo = tr_read(a), hi = tr_read(a + 16 * stride);
    return (bf16x8){lo[0], lo[1], lo[2], lo[3], hi[0], hi[1], hi[2], hi[3]};
}
__device__ __forceinline__ bf16x8 frag_perm_row(const LAS unsigned char* rowbase, int stride, int lane) {
    const LAS unsigned char* a = rowbase + (lane & 15) * stride + 8 * (lane >> 4);
    const s16x4 lo = *(const LAS s16x4*)a, hi = *(const LAS s16x4*)(a + 32);
    return (bf16x8){lo[0], lo[1], lo[2], lo[3], hi[0], hi[1], hi[2], hi[3]};
}

constexpr int SGU_VF_STRIDE = 544, SGU_W_STRIDE = 272, SGU_VF_OFF = 0, SGU_W_OFF = 128 * SGU_VF_STRIDE;
__device__ __forceinline__ void sgu_item(LAS unsigned char* lds, int item, const bf16* Z, const float* v_norm, const float* w_s, const float* b_s, bf16* Y, int tid) {
    const int lane = tid & 63, wave = __builtin_amdgcn_readfirstlane(tid >> 6);
    const int g = item & 3, c = (item >> 2) & 15, b = item >> 6;
    const size_t tok0 = (size_t)b * SEQ + 128 * c;
    LAS unsigned char* VF = lds + SGU_VF_OFF; LAS unsigned char* WS = lds + SGU_W_OFF;
    {
        const int sub = lane >> 4, cl = lane & 15;
        float vn[16];
#pragma unroll
        for (int j = 0; j < 4; ++j) { const f32x4 t = *(const f32x4*)(v_norm + g * 256 + 16 * cl + 4 * j); vn[4 * j] = t[0]; vn[4 * j + 1] = t[1]; vn[4 * j + 2] = t[2]; vn[4 * j + 3] = t[3]; }
#pragma unroll
        for (int ps = 0; ps < 4; ++ps) {
            const int row = 16 * wave + 4 * ps + sub;
            const v4u* src = (const v4u*)(Z + (tok0 + row) * OD_Z + 4096 + 256 * g + 16 * cl);
            const v4u w0 = src[0], w1 = src[1];
            float x[16];
#pragma unroll
            for (int j = 0; j < 4; ++j) { x[2 * j] = fast_gelu(bflo(w0[j])); x[2 * j + 1] = fast_gelu(bfhi(w0[j])); x[8 + 2 * j] = fast_gelu(bflo(w1[j])); x[9 + 2 * j] = fast_gelu(bfhi(w1[j])); }
            float s = 0.f;
#pragma unroll
            for (int j = 0; j < 16; ++j) s += x[j];
            s += __shfl_xor(s, 1); s += __shfl_xor(s, 2); s += __shfl_xor(s, 4); s += __shfl_xor(s, 8);
            const float mu = s * (1.f / 256.f);
            float q = 0.f;
#pragma unroll
            for (int j = 0; j < 16; ++j) { x[j] -= mu; q += x[j] * x[j]; }
            q += __shfl_xor(q, 1); q += __shfl_xor(q, 2); q += __shfl_xor(q, 4); q += __shfl_xor(q, 8);
            const float rstd = __builtin_amdgcn_rsqf(q * (1.f / 256.f) + 1e-6f);
            v4u o0, o1;
#pragma unroll
            for (int j = 0; j < 4; ++j) { o0[j] = cvtpk(x[2 * j] * rstd * vn[2 * j], x[2 * j + 1] * rstd * vn[2 * j + 1]); o1[j] = cvtpk(x[8 + 2 * j] * rstd * vn[8 + 2 * j], x[9 + 2 * j] * rstd * vn[9 + 2 * j]); }
            LAS v4u* dst = (LAS v4u*)(VF + row * SGU_VF_STRIDE + 32 * cl);
            dst[0] = o0; dst[1] = o1;
        }
    }
    {
        const int t = tid >> 2, s0 = (tid & 3) * 32;
        const f32x4* src = (const f32x4*)(w_s + ((size_t)g * 128 + t) * 128 + s0);
#pragma unroll
        for (int j = 0; j < 4; ++j) { const f32x4 a = src[2 * j], bb = src[2 * j + 1]; const int s = s0 + 8 * j;
            v4u o; o[0] = cvtpk(s + 0 <= t ? a[0] : 0.f, s + 1 <= t ? a[1] : 0.f); o[1] = cvtpk(s + 2 <= t ? a[2] : 0.f, s + 3 <= t ? a[3] : 0.f);
            o[2] = cvtpk(s + 4 <= t ? bb[0] : 0.f, s + 5 <= t ? bb[1] : 0.f); o[3] = cvtpk(s + 6 <= t ? bb[2] : 0.f, s + 7 <= t ? bb[3] : 0.f);
            *(LAS v4u*)(WS + t * SGU_W_STRIDE + 2 * s) = o; }
    }
    __syncthreads();
    f32x4 acc[2][8];
#pragma unroll
    for (int eb = 0; eb < 2; ++eb)
#pragma unroll
        for (int tb = 0; tb < 8; ++tb) acc[eb][tb] = (f32x4){0.f, 0.f, 0.f, 0.f};
#pragma unroll
    for (int ks = 0; ks < 4; ++ks) {
        bf16x8 af[2];
#pragma unroll
        for (int eb = 0; eb < 2; ++eb) af[eb] = frag_tr(VF + (32 * ks) * SGU_VF_STRIDE + (16 * (2 * wave + eb)) * 2, SGU_VF_STRIDE, lane);
#pragma unroll
        for (int tb = 2 * ks; tb < 8; ++tb) {
            const bf16x8 bfr = frag_perm_row(WS + (16 * tb) * SGU_W_STRIDE + (32 * ks) * 2, SGU_W_STRIDE, lane);
#pragma unroll
            for (int eb = 0; eb < 2; ++eb) acc[eb][tb] = __builtin_amdgcn_mfma_f32_16x16x32_bf16(af[eb], bfr, acc[eb][tb], 0, 0, 0);
        }
    }
    {
        const int G = lane >> 4, tl = lane & 15;
#pragma unroll
        for (int tb = 0; tb < 8; ++tb) {
            const int t = 16 * tb + tl; const float bs = b_s[g * 128 + t];
            const bf16* zr = Z + (tok0 + t) * OD_Z + 256 * g;
            bf16* yr = Y + (tok0 + t) * DM + 1024 + 256 * g;
#pragma unroll
            for (int eb = 0; eb < 2; ++eb) {
                const int e = 16 * (2 * wave + eb) + 4 * G;
                const u32x2 uu = *(const u32x2*)(zr + 3072 + e), gg = *(const u32x2*)(zr + 5120 + e);
                const f32x4 a = acc[eb][tb];
                const float y0 = fast_gelu(bflo(uu[0])) * (a[0] + bs) * fast_silu(bflo(gg[0])), y1 = fast_gelu(bfhi(uu[0])) * (a[1] + bs) * fast_silu(bfhi(gg[0]));
                const float y2 = fast_gelu(bflo(uu[1])) * (a[2] + bs) * fast_silu(bflo(gg[1])), y3 = fast_gelu(bfhi(uu[1])) * (a[3] + bs) * fast_silu(bfhi(gg[1]));
                u32x2 o; o[0] = cvtpk(y0, y1); o[1] = cvtpk(y2, y3);
                *(u32x2*)(yr + e) = o;
            }
        }
    }
    __syncthreads();
}

constexpr int AT_STRIDE = 288, AT_K_OFF = 0, AT_V_OFF = 256 * AT_STRIDE, AT_V_ROWS = 272, AT_LDS_END = AT_V_OFF + AT_V_ROWS * AT_STRIDE;
__device__ __forceinline__ void attn_item(LAS unsigned char* lds, int item, const bf16* Z, bf16* OG, float* LSE, int tid) {
    const int lane = tid & 63, wave = __builtin_amdgcn_readfirstlane(tid >> 6), G = lane >> 4, ql = lane & 15;
    const int g = item >> 8, rem = item & 255, j = rem & 3, rn = (rem >> 2) & 15, b = rem >> 6;
    const int d = 1 << (2 * g), nb = 16 >> (2 * g), n = rn % nb, r = rn / nb;
    const size_t tokb = (size_t)b * SEQ;
    LAS unsigned char* KT = lds + AT_K_OFF; LAS unsigned char* VT = lds + AT_V_OFF;
    const int q0 = 16 * wave;
    const size_t qtok = tokb + (size_t)(128 * n + q0 + ql) * d + r;
    bf16x8 qf[4];
    { const bf16* qp = Z + qtok * EV_IN + 3072 + g * 512 + j * 128 + 8 * G;
#pragma unroll
      for (int ks = 0; ks < 4; ++ks) qf[ks] = *(const bf16x8*)(qp + 32 * ks); }
    {
        const int c16 = tid & 15, rw = tid >> 4;
        const bf16* kb = Z + 4608 + g * 512 + j * 128 + 8 * c16;
#pragma unroll
        for (int ps = 0; ps < 8; ++ps) {
            const int kk = 32 * ps + rw; const int l = 128 * (n - 1) + kk;
            v4u kv = (v4u){0u, 0u, 0u, 0u}, vv = (v4u){0u, 0u, 0u, 0u};
            if (l >= 0) { const bf16* p = kb + (tokb + (size_t)l * d + r) * EV_IN; kv = *(const v4u*)p; vv = *(const v4u*)(p + 1536); }
            *(LAS v4u*)(KT + kk * AT_STRIDE + 16 * c16) = kv; *(LAS v4u*)(VT + kk * AT_STRIDE + 16 * c16) = vv;
        }
        if (tid < 16 * 18) *(LAS v4u*)(VT + 256 * AT_STRIDE + 16 * tid) = (v4u){0u, 0u, 0u, 0u};
    }
    __syncthreads();
    f32x4 sc[9];
#pragma unroll
    for (int t = 0; t < 9; ++t) {
        sc[t] = (f32x4){0.f, 0.f, 0.f, 0.f};
        const LAS unsigned char* kp = KT + (16 * wave + 16 * t + ql) * AT_STRIDE + 16 * G;
#pragma unroll
        for (int ks = 0; ks < 4; ++ks) sc[t] = __builtin_amdgcn_mfma_f32_16x16x32_bf16(*(const LAS bf16x8*)(kp + 64 * ks), qf[ks], sc[t], 0, 0, 0);
    }
    const float slope2 = exp2f(-8.0f * (float)(g + 3 * j + 1) / 12.0f) * (float)d * 1.4426950408889634f;
    const float scale2 = 0.08838834764831845f * 1.4426950408889634f;
    float mx = -INFINITY;
#pragma unroll
    for (int t = 0; t < 9; ++t)
#pragma unroll
        for (int rg = 0; rg < 4; ++rg) {
            const int rel = 16 * t + 4 * G + rg - ql;
            const bool ok = (rel >= 0) && (rel <= 128) && (n > 0 || (q0 + ql + rel) >= 128);
            const float s = sc[t][rg] * scale2 - slope2 * (float)(128 - rel);
            sc[t][rg] = ok ? s : -INFINITY;
            mx = fmaxf(mx, sc[t][rg]);
        }
    mx = fmaxf(mx, __shfl_xor(mx, 16)); mx = fmaxf(mx, __shfl_xor(mx, 32));
    float den = 0.f;
#pragma unroll
    for (int t = 0; t < 9; ++t)
#pragma unroll
        for (int rg = 0; rg < 4; ++rg) { const float p = __builtin_amdgcn_exp2f(sc[t][rg] - mx); sc[t][rg] = p; den += p; }
    den += __shfl_xor(den, 16); den += __shfl_xor(den, 32);
    f32x4 oc[8];
#pragma unroll
    for (int dvb = 0; dvb < 8; ++dvb) oc[dvb] = (f32x4){0.f, 0.f, 0.f, 0.f};
#pragma unroll
    for (int s = 0; s < 5; ++s) {
        const f32x4 plo = sc[2 * s], phi = (s < 4) ? sc[2 * s + 1] : (f32x4){0.f, 0.f, 0.f, 0.f};
        const unsigned w0 = cvtpk(plo[0], plo[1]), w1 = cvtpk(plo[2], plo[3]), w2 = cvtpk(phi[0], phi[1]), w3 = cvtpk(phi[2], phi[3]);
        const bf16x8 pf = __builtin_bit_cast(bf16x8, (v4u){w0, w1, w2, w3});
#pragma unroll
        for (int dvb = 0; dvb < 8; ++dvb) {
            const bf16x8 vf = frag_tr(VT + (16 * wave + 32 * s) * AT_STRIDE + (16 * dvb) * 2, AT_STRIDE, lane);
            oc[dvb] = __builtin_amdgcn_mfma_f32_16x16x32_bf16(vf, pf, oc[dvb], 0, 0, 0);
        }
    }
    const float rden = __builtin_amdgcn_rcpf(den);
    bf16* op = OG + ((size_t)g * MTOK + qtok) * 512 + j * 128 + 4 * G;
#pragma unroll
    for (int dvb = 0; dvb < 8; ++dvb) { u32x2 o; o[0] = cvtpk(oc[dvb][0] * rden, oc[dvb][1] * rden); o[1] = cvtpk(oc[dvb][2] * rden, oc[dvb][3] * rden); *(u32x2*)(op + 16 * dvb) = o; }
    if (G == 0) LSE[((size_t)g * MTOK + qtok) * 4 + j] = mx + __builtin_amdgcn_logf(den);
    __syncthreads();
}
__device__ __forceinline__ void attn_merge(const bf16* Z, const bf16* OG, const float* LSE, bf16* Y, int gtid, int gthreads) {
    for (int it = gtid; it < MTOK * 64; it += gthreads) {
        const int tok = it >> 6, c8 = it & 63, j = c8 >> 4;
        const float l0 = LSE[((size_t)0 * MTOK + tok) * 4 + j], l1 = LSE[((size_t)1 * MTOK + tok) * 4 + j], l2 = LSE[((size_t)2 * MTOK + tok) * 4 + j];
        const float m = fmaxf(l0, fmaxf(l1, l2));
        float w0 = __builtin_amdgcn_exp2f(l0 - m), w1 = __builtin_amdgcn_exp2f(l1 - m), w2 = __builtin_amdgcn_exp2f(l2 - m);
        const float rs = __builtin_amdgcn_rcpf(w0 + w1 + w2); w0 *= rs; w1 *= rs; w2 *= rs;
        const v4u a = *(const v4u*)(OG + ((size_t)0 * MTOK + tok) * 512 + 8 * c8), bb = *(const v4u*)(OG + ((size_t)1 * MTOK + tok) * 512 + 8 * c8), cc = *(const v4u*)(OG + ((size_t)2 * MTOK + tok) * 512 + 8 * c8);
        const v4u gt = *(const v4u*)(Z + (size_t)tok * EV_IN + 7680 + 8 * c8);
        v4u o;
#pragma unroll
        for (int k = 0; k < 4; ++k) {
            const float ylo = (w0 * bflo(a[k]) + w1 * bflo(bb[k]) + w2 * bflo(cc[k])) * fast_silu(bflo(gt[k]));
            const float yhi = (w0 * bfhi(a[k]) + w1 * bfhi(bb[k]) + w2 * bfhi(cc[k])) * fast_silu(bfhi(gt[k]));
            o[k] = cvtpk(ylo, yhi);
        }
        *(v4u*)(Y + (size_t)tok * DM + 1536 + 8 * c8) = o;
    }
}

constexpr int LR_XC_STRIDE = 272, LR_XC_OFF = 0, LR_F_STRIDE = 528  , LR_XCF_OFF = 128 * LR_XC_STRIDE, LR_A_OFF = LR_XCF_OFF + 32 * LR_F_STRIDE, LR_U_OFF = LR_A_OFF + 32 * LR_F_STRIDE, LR_LDS_END = LR_U_OFF + 32 * LR_F_STRIDE;
struct LruParams { const float *conv_w, *conv_b, *b_a, *b_i, *lam; const bf16* wg; };
__device__ __forceinline__ void lru_load_tile(v4u (&xa)[7], v4u& ga, const bf16* Z, size_t tokb, int t0, int h, int c4, int tid) {
    const int co = tid & 15, rg = tid >> 4;
#pragma unroll
    for (int k = 0; k < 7; ++k) { const int t = t0 + 4 * rg + k - 3;
        xa[k] = (t >= 0) ? *(const v4u*)(Z + (tokb + t) * EV_IN + h * 128 + 8 * co) : (v4u){0u, 0u, 0u, 0u}; }
    ga = *(const v4u*)(Z + (tokb + t0 + (tid >> 2)) * EV_IN + 1536 + h * 128 + 32 * c4 + 8 * (tid & 3));
}
__device__ __forceinline__ void lru_item(LAS unsigned char* lds, int item, const bf16* Z, const LruParams& P, bf16* Y, int tid) {
    const int lane = tid & 63, wave = __builtin_amdgcn_readfirstlane(tid >> 6), G = lane >> 4, ql = lane & 15;
    const int c4 = item & 3, h = (item >> 2) % 12, b = item / 48;
    const size_t tokb = (size_t)b * SEQ;
    LAS unsigned char* XC = lds + LR_XC_OFF; LAS unsigned char* XCF = lds + LR_XCF_OFF; LAS unsigned char* AL = lds + LR_A_OFF; LAS unsigned char* UL = lds + LR_U_OFF;
    bf16x8 wf[2][2][4];
#pragma unroll
    for (int gate = 0; gate < 2; ++gate)
#pragma unroll
        for (int cb = 0; cb < 2; ++cb)
#pragma unroll
            for (int ks = 0; ks < 4; ++ks) wf[gate][cb][ks] = *(const bf16x8*)(P.wg + ((size_t)(h * 2 + gate) * 128 + 32 * c4 + 16 * cb + ql) * 128 + 32 * ks + 8 * G);
    float ba[2], bi[2], sp8[2];
#pragma unroll
    for (int cb = 0; cb < 2; ++cb) { const int ch = h * 128 + 32 * c4 + 16 * cb + ql; ba[cb] = P.b_a[ch]; bi[cb] = P.b_i[ch];
        const float nl = -P.lam[ch]; sp8[cb] = 8.0f * (nl > 20.f ? nl : log1pf(__expf(nl))); }
    float hc = 0.f;
    v4u xa[7], ga;
    lru_load_tile(xa, ga, Z, tokb, 0, h, c4, tid);
    for (int sc = 0; sc < 16; ++sc) {
        const int t0 = 128 * sc;
        {
            const int co = tid & 15, rg = tid >> 4;
            v4u orow[4];
            const bool mine = (co >> 2) == c4;
#pragma unroll
            for (int e = 0; e < 4; ++e) {
                typedef float f32x2 __attribute__((ext_vector_type(2)));
                const int chn = h * 128 + 8 * co + 2 * e;
                const f32x2 w0 = *(const f32x2*)(P.conv_w + 0 * LRU_W + chn), w1 = *(const f32x2*)(P.conv_w + 1 * LRU_W + chn), w2 = *(const f32x2*)(P.conv_w + 2 * LRU_W + chn), w3 = *(const f32x2*)(P.conv_w + 3 * LRU_W + chn);
                const f32x2 cb2 = *(const f32x2*)(P.conv_b + chn);
                float lo[7], hi[7];
#pragma unroll
                for (int k = 0; k < 7; ++k) { lo[k] = bflo(xa[k][e]); hi[k] = bfhi(xa[k][e]); }
                f32x4 xlo, xhi;
#pragma unroll
                for (int r = 0; r < 4; ++r) { xlo[r] = cb2[0] + w0[0] * lo[r] + w1[0] * lo[r + 1] + w2[0] * lo[r + 2] + w3[0] * lo[r + 3];
                                              xhi[r] = cb2[1] + w0[1] * hi[r] + w1[1] * hi[r + 1] + w2[1] * hi[r + 2] + w3[1] * hi[r + 3]; orow[r][e] = cvtpk(xlo[r], xhi[r]); }
                if (mine) { *(LAS f32x4*)(XCF + (8 * (co & 3) + 2 * e) * LR_F_STRIDE + 16 * rg) = xlo; *(LAS f32x4*)(XCF + (8 * (co & 3) + 2 * e + 1) * LR_F_STRIDE + 16 * rg) = xhi; }
            }
#pragma unroll
            for (int r = 0; r < 4; ++r) *(LAS v4u*)(XC + (4 * rg + r) * LR_XC_STRIDE + 16 * co) = orow[r];
        }
        const v4u ga_cur = ga;
        if (sc < 15) lru_load_tile(xa, ga, Z, tokb, t0 + 128, h, c4, tid);
        __syncthreads();
        f32x4 acc[2][2];
#pragma unroll
        for (int gate = 0; gate < 2; ++gate)
#pragma unroll
            for (int cb = 0; cb < 2; ++cb) acc[gate][cb] = (f32x4){0.f, 0.f, 0.f, 0.f};
#pragma unroll
        for (int ks = 0; ks < 4; ++ks) {
            const bf16x8 af = *(const LAS bf16x8*)(XC + (16 * wave + ql) * LR_XC_STRIDE + 64 * ks + 16 * G);
#pragma unroll
            for (int gate = 0; gate < 2; ++gate)
#pragma unroll
                for (int cb = 0; cb < 2; ++cb) acc[gate][cb] = __builtin_amdgcn_mfma_f32_16x16x32_bf16(af, wf[gate][cb][ks], acc[gate][cb], 0, 0, 0);
        }
#pragma unroll
        for (int cb = 0; cb < 2; ++cb) {
            const int off = (16 * cb + ql) * LR_F_STRIDE + (16 * wave + 4 * G) * 4;
            const f32x4 xcv = *(const LAS f32x4*)(XCF + off);
            f32x4 av, uv;
#pragma unroll
            for (int rg2 = 0; rg2 < 4; ++rg2) {
                const float r = fast_sigmoid(acc[0][cb][rg2] + ba[cb]), ig = fast_sigmoid(acc[1][cb][rg2] + bi[cb]);
                const float la = -r * sp8[cb];
                const float a = __builtin_amdgcn_exp2f(la * 1.4426950408889634f);
                const float x2 = 2.f * la;
                const float om = (x2 > -0.05f) ? -x2 * (1.f + x2 * (0.5f + x2 * (0.16666667f + x2 * 0.041666667f))) : 1.f - a * a;
                av[rg2] = a; uv[rg2] = __builtin_amdgcn_sqrtf(om) * ig * xcv[rg2];
            }
            *(LAS f32x4*)(AL + off) = av; *(LAS f32x4*)(UL + off) = uv;
        }
        __syncthreads();
        {
            const int seg = ql, off = (4 * wave + G) * LR_F_STRIDE + 32 * seg;
            const f32x4 a0 = *(const LAS f32x4*)(AL + off), a1 = *(const LAS f32x4*)(AL + off + 16), u0 = *(const LAS f32x4*)(UL + off), u1 = *(const LAS f32x4*)(UL + off + 16);
            float Pp = 1.f, Hh = 0.f;
#pragma unroll
            for (int k = 0; k < 4; ++k) { Hh = a0[k] * Hh + u0[k]; Pp *= a0[k]; }
#pragma unroll
            for (int k = 0; k < 4; ++k) { Hh = a1[k] * Hh + u1[k]; Pp *= a1[k]; }
#pragma unroll
            for (int o = 1; o < 16; o <<= 1) { const float Pl = __shfl_up(Pp, o, 16), Hl = __shfl_up(Hh, o, 16); if (seg >= o) { Hh = Pp * Hl + Hh; Pp = Pp * Pl; } }
            float Pe = __shfl_up(Pp, 1, 16), He = __shfl_up(Hh, 1, 16);
            if (seg == 0) { Pe = 1.f; He = 0.f; }
            float hh = Pe * hc + He;
            f32x4 h0, h1;
#pragma unroll
            for (int k = 0; k < 4; ++k) { hh = a0[k] * hh + u0[k]; h0[k] = hh; }
#pragma unroll
            for (int k = 0; k < 4; ++k) { hh = a1[k] * hh + u1[k]; h1[k] = hh; }
            *(LAS f32x4*)(UL + off) = h0; *(LAS f32x4*)(UL + off + 16) = h1;
            hc = __shfl(hh, (lane & 48) + 15);
        }
        __syncthreads();
        {
            const int tk = tid >> 2, oc = tid & 3;
            float hv[8];
#pragma unroll
            for (int e = 0; e < 8; ++e) hv[e] = *(const LAS float*)(UL + (8 * oc + e) * LR_F_STRIDE + 4 * tk);
            v4u o;
#pragma unroll
            for (int e = 0; e < 4; ++e) o[e] = cvtpk(hv[2 * e] * fast_silu(bflo(ga_cur[e])), hv[2 * e + 1] * fast_silu(bfhi(ga_cur[e])));
            *(v4u*)(Y + (tokb + t0 + tk) * DM + h * 128 + 32 * c4 + 8 * oc) = o;
        }
    }
    __syncthreads();
}

constexpr int G1_ALR_OFF = 0, G1_TOT_OFF = 4096, G1_LDS_END = 6144;
__device__ __forceinline__ void gla1a_item(LAS unsigned char* lds, int item, const bf16* Z, const float* ALR, const float* w_alpha, const float* b_alpha, bf16* QT, bf16* KT, bf16* KD, float* DEC, int tid) {
    const int c = item & 31, h = (item >> 5) & 3, b = item >> 7;
    const size_t tok0 = (size_t)b * SEQ + 64 * c;
    LAS float* ALRs = (LAS float*)(lds + G1_ALR_OFF); LAS float* TOT = (LAS float*)(lds + G1_TOT_OFF);
    if (tid < 256) *(LAS f32x4*)(ALRs + 4 * tid) = *(const f32x4*)(ALR + tok0 * 16 + 4 * tid);
    const int e = tid & 127, tq = tid >> 7;
    float wa[16];
#pragma unroll
    for (int r = 0; r < 16; ++r) wa[r] = w_alpha[r * 512 + h * 128 + e];
    const float bal = b_alpha[h * 128 + e];
    float qv[16], kv[16];
#pragma unroll
    for (int t = 0; t < 16; ++t) { const bf16* zr = Z + (tok0 + 16 * tq + t) * OD_Z + h * 128 + e; qv[t] = bf2f(zr[0]); kv[t] = bf2f(zr[512]); }
    __syncthreads();
    float bc[16]; float run = 0.f;
#pragma unroll
    for (int t = 0; t < 16; ++t) {
        float s = bal;
#pragma unroll
        for (int r = 0; r < 16; ++r) s += ALRs[(16 * tq + t) * 16 + r] * wa[r];
        const float sp = (s < -20.f) ? -s : __builtin_amdgcn_logf(1.f + __builtin_amdgcn_exp2f(-s * 1.4426950408889634f)) * 0.6931471805599453f;
        run -= sp * 0.0625f; bc[t] = run;
    }
    TOT[tq * 128 + e] = run;
    __syncthreads();
    const float t0s = TOT[e], t1s = TOT[128 + e], t2s = TOT[256 + e], t3s = TOT[384 + e];
    const float offs = (tq > 0 ? t0s : 0.f) + (tq > 1 ? t1s : 0.f) + (tq > 2 ? t2s : 0.f), blast = (t0s + t1s) + (t2s + t3s);
    if (tq == 0) DEC[(size_t)item * 128 + e] = __builtin_amdgcn_exp2f(blast * 1.4426950408889634f);
#pragma unroll
    for (int t = 0; t < 16; ++t) {
        const float bb = bc[t] + offs;
        const float eb = __builtin_amdgcn_exp2f(bb * 1.4426950408889634f), enb = __builtin_amdgcn_exp2f(-bb * 1.4426950408889634f), edl = __builtin_amdgcn_exp2f((blast - bb) * 1.4426950408889634f);
        const size_t o = (tok0 + 16 * tq + t) * 512 + h * 128 + e;
        QT[o] = (bf16)f2bf(qv[t] * 0.08838834764831845f * eb); KT[o] = (bf16)f2bf(kv[t] * enb); KD[o] = (bf16)f2bf(kv[t] * edl);
    }
    __syncthreads();
}

constexpr int G2_KD_STRIDE = 288, G2_V_STRIDE = 160, G2_KD_OFF = 0, G2_V_OFF = 64 * G2_KD_STRIDE, G2_BUF = G2_V_OFF + 64 * G2_V_STRIDE, G2_DEC_OFF = 2 * G2_BUF, G2_LDS_END = G2_DEC_OFF + 32 * 128 * 4;
struct Gla2Stage { v4u kd[2], v; };
__device__ __forceinline__ void gla2_load(Gla2Stage& st, const bf16* Z, const bf16* KD, size_t tok0, int h, int slice, int tid) {
    const int rw = tid >> 4, c16 = tid & 15;
#pragma unroll
    for (int ps = 0; ps < 2; ++ps) st.kd[ps] = *(const v4u*)(KD + (tok0 + 32 * ps + rw) * 512 + h * 128 + 8 * c16);
    st.v = *(const v4u*)(Z + (tok0 + (tid >> 3)) * OD_Z + 1024 + h * 256 + 64 * slice + 8 * (tid & 7));
}
__device__ __forceinline__ void gla2_store(const Gla2Stage& st, LAS unsigned char* buf, int tid) {
    const int rw = tid >> 4, c16 = tid & 15;
#pragma unroll
    for (int ps = 0; ps < 2; ++ps) *(LAS v4u*)(buf + G2_KD_OFF + (32 * ps + rw) * G2_KD_STRIDE + 16 * c16) = st.kd[ps];
    *(LAS v4u*)(buf + G2_V_OFF + (tid >> 3) * G2_V_STRIDE + 16 * (tid & 7)) = st.v;
}
__device__ __forceinline__ void gla2s_item(LAS unsigned char* lds, int item, const bf16* Z, const bf16* KD, const float* DEC, bf16* SST, int tid) {
    const int lane = tid & 63, wave = __builtin_amdgcn_readfirstlane(tid >> 6), G = lane >> 4, ql = lane & 15;
    const int slice = item & 3, bh = item >> 2, h = bh & 3, b = bh >> 2;
    const size_t tokb = (size_t)b * SEQ;
    f32x4 sacc[4];
#pragma unroll
    for (int db = 0; db < 4; ++db) sacc[db] = (f32x4){0.f, 0.f, 0.f, 0.f};
    { Gla2Stage st; gla2_load(st, Z, KD, tokb, h, slice, tid); gla2_store(st, lds, tid);
#pragma unroll
      for (int k = 0; k < 2; ++k) *(LAS f32x4*)(lds + G2_DEC_OFF + 16 * (tid + 512 * k)) = *(const f32x4*)(DEC + (size_t)(bh * 32) * 128 + 4 * (tid + 512 * k)); }
    __syncthreads();
    for (int c = 0; c < 32; ++c) {
        LAS unsigned char* buf = lds + (c & 1) * G2_BUF;
        Gla2Stage st;
        if (c < 31) gla2_load(st, Z, KD, tokb + 64 * (c + 1), h, slice, tid);
        bf16* sp = SST + ((size_t)(bh * 32 + c) * 256 + 64 * slice + ql) * 128 + 16 * wave + 4 * G;
#pragma unroll
        for (int db = 0; db < 4; ++db) { u32x2 o; o[0] = cvtpk(sacc[db][0], sacc[db][1]); o[1] = cvtpk(sacc[db][2], sacc[db][3]); *(u32x2*)(sp + (size_t)(16 * db) * 128) = o; }
        const f32x4 dec = *(const LAS f32x4*)(lds + G2_DEC_OFF + (128 * c + 16 * wave + 4 * G) * 4);
#pragma unroll
        for (int db = 0; db < 4; ++db) sacc[db] *= dec;
#pragma unroll
        for (int s = 0; s < 2; ++s) {
            const bf16x8 kf = frag_tr(buf + G2_KD_OFF + (32 * s) * G2_KD_STRIDE + (16 * wave) * 2, G2_KD_STRIDE, lane);
#pragma unroll
            for (int db = 0; db < 4; ++db) {
                const bf16x8 vf = frag_tr(buf + G2_V_OFF + (32 * s) * G2_V_STRIDE + (16 * db) * 2, G2_V_STRIDE, lane);
                sacc[db] = __builtin_amdgcn_mfma_f32_16x16x32_bf16(kf, vf, sacc[db], 0, 0, 0);
            }
        }
        if (c < 31) gla2_store(st, lds + ((c + 1) & 1) * G2_BUF, tid);
        __syncthreads();
    }
}

constexpr int G3_QK_STRIDE = 272, G3_V_STRIDE = 544, G3_QT_OFF = 0, G3_KT_OFF = G3_QT_OFF + 64 * G3_QK_STRIDE, G3_V_OFF = G3_KT_OFF + 64 * G3_QK_STRIDE, G3_ST_OFF = G3_V_OFF + 64 * G3_V_STRIDE,
              G3_PART_OFF = G3_ST_OFF + 256 * G3_QK_STRIDE, G3_LDS_END = G3_PART_OFF + 8 * 16 * 4;
__device__ __forceinline__ void gla3_item(LAS unsigned char* lds, int item, const bf16* Z, const bf16* QT, const bf16* KT, const bf16* SST, const float* head_norm, bf16* Y, int tid) {
    const int lane = tid & 63, wave = __builtin_amdgcn_readfirstlane(tid >> 6), G = lane >> 4, ql = lane & 15;
    const int c = item & 31, h = (item >> 5) & 3, b = item >> 7;
    const size_t tok0 = (size_t)b * SEQ + 64 * c;
    LAS unsigned char* QTl = lds + G3_QT_OFF; LAS unsigned char* KTl = lds + G3_KT_OFF; LAS unsigned char* Vl = lds + G3_V_OFF; LAS unsigned char* STl = lds + G3_ST_OFF;
    LAS float* PART = (LAS float*)(lds + G3_PART_OFF);
    { const int rw = tid >> 4, c16 = tid & 15;
#pragma unroll
      for (int ps = 0; ps < 2; ++ps) { const size_t o = (tok0 + 32 * ps + rw) * 512 + h * 128 + 8 * c16;
          *(LAS v4u*)(QTl + (32 * ps + rw) * G3_QK_STRIDE + 16 * c16) = *(const v4u*)(QT + o); *(LAS v4u*)(KTl + (32 * ps + rw) * G3_QK_STRIDE + 16 * c16) = *(const v4u*)(KT + o); }
      const int rv = tid >> 5, c32 = tid & 31;
#pragma unroll
      for (int ps = 0; ps < 4; ++ps) *(LAS v4u*)(Vl + (16 * ps + rv) * G3_V_STRIDE + 16 * c32) = *(const v4u*)(Z + (tok0 + 16 * ps + rv) * OD_Z + 1024 + h * 256 + 8 * c32);
      const bf16* sp = SST + (size_t)item * 256 * 128;
#pragma unroll
      for (int ps = 0; ps < 8; ++ps) *(LAS v4u*)(STl + (32 * ps + rw) * G3_QK_STRIDE + 16 * c16) = *(const v4u*)(sp + (size_t)(32 * ps + rw) * 128 + 8 * c16); }
    const int ib = wave >> 1, dh = wave & 1;
    u32x2 gcv[8];
    { const bf16* gp = Z + (tok0 + 16 * ib + ql) * OD_Z + 2048 + h * 256 + 128 * dh + 4 * G;
#pragma unroll
      for (int dvb = 0; dvb < 8; ++dvb) gcv[dvb] = *(const u32x2*)(gp + 16 * dvb); }
    __syncthreads();
    bf16x8 qf[4];
#pragma unroll
    for (int ks = 0; ks < 4; ++ks) qf[ks] = *(const LAS bf16x8*)(QTl + (16 * ib + ql) * G3_QK_STRIDE + 64 * ks + 16 * G);
    f32x4 at[4];
#pragma unroll
    for (int jb = 0; jb < 4; ++jb) {
        at[jb] = (f32x4){0.f, 0.f, 0.f, 0.f};
        if (jb <= ib) {
#pragma unroll
            for (int ks = 0; ks < 4; ++ks) at[jb] = __builtin_amdgcn_mfma_f32_16x16x32_bf16(*(const LAS bf16x8*)(KTl + (16 * jb + ql) * G3_QK_STRIDE + 64 * ks + 16 * G), qf[ks], at[jb], 0, 0, 0);
#pragma unroll
            for (int rg = 0; rg < 4; ++rg) if (16 * jb + 4 * G + rg > 16 * ib + ql) at[jb][rg] = 0.f;
        }
    }
    f32x4 oc[8];
#pragma unroll
    for (int dvb = 0; dvb < 8; ++dvb) oc[dvb] = (f32x4){0.f, 0.f, 0.f, 0.f};
#pragma unroll
    for (int ks = 0; ks < 4; ++ks)
#pragma unroll
        for (int dvb = 0; dvb < 8; ++dvb)
            oc[dvb] = __builtin_amdgcn_mfma_f32_16x16x32_bf16(*(const LAS bf16x8*)(STl + (128 * dh + 16 * dvb + ql) * G3_QK_STRIDE + 64 * ks + 16 * G), qf[ks], oc[dvb], 0, 0, 0);
#pragma unroll
    for (int s = 0; s < 2; ++s) {
        if (2 * s <= ib) {
            const bf16x8 pf = __builtin_bit_cast(bf16x8, (v4u){cvtpk(at[2 * s][0], at[2 * s][1]), cvtpk(at[2 * s][2], at[2 * s][3]), cvtpk(at[2 * s + 1][0], at[2 * s + 1][1]), cvtpk(at[2 * s + 1][2], at[2 * s + 1][3])});
#pragma unroll
            for (int dvb = 0; dvb < 8; ++dvb) {
                const bf16x8 vf = frag_tr(Vl + (32 * s) * G3_V_STRIDE + (128 * dh + 16 * dvb) * 2, G3_V_STRIDE, lane);
                oc[dvb] = __builtin_amdgcn_mfma_f32_16x16x32_bf16(vf, pf, oc[dvb], 0, 0, 0);
            }
        }
    }
    float ss = 0.f;
#pragma unroll
    for (int dvb = 0; dvb < 8; ++dvb) ss += (oc[dvb][0] * oc[dvb][0] + oc[dvb][1] * oc[dvb][1]) + (oc[dvb][2] * oc[dvb][2] + oc[dvb][3] * oc[dvb][3]);
    ss += __shfl_xor(ss, 16); ss += __shfl_xor(ss, 32);
    if (G == 0) PART[wave * 16 + ql] = ss;
    __syncthreads();
    const float rs = __builtin_amdgcn_rsqf((PART[(wave & ~1) * 16 + ql] + PART[(wave | 1) * 16 + ql]) * (1.f / 256.f) + 1e-6f);
    bf16* yp = Y + (tok0 + 16 * ib + ql) * DM + h * 256 + 128 * dh + 4 * G;
    const float* hp = head_norm + h * 256 + 128 * dh + 4 * G;
#pragma unroll
    for (int dvb = 0; dvb < 8; ++dvb) {
        const f32x4 hn = *(const f32x4*)(hp + 16 * dvb); const f32x4 o = oc[dvb]; const u32x2 gc = gcv[dvb];
        u32x2 y; y[0] = cvtpk(o[0] * rs * hn[0] * fast_silu(bflo(gc[0])), o[1] * rs * hn[1] * fast_silu(bfhi(gc[0])));
        y[1] = cvtpk(o[2] * rs * hn[2] * fast_silu(bflo(gc[1])), o[3] * rs * hn[3] * fast_silu(bfhi(gc[1])));
        *(u32x2*)(yp + 16 * dvb) = y;
    }
    __syncthreads();
}
#define OPT_ATTN 1
#define OPT_LRU 1
#define OPT_GLA 1
constexpr int NWAVES = 8;
constexpr size_t MiB = 1u << 20;
constexpr size_t WS_CTL = 0, CTL_ZERO_BYTES = 1 * MiB;
constexpr size_t WS_WEVIN = 2 * MiB;
constexpr size_t WS_WEVOUT = 66 * MiB;
constexpr size_t WS_WODIN = 82 * MiB;
constexpr size_t WS_WODOUT = 130 * MiB;
constexpr size_t WS_WALR = 146 * MiB;
constexpr size_t WS_WGATE = 147 * MiB;
constexpr size_t WS_X = 150 * MiB;
constexpr size_t WS_XG = 214 * MiB;
constexpr size_t WS_Z = 246 * MiB;
constexpr size_t WS_Y = 374 * MiB;
constexpr size_t WS_ALR = 406 * MiB;
constexpr size_t WS_SUMP = 406 * MiB + 512 * 1024;
constexpr size_t WS_T0 = 408 * MiB;
constexpr size_t WS_T1 = 456 * MiB;
constexpr size_t WS_END = 504 * MiB;
constexpr int CW_BAR = 4096;
constexpr int MAX_LAUNCH = 8;
static_assert((CW_BAR + MAX_LAUNCH * XCD_BAR_WORDS) * 4 <= (int)CTL_ZERO_BYTES, "ctl map");
constexpr int RING_OFF = 0, RING_BYTES = 131072;
constexpr int LDSCTL_OFF = 152064, MISC_OFF = LDSCTL_OFF + 320;
constexpr int LDS_BYTES = 156160;
static_assert(G1_LDS_END <= LDSCTL_OFF && G2_LDS_END <= LDSCTL_OFF && G3_LDS_END <= LDSCTL_OFF && AT_LDS_END <= LDSCTL_OFF && LR_LDS_END <= LDSCTL_OFF && SGU_W_OFF + 128 * SGU_W_STRIDE <= LDSCTL_OFF, "LDS map");

constexpr int PH_PROLOGUE = 0, PH_FINAL = 21, N_PHASES = 22;

struct Args {
    const float* in[21]; float* out; unsigned char* ws;
    const float* gn[4];
    const float* xold[4];
    int ph_lo, ph_hi, li, pad;
};
#define CAS __attribute__((address_space(4)))
template <class T> __device__ __forceinline__ T* karg(const CAS char* ka, int byte_off) { T* p = *(T* const CAS*)(ka + byte_off); return (T*)(__attribute__((address_space(1))) T*)p; }
#define KIN(k) karg<const float>(ka_, 8 * (k))

__device__ __forceinline__ float wave_sum(float v) {
#pragma unroll
    for (int o = 1; o < 64; o <<= 1) v += __shfl_xor(v, o);
    return v;
}
__device__ __forceinline__ void p0_transpose_item(const float* W, int K, int ldw, int nblk, bf16* WT, int skip_at, int skip, LAS float* scr, int item, int lane) {
    const int kb = item / nblk, nb = item % nblk, k0 = 64 * kb, n0 = 32 * nb, s0 = n0 + (n0 >= skip_at ? skip : 0);
#pragma unroll 8
    for (int i = 0; i < 32; ++i) { const int kk = 2 * i + (lane >> 5); scr[kk * 33 + (lane & 31)] = W[(size_t)(k0 + kk) * ldw + s0 + (lane & 31)]; }
    LDS_WAIT(); asm volatile("" ::: "memory");
    const int c = lane & 7;
#pragma unroll
    for (int j = 0; j < 4; ++j) { const int n = (lane >> 3) + 8 * j; const LAS float* s = scr + (8 * c) * 33 + n;
        v4u o; o.x = pk2(s[0 * 33], s[1 * 33]); o.y = pk2(s[2 * 33], s[3 * 33]); o.z = pk2(s[4 * 33], s[5 * 33]); o.w = pk2(s[6 * 33], s[7 * 33]);
        *(GAS v4u*)(WT + (size_t)(n0 + n) * K + k0 + 8 * c) = o; }
    LDS_WAIT(); asm volatile("" ::: "memory");
}

__global__ void __launch_bounds__(NWAVES * 64, 2) mk_fwd(Args args) {
    extern __shared__ __attribute__((aligned(16))) unsigned char lds_raw[];
    LAS unsigned char* lds = (LAS unsigned char*)lds_raw;
    volatile LAS unsigned* MISC = (volatile LAS unsigned*)(lds + MISC_OFF);
    const int G0 = gridDim.x;
    unsigned char* ws = args.ws;
    unsigned* ctl = (unsigned*)(ws + WS_CTL);
    float* SUMP = (float*)(ws + WS_SUMP);
    for (int u = threadIdx.x; u < (LDS_BYTES - LDSCTL_OFF) / 4; u += NWAVES * 64) ((LAS unsigned*)(lds + LDSCTL_OFF))[u] = 0u;
    __syncthreads();
    XcdBarrier bar = xcd_barrier_post(ctl + CW_BAR + args.li * XCD_BAR_WORDS, MISC + 8);

    float* X = (float*)(ws + WS_X); bf16* XG = (bf16*)(ws + WS_XG); bf16* Z = (bf16*)(ws + WS_Z); bf16* Y = (bf16*)(ws + WS_Y);
    float* ALR = (float*)(ws + WS_ALR);

#ifndef REP_COND
#define REP_COND(ph) false
#endif
    int rep_done = 0, first = 1;
    for (int ph = args.ph_lo; ph < args.ph_hi; ) {
        if (ph != PH_PROLOGUE && ph != PH_FINAL && ((ph - 1) % 5) == 3 && ((((ph - 1) / 5) & 1) == 0)) { ++ph; continue; }
        if (!first) xcd_barrier(bar);
        first = 0;
        int tid = threadIdx.x; asm volatile("" : "+v"(tid));
        int G = G0; asm volatile("" : "+s"(G));
        const int lane = tid & 63, wave = __builtin_amdgcn_readfirstlane(tid >> 6);
        const CAS char* ka_ = (const CAS char*)__builtin_amdgcn_kernarg_segment_ptr(); asm volatile("" : "+s"(ka_));
        const float* x_in = KIN(0);
        if (ph == PH_PROLOGUE) {
            LAS float* scr = (LAS float*)(lds + RING_OFF + wave * 16384);
            const int gw = blockIdx.x * NWAVES + wave, NGW = G * NWAVES;
            constexpr int I_EVIN = 32 * 256, I_EVOUT = 32 * 64, I_ODIN = 32 * 192, I_ODOUT = 32 * 64, I_GATE = 2 * 4;
            constexpr int NITEMS = 2 * (I_EVIN + I_EVOUT + I_ODIN + I_ODOUT) + 2 * 12 * 2 * I_GATE;
            for (int it = gw; it < NITEMS; it += NGW) {
                int r = it;
                if (r < 2 * I_EVIN) { const int i = r / I_EVIN; p0_transpose_item(KIN(2) + (size_t)i * DM * EV_IN, DM, EV_IN, 256, (bf16*)(ws + WS_WEVIN) + (size_t)i * EV_IN * DM, 1 << 30, 0, scr, r % I_EVIN, lane); continue; } r -= 2 * I_EVIN;
                if (r < 2 * I_EVOUT) { const int i = r / I_EVOUT; p0_transpose_item(KIN(10) + (size_t)i * DM * DM, DM, DM, 64, (bf16*)(ws + WS_WEVOUT) + (size_t)i * DM * DM, 1 << 30, 0, scr, r % I_EVOUT, lane); continue; } r -= 2 * I_EVOUT;
                if (r < 2 * I_ODIN) { const int i = r / I_ODIN; p0_transpose_item(KIN(12) + (size_t)i * DM * OD_IN, DM, OD_IN, 192, (bf16*)(ws + WS_WODIN) + (size_t)i * OD_Z * DM, 2048, 16, scr, r % I_ODIN, lane); continue; } r -= 2 * I_ODIN;
                if (r < 2 * I_ODOUT) { const int i = r / I_ODOUT; p0_transpose_item(KIN(19) + (size_t)i * DM * DM, DM, DM, 64, (bf16*)(ws + WS_WODOUT) + (size_t)i * DM * DM, 1 << 30, 0, scr, r % I_ODOUT, lane); continue; } r -= 2 * I_ODOUT;
                { const int mat = r / I_GATE, li2 = mat / 24, h = (mat % 24) >> 1, gate = mat & 1;
                  const float* src = KIN(gate ? 7 : 5) + ((size_t)li2 * 12 + h) * 128 * 128;
                  p0_transpose_item(src, 128, 128, 4, (bf16*)(ws + WS_WGATE) + (size_t)mat * 128 * 128, 1 << 30, 0, scr, r % I_GATE, lane); }
            }
            for (int e = blockIdx.x * 512 + tid; e < 2 * 16 * 2048; e += G * 512) { const int i = e >> 15, j = (e >> 11) & 15, k = e & 2047;
                ((bf16*)(ws + WS_WALR))[e] = (bf16)f2bf(KIN(12)[(size_t)i * DM * OD_IN + (size_t)k * OD_IN + 2048 + j]); }
            const float* g0 = KIN(1);
            for (int m = gw; m < MTOK; m += NGW) {
                const f32x4* xr = (const f32x4*)(x_in + (size_t)m * DM) + lane; float s = 0.f;
                unsigned long long* o8 = (unsigned long long*)(XG + (size_t)m * DM) + lane;
#pragma unroll
                for (int j = 0; j < 8; ++j) { const f32x4 v = xr[64 * j]; const f32x4 gg = ((const f32x4*)g0)[lane + 64 * j];
                    s += (v[0] * v[0] + v[1] * v[1]) + (v[2] * v[2] + v[3] * v[3]);
                    o8[64 * j] = (unsigned long long)pk2(v[0] * gg[0], v[1] * gg[1]) | ((unsigned long long)pk2(v[2] * gg[2], v[3] * gg[3]) << 32); }
                s = wave_sum(s);
                if (lane < 8) SUMP[(size_t)m * 8 + lane] = (lane == 0) ? s : 0.f;
            }
        } else if (ph == PH_FINAL) {
            const int gw = blockIdx.x * NWAVES + wave, NGW = G * NWAVES;
            const float* gf = KIN(20);
            for (int m = gw; m < MTOK; m += NGW) {
                const f32x4 p0 = *(const f32x4*)(SUMP + ((size_t)4 * 8192 + m) * 8), p1 = *(const f32x4*)(SUMP + ((size_t)4 * 8192 + m) * 8 + 4);
                const float rs = __builtin_amdgcn_rsqf((((p0[0] + p0[1]) + (p0[2] + p0[3])) + ((p1[0] + p1[1]) + (p1[2] + p1[3]))) * (1.0f / 2048.0f) + 1e-6f);
                const f32x4* xr = (const f32x4*)(X + (size_t)m * DM) + lane; f32x4* o = (f32x4*)(args.out + (size_t)m * DM) + lane;
#pragma unroll
                for (int j = 0; j < 8; ++j) { const f32x4 v = xr[64 * j]; const f32x4 gg = ((const f32x4*)gf)[lane + 64 * j]; o[64 * j] = v * gg * rs; }
            }
        } else {
            const int L = (ph - 1) / 5, sub = (ph - 1) % 5, i = L >> 1, odd = L & 1;
            if (sub == 0) {
                const int N = odd ? OD_Z : EV_IN;
                const bf16* Wt = (const bf16*)(ws + (odd ? WS_WODIN : WS_WEVIN)) + (size_t)i * N * DM;
                pg8::Gemm g{XG, Wt, MTOK, N, DM}; pg8::StaticOrder S; S.init(MTOK, N, G, (int)blockIdx.x);
                pg8::EpiIn E{Z, N, SUMP + (size_t)L * 8192 * 8};
                pg8::gemm_phase<pg8::EpiIn, pg8::StaticOrder, true, true>(lds + RING_OFF, g, S, E);
                if (odd) {
                    const bf16* WA = (const bf16*)(ws + WS_WALR) + (size_t)i * 16 * 2048;
                    for (int rb0 = blockIdx.x * 32; rb0 < MTOK; rb0 += G * 32) {
                        const int rb = wave & 1, kq = wave >> 1, fr = lane & 15, fq = lane >> 4;
                        const bf16* ap = XG + (size_t)(rb0 + 16 * rb + fr) * DM + kq * 512 + 8 * fq;
                        const bf16* bp = WA + (size_t)fr * DM + kq * 512 + 8 * fq;
                        f32x4 acc = {0.f, 0.f, 0.f, 0.f};
#pragma unroll 8
                        for (int ks = 0; ks < 16; ++ks) { const bf16x8 a = *(const bf16x8*)(ap + ks * 32), b = *(const bf16x8*)(bp + ks * 32);
                            acc = __builtin_amdgcn_mfma_f32_16x16x32_bf16(a, b, acc, 0, 0, 0); }
                        LAS float* part = (LAS float*)(lds + RING_OFF);
#pragma unroll
                        for (int r = 0; r < 4; ++r) part[(kq * 32 + 16 * rb + 4 * fq + r) * 16 + fr] = acc[r];
                        __syncthreads();
                        { const int row = tid >> 4, j = tid & 15;
                          const float s = (part[(0 * 32 + row) * 16 + j] + part[(1 * 32 + row) * 16 + j]) + (part[(2 * 32 + row) * 16 + j] + part[(3 * 32 + row) * 16 + j]);
                          const float* sp_ = SUMP + ((size_t)L * 8192 + rb0 + row) * 8; const f32x4 p0 = *(const f32x4*)sp_, p1 = *(const f32x4*)(sp_ + 4);
                          const float rs = __builtin_amdgcn_rsqf((((p0[0] + p0[1]) + (p0[2] + p0[3])) + ((p1[0] + p1[1]) + (p1[2] + p1[3]))) * (1.0f / 2048.0f) + 1e-6f);
                          ALR[(size_t)(rb0 + row) * 16 + j] = s * rs; }
                        __syncthreads();
                    }
                }
            } else if (sub == 4) {
                const bf16* Wt = (const bf16*)(ws + (odd ? WS_WODOUT : WS_WEVOUT)) + (size_t)i * DM * DM;
                const float* gn = karg<const float>(ka_, (int)offsetof(Args, gn) + 8 * L);
                const float* xo = karg<const float>(ka_, (int)offsetof(Args, xold) + 8 * L);
                pg8::Gemm g{Y, Wt, MTOK, DM, DM}; pg8::StaticOrder S; S.init(MTOK, DM, G, (int)blockIdx.x);
                pg8::EpiOut E{xo, X, XG, gn, SUMP + (size_t)(L + 1) * 8192 * 8, L < 3 ? 1 : 0, (LAS float*)(lds + RING_BYTES)};
                pg8::gemm_phase<pg8::EpiOut, pg8::StaticOrder, true, true>(lds + RING_OFF, g, S, E);
            }
            else if (sub == 1 && !odd) {
#ifdef OPT_LRU
                { LruParams P{KIN(3) + (size_t)i * 4 * LRU_W, KIN(4) + (size_t)i * LRU_W, KIN(6) + (size_t)i * LRU_W, KIN(8) + (size_t)i * LRU_W, KIN(9) + (size_t)i * LRU_W,
                              (const bf16*)(ws + WS_WGATE) + (size_t)i * 12 * 2 * 128 * 128};
                  for (int item = blockIdx.x; item < 192; item += G) lru_item(lds, item, Z, P, Y, tid); }
#endif
#ifdef OPT_ATTN
                for (int item = blockIdx.x; item < 768; item += G) attn_item(lds, item, Z, (bf16*)(ws + WS_T0), (float*)(ws + WS_T1), tid);
#endif
            } else if (sub == 2 && !odd) {
#ifdef OPT_ATTN
                attn_merge(Z, (const bf16*)(ws + WS_T0), (const float*)(ws + WS_T1), Y, blockIdx.x * 512 + tid, G * 512);
#endif
            }
            else if (sub == 1 && odd) {
                const float* wal = KIN(13) + (size_t)i * 16 * 512; const float* bal = KIN(14) + (size_t)i * 512;
                for (int item = blockIdx.x; item < 512; item += G)
                    gla1a_item(lds, item, Z, ALR, wal, bal, (bf16*)(ws + WS_T0), (bf16*)(ws + WS_T0 + 8 * MiB), (bf16*)(ws + WS_T0 + 16 * MiB), (float*)(ws + WS_T0 + 24 * MiB), tid);
            }
            else if (sub == 2 && odd) {
                if (blockIdx.x < 64) {
                    gla2s_item(lds, blockIdx.x, Z, (const bf16*)(ws + WS_T0 + 16 * MiB), (const float*)(ws + WS_T0 + 24 * MiB), (bf16*)(ws + WS_T1), tid);
                } else {
                    const float* vn = KIN(16) + (size_t)i * 1024; const float* wsg = KIN(17) + (size_t)i * 4 * 128 * 128; const float* bsg = KIN(18) + (size_t)i * 4 * 128;
                    for (int item = blockIdx.x - 64; item < 256; item += G - 64) sgu_item(lds, item, Z, vn, wsg, bsg, Y, tid);
                }
            }
            else if (sub == 3 && odd) {
                for (int item = blockIdx.x; item < 512; item += G)
                    gla3_item(lds, item, Z, (const bf16*)(ws + WS_T0), (const bf16*)(ws + WS_T0 + 8 * MiB), (const bf16*)(ws + WS_T1), KIN(15) + (size_t)i * 1024, Y, tid);
            }
        }
        if (REP_COND(ph) && !rep_done) rep_done = 1; else { rep_done = 0; ++ph; }
    }
}

#define OPT_SGU 1
constexpr int OPT_EVEN_LO = 2, OPT_ODD_LO = 2;
static void launch_mk(Args& a, int lo, int hi, int li, int grid, hipStream_t stream) {
    a.ph_lo = lo; a.ph_hi = hi; a.li = li;
    hipLaunchKernelGGL(mk_fwd, dim3(grid), dim3(NWAVES * 64), LDS_BYTES, stream, a);
}
extern "C" void kernel_launch(void* const* d_in, const int* in_sizes, int n_in, void* d_out, int out_size, void* d_ws, size_t ws_size, hipStream_t stream) {
    static int grid = 0;
    if (grid == 0) {
        if (n_in != 21 || ws_size < WS_END) { fprintf(stderr, "kernel_launch: unexpected n_in %d / ws_size %zu\n", n_in, ws_size); grid = -1; return; }
        int dev = 0, cus = 0, per_cu = 0;
        if (hipGetDevice(&dev) != hipSuccess || hipDeviceGetAttribute(&cus, hipDeviceAttributeMultiprocessorCount, dev) != hipSuccess) { grid = -1; return; }
        if (hipFuncSetAttribute((const void*)mk_fwd, hipFuncAttributeMaxDynamicSharedMemorySize, LDS_BYTES) != hipSuccess) { fprintf(stderr, "kernel_launch: hipFuncSetAttribute failed\n"); grid = -1; return; }
        if (hipOccupancyMaxActiveBlocksPerMultiprocessor(&per_cu, (const void*)mk_fwd, NWAVES * 64, LDS_BYTES) != hipSuccess || per_cu < 1) { fprintf(stderr, "kernel_launch: occupancy query says %d\n", per_cu); }
        (void)hipGetLastError();
        grid = cus;
    }
    if (grid < 0) return;
    hipMemsetAsync((char*)d_ws + WS_CTL, 0, CTL_ZERO_BYTES, stream);
    Args a{};
    for (int i = 0; i < 21; ++i) a.in[i] = (const float*)d_in[i];
    a.out = (float*)d_out; a.ws = (unsigned char*)d_ws;
    a.gn[0] = a.in[11]; a.gn[1] = a.in[1] + DM; a.gn[2] = a.in[11] + DM; a.gn[3] = a.in[20];
    a.xold[0] = a.in[0]; a.xold[1] = a.xold[2] = a.xold[3] = (const float*)((char*)d_ws + WS_X);
    const float *ev_conv_w = a.in[3], *ev_conv_b = a.in[4], *ev_w_a = a.in[5], *ev_b_a = a.in[6], *ev_w_i = a.in[7], *ev_b_i = a.in[8], *ev_lam = a.in[9];
    const float *od_w_alpha = a.in[13], *od_b_alpha = a.in[14], *od_head_norm = a.in[15], *od_v_norm = a.in[16], *od_w_s = a.in[17], *od_b_s = a.in[18];
    char* ws = (char*)d_ws;
    bf16* Z = (bf16*)(ws + WS_Z); bf16* Y = (bf16*)(ws + WS_Y); float* ALR = (float*)(ws + WS_ALR); float* T0 = (float*)(ws + WS_T0); float* T1 = (float*)(ws + WS_T1);
    launch_mk(a, 0, N_PHASES, 0, grid, stream);
}
```

```cpp
#include <hip/hip_runtime.h>
#include <cstdio>
#include <cstdint>

constexpr int DM = 2048, NB = 4, SEQ = 2048, MTOK = NB * SEQ;
constexpr int LRU_W = 1536, EV_IN = 8192;
constexpr int OD_IN = 6160, OD_Z = 6144;
constexpr float EPS = 1e-6f;

typedef unsigned short bf16;
typedef bf16 AT;

__device__ __forceinline__ float bf2f(bf16 v) { return __uint_as_float((unsigned)v << 16); }
__device__ __forceinline__ unsigned f2bf(float f) { unsigned u = __builtin_bit_cast(unsigned, f); return (u + 0x7fffu + ((u >> 16) & 1u)) >> 16; }
__device__ __forceinline__ unsigned pk2(float lo, float hi) { return f2bf(lo) | (f2bf(hi) << 16); }
__device__ __forceinline__ float ldA(const bf16* p, size_t i) { return bf2f(p[i]); }
__device__ __forceinline__ void stA(bf16* p, size_t i, float v) { p[i] = (bf16)f2bf(v); }

__device__ __forceinline__ float sigmoidf_(float x) { return 1.f / (1.f + __expf(-x)); }
__device__ __forceinline__ float siluf_(float x) { return x * sigmoidf_(x); }
__device__ __forceinline__ float geluf_(float x) { return 0.5f * x * (1.f + tanhf(0.7978845608028654f * (x + 0.044715f * x * x * x))); }
__device__ __forceinline__ float softplusf_(float x) { return x > 20.f ? x : log1pf(__expf(x)); }
__device__ __forceinline__ float logsigmoidf_(float x) { return -softplusf_(-x); }

__device__ __forceinline__ float block_sum(float v, float* red) {
#pragma unroll
    for (int o = 32; o > 0; o >>= 1) v += __shfl_xor(v, o);
    const int w = threadIdx.x >> 6, nw = blockDim.x >> 6;
    __syncthreads();
    if ((threadIdx.x & 63) == 0) red[w] = v;
    __syncthreads();
    float s = 0.f;
    for (int i = 0; i < nw; ++i) s += red[i];
    return s;
}
__device__ __forceinline__ float block_max(float v, float* red) {
#pragma unroll
    for (int o = 32; o > 0; o >>= 1) v = fmaxf(v, __shfl_xor(v, o));
    const int w = threadIdx.x >> 6, nw = blockDim.x >> 6;
    __syncthreads();
    if ((threadIdx.x & 63) == 0) red[w] = v;
    __syncthreads();
    float s = -INFINITY;
    for (int i = 0; i < nw; ++i) s = fmaxf(s, red[i]);
    return s;
}

__global__ void __launch_bounds__(128) nv_lru_gates(const AT* z, const float* conv_w, const float* conv_b, const float* w_a, const float* b_a, const float* w_i, const float* b_i,
                                                    const float* lam, float* a_out, float* u_out) {
    __shared__ float xc[128];
    const int tok = blockIdx.x, h = blockIdx.y, j = threadIdx.x, t = tok % SEQ, ch = h * 128 + j;
    float v = conv_b[ch];
    for (int q = 0; q < 4; ++q) { const int tt = t + q - 3; if (tt >= 0) v += ldA(z, (size_t)(tok + q - 3) * EV_IN + ch) * conv_w[q * LRU_W + ch]; }
    xc[j] = v; __syncthreads();
    float ra = b_a[ch], ri = b_i[ch];
    const float* wa = w_a + (size_t)h * 128 * 128; const float* wi = w_i + (size_t)h * 128 * 128;
    for (int i = 0; i < 128; ++i) { ra += xc[i] * wa[i * 128 + j]; ri += xc[i] * wi[i * 128 + j]; }
    const float r = sigmoidf_(ra), ig = sigmoidf_(ri);
    const float log_a = -8.0f * r * softplusf_(-lam[ch]);
    const float a = __expf(log_a);
    const float u = sqrtf(-expm1f(2.f * log_a)) * (ig * v);
    a_out[(size_t)tok * LRU_W + ch] = a; u_out[(size_t)tok * LRU_W + ch] = u;
}
__global__ void __launch_bounds__(256) nv_lru_scan(const float* a, const float* u, const AT* z, AT* y) {
    const int idx = blockIdx.x * 256 + threadIdx.x; if (idx >= NB * LRU_W) return;
    const int b = idx / LRU_W, ch = idx % LRU_W; float h = 0.f;
    for (int t = 0; t < SEQ; ++t) { const size_t tok = (size_t)b * SEQ + t; h = a[tok * LRU_W + ch] * h + u[tok * LRU_W + ch];
        stA(y, tok * DM + ch, h * siluf_(ldA(z, tok * EV_IN + LRU_W + ch))); }
}
__global__ void __launch_bounds__(256) nv_attn(const AT* z, AT* y) {
    __shared__ float qs[128], ps[132], red[16], og[3][128], lse[3];
    const int tok = blockIdx.x, j = blockIdx.y, t = tok % SEQ, tid = threadIdx.x;
    for (int g = 0; g < 3; ++g) {
        const int d = 1 << (2 * g);
        const float slope = exp2f(-8.0f * (float)(g + 3 * j + 1) / 12.0f);
        const size_t qoff = 3072 + g * 512 + j * 128, koff = 4608 + g * 512 + j * 128, voff = 6144 + g * 512 + j * 128;
        __syncthreads();
        if (tid < 128) qs[tid] = ldA(z, (size_t)tok * EV_IN + qoff + tid);
        __syncthreads();
        float s = -INFINITY;
        if (tid <= 128 && t - tid * d >= 0) {
            const AT* kr = z + (size_t)(tok - tid * d) * EV_IN + koff; float acc = 0.f;
            for (int e = 0; e < 128; ++e) acc += qs[e] * ldA(kr, e);
            s = acc * 0.08838834764831845f - slope * (float)(tid * d);
        }
        const float m = block_max(s, red);
        const float p = (s == -INFINITY) ? 0.f : __expf(s - m);
        if (tid <= 128) ps[tid] = p;
        const float den = block_sum(p, red);
        __syncthreads();
        if (tid < 128) { float o = 0.f;
            for (int i = 0; i <= 128; ++i) { if (t - i * d < 0) break; o += ps[i] * ldA(z, (size_t)(tok - i * d) * EV_IN + voff + tid); }
            og[g][tid] = o / den; }
        if (tid == 0) lse[g] = m + __logf(den);
    }
    __syncthreads();
    if (tid < 128) {
        const float mm = fmaxf(lse[0], fmaxf(lse[1], lse[2]));
        const float w0 = __expf(lse[0] - mm), w1 = __expf(lse[1] - mm), w2 = __expf(lse[2] - mm);
        const float yv = (w0 * og[0][tid] + w1 * og[1][tid] + w2 * og[2][tid]) / (w0 + w1 + w2);
        stA(y, (size_t)tok * DM + LRU_W + j * 128 + tid, yv * siluf_(ldA(z, (size_t)tok * EV_IN + 7680 + j * 128 + tid)));
    }
}

__global__ void __launch_bounds__(256) nv_gla(const AT* z, const float* alr, const float* w_alpha, const float* b_alpha, const float* head_norm, AT* y) {
    __shared__ float qs[128], ks[128], al[128], ar[16], red[16];
    const int b = blockIdx.x >> 2, h = blockIdx.x & 3, v = threadIdx.x;
    float S[128];
#pragma unroll
    for (int e = 0; e < 128; ++e) S[e] = 0.f;
    for (int t = 0; t < SEQ; ++t) {
        const size_t tok = (size_t)b * SEQ + t;
        __syncthreads();
        if (v < 16) ar[v] = alr[tok * 16 + v];
        if (v < 128) { qs[v] = ldA(z, tok * OD_Z + h * 128 + v) * 0.08838834764831845f; ks[v] = ldA(z, tok * OD_Z + 512 + h * 128 + v); }
        __syncthreads();
        if (v < 128) { float s = b_alpha[h * 128 + v];
            for (int r = 0; r < 16; ++r) s += ar[r] * w_alpha[r * 512 + h * 128 + v];
            al[v] = __expf(logsigmoidf_(s) * (1.f / 16.f)); }
        __syncthreads();
        const float vv = ldA(z, tok * OD_Z + 1024 + h * 256 + v);
        float o = 0.f;
#pragma unroll
        for (int e = 0; e < 128; ++e) { S[e] = al[e] * S[e] + ks[e] * vv; o += qs[e] * S[e]; }
        const float ss = block_sum(o * o, red);
        const float r = rsqrtf(ss / 256.f + EPS);
        stA(y, tok * DM + h * 256 + v, o * r * head_norm[h * 256 + v] * siluf_(ldA(z, tok * OD_Z + 2048 + h * 256 + v)));
    }
}
__global__ void __launch_bounds__(256) nv_sgu_ln(const AT* z, const float* v_norm, float* vf) {
    __shared__ float red[16];
    const int tok = blockIdx.x, g = blockIdx.y, e = threadIdx.x;
    const float val = geluf_(ldA(z, (size_t)tok * OD_Z + 4096 + g * 256 + e));
    const float mu = block_sum(val, red) / 256.f;
    const float dv = val - mu;
    const float var = block_sum(dv * dv, red) / 256.f;
    vf[(size_t)tok * 1024 + g * 256 + e] = dv * rsqrtf(var + EPS) * v_norm[g * 256 + e];
}
__global__ void __launch_bounds__(256) nv_sgu_mix(const AT* z, const float* vf, const float* w_s, const float* b_s, AT* y) {
    const int tok = blockIdx.x, g = blockIdx.y, e = threadIdx.x, t = tok % 128, base = tok - t;
    float acc = b_s[g * 128 + t];
    const float* w = w_s + ((size_t)g * 128 + t) * 128;
    for (int s = 0; s <= t; ++s) acc += w[s] * vf[(size_t)(base + s) * 1024 + g * 256 + e];
    const float u = geluf_(ldA(z, (size_t)tok * OD_Z + 3072 + g * 256 + e));
    stA(y, (size_t)tok * DM + 1024 + g * 256 + e, u * acc * siluf_(ldA(z, (size_t)tok * OD_Z + 5120 + g * 256 + e)));
}
namespace pg8 {
#define PG8_LAS __attribute__((address_space(3)))
typedef unsigned short bf16_t;
typedef short bf16x8 __attribute__((ext_vector_type(8)));
typedef float f32x4 __attribute__((ext_vector_type(4)));
typedef unsigned u32x4 __attribute__((ext_vector_type(4)));
constexpr int BM = 256, BK = 64, HALF = 128, HTB = HALF * BK * 2  , STAGE_BYTES = 8 * HTB, NXCD = 8, WGM = 8;

__host__ __device__ __forceinline__ int lds_byte(int r, int c) { const int st = (r >> 4) * 2 + (c >> 5), rr = r & 15, cc = c & 31, ob = rr * 64 + cc * 2; return st * 1024 + (ob ^ (((ob >> 9) & 1) << 5)); }
__host__ __device__ __forceinline__ void stage_rc(int b, int& R, int& C) { const int st = b / 1024, sb = b % 1024, swz = sb ^ (((sb >> 9) & 1) << 5); R = (st >> 1) * 16 + swz / 64; C = (st & 1) * 32 + (swz % 64) / 2; }
__host__ __device__ __forceinline__ int perm32(int rho) { const int n = rho >> 4, i = rho & 15; return 8 * (i >> 2) + 4 * n + (i & 3); }

struct Unit { int pm, pn; };
struct Gemm { const bf16_t* A; const bf16_t* Bt; int M, N, K; };

struct StaticOrder {
    int nM, nN, nwg, G, c;
    __host__ __device__ void init(int M, int N, int G_, int c_) { nM = M / BM; nN = N / BM; nwg = nM * nN; G = G_; c = c_; }
    __host__ __device__ bool next(int i, Unit& u) const {
        const long L = (long)i * G + c; if (L >= nwg) return false;
        int wgid = (int)L; { const int q = nwg / NXCD, r = nwg % NXCD, xcd = wgid % NXCD, off = wgid / NXCD; wgid = (xcd < r ? xcd * (q + 1) : r * (q + 1) + (xcd - r) * q) + off; }
        const int nig = WGM * nN, gid = wgid / nig, fm = gid * WGM, gsz = (nM - fm) < WGM ? (nM - fm) : WGM;
        u.pm = fm + ((wgid % nig) % gsz); u.pn = (wgid % nig) / gsz; return true;
    }
    __device__ __forceinline__ void a_ready(const Unit&) const {}
    __device__ __forceinline__ void done(const Unit&) const {}
};

__device__ __forceinline__ unsigned cvt_pk_bf16(float lo, float hi) { unsigned r; asm volatile("v_cvt_pk_bf16_f32 %0, %1, %2" : "=v"(r) : "v"(lo), "v"(hi)); return r; }
struct EpiIn {
    static constexpr bool PERM = true, AFTER_DRAIN = false;
    bf16_t* O; int ldc; const float* sump;
    __device__ __forceinline__ void operator()(const f32x4 (&acc)[2][2][4][2], const Unit& u, int wr, int wc, int fr, int fq) const {
        const int row0 = u.pm * BM + wr * 64 + fr, col0 = u.pn * BM + wc * 32 + 8 * fq;
#pragma unroll
        for (int ai = 0; ai < 2; ++ai)
#pragma unroll
            for (int m = 0; m < 4; ++m) { const int row = row0 + ai * HALF + m * 16;
                const f32x4 p0 = *(const f32x4*)(sump + (size_t)row * 8), p1 = *(const f32x4*)(sump + (size_t)row * 8 + 4);
                const float rs = __builtin_amdgcn_rsqf((((p0[0] + p0[1]) + (p0[2] + p0[3])) + ((p1[0] + p1[1]) + (p1[2] + p1[3]))) * (1.0f / 2048.0f) + 1e-6f);
                bf16_t* rowp = O + (size_t)row * ldc + col0;
#pragma unroll
                for (int bj = 0; bj < 2; ++bj) { const f32x4 v0 = acc[ai][bj][m][0] * rs, v1 = acc[ai][bj][m][1] * rs;
                    u32x4 w; w.x = cvt_pk_bf16(v0[0], v0[1]); w.y = cvt_pk_bf16(v0[2], v0[3]); w.z = cvt_pk_bf16(v1[0], v1[1]); w.w = cvt_pk_bf16(v1[2], v1[3]);
                    *(u32x4*)(rowp + bj * HALF) = w; } }
    }
};
struct EpiOut {
    static constexpr bool PERM = true, AFTER_DRAIN = false;
    bf16_t* x; float* sump_next; PG8_LAS float* xs;
    __device__ __forceinline__ void operator()(const f32x4 (&acc)[2][2][4][2], const Unit& u, int wr, int wc, int fr, int fq) const {
        const int row0 = u.pm * BM + wr * 64 + fr, col0 = u.pn * BM + wc * 32 + 8 * fq;
#pragma unroll
        for (int ai = 0; ai < 2; ++ai) {
            u32x4 xo[4][2];
#pragma unroll
            for (int m = 0; m < 4; ++m) { const size_t off = (size_t)(row0 + ai * HALF + m * 16) * 2048 + col0;
#pragma unroll
                for (int bj = 0; bj < 2; ++bj) xo[m][bj] = *(const u32x4*)(x + off + bj * HALF); }
            asm volatile("" ::: "memory");
#pragma unroll
            for (int m = 0; m < 4; ++m) { const size_t off = (size_t)(row0 + ai * HALF + m * 16) * 2048 + col0; float ss = 0.f;
#pragma unroll
                for (int bj = 0; bj < 2; ++bj) {
                    const u32x4 o = xo[m][bj]; u32x4 w;
#pragma unroll
                    for (int k = 0; k < 4; ++k) { const float lo = __uint_as_float(o[k] << 16) + acc[ai][bj][m][k >> 1][(k & 1) * 2], hi = __uint_as_float(o[k] & 0xffff0000u) + acc[ai][bj][m][k >> 1][(k & 1) * 2 + 1];
                        const unsigned p = cvt_pk_bf16(lo, hi); w[k] = p;
                        const float rl = __uint_as_float(p << 16), rh = __uint_as_float(p & 0xffff0000u); ss += rl * rl + rh * rh; }
                    *(u32x4*)(x + off + bj * HALF) = w; }
                ss += __shfl_xor(ss, 16); ss += __shfl_xor(ss, 32);
                if (fq == 0) xs[(ai * HALF + wr * 64 + m * 16 + fr) * 4 + wc] = ss; }
            asm volatile("" ::: "memory");
        }
        asm volatile("s_waitcnt lgkmcnt(0)" ::: "memory"); __builtin_amdgcn_s_barrier(); asm volatile("" ::: "memory");
        { const int t = threadIdx.x; if (t < 256) { const f32x4 p = *(const PG8_LAS f32x4*)(xs + 4 * t); sump_next[(size_t)(u.pm * BM + t) * 8 + u.pn] = (p[0] + p[1]) + (p[2] + p[3]); } }
    }
};
template <class Epi, class Sched, bool ALIGN_EPI = false, bool SP2 = false>
__device__ __forceinline__ void gemm_phase(PG8_LAS unsigned char* lds, const Gemm g, const Sched& S, const Epi& E) {
    int tid_op = threadIdx.x; asm volatile("" : "+v"(tid_op));
    const int tid = tid_op, wid = __builtin_amdgcn_readfirstlane(tid >> 6), lane = tid & 63, wr = wid >> 2, wc = wid & 3, fr = lane & 15, fq = lane >> 4;
    const int K = g.K, nt = K / BK;
    unsigned voffA[2], voffB[2];
#pragma unroll
    for (int i = 0; i < 2; ++i) { int R, C; stage_rc(tid * 16 + i * 8192, R, C); const int Rb = Epi::PERM ? ((R & ~31) + perm32(R & 31)) : R;
        voffA[i] = (unsigned)(R * K + C) * 2u; voffB[i] = (unsigned)(Rb * K + C) * 2u; }
    const size_t kstep = (size_t)(BK * 2);
    const size_t hstep = (size_t)HALF * K * 2;
    const size_t tstep = 2 * hstep;
    const unsigned ldsw = (unsigned)wid * 1024u;
    const int aoff = lds_byte(wr * 64 + fr, fq * 8), boff = lds_byte(wc * 32 + fr, fq * 8);
#define PG8_SA(b, h) (((b) * 2 + (h)) * HTB)
#define PG8_SB(b, h) ((4 + (b) * 2 + (h)) * HTB)
#define PG8_STAGE(bufoff, gbase, voff) do { _Pragma("unroll") for (int _i = 0; _i < 2; ++_i) \
        __builtin_amdgcn_global_load_lds((const unsigned*)((const char*)(gbase) + (voff)[_i]), (PG8_LAS unsigned*)(lds + (bufoff) + ldsw + _i * 8192), 16, 0, 0); } while (0)
#define PG8_LDA(dst, b, h) do { _Pragma("unroll") for (int m = 0; m < 4; ++m) _Pragma("unroll") for (int k = 0; k < 2; ++k) dst[m][k] = *(const PG8_LAS bf16x8*)(lds + PG8_SA(b, h) + aoff + m * 2048 + k * 1024); } while (0)
#define PG8_LDB(dst, b, h) do { _Pragma("unroll") for (int n = 0; n < 2; ++n) _Pragma("unroll") for (int k = 0; k < 2; ++k) dst[n][k] = *(const PG8_LAS bf16x8*)(lds + PG8_SB(b, h) + boff + n * 2048 + k * 1024); } while (0)
#define PG8_MMA(ai, bj, At, Bt) do { __builtin_amdgcn_s_setprio(1); _Pragma("unroll") for (int m = 0; m < 4; ++m) _Pragma("unroll") for (int n = 0; n < 2; ++n) _Pragma("unroll") for (int k = 0; k < 2; ++k) \
        acc[ai][bj][m][n] = __builtin_amdgcn_mfma_f32_16x16x32_bf16(Bt[n][k], At[m][k], acc[ai][bj][m][n], 0, 0, 0); __builtin_amdgcn_s_setprio(0); } while (0)
#define PG8_WAIT_V(n) asm volatile("s_waitcnt vmcnt(" #n ")" ::: "memory")
#define PG8_WAIT_L(n) asm volatile("s_waitcnt lgkmcnt(" #n ")" ::: "memory")
#define PG8_BAR __builtin_amdgcn_s_barrier()
#define PG8_SCHED __builtin_amdgcn_sched_barrier(0)
    Unit cur, nxt; int ui = 0;
    if (!S.next(0, cur)) return;
    f32x4 acc[2][2][4][2];
#pragma unroll
    for (int a = 0; a < 2; ++a)
#pragma unroll
        for (int b = 0; b < 2; ++b)
#pragma unroll
            for (int m = 0; m < 4; ++m)
#pragma unroll
                for (int n = 0; n < 2; ++n) acc[a][b][m][n] = (f32x4){0.f, 0.f, 0.f, 0.f};
    bf16x8 At[4][2], B0[2][2], B1[2][2];
    const char* cA = (const char*)g.A + (size_t)cur.pm * tstep; const char* cB = (const char*)g.Bt + (size_t)cur.pn * tstep;
    S.a_ready(cur);
    if constexpr (SP2) {
        PG8_STAGE(PG8_SB(0, 0), cB, voffB); PG8_STAGE(PG8_SB(0, 1), cB + hstep, voffB); PG8_STAGE(PG8_SA(0, 0), cA, voffA); PG8_STAGE(PG8_SA(0, 1), cA + hstep, voffA);
        if (wr == 1) PG8_BAR;
        PG8_WAIT_V(2); PG8_BAR;
        PG8_STAGE(PG8_SB(1, 0), cB + kstep, voffB); PG8_STAGE(PG8_SA(1, 0), cA + kstep, voffA); PG8_STAGE(PG8_SB(1, 1), cB + hstep + kstep, voffB);
        PG8_WAIT_V(6); PG8_BAR;
    } else {
        PG8_STAGE(PG8_SB(0, 0), cB, voffB); PG8_STAGE(PG8_SA(0, 0), cA, voffA); PG8_STAGE(PG8_SB(0, 1), cB + hstep, voffB); PG8_STAGE(PG8_SA(0, 1), cA + hstep, voffA);
        if (wr == 1) PG8_BAR;
        PG8_WAIT_V(4); PG8_BAR;
        PG8_STAGE(PG8_SB(1, 0), cB + kstep, voffB); PG8_STAGE(PG8_SA(1, 0), cA + kstep, voffA); PG8_STAGE(PG8_SB(1, 1), cB + hstep + kstep, voffB);
        PG8_WAIT_V(6); PG8_BAR;
    }
    for (;;) {
        const bool has_next = S.next(ui + 1, nxt);
        const char* nA = has_next ? (const char*)g.A + (size_t)nxt.pm * tstep : cA; const char* nB = has_next ? (const char*)g.Bt + (size_t)nxt.pn * tstep : cB;
        for (int t = 0; t < nt; t += 2) {
            const bool last = (t == nt - 2);
            const char* a1 = cA + (size_t)(t + 1) * kstep;
            const char* a2 = last ? nA : cA + (size_t)(t + 2) * kstep; const char* b2 = last ? nB : cB + (size_t)(t + 2) * kstep;
            const char* a3 = a2 + kstep; const char* b3 = b2 + kstep;
            if (last && has_next) S.a_ready(nxt);
            if constexpr (SP2) {
            PG8_LDB(B0, 0, 0); PG8_LDB(B1, 0, 1); PG8_SCHED; PG8_LDA(At, 0, 0); PG8_STAGE(PG8_SA(1, 1), a1 + hstep, voffA);
            PG8_WAIT_V(8); PG8_WAIT_L(0); PG8_BAR; PG8_MMA(0, 0, At, B0); PG8_MMA(0, 1, At, B1); PG8_BAR; PG8_SCHED;
            PG8_LDA(At, 0, 1); PG8_STAGE(PG8_SB(0, 0), b2, voffB); PG8_STAGE(PG8_SB(0, 1), b2 + hstep, voffB); PG8_STAGE(PG8_SA(0, 0), a2, voffA);
            PG8_WAIT_V(8); PG8_WAIT_L(0); PG8_BAR; PG8_MMA(1, 0, At, B0); PG8_MMA(1, 1, At, B1); PG8_BAR; PG8_SCHED;
            PG8_LDB(B0, 1, 0); PG8_LDB(B1, 1, 1); PG8_SCHED; PG8_LDA(At, 1, 0); PG8_STAGE(PG8_SA(0, 1), a2 + hstep, voffA);
            PG8_WAIT_V(8); PG8_WAIT_L(0); PG8_BAR; PG8_MMA(0, 0, At, B0); PG8_MMA(0, 1, At, B1); PG8_BAR; PG8_SCHED;
            PG8_LDA(At, 1, 1); PG8_STAGE(PG8_SB(1, 0), b3, voffB); PG8_STAGE(PG8_SB(1, 1), b3 + hstep, voffB); PG8_STAGE(PG8_SA(1, 0), a3, voffA);
            PG8_WAIT_V(8); PG8_WAIT_L(0); PG8_BAR; PG8_MMA(1, 0, At, B0); PG8_MMA(1, 1, At, B1); PG8_BAR; PG8_SCHED;
            } else {
            PG8_LDB(B0, 0, 0); PG8_SCHED; PG8_LDA(At, 0, 0); PG8_STAGE(PG8_SA(1, 1), a1 + hstep, voffA);
            PG8_WAIT_L(8); PG8_BAR; PG8_WAIT_L(0); PG8_MMA(0, 0, At, B0); PG8_BAR; PG8_SCHED;
            PG8_LDB(B1, 0, 1); PG8_STAGE(PG8_SB(0, 0), b2, voffB);
            PG8_BAR; PG8_WAIT_L(0); PG8_MMA(0, 1, At, B1); PG8_BAR;
            PG8_LDA(At, 0, 1); PG8_STAGE(PG8_SA(0, 0), a2, voffA);
            PG8_BAR; PG8_WAIT_L(0); PG8_MMA(1, 0, At, B0); PG8_BAR; PG8_SCHED;
            PG8_STAGE(PG8_SB(0, 1), b2 + hstep, voffB);
            PG8_WAIT_V(6); PG8_BAR; PG8_MMA(1, 1, At, B1); PG8_BAR;
            PG8_LDB(B0, 1, 0); PG8_SCHED; PG8_LDA(At, 1, 0); PG8_STAGE(PG8_SA(0, 1), a2 + hstep, voffA);
            PG8_WAIT_L(8); PG8_BAR; PG8_WAIT_L(0); PG8_MMA(0, 0, At, B0); PG8_BAR; PG8_SCHED;
            PG8_LDB(B1, 1, 1); PG8_STAGE(PG8_SB(1, 0), b3, voffB);
            PG8_BAR; PG8_WAIT_L(0); PG8_MMA(0, 1, At, B1); PG8_BAR;
            PG8_LDA(At, 1, 1); PG8_STAGE(PG8_SA(1, 0), a3, voffA);
            PG8_BAR; PG8_WAIT_L(0); PG8_MMA(1, 0, At, B0); PG8_BAR; PG8_SCHED;
            PG8_STAGE(PG8_SB(1, 1), b3 + hstep, voffB);
            PG8_WAIT_V(6); PG8_BAR; PG8_MMA(1, 1, At, B1); PG8_BAR;
            }
        }
        if constexpr (ALIGN_EPI) { if (wr == 0) PG8_BAR; }
        if constexpr (!Epi::AFTER_DRAIN) { E(acc, cur, wr, wc, fr, fq); S.done(cur); }
        if (!has_next) break;
#pragma unroll
        for (int a = 0; a < 2; ++a)
#pragma unroll
            for (int b = 0; b < 2; ++b)
#pragma unroll
                for (int m = 0; m < 4; ++m)
#pragma unroll
                    for (int n = 0; n < 2; ++n) acc[a][b][m][n] = (f32x4){0.f, 0.f, 0.f, 0.f};
        cur = nxt; cA = nA; cB = nB; ++ui;
        if constexpr (ALIGN_EPI) { if (wr == 1) PG8_BAR; }
    }
    PG8_WAIT_V(0);
    if constexpr (!ALIGN_EPI) { if (wr == 0) PG8_BAR; }
    PG8_BAR;
    if constexpr (Epi::AFTER_DRAIN) { E.fused(acc, cur, wr, wc, fr, fq, lds, wid, lane); S.done(cur); }
#undef PG8_SA
#undef PG8_SB
#undef PG8_STAGE
#undef PG8_LDA
#undef PG8_LDB
#undef PG8_MMA
#undef PG8_WAIT_V
#undef PG8_WAIT_L
#undef PG8_BAR
#undef PG8_SCHED
}
}
#define GAS __attribute__((address_space(1)))
#define LAS __attribute__((address_space(3)))
typedef unsigned v4u __attribute__((ext_vector_type(4)));
typedef float f32x4 __attribute__((ext_vector_type(4)));
typedef short bf16x8 __attribute__((ext_vector_type(8)));
typedef GAS unsigned gu32;
#define RLX_AGENT __ATOMIC_RELAXED, __HIP_MEMORY_SCOPE_AGENT
#define LDS_WAIT() asm volatile("s_waitcnt lgkmcnt(0)" ::: "memory")
#define VM_WAIT() asm volatile("s_waitcnt vmcnt(0)" ::: "memory")
#define XB_TMO      128
#define XB_XCNT(j)  (256  + 64 * (j))
#define XB_XSUB(j)  (1280 + 64 * (j))
#define XB_XGEN(j)  (2304 + 64 * (j))
#define XB_TOP      3328
#define XB_TOPGEN   3392
#define XCD_BAR_WORDS 3456
#define XB_SPIN_CAP (1u << 18)

__device__ __forceinline__ unsigned xb_ld(unsigned* p)              { return __hip_atomic_load(p, __ATOMIC_RELAXED, __HIP_MEMORY_SCOPE_AGENT); }
__device__ __forceinline__ unsigned xb_add(unsigned* p, unsigned v) { return __hip_atomic_fetch_add(p, v, __ATOMIC_RELAXED, __HIP_MEMORY_SCOPE_AGENT); }
__device__ __forceinline__ unsigned xb_xcc_id() { return (unsigned)__builtin_amdgcn_s_getreg((3 << 11) | 20) & 0xFu; }
#define XB_SPIN(cond, bar) do { unsigned _sp = 0; while (cond) { __builtin_amdgcn_s_sleep(1); \
    if ((++_sp & 255u) == 0u) { if (xb_ld(&(bar)[XB_TMO])) break; if (_sp > XB_SPIN_CAP) { atomicAdd(&(bar)[XB_TMO], 1u); break; } } } } while (0)

struct XcdBarrier {
    unsigned* bar; unsigned x;
    volatile LAS unsigned* st;
};

__device__ __forceinline__ XcdBarrier xcd_barrier_post(unsigned* bar, volatile LAS unsigned* st) {
    XcdBarrier b; b.bar = bar; b.x = xb_xcc_id(); b.st = st;
    if (threadIdx.x == 0) (void)xb_add(&bar[XB_XCNT(b.x)], 1u);
    return b;
}
__device__ __forceinline__ void xcd_barrier_complete(unsigned* bar, unsigned x, unsigned& nloc, unsigned& nx) {
    const unsigned G = gridDim.x * gridDim.y * gridDim.z;
    unsigned sum, cnt, mine, sp = 0u;
    for (;;) {
        sum = 0u; cnt = 0u; mine = 0u;
#pragma unroll
        for (unsigned j = 0; j < 16; ++j) { const unsigned c = xb_ld(&bar[XB_XCNT(j)]); sum += c; cnt += (c > 0u) ? 1u : 0u; mine = (j == x) ? c : mine; }
        if (sum == G) break;
        __builtin_amdgcn_s_sleep(1);
        if ((++sp & 255u) == 0u) { if (xb_ld(&bar[XB_TMO])) break; if (sp > XB_SPIN_CAP) { atomicAdd(&bar[XB_TMO], 1u); break; } }
    }
    nloc = mine > 0u ? mine : 1u; nx = cnt > 0u ? cnt : 1u;
}

__device__ __forceinline__ void xcd_barrier(const XcdBarrier& b) {
    asm volatile("s_waitcnt vmcnt(0)" ::: "memory");
    __syncthreads();
    if (threadIdx.x == 0) {
        unsigned* bar = b.bar;
        __builtin_amdgcn_s_waitcnt(0);
        unsigned nloc = b.st[0], nx = b.st[1];
        if (nloc == 0u) { xcd_barrier_complete(bar, b.x, nloc, nx); b.st[0] = nloc; b.st[1] = nx; }
        const unsigned old = xb_add(&bar[XB_XSUB(b.x)], 1u);
        const unsigned gen = old / nloc;
        if (old + 1u == (gen + 1u) * nloc) {
            __builtin_amdgcn_fence(__ATOMIC_RELEASE, "agent");
            asm volatile("s_waitcnt vmcnt(0)" ::: "memory");
            const unsigned og = xb_add(&bar[XB_TOP], 1u);
            const unsigned tg = og / nx;
            if (og + 1u == (tg + 1u) * nx) xb_add(&bar[XB_TOPGEN], 1u);
            else XB_SPIN(xb_ld(&bar[XB_TOPGEN]) == tg, bar);
            __builtin_amdgcn_fence(__ATOMIC_ACQUIRE, "agent");
            xb_add(&bar[XB_XGEN(b.x)], 1u);
            asm volatile("s_waitcnt vmcnt(0)" ::: "memory");
        } else {
            XB_SPIN(xb_ld(&bar[XB_XGEN(b.x)]) == gen, bar);
            __builtin_amdgcn_fence(__ATOMIC_ACQUIRE, "agent");
            asm volatile("s_waitcnt vmcnt(0)" ::: "memory");
        }
    }
    __syncthreads();
}

typedef short s16x4 __attribute__((ext_vector_type(4)));
typedef unsigned u32x2 __attribute__((ext_vector_type(2)));
__device__ __forceinline__ float fast_sigmoid(float x) { return __builtin_amdgcn_rcpf(1.f + __builtin_amdgcn_exp2f(-1.4426950408889634f * x)); }
__device__ __forceinline__ float fast_silu(float x) { return x * fast_sigmoid(x); }
__device__ __forceinline__ float fast_gelu(float x) { return x * fast_sigmoid(x * (1.5957691216057308f + 0.0713548162726f * x * x)); }
__device__ __forceinline__ float bflo(unsigned w) { return __uint_as_float(w << 16); }
__device__ __forceinline__ float bfhi(unsigned w) { return __uint_as_float(w & 0xffff0000u); }
typedef float f32x2_t __attribute__((ext_vector_type(2))); typedef __bf16 bf16x2_t __attribute__((ext_vector_type(2)));
__device__ __forceinline__ unsigned cvtpk(float lo, float hi) { const f32x2_t v = {lo, hi}; const bf16x2_t b = __builtin_convertvector(v, bf16x2_t); return __builtin_bit_cast(unsigned, b); }
__device__ __forceinline__ s16x4 tr_read(const LAS unsigned char* p) { return __builtin_bit_cast(s16x4, __builtin_amdgcn_ds_read_tr16_b64_v4i16((LAS s16x4*)p)); }
__device__ __forceinline__ bf16x8 frag_tr(const LAS unsigned char* base, int stride, int lane) {
    const int G = lane >> 4, q = (lane >> 2) & 3, p = lane & 3;
    const LAS unsigned char* a = base + (4 * G + q) * stride + 8 * p;
    const s16x4 lo = tr_read(a), hi = tr_read(a + 16 * stride);
    return (bf16x8){lo[0], lo[1], lo[2], lo[3], hi[0], hi[1], hi[2], hi[3]};
}
__device__ __forceinline__ bf16x8 frag_perm_row(const LAS unsigned char* rowbase, int stride, int lane) {
    const LAS unsigned char* a = rowbase + (lane & 15) * stride + 8 * (lane >> 4);
    const s16x4 lo = *(const LAS s16x4*)a, hi = *(const LAS s16x4*)(a + 32);
    return (bf16x8){lo[0], lo[1], lo[2], lo[3], hi[0], hi[1], hi[2], hi[3]};
}

constexpr int SGU_VF_STRIDE = 544, SGU_W_STRIDE = 272, SGU_VF_OFF = 0, SGU_W_OFF = 128 * SGU_VF_STRIDE;
__device__ __forceinline__ void sgu_item(LAS unsigned char* lds, int item, const bf16* Z, const float* v_norm, const float* w_s, const float* b_s, bf16* Y, int tid) {
    const int lane = tid & 63, wave = __builtin_amdgcn_readfirstlane(tid >> 6);
    const int g = item & 3, c = (item >> 2) & 15, b = item >> 6;
    const size_t tok0 = (size_t)b * SEQ + 128 * c;
    LAS unsigned char* VF = lds + SGU_VF_OFF; LAS unsigned char* WS = lds + SGU_W_OFF;
    {
        const int sub = lane >> 4, cl = lane & 15;
        float vn[16];
#pragma unroll
        for (int j = 0; j < 4; ++j) { const f32x4 t = *(const f32x4*)(v_norm + g * 256 + 16 * cl + 4 * j); vn[4 * j] = t[0]; vn[4 * j + 1] = t[1]; vn[4 * j + 2] = t[2]; vn[4 * j + 3] = t[3]; }
#pragma unroll
        for (int ps = 0; ps < 4; ++ps) {
            const int row = 16 * wave + 4 * ps + sub;
            const v4u* src = (const v4u*)(Z + (tok0 + row) * OD_Z + 4096 + 256 * g + 16 * cl);
            const v4u w0 = src[0], w1 = src[1];
            float x[16];
#pragma unroll
            for (int j = 0; j < 4; ++j) { x[2 * j] = fast_gelu(bflo(w0[j])); x[2 * j + 1] = fast_gelu(bfhi(w0[j])); x[8 + 2 * j] = fast_gelu(bflo(w1[j])); x[9 + 2 * j] = fast_gelu(bfhi(w1[j])); }
            float s = 0.f;
#pragma unroll
            for (int j = 0; j < 16; ++j) s += x[j];
            s += __shfl_xor(s, 1); s += __shfl_xor(s, 2); s += __shfl_xor(s, 4); s += __shfl_xor(s, 8);
            const float mu = s * (1.f / 256.f);
            float q = 0.f;
#pragma unroll
            for (int j = 0; j < 16; ++j) { x[j] -= mu; q += x[j] * x[j]; }
            q += __shfl_xor(q, 1); q += __shfl_xor(q, 2); q += __shfl_xor(q, 4); q += __shfl_xor(q, 8);
            const float rstd = __builtin_amdgcn_rsqf(q * (1.f / 256.f) + 1e-6f);
            v4u o0, o1;
#pragma unroll
            for (int j = 0; j < 4; ++j) { o0[j] = cvtpk(x[2 * j] * rstd * vn[2 * j], x[2 * j + 1] * rstd * vn[2 * j + 1]); o1[j] = cvtpk(x[8 + 2 * j] * rstd * vn[8 + 2 * j], x[9 + 2 * j] * rstd * vn[9 + 2 * j]); }
            LAS v4u* dst = (LAS v4u*)(VF + row * SGU_VF_STRIDE + 32 * cl);
            dst[0] = o0; dst[1] = o1;
        }
    }
    {
        const int t = tid >> 2, s0 = (tid & 3) * 32;
        const f32x4* src = (const f32x4*)(w_s + ((size_t)g * 128 + t) * 128 + s0);
#pragma unroll
        for (int j = 0; j < 4; ++j) { const f32x4 a = src[2 * j], bb = src[2 * j + 1]; const int s = s0 + 8 * j;
            v4u o; o[0] = cvtpk(s + 0 <= t ? a[0] : 0.f, s + 1 <= t ? a[1] : 0.f); o[1] = cvtpk(s + 2 <= t ? a[2] : 0.f, s + 3 <= t ? a[3] : 0.f);
            o[2] = cvtpk(s + 4 <= t ? bb[0] : 0.f, s + 5 <= t ? bb[1] : 0.f); o[3] = cvtpk(s + 6 <= t ? bb[2] : 0.f, s + 7 <= t ? bb[3] : 0.f);
            *(LAS v4u*)(WS + t * SGU_W_STRIDE + 2 * s) = o; }
    }
    __syncthreads();
    f32x4 acc[2][8];
#pragma unroll
    for (int eb = 0; eb < 2; ++eb)
#pragma unroll
        for (int tb = 0; tb < 8; ++tb) acc[eb][tb] = (f32x4){0.f, 0.f, 0.f, 0.f};
#pragma unroll
    for (int ks = 0; ks < 4; ++ks) {
        bf16x8 af[2];
#pragma unroll
        for (int eb = 0; eb < 2; ++eb) af[eb] = frag_tr(VF + (32 * ks) * SGU_VF_STRIDE + (16 * (2 * wave + eb)) * 2, SGU_VF_STRIDE, lane);
#pragma unroll
        for (int tb = 2 * ks; tb < 8; ++tb) {
            const bf16x8 bfr = frag_perm_row(WS + (16 * tb) * SGU_W_STRIDE + (32 * ks) * 2, SGU_W_STRIDE, lane);
#pragma unroll
            for (int eb = 0; eb < 2; ++eb) acc[eb][tb] = __builtin_amdgcn_mfma_f32_16x16x32_bf16(af[eb], bfr, acc[eb][tb], 0, 0, 0);
        }
    }
    {
        const int G = lane >> 4, tl = lane & 15;
#pragma unroll
        for (int tb = 0; tb < 8; ++tb) {
            const int t = 16 * tb + tl; const float bs = b_s[g * 128 + t];
            const bf16* zr = Z + (tok0 + t) * OD_Z + 256 * g;
            bf16* yr = Y + (tok0 + t) * DM + 1024 + 256 * g;
#pragma unroll
            for (int eb = 0; eb < 2; ++eb) {
                const int e = 16 * (2 * wave + eb) + 4 * G;
                const u32x2 uu = *(const u32x2*)(zr + 3072 + e), gg = *(const u32x2*)(zr + 5120 + e);
                const f32x4 a = acc[eb][tb];
                const float y0 = fast_gelu(bflo(uu[0])) * (a[0] + bs) * fast_silu(bflo(gg[0])), y1 = fast_gelu(bfhi(uu[0])) * (a[1] + bs) * fast_silu(bfhi(gg[0]));
                const float y2 = fast_gelu(bflo(uu[1])) * (a[2] + bs) * fast_silu(bflo(gg[1])), y3 = fast_gelu(bfhi(uu[1])) * (a[3] + bs) * fast_silu(bfhi(gg[1]));
                u32x2 o; o[0] = cvtpk(y0, y1); o[1] = cvtpk(y2, y3);
                *(u32x2*)(yr + e) = o;
            }
        }
    }
    __syncthreads();
}

constexpr int AT_STRIDE = 288, AT_K_OFF = 0, AT_V_OFF = 256 * AT_STRIDE, AT_V_ROWS = 272, AT_LDS_END = AT_V_OFF + AT_V_ROWS * AT_STRIDE;
__device__ __forceinline__ void attn_item(LAS unsigned char* lds, int item, const bf16* Z, bf16* OG, float* LSE, int tid) {
    const int lane = tid & 63, wave = __builtin_amdgcn_readfirstlane(tid >> 6), G = lane >> 4, ql = lane & 15;
    const int g = item >> 8, rem = item & 255, j = rem & 3, rn = (rem >> 2) & 15, b = rem >> 6;
    const int d = 1 << (2 * g), nb = 16 >> (2 * g), n = rn % nb, r = rn / nb;
    const size_t tokb = (size_t)b * SEQ;
    LAS unsigned char* KT = lds + AT_K_OFF; LAS unsigned char* VT = lds + AT_V_OFF;
    const int q0 = 16 * wave;
    const size_t qtok = tokb + (size_t)(128 * n + q0 + ql) * d + r;
    bf16x8 qf[4];
    { const bf16* qp = Z + qtok * EV_IN + 3072 + g * 512 + j * 128 + 8 * G;
#pragma unroll
      for (int ks = 0; ks < 4; ++ks) qf[ks] = *(const bf16x8*)(qp + 32 * ks); }
    {
        const int c16 = tid & 15, rw = tid >> 4;
        const bf16* kb = Z + 4608 + g * 512 + j * 128 + 8 * c16;
        v4u kvs[8], vvs[8];
#pragma unroll
        for (int ps = 0; ps < 8; ++ps) {
            const int kk = 32 * ps + rw; const int l = 128 * (n - 1) + kk; const int lc = l < 0 ? 0 : l;
            const bf16* p = kb + (tokb + (size_t)lc * d + r) * EV_IN;
            kvs[ps] = *(const v4u*)p; vvs[ps] = *(const v4u*)(p + 1536);
            if (l < 0) { kvs[ps] = (v4u){0u, 0u, 0u, 0u}; vvs[ps] = (v4u){0u, 0u, 0u, 0u}; }
        }
#pragma unroll
        for (int ps = 0; ps < 8; ++ps) { const int kk = 32 * ps + rw; *(LAS v4u*)(KT + kk * AT_STRIDE + 16 * c16) = kvs[ps]; *(LAS v4u*)(VT + kk * AT_STRIDE + 16 * c16) = vvs[ps]; }
        if (tid < 16 * 18) *(LAS v4u*)(VT + 256 * AT_STRIDE + 16 * tid) = (v4u){0u, 0u, 0u, 0u};
    }
    __syncthreads();
    f32x4 sc[9];
#pragma unroll
    for (int t = 0; t < 9; ++t) {
        sc[t] = (f32x4){0.f, 0.f, 0.f, 0.f};
        const LAS unsigned char* kp = KT + (16 * wave + 16 * t + ql) * AT_STRIDE + 16 * G;
#pragma unroll
        for (int ks = 0; ks < 4; ++ks) sc[t] = __builtin_amdgcn_mfma_f32_16x16x32_bf16(*(const LAS bf16x8*)(kp + 64 * ks), qf[ks], sc[t], 0, 0, 0);
    }
    const float slope2 = exp2f(-8.0f * (float)(g + 3 * j + 1) / 12.0f) * (float)d * 1.4426950408889634f;
    const float scale2 = 0.08838834764831845f * 1.4426950408889634f;
    float mx = -INFINITY;
#pragma unroll
    for (int t = 0; t < 9; ++t)
#pragma unroll
        for (int rg = 0; rg < 4; ++rg) {
            const int rel = 16 * t + 4 * G + rg - ql;
            const bool ok = (rel >= 0) && (rel <= 128) && (n > 0 || (q0 + ql + rel) >= 128);
            const float s = sc[t][rg] * scale2 - slope2 * (float)(128 - rel);
            sc[t][rg] = ok ? s : -INFINITY;
            mx = fmaxf(mx, sc[t][rg]);
        }
    mx = fmaxf(mx, __shfl_xor(mx, 16)); mx = fmaxf(mx, __shfl_xor(mx, 32));
    float den = 0.f;
#pragma unroll
    for (int t = 0; t < 9; ++t)
#pragma unroll
        for (int rg = 0; rg < 4; ++rg) { const float p = __builtin_amdgcn_exp2f(sc[t][rg] - mx); sc[t][rg] = p; den += p; }
    den += __shfl_xor(den, 16); den += __shfl_xor(den, 32);
    f32x4 oc[8];
#pragma unroll
    for (int dvb = 0; dvb < 8; ++dvb) oc[dvb] = (f32x4){0.f, 0.f, 0.f, 0.f};
#pragma unroll
    for (int s = 0; s < 5; ++s) {
        const f32x4 plo = sc[2 * s], phi = (s < 4) ? sc[2 * s + 1] : (f32x4){0.f, 0.f, 0.f, 0.f};
        const unsigned w0 = cvtpk(plo[0], plo[1]), w1 = cvtpk(plo[2], plo[3]), w2 = cvtpk(phi[0], phi[1]), w3 = cvtpk(phi[2], phi[3]);
        const bf16x8 pf = __builtin_bit_cast(bf16x8, (v4u){w0, w1, w2, w3});
#pragma unroll
        for (int dvb = 0; dvb < 8; ++dvb) {
            const bf16x8 vf = frag_tr(VT + (16 * wave + 32 * s) * AT_STRIDE + (16 * dvb) * 2, AT_STRIDE, lane);
            oc[dvb] = __builtin_amdgcn_mfma_f32_16x16x32_bf16(vf, pf, oc[dvb], 0, 0, 0);
        }
    }
    const float rden = __builtin_amdgcn_rcpf(den);
    bf16* op = OG + ((size_t)g * MTOK + qtok) * 512 + j * 128 + 4 * G;
#pragma unroll
    for (int dvb = 0; dvb < 8; ++dvb) { u32x2 o; o[0] = cvtpk(oc[dvb][0] * rden, oc[dvb][1] * rden); o[1] = cvtpk(oc[dvb][2] * rden, oc[dvb][3] * rden); *(u32x2*)(op + 16 * dvb) = o; }
    if (G == 0) LSE[((size_t)g * MTOK + qtok) * 4 + j] = mx + __builtin_amdgcn_logf(den);
    __syncthreads();
}
__device__ __forceinline__ void attn_merge(const bf16* Z, const bf16* OG, const float* LSE, bf16* Y, int gtid, int gthreads) {
    for (int it = gtid; it < MTOK * 64; it += gthreads) {
        const int tok = it >> 6, c8 = it & 63, j = c8 >> 4;
        const float l0 = LSE[((size_t)0 * MTOK + tok) * 4 + j], l1 = LSE[((size_t)1 * MTOK + tok) * 4 + j], l2 = LSE[((size_t)2 * MTOK + tok) * 4 + j];
        const float m = fmaxf(l0, fmaxf(l1, l2));
        float w0 = __builtin_amdgcn_exp2f(l0 - m), w1 = __builtin_amdgcn_exp2f(l1 - m), w2 = __builtin_amdgcn_exp2f(l2 - m);
        const float rs = __builtin_amdgcn_rcpf(w0 + w1 + w2); w0 *= rs; w1 *= rs; w2 *= rs;
        const v4u a = *(const v4u*)(OG + ((size_t)0 * MTOK + tok) * 512 + 8 * c8), bb = *(const v4u*)(OG + ((size_t)1 * MTOK + tok) * 512 + 8 * c8), cc = *(const v4u*)(OG + ((size_t)2 * MTOK + tok) * 512 + 8 * c8);
        const v4u gt = *(const v4u*)(Z + (size_t)tok * EV_IN + 7680 + 8 * c8);
        v4u o;
#pragma unroll
        for (int k = 0; k < 4; ++k) {
            const float ylo = (w0 * bflo(a[k]) + w1 * bflo(bb[k]) + w2 * bflo(cc[k])) * fast_silu(bflo(gt[k]));
            const float yhi = (w0 * bfhi(a[k]) + w1 * bfhi(bb[k]) + w2 * bfhi(cc[k])) * fast_silu(bfhi(gt[k]));
            o[k] = cvtpk(ylo, yhi);
        }
        *(v4u*)(Y + (size_t)tok * DM + 1536 + 8 * c8) = o;
    }
}

constexpr int LR_XC_STRIDE = 272, LR_XC_OFF = 0, LR_F_STRIDE = 528  , LR_XCF_OFF = 128 * LR_XC_STRIDE, LR_A_OFF = LR_XCF_OFF + 32 * LR_F_STRIDE, LR_U_OFF = LR_A_OFF + 32 * LR_F_STRIDE, LR_LDS_END = LR_U_OFF + 32 * LR_F_STRIDE;
struct LruParams { const float *conv_w, *conv_b, *b_a, *b_i, *lam; const bf16* wg; };
__device__ __forceinline__ void lru_load_tile(v4u (&xa)[7], v4u& ga, const bf16* Z, size_t tokb, int t0, int h, int c4, int tid) {
    const int co = tid & 15, rg = tid >> 4;
#pragma unroll
    for (int k = 0; k < 7; ++k) { const int t = t0 + 4 * rg + k - 3; const int tc = t < 0 ? 0 : t;
        const v4u v = *(const v4u*)(Z + (tokb + tc) * EV_IN + h * 128 + 8 * co);
        xa[k] = (v4u){t >= 0 ? v[0] : 0u, t >= 0 ? v[1] : 0u, t >= 0 ? v[2] : 0u, t >= 0 ? v[3] : 0u}; }
    ga = *(const v4u*)(Z + (tokb + t0 + (tid >> 2)) * EV_IN + 1536 + h * 128 + 32 * c4 + 8 * (tid & 3));
}
__device__ __forceinline__ void lru_item(LAS unsigned char* lds, int item, const bf16* Z, const LruParams& P, bf16* Y, int tid) {
    const int lane = tid & 63, wave = __builtin_amdgcn_readfirstlane(tid >> 6), G = lane >> 4, ql = lane & 15;
    const int c4 = item & 3, h = (item >> 2) % 12, b = item / 48;
    const size_t tokb = (size_t)b * SEQ;
    LAS unsigned char* XC = lds + LR_XC_OFF; LAS unsigned char* XCF = lds + LR_XCF_OFF; LAS unsigned char* AL = lds + LR_A_OFF; LAS unsigned char* UL = lds + LR_U_OFF;
    bf16x8 wf[2][2][4];
#pragma unroll
    for (int gate = 0; gate < 2; ++gate)
#pragma unroll
        for (int cb = 0; cb < 2; ++cb)
#pragma unroll
            for (int ks = 0; ks < 4; ++ks) wf[gate][cb][ks] = *(const bf16x8*)(P.wg + ((size_t)(h * 2 + gate) * 128 + 32 * c4 + 16 * cb + ql) * 128 + 32 * ks + 8 * G);
    float ba[2], bi[2], sp8[2];
#pragma unroll
    for (int cb = 0; cb < 2; ++cb) { const int ch = h * 128 + 32 * c4 + 16 * cb + ql; ba[cb] = P.b_a[ch]; bi[cb] = P.b_i[ch];
        const float nl = -P.lam[ch]; sp8[cb] = 8.0f * (nl > 20.f ? nl : log1pf(__expf(nl))); }
    float hc = 0.f;
    v4u xa[7], ga;
    lru_load_tile(xa, ga, Z, tokb, 0, h, c4, tid);
    for (int sc = 0; sc < 16; ++sc) {
        const int t0 = 128 * sc;
#ifdef LRU_REP_CONV
        for (int rr = 0; rr < 2; ++rr)
#endif
        {
            const int co = tid & 15, rg = tid >> 4;
            v4u orow[4];
            const bool mine = (co >> 2) == c4;
#pragma unroll
            for (int e = 0; e < 4; ++e) {
                typedef float f32x2 __attribute__((ext_vector_type(2)));
                const int chn = h * 128 + 8 * co + 2 * e;
                const f32x2 w0 = *(const f32x2*)(P.conv_w + 0 * LRU_W + chn), w1 = *(const f32x2*)(P.conv_w + 1 * LRU_W + chn), w2 = *(const f32x2*)(P.conv_w + 2 * LRU_W + chn), w3 = *(const f32x2*)(P.conv_w + 3 * LRU_W + chn);
                const f32x2 cb2 = *(const f32x2*)(P.conv_b + chn);
                float lo[7], hi[7];
#pragma unroll
                for (int k = 0; k < 7; ++k) { lo[k] = bflo(xa[k][e]); hi[k] = bfhi(xa[k][e]); }
                f32x4 xlo, xhi;
#pragma unroll
                for (int r = 0; r < 4; ++r) { xlo[r] = cb2[0] + w0[0] * lo[r] + w1[0] * lo[r + 1] + w2[0] * lo[r + 2] + w3[0] * lo[r + 3];
                                              xhi[r] = cb2[1] + w0[1] * hi[r] + w1[1] * hi[r + 1] + w2[1] * hi[r + 2] + w3[1] * hi[r + 3]; orow[r][e] = cvtpk(xlo[r], xhi[r]); }
                if (mine) { *(LAS f32x4*)(XCF + (8 * (co & 3) + 2 * e) * LR_F_STRIDE + 16 * rg) = xlo; *(LAS f32x4*)(XCF + (8 * (co & 3) + 2 * e + 1) * LR_F_STRIDE + 16 * rg) = xhi; }
            }
#pragma unroll
            for (int r = 0; r < 4; ++r) *(LAS v4u*)(XC + (4 * rg + r) * LR_XC_STRIDE + 16 * co) = orow[r];
        }
        const v4u ga_cur = ga;
        if (sc < 15) lru_load_tile(xa, ga, Z, tokb, t0 + 128, h, c4, tid);
        __syncthreads();
        f32x4 acc[2][2];
#ifdef LRU_REP_EPI
        for (int rr = 0; rr < 2; ++rr) {
#endif
#pragma unroll
        for (int gate = 0; gate < 2; ++gate)
#pragma unroll
            for (int cb = 0; cb < 2; ++cb) acc[gate][cb] = (f32x4){0.f, 0.f, 0.f, 0.f};
#pragma unroll
        for (int ks = 0; ks < 4; ++ks) {
            const bf16x8 af = *(const LAS bf16x8*)(XC + (16 * wave + ql) * LR_XC_STRIDE + 64 * ks + 16 * G);
#pragma unroll
            for (int gate = 0; gate < 2; ++gate)
#pragma unroll
                for (int cb = 0; cb < 2; ++cb) acc[gate][cb] = __builtin_amdgcn_mfma_f32_16x16x32_bf16(af, wf[gate][cb][ks], acc[gate][cb], 0, 0, 0);
        }
#pragma unroll
        for (int cb = 0; cb < 2; ++cb) {
            const int off = (16 * cb + ql) * LR_F_STRIDE + (16 * wave + 4 * G) * 4;
            const f32x4 xcv = *(const LAS f32x4*)(XCF + off);
            f32x4 av, uv;
#pragma unroll
            for (int rg2 = 0; rg2 < 4; ++rg2) {
                const float r = fast_sigmoid(acc[0][cb][rg2] + ba[cb]), ig = fast_sigmoid(acc[1][cb][rg2] + bi[cb]);
                const float la = -r * sp8[cb];
                const float a = __builtin_amdgcn_exp2f(la * 1.4426950408889634f);
                const float x2 = 2.f * la;
                const float om = (x2 > -0.05f) ? -x2 * (1.f + x2 * (0.5f + x2 * (0.16666667f + x2 * 0.041666667f))) : 1.f - a * a;
                av[rg2] = a; uv[rg2] = __builtin_amdgcn_sqrtf(om) * ig * xcv[rg2];
            }
            *(LAS f32x4*)(AL + off) = av; *(LAS f32x4*)(UL + off) = uv;
        }
#ifdef LRU_REP_EPI
        }
#endif
        __syncthreads();
        {
            const int seg = ql, off = (4 * wave + G) * LR_F_STRIDE + 32 * seg;
            const f32x4 a0 = *(const LAS f32x4*)(AL + off), a1 = *(const LAS f32x4*)(AL + off + 16), u0 = *(const LAS f32x4*)(UL + off), u1 = *(const LAS f32x4*)(UL + off + 16);
            float Pp = 1.f, Hh = 0.f;
#pragma unroll
            for (int k = 0; k < 4; ++k) { Hh = a0[k] * Hh + u0[k]; Pp *= a0[k]; }
#pragma unroll
            for (int k = 0; k < 4; ++k) { Hh = a1[k] * Hh + u1[k]; Pp *= a1[k]; }
#pragma unroll
            for (int o = 1; o < 16; o <<= 1) { const float Pl = __shfl_up(Pp, o, 16), Hl = __shfl_up(Hh, o, 16); if (seg >= o) { Hh = Pp * Hl + Hh; Pp = Pp * Pl; } }
            float Pe = __shfl_up(Pp, 1, 16), He = __shfl_up(Hh, 1, 16);
            if (seg == 0) { Pe = 1.f; He = 0.f; }
            float hh = Pe * hc + He;
            f32x4 h0, h1;
#pragma unroll
            for (int k = 0; k < 4; ++k) { hh = a0[k] * hh + u0[k]; h0[k] = hh; }
#pragma unroll
            for (int k = 0; k < 4; ++k) { hh = a1[k] * hh + u1[k]; h1[k] = hh; }
            *(LAS f32x4*)(UL + off) = h0; *(LAS f32x4*)(UL + off + 16) = h1;
            hc = __shfl(hh, (lane & 48) + 15);
        }
        __syncthreads();
#ifdef LRU_REP_OUT
        for (int rr = 0; rr < 2; ++rr)
#endif
        {
            const int tk = tid >> 2, oc = tid & 3;
            float hv[8];
#pragma unroll
            for (int e = 0; e < 8; ++e) hv[e] = *(const LAS float*)(UL + (8 * oc + e) * LR_F_STRIDE + 4 * tk);
            v4u o;
#pragma unroll
            for (int e = 0; e < 4; ++e) o[e] = cvtpk(hv[2 * e] * fast_silu(bflo(ga_cur[e])), hv[2 * e + 1] * fast_silu(bfhi(ga_cur[e])));
            *(v4u*)(Y + (tokb + t0 + tk) * DM + h * 128 + 32 * c4 + 8 * oc) = o;
        }
    }
    __syncthreads();
}

constexpr int G1_ALR_OFF = 0, G1_TOT_OFF = 4096, G1_LDS_END = 6144;
__device__ __forceinline__ void gla1a_item(LAS unsigned char* lds, int item, const bf16* Z, const float* ALR, const float* w_alpha, const float* b_alpha, bf16* QT, bf16* KT, bf16* KD, float* DEC, int tid) {
    const int c = item & 31, h = (item >> 5) & 3, b = item >> 7;
    const size_t tok0 = (size_t)b * SEQ + 64 * c;
    LAS float* ALRs = (LAS float*)(lds + G1_ALR_OFF); LAS float* TOT = (LAS float*)(lds + G1_TOT_OFF);
    if (tid < 256) *(LAS f32x4*)(ALRs + 4 * tid) = *(const f32x4*)(ALR + tok0 * 16 + 4 * tid);
    const int e = tid & 127, tq = tid >> 7;
    float wa[16];
#pragma unroll
    for (int r = 0; r < 16; ++r) wa[r] = w_alpha[r * 512 + h * 128 + e];
    const float bal = b_alpha[h * 128 + e];
    float qv[16], kv[16];
#pragma unroll
    for (int t = 0; t < 16; ++t) { const bf16* zr = Z + (tok0 + 16 * tq + t) * OD_Z + h * 128 + e; qv[t] = bf2f(zr[0]); kv[t] = bf2f(zr[512]); }
    __syncthreads();
    float bc[16]; float run = 0.f;
#pragma unroll
    for (int t = 0; t < 16; ++t) {
        float s = bal;
#pragma unroll
        for (int r = 0; r < 16; ++r) s += ALRs[(16 * tq + t) * 16 + r] * wa[r];
        const float sp = (s < -20.f) ? -s : __builtin_amdgcn_logf(1.f + __builtin_amdgcn_exp2f(-s * 1.4426950408889634f)) * 0.6931471805599453f;
        run -= sp * 0.0625f; bc[t] = run;
    }
    TOT[tq * 128 + e] = run;
    __syncthreads();
    const float t0s = TOT[e], t1s = TOT[128 + e], t2s = TOT[256 + e], t3s = TOT[384 + e];
    const float offs = (tq > 0 ? t0s : 0.f) + (tq > 1 ? t1s : 0.f) + (tq > 2 ? t2s : 0.f), blast = (t0s + t1s) + (t2s + t3s);
    if (tq == 0) DEC[(size_t)item * 128 + e] = __builtin_amdgcn_exp2f(blast * 1.4426950408889634f);
#pragma unroll
    for (int t = 0; t < 16; ++t) {
        const float bb = bc[t] + offs;
        const float eb = __builtin_amdgcn_exp2f(bb * 1.4426950408889634f), enb = __builtin_amdgcn_exp2f(-bb * 1.4426950408889634f), edl = __builtin_amdgcn_exp2f((blast - bb) * 1.4426950408889634f);
        const size_t o = (tok0 + 16 * tq + t) * 512 + h * 128 + e;
        QT[o] = (bf16)f2bf(qv[t] * 0.08838834764831845f * eb); KT[o] = (bf16)f2bf(kv[t] * enb); KD[o] = (bf16)f2bf(kv[t] * edl);
    }
    __syncthreads();
}

constexpr int G2_KD_STRIDE = 288, G2_V_STRIDE = 160, G2_KD_OFF = 0, G2_V_OFF = 64 * G2_KD_STRIDE, G2_BUF = G2_V_OFF + 64 * G2_V_STRIDE, G2_DEC_OFF = 2 * G2_BUF, G2_LDS_END = G2_DEC_OFF + 32 * 128 * 4;
struct Gla2Stage { v4u kd[2], v; };
__device__ __forceinline__ void gla2_load(Gla2Stage& st, const bf16* Z, const bf16* KD, size_t tok0, int h, int slice, int tid) {
    const int rw = tid >> 4, c16 = tid & 15;
#pragma unroll
    for (int ps = 0; ps < 2; ++ps) st.kd[ps] = *(const v4u*)(KD + (tok0 + 32 * ps + rw) * 512 + h * 128 + 8 * c16);
    st.v = *(const v4u*)(Z + (tok0 + (tid >> 3)) * OD_Z + 1024 + h * 256 + 64 * slice + 8 * (tid & 7));
}
__device__ __forceinline__ void gla2_store(const Gla2Stage& st, LAS unsigned char* buf, int tid) {
    const int rw = tid >> 4, c16 = tid & 15;
#pragma unroll
    for (int ps = 0; ps < 2; ++ps) *(LAS v4u*)(buf + G2_KD_OFF + (32 * ps + rw) * G2_KD_STRIDE + 16 * c16) = st.kd[ps];
    *(LAS v4u*)(buf + G2_V_OFF + (tid >> 3) * G2_V_STRIDE + 16 * (tid & 7)) = st.v;
}
__device__ __forceinline__ void gla2s_item(LAS unsigned char* lds, int item, const bf16* Z, const bf16* KD, const float* DEC, bf16* SST, int tid) {
    const int lane = tid & 63, wave = __builtin_amdgcn_readfirstlane(tid >> 6), G = lane >> 4, ql = lane & 15;
    const int slice = item & 3, bh = item >> 2, h = bh & 3, b = bh >> 2;
    const size_t tokb = (size_t)b * SEQ;
    f32x4 sacc[4];
#pragma unroll
    for (int db = 0; db < 4; ++db) sacc[db] = (f32x4){0.f, 0.f, 0.f, 0.f};
    { Gla2Stage st; gla2_load(st, Z, KD, tokb, h, slice, tid); gla2_store(st, lds, tid);
#pragma unroll
      for (int k = 0; k < 2; ++k) *(LAS f32x4*)(lds + G2_DEC_OFF + 16 * (tid + 512 * k)) = *(const f32x4*)(DEC + (size_t)(bh * 32) * 128 + 4 * (tid + 512 * k)); }
    __syncthreads();
    for (int c = 0; c < 32; ++c) {
        LAS unsigned char* buf = lds + (c & 1) * G2_BUF;
        Gla2Stage st;
        if (c < 31) gla2_load(st, Z, KD, tokb + 64 * (c + 1), h, slice, tid);
        bf16* sp = SST + ((size_t)(bh * 32 + c) * 256 + 64 * slice + ql) * 128 + 16 * wave + 4 * G;
#pragma unroll
        for (int db = 0; db < 4; ++db) { u32x2 o; o[0] = cvtpk(sacc[db][0], sacc[db][1]); o[1] = cvtpk(sacc[db][2], sacc[db][3]); *(u32x2*)(sp + (size_t)(16 * db) * 128) = o; }
        const f32x4 dec = *(const LAS f32x4*)(lds + G2_DEC_OFF + (128 * c + 16 * wave + 4 * G) * 4);
#pragma unroll
        for (int db = 0; db < 4; ++db) sacc[db] *= dec;
#pragma unroll
        for (int s = 0; s < 2; ++s) {
            const bf16x8 kf = frag_tr(buf + G2_KD_OFF + (32 * s) * G2_KD_STRIDE + (16 * wave) * 2, G2_KD_STRIDE, lane);
#pragma unroll
            for (int db = 0; db < 4; ++db) {
                const bf16x8 vf = frag_tr(buf + G2_V_OFF + (32 * s) * G2_V_STRIDE + (16 * db) * 2, G2_V_STRIDE, lane);
                sacc[db] = __builtin_amdgcn_mfma_f32_16x16x32_bf16(kf, vf, sacc[db], 0, 0, 0);
            }
        }
        if (c < 31) gla2_store(st, lds + ((c + 1) & 1) * G2_BUF, tid);
        __syncthreads();
    }
}

constexpr int G3_QK_STRIDE = 272, G3_V_STRIDE = 544, G3_QT_OFF = 0, G3_KT_OFF = G3_QT_OFF + 64 * G3_QK_STRIDE, G3_V_OFF = G3_KT_OFF + 64 * G3_QK_STRIDE, G3_ST_OFF = G3_V_OFF + 64 * G3_V_STRIDE,
              G3_PART_OFF = G3_ST_OFF + 256 * G3_QK_STRIDE, G3_LDS_END = G3_PART_OFF + 8 * 16 * 4;
__device__ __forceinline__ void gla3_item(LAS unsigned char* lds, int item, const bf16* Z, const bf16* QT, const bf16* KT, const bf16* SST, const float* head_norm, bf16* Y, int tid) {
    const int lane = tid & 63, wave = __builtin_amdgcn_readfirstlane(tid >> 6), G = lane >> 4, ql = lane & 15;
    const int c = item & 31, h = (item >> 5) & 3, b = item >> 7;
    const size_t tok0 = (size_t)b * SEQ + 64 * c;
    LAS unsigned char* QTl = lds + G3_QT_OFF; LAS unsigned char* KTl = lds + G3_KT_OFF; LAS unsigned char* Vl = lds + G3_V_OFF; LAS unsigned char* STl = lds + G3_ST_OFF;
    LAS float* PART = (LAS float*)(lds + G3_PART_OFF);
    { const int rw = tid >> 4, c16 = tid & 15;
#pragma unroll
      for (int ps = 0; ps < 2; ++ps) { const size_t o = (tok0 + 32 * ps + rw) * 512 + h * 128 + 8 * c16;
          *(LAS v4u*)(QTl + (32 * ps + rw) * G3_QK_STRIDE + 16 * c16) = *(const v4u*)(QT + o); *(LAS v4u*)(KTl + (32 * ps + rw) * G3_QK_STRIDE + 16 * c16) = *(const v4u*)(KT + o); }
      const int rv = tid >> 5, c32 = tid & 31;
#pragma unroll
      for (int ps = 0; ps < 4; ++ps) *(LAS v4u*)(Vl + (16 * ps + rv) * G3_V_STRIDE + 16 * c32) = *(const v4u*)(Z + (tok0 + 16 * ps + rv) * OD_Z + 1024 + h * 256 + 8 * c32);
      const bf16* sp = SST + (size_t)item * 256 * 128;
#pragma unroll
      for (int ps = 0; ps < 8; ++ps) *(LAS v4u*)(STl + (32 * ps + rw) * G3_QK_STRIDE + 16 * c16) = *(const v4u*)(sp + (size_t)(32 * ps + rw) * 128 + 8 * c16); }
    const int ib = wave >> 1, dh = wave & 1;
    u32x2 gcv[8];
    { const bf16* gp = Z + (tok0 + 16 * ib + ql) * OD_Z + 2048 + h * 256 + 128 * dh + 4 * G;
#pragma unroll
      for (int dvb = 0; dvb < 8; ++dvb) gcv[dvb] = *(const u32x2*)(gp + 16 * dvb); }
    __syncthreads();
    bf16x8 qf[4];
#pragma unroll
    for (int ks = 0; ks < 4; ++ks) qf[ks] = *(const LAS bf16x8*)(QTl + (16 * ib + ql) * G3_QK_STRIDE + 64 * ks + 16 * G);
    f32x4 at[4];
#pragma unroll
    for (int jb = 0; jb < 4; ++jb) {
        at[jb] = (f32x4){0.f, 0.f, 0.f, 0.f};
        if (jb <= ib) {
#pragma unroll
            for (int ks = 0; ks < 4; ++ks) at[jb] = __builtin_amdgcn_mfma_f32_16x16x32_bf16(*(const LAS bf16x8*)(KTl + (16 * jb + ql) * G3_QK_STRIDE + 64 * ks + 16 * G), qf[ks], at[jb], 0, 0, 0);
#pragma unroll
            for (int rg = 0; rg < 4; ++rg) if (16 * jb + 4 * G + rg > 16 * ib + ql) at[jb][rg] = 0.f;
        }
    }
    f32x4 oc[8];
#pragma unroll
    for (int dvb = 0; dvb < 8; ++dvb) oc[dvb] = (f32x4){0.f, 0.f, 0.f, 0.f};
#pragma unroll
    for (int ks = 0; ks < 4; ++ks)
#pragma unroll
        for (int dvb = 0; dvb < 8; ++dvb)
            oc[dvb] = __builtin_amdgcn_mfma_f32_16x16x32_bf16(*(const LAS bf16x8*)(STl + (128 * dh + 16 * dvb + ql) * G3_QK_STRIDE + 64 * ks + 16 * G), qf[ks], oc[dvb], 0, 0, 0);
#pragma unroll
    for (int s = 0; s < 2; ++s) {
        if (2 * s <= ib) {
            const bf16x8 pf = __builtin_bit_cast(bf16x8, (v4u){cvtpk(at[2 * s][0], at[2 * s][1]), cvtpk(at[2 * s][2], at[2 * s][3]), cvtpk(at[2 * s + 1][0], at[2 * s + 1][1]), cvtpk(at[2 * s + 1][2], at[2 * s + 1][3])});
#pragma unroll
            for (int dvb = 0; dvb < 8; ++dvb) {
                const bf16x8 vf = frag_tr(Vl + (32 * s) * G3_V_STRIDE + (128 * dh + 16 * dvb) * 2, G3_V_STRIDE, lane);
                oc[dvb] = __builtin_amdgcn_mfma_f32_16x16x32_bf16(vf, pf, oc[dvb], 0, 0, 0);
            }
        }
    }
    float ss = 0.f;
#pragma unroll
    for (int dvb = 0; dvb < 8; ++dvb) ss += (oc[dvb][0] * oc[dvb][0] + oc[dvb][1] * oc[dvb][1]) + (oc[dvb][2] * oc[dvb][2] + oc[dvb][3] * oc[dvb][3]);
    ss += __shfl_xor(ss, 16); ss += __shfl_xor(ss, 32);
    if (G == 0) PART[wave * 16 + ql] = ss;
    __syncthreads();
    const float rs = __builtin_amdgcn_rsqf((PART[(wave & ~1) * 16 + ql] + PART[(wave | 1) * 16 + ql]) * (1.f / 256.f) + 1e-6f);
    bf16* yp = Y + (tok0 + 16 * ib + ql) * DM + h * 256 + 128 * dh + 4 * G;
    const float* hp = head_norm + h * 256 + 128 * dh + 4 * G;
#pragma unroll
    for (int dvb = 0; dvb < 8; ++dvb) {
        const f32x4 hn = *(const f32x4*)(hp + 16 * dvb); const f32x4 o = oc[dvb]; const u32x2 gc = gcv[dvb];
        u32x2 y; y[0] = cvtpk(o[0] * rs * hn[0] * fast_silu(bflo(gc[0])), o[1] * rs * hn[1] * fast_silu(bfhi(gc[0])));
        y[1] = cvtpk(o[2] * rs * hn[2] * fast_silu(bflo(gc[1])), o[3] * rs * hn[3] * fast_silu(bfhi(gc[1])));
        *(u32x2*)(yp + 16 * dvb) = y;
    }
    __syncthreads();
}
#define OPT_ATTN 1
#define OPT_LRU 1
#define OPT_GLA 1
constexpr int NWAVES = 8;
constexpr size_t MiB = 1u << 20;
constexpr size_t WS_CTL = 0, CTL_ZERO_BYTES = 1 * MiB;
constexpr size_t WS_WEVIN = 2 * MiB;
constexpr size_t WS_WEVOUT = 66 * MiB;
constexpr size_t WS_WODIN = 82 * MiB;
constexpr size_t WS_WODOUT = 130 * MiB;
constexpr size_t WS_WALR = 146 * MiB;
constexpr size_t WS_WGATE = 147 * MiB;
constexpr size_t WS_X = 150 * MiB;
constexpr size_t WS_XG = 214 * MiB;
constexpr size_t WS_Z = 246 * MiB;
constexpr size_t WS_Y = 374 * MiB;
constexpr size_t WS_ALR = 406 * MiB;
constexpr size_t WS_SUMP = 406 * MiB + 512 * 1024;
constexpr size_t WS_T0 = 408 * MiB;
constexpr size_t WS_T1 = 456 * MiB;
constexpr size_t WS_END = 504 * MiB;
constexpr int CW_BAR = 4096;
constexpr int MAX_LAUNCH = 8;
static_assert((CW_BAR + MAX_LAUNCH * XCD_BAR_WORDS) * 4 <= (int)CTL_ZERO_BYTES, "ctl map");
constexpr int RING_OFF = 0, RING_BYTES = 131072;
constexpr int LDSCTL_OFF = 152064, MISC_OFF = LDSCTL_OFF + 320;
constexpr int LDS_BYTES = 156160;
static_assert(G1_LDS_END <= LDSCTL_OFF && G2_LDS_END <= LDSCTL_OFF && G3_LDS_END <= LDSCTL_OFF && AT_LDS_END <= LDSCTL_OFF && LR_LDS_END <= LDSCTL_OFF && SGU_W_OFF + 128 * SGU_W_STRIDE <= LDSCTL_OFF, "LDS map");

constexpr int PH_PROLOGUE = 0, PH_FINAL = 21, N_PHASES = 22;

struct Args {
    const float* in[21]; float* out; unsigned char* ws;
    const float* gn[4];
    const float* xold[4];
    int ph_lo, ph_hi, li, pad;
};
#define CAS __attribute__((address_space(4)))
template <class T> __device__ __forceinline__ T* karg(const CAS char* ka, int byte_off) { T* p = *(T* const CAS*)(ka + byte_off); return (T*)(__attribute__((address_space(1))) T*)p; }
#define KIN(k) karg<const float>(ka_, 8 * (k))

__device__ __forceinline__ float wave_sum(float v) {
#pragma unroll
    for (int o = 1; o < 64; o <<= 1) v += __shfl_xor(v, o);
    return v;
}
__device__ __forceinline__ void p0_transpose_item(const float* W, int K, int ldw, int nblk, bf16* WT, int skip_at, int skip, const float* gk, LAS float* scr, int item, int lane) {
    const int kb = item / nblk, nb = item % nblk, k0 = 64 * kb, n0 = 32 * nb, s0 = n0 + (n0 >= skip_at ? skip : 0);
    const int c = lane & 7;
    f32x4 g0 = {1.f, 1.f, 1.f, 1.f}, g1 = {1.f, 1.f, 1.f, 1.f};
    if (gk) { g0 = *(const f32x4*)(gk + k0 + 8 * c); g1 = *(const f32x4*)(gk + k0 + 8 * c + 4); }
#pragma unroll 8
    for (int i = 0; i < 32; ++i) { const int kk = 2 * i + (lane >> 5); scr[kk * 33 + (lane & 31)] = W[(size_t)(k0 + kk) * ldw + s0 + (lane & 31)]; }
    LDS_WAIT(); asm volatile("" ::: "memory");
#pragma unroll
    for (int j = 0; j < 4; ++j) { const int n = (lane >> 3) + 8 * j; const LAS float* s = scr + (8 * c) * 33 + n;
        v4u o; o.x = pk2(s[0 * 33] * g0[0], s[1 * 33] * g0[1]); o.y = pk2(s[2 * 33] * g0[2], s[3 * 33] * g0[3]); o.z = pk2(s[4 * 33] * g1[0], s[5 * 33] * g1[1]); o.w = pk2(s[6 * 33] * g1[2], s[7 * 33] * g1[3]);
        *(GAS v4u*)(WT + (size_t)(n0 + n) * K + k0 + 8 * c) = o; }
    LDS_WAIT(); asm volatile("" ::: "memory");
}

__global__ void __launch_bounds__(NWAVES * 64, 2) mk_fwd(Args args) {
    extern __shared__ __attribute__((aligned(16))) unsigned char lds_raw[];
    LAS unsigned char* lds = (LAS unsigned char*)lds_raw;
    volatile LAS unsigned* MISC = (volatile LAS unsigned*)(lds + MISC_OFF);
    const int G0 = gridDim.x;
    unsigned char* ws = args.ws;
    unsigned* ctl = (unsigned*)(ws + WS_CTL);
    float* SUMP = (float*)(ws + WS_SUMP);
    for (int u = threadIdx.x; u < (LDS_BYTES - LDSCTL_OFF) / 4; u += NWAVES * 64) ((LAS unsigned*)(lds + LDSCTL_OFF))[u] = 0u;
    __syncthreads();
    XcdBarrier bar = xcd_barrier_post(ctl + CW_BAR + args.li * XCD_BAR_WORDS, MISC + 8);

    float* X = (float*)(ws + WS_X); bf16* XG = (bf16*)(ws + WS_XG); bf16* Z = (bf16*)(ws + WS_Z); bf16* Y = (bf16*)(ws + WS_Y);
    float* ALR = (float*)(ws + WS_ALR);

#ifndef REP_COND
#define REP_COND(ph) false
#endif
    int rep_done = 0, first = 1;
    for (int ph = args.ph_lo; ph < args.ph_hi; ) {
        if (ph != PH_PROLOGUE && ph != PH_FINAL && ((ph - 1) % 5) == 3 && ((((ph - 1) / 5) & 1) == 0)) { ++ph; continue; }
        if (!first) xcd_barrier(bar);
        first = 0;
        int tid = threadIdx.x; asm volatile("" : "+v"(tid));
        int G = G0; asm volatile("" : "+s"(G));
        const int lane = tid & 63, wave = __builtin_amdgcn_readfirstlane(tid >> 6);
        const CAS char* ka_ = (const CAS char*)__builtin_amdgcn_kernarg_segment_ptr(); asm volatile("" : "+s"(ka_));
        const float* x_in = KIN(0);
        if (ph == PH_PROLOGUE) {
            LAS float* scr = (LAS float*)(lds + RING_OFF + wave * 16384);
            const int gw = blockIdx.x * NWAVES + wave, NGW = G * NWAVES;
            constexpr int I_EVIN = 32 * 256, I_EVOUT = 32 * 64, I_ODIN = 32 * 192, I_ODOUT = 32 * 64, I_GATE = 2 * 4;
            constexpr int NITEMS = 2 * (I_EVIN + I_EVOUT + I_ODIN + I_ODOUT) + 2 * 12 * 2 * I_GATE;
            for (int it = gw; it < NITEMS; it += NGW) {
                int r = it;
                if (r < 2 * I_EVIN) { const int i = r / I_EVIN; p0_transpose_item(KIN(2) + (size_t)i * DM * EV_IN, DM, EV_IN, 256, (bf16*)(ws + WS_WEVIN) + (size_t)i * EV_IN * DM, 1 << 30, 0, KIN(1) + (size_t)i * DM, scr, r % I_EVIN, lane); continue; } r -= 2 * I_EVIN;
                if (r < 2 * I_EVOUT) { const int i = r / I_EVOUT; p0_transpose_item(KIN(10) + (size_t)i * DM * DM, DM, DM, 64, (bf16*)(ws + WS_WEVOUT) + (size_t)i * DM * DM, 1 << 30, 0, nullptr, scr, r % I_EVOUT, lane); continue; } r -= 2 * I_EVOUT;
                if (r < 2 * I_ODIN) { const int i = r / I_ODIN; p0_transpose_item(KIN(12) + (size_t)i * DM * OD_IN, DM, OD_IN, 192, (bf16*)(ws + WS_WODIN) + (size_t)i * OD_Z * DM, 2048, 16, KIN(11) + (size_t)i * DM, scr, r % I_ODIN, lane); continue; } r -= 2 * I_ODIN;
                if (r < 2 * I_ODOUT) { const int i = r / I_ODOUT; p0_transpose_item(KIN(19) + (size_t)i * DM * DM, DM, DM, 64, (bf16*)(ws + WS_WODOUT) + (size_t)i * DM * DM, 1 << 30, 0, nullptr, scr, r % I_ODOUT, lane); continue; } r -= 2 * I_ODOUT;
                { const int mat = r / I_GATE, li2 = mat / 24, h = (mat % 24) >> 1, gate = mat & 1;
                  const float* src = KIN(gate ? 7 : 5) + ((size_t)li2 * 12 + h) * 128 * 128;
                  p0_transpose_item(src, 128, 128, 4, (bf16*)(ws + WS_WGATE) + (size_t)mat * 128 * 128, 1 << 30, 0, nullptr, scr, r % I_GATE, lane); }
            }
            for (int e = blockIdx.x * 512 + tid; e < 2 * 16 * 2048; e += G * 512) { const int i = e >> 15, j = (e >> 11) & 15, k = e & 2047;
                ((bf16*)(ws + WS_WALR))[e] = (bf16)f2bf(KIN(12)[(size_t)i * DM * OD_IN + (size_t)k * OD_IN + 2048 + j] * KIN(11)[(size_t)i * DM + k]); }
            for (int m = gw; m < MTOK; m += NGW) {
                const f32x4* xr = (const f32x4*)(x_in + (size_t)m * DM) + lane; float s = 0.f;
                unsigned long long* o8 = (unsigned long long*)(XG + (size_t)m * DM) + lane;
#pragma unroll
                for (int j = 0; j < 8; ++j) { const f32x4 v = xr[64 * j]; const unsigned p0 = pk2(v[0], v[1]), p1 = pk2(v[2], v[3]);
                    const float r0 = __uint_as_float(p0 << 16), r1 = __uint_as_float(p0 & 0xffff0000u), r2 = __uint_as_float(p1 << 16), r3 = __uint_as_float(p1 & 0xffff0000u);
                    s += (r0 * r0 + r1 * r1) + (r2 * r2 + r3 * r3);
                    o8[64 * j] = (unsigned long long)p0 | ((unsigned long long)p1 << 32); }
                s = wave_sum(s);
                if (lane < 8) SUMP[(size_t)m * 8 + lane] = (lane == 0) ? s : 0.f;
            }
        } else if (ph == PH_FINAL) {
            const int gw = blockIdx.x * NWAVES + wave, NGW = G * NWAVES;
            const float* gf = KIN(20);
            for (int m = gw; m < MTOK; m += NGW) {
                const f32x4 p0 = *(const f32x4*)(SUMP + ((size_t)4 * 8192 + m) * 8), p1 = *(const f32x4*)(SUMP + ((size_t)4 * 8192 + m) * 8 + 4);
                const float rs = __builtin_amdgcn_rsqf((((p0[0] + p0[1]) + (p0[2] + p0[3])) + ((p1[0] + p1[1]) + (p1[2] + p1[3]))) * (1.0f / 2048.0f) + 1e-6f);
                const unsigned long long* xr = (const unsigned long long*)(XG + (size_t)m * DM) + lane; f32x4* o = (f32x4*)(args.out + (size_t)m * DM) + lane;
#pragma unroll
                for (int j = 0; j < 8; ++j) { const unsigned long long w = xr[64 * j]; const unsigned w0 = (unsigned)w, w1 = (unsigned)(w >> 32); const f32x4 gg = ((const f32x4*)gf)[lane + 64 * j];
                    o[64 * j] = (f32x4){__uint_as_float(w0 << 16) * gg[0] * rs, __uint_as_float(w0 & 0xffff0000u) * gg[1] * rs, __uint_as_float(w1 << 16) * gg[2] * rs, __uint_as_float(w1 & 0xffff0000u) * gg[3] * rs}; }
            }
        } else {
            const int L = (ph - 1) / 5, sub = (ph - 1) % 5, i = L >> 1, odd = L & 1;
            if (sub == 0) {
                const int N = odd ? OD_Z : EV_IN;
                const bf16* Wt = (const bf16*)(ws + (odd ? WS_WODIN : WS_WEVIN)) + (size_t)i * N * DM;
                pg8::Gemm g{XG, Wt, MTOK, N, DM}; pg8::StaticOrder S; S.init(MTOK, N, G, (int)blockIdx.x);
                pg8::EpiIn E{Z, N, SUMP + (size_t)L * 8192 * 8};
                pg8::gemm_phase<pg8::EpiIn, pg8::StaticOrder, true, true>(lds + RING_OFF, g, S, E);
                if (odd) {
                    const bf16* WA = (const bf16*)(ws + WS_WALR) + (size_t)i * 16 * 2048;
                    for (int rb0 = blockIdx.x * 32; rb0 < MTOK; rb0 += G * 32) {
                        const int rb = wave & 1, kq = wave >> 1, fr = lane & 15, fq = lane >> 4;
                        const bf16* ap = XG + (size_t)(rb0 + 16 * rb + fr) * DM + kq * 512 + 8 * fq;
                        const bf16* bp = WA + (size_t)fr * DM + kq * 512 + 8 * fq;
                        f32x4 acc = {0.f, 0.f, 0.f, 0.f};
#pragma unroll 8
                        for (int ks = 0; ks < 16; ++ks) { const bf16x8 a = *(const bf16x8*)(ap + ks * 32), b = *(const bf16x8*)(bp + ks * 32);
                            acc = __builtin_amdgcn_mfma_f32_16x16x32_bf16(a, b, acc, 0, 0, 0); }
                        LAS float* part = (LAS float*)(lds + RING_OFF);
#pragma unroll
                        for (int r = 0; r < 4; ++r) part[(kq * 32 + 16 * rb + 4 * fq + r) * 16 + fr] = acc[r];
                        __syncthreads();
                        { const int row = tid >> 4, j = tid & 15;
                          const float s = (part[(0 * 32 + row) * 16 + j] + part[(1 * 32 + row) * 16 + j]) + (part[(2 * 32 + row) * 16 + j] + part[(3 * 32 + row) * 16 + j]);
                          const float* sp_ = SUMP + ((size_t)L * 8192 + rb0 + row) * 8; const f32x4 p0 = *(const f32x4*)sp_, p1 = *(const f32x4*)(sp_ + 4);
                          const float rs = __builtin_amdgcn_rsqf((((p0[0] + p0[1]) + (p0[2] + p0[3])) + ((p1[0] + p1[1]) + (p1[2] + p1[3]))) * (1.0f / 2048.0f) + 1e-6f);
                          ALR[(size_t)(rb0 + row) * 16 + j] = s * rs; }
                        __syncthreads();
                    }
                }
            } else if (sub == 4) {
                const bf16* Wt = (const bf16*)(ws + (odd ? WS_WODOUT : WS_WEVOUT)) + (size_t)i * DM * DM;
                pg8::Gemm g{Y, Wt, MTOK, DM, DM}; pg8::StaticOrder S; S.init(MTOK, DM, G, (int)blockIdx.x);
                pg8::EpiOut E{XG, SUMP + (size_t)(L + 1) * 8192 * 8, (LAS float*)(lds + RING_BYTES)};
                pg8::gemm_phase<pg8::EpiOut, pg8::StaticOrder, true, true>(lds + RING_OFF, g, S, E);
            }
            else if (sub == 1 && !odd) {
#ifdef OPT_LRU
                { LruParams P{KIN(3) + (size_t)i * 4 * LRU_W, KIN(4) + (size_t)i * LRU_W, KIN(6) + (size_t)i * LRU_W, KIN(8) + (size_t)i * LRU_W, KIN(9) + (size_t)i * LRU_W,
                              (const bf16*)(ws + WS_WGATE) + (size_t)i * 12 * 2 * 128 * 128};
#ifdef LRU_TWICE
                  for (int rr = 0; rr < 2; ++rr)
#endif
                  for (int item = blockIdx.x; item < 192; item += G) lru_item(lds, item, Z, P, Y, tid); }
#endif
#ifdef OPT_ATTN
#ifdef ATT_TWICE
                for (int rr = 0; rr < 2; ++rr)
#endif
                for (int item = blockIdx.x; item < 768; item += G) attn_item(lds, item, Z, (bf16*)(ws + WS_T0), (float*)(ws + WS_T1), tid);
#endif
            } else if (sub == 2 && !odd) {
#ifdef OPT_ATTN
                attn_merge(Z, (const bf16*)(ws + WS_T0), (const float*)(ws + WS_T1), Y, blockIdx.x * 512 + tid, G * 512);
#endif
            }
            else if (sub == 1 && odd) {
                const float* wal = KIN(13) + (size_t)i * 16 * 512; const float* bal = KIN(14) + (size_t)i * 512;
                for (int item = blockIdx.x; item < 512; item += G)
                    gla1a_item(lds, item, Z, ALR, wal, bal, (bf16*)(ws + WS_T0), (bf16*)(ws + WS_T0 + 8 * MiB), (bf16*)(ws + WS_T0 + 16 * MiB), (float*)(ws + WS_T0 + 24 * MiB), tid);
            }
            else if (sub == 2 && odd) {
                if (blockIdx.x < 64) {
                    gla2s_item(lds, blockIdx.x, Z, (const bf16*)(ws + WS_T0 + 16 * MiB), (const float*)(ws + WS_T0 + 24 * MiB), (bf16*)(ws + WS_T1), tid);
                } else {
                    const float* vn = KIN(16) + (size_t)i * 1024; const float* wsg = KIN(17) + (size_t)i * 4 * 128 * 128; const float* bsg = KIN(18) + (size_t)i * 4 * 128;
                    for (int item = blockIdx.x - 64; item < 256; item += G - 64) sgu_item(lds, item, Z, vn, wsg, bsg, Y, tid);
                }
            }
            else if (sub == 3 && odd) {
                for (int item = blockIdx.x; item < 512; item += G)
                    gla3_item(lds, item, Z, (const bf16*)(ws + WS_T0), (const bf16*)(ws + WS_T0 + 8 * MiB), (const bf16*)(ws + WS_T1), KIN(15) + (size_t)i * 1024, Y, tid);
            }
        }
        if (REP_COND(ph) && !rep_done) rep_done = 1; else { rep_done = 0; ++ph; }
    }
}

#define OPT_SGU 1
constexpr int OPT_EVEN_LO = 2, OPT_ODD_LO = 2;
static void launch_mk(Args& a, int lo, int hi, int li, int grid, hipStream_t stream) {
    a.ph_lo = lo; a.ph_hi = hi; a.li = li;
    hipLaunchKernelGGL(mk_fwd, dim3(grid), dim3(NWAVES * 64), LDS_BYTES, stream, a);
}
extern "C" void kernel_launch(void* const* d_in, const int* in_sizes, int n_in, void* d_out, int out_size, void* d_ws, size_t ws_size, hipStream_t stream) {
    static int grid = 0;
    if (grid == 0) {
        if (n_in != 21 || ws_size < WS_END) { fprintf(stderr, "kernel_launch: unexpected n_in %d / ws_size %zu\n", n_in, ws_size); grid = -1; return; }
        int dev = 0, cus = 0, per_cu = 0;
        if (hipGetDevice(&dev) != hipSuccess || hipDeviceGetAttribute(&cus, hipDeviceAttributeMultiprocessorCount, dev) != hipSuccess) { grid = -1; return; }
        if (hipFuncSetAttribute((const void*)mk_fwd, hipFuncAttributeMaxDynamicSharedMemorySize, LDS_BYTES) != hipSuccess) { fprintf(stderr, "kernel_launch: hipFuncSetAttribute failed\n"); grid = -1; return; }
        if (hipOccupancyMaxActiveBlocksPerMultiprocessor(&per_cu, (const void*)mk_fwd, NWAVES * 64, LDS_BYTES) != hipSuccess || per_cu < 1) { fprintf(stderr, "kernel_launch: occupancy query says %d\n", per_cu); }
        (void)hipGetLastError();
        grid = cus;
    }
    if (grid < 0) return;
    hipMemsetAsync((char*)d_ws + WS_CTL, 0, CTL_ZERO_BYTES, stream);
    Args a{};
    for (int i = 0; i < 21; ++i) a.in[i] = (const float*)d_in[i];
    a.out = (float*)d_out; a.ws = (unsigned char*)d_ws;
    a.gn[0] = a.in[11]; a.gn[1] = a.in[1] + DM; a.gn[2] = a.in[11] + DM; a.gn[3] = a.in[20];
    a.xold[0] = a.in[0]; a.xold[1] = a.xold[2] = a.xold[3] = (const float*)((char*)d_ws + WS_X);
    const float *ev_conv_w = a.in[3], *ev_conv_b = a.in[4], *ev_w_a = a.in[5], *ev_b_a = a.in[6], *ev_w_i = a.in[7], *ev_b_i = a.in[8], *ev_lam = a.in[9];
    const float *od_w_alpha = a.in[13], *od_b_alpha = a.in[14], *od_head_norm = a.in[15], *od_v_norm = a.in[16], *od_w_s = a.in[17], *od_b_s = a.in[18];
    char* ws = (char*)d_ws;
    bf16* Z = (bf16*)(ws + WS_Z); bf16* Y = (bf16*)(ws + WS_Y); float* ALR = (float*)(ws + WS_ALR); float* T0 = (float*)(ws + WS_T0); float* T1 = (float*)(ws + WS_T1);
    launch_mk(a, 0, N_PHASES, 0, grid, stream);
}
```

```cpp
#include <hip/hip_runtime.h>
#include <cstdio>
#include <cstdint>

constexpr int DM = 2048, NB = 4, SEQ = 2048, MTOK = NB * SEQ;
constexpr int LRU_W = 1536, EV_IN = 8192;
constexpr int OD_IN = 6160, OD_Z = 6144;
constexpr float EPS = 1e-6f;

typedef unsigned short bf16;
typedef bf16 AT;

__device__ __forceinline__ float bf2f(bf16 v) { return __uint_as_float((unsigned)v << 16); }
__device__ __forceinline__ unsigned f2bf(float f) { unsigned u = __builtin_bit_cast(unsigned, f); return (u + 0x7fffu + ((u >> 16) & 1u)) >> 16; }
__device__ __forceinline__ unsigned pk2(float lo, float hi) { return f2bf(lo) | (f2bf(hi) << 16); }
__device__ __forceinline__ float ldA(const bf16* p, size_t i) { return bf2f(p[i]); }
__device__ __forceinline__ void stA(bf16* p, size_t i, float v) { p[i] = (bf16)f2bf(v); }

__device__ __forceinline__ float sigmoidf_(float x) { return 1.f / (1.f + __expf(-x)); }
__device__ __forceinline__ float siluf_(float x) { return x * sigmoidf_(x); }
__device__ __forceinline__ float geluf_(float x) { return 0.5f * x * (1.f + tanhf(0.7978845608028654f * (x + 0.044715f * x * x * x))); }
__device__ __forceinline__ float softplusf_(float x) { return x > 20.f ? x : log1pf(__expf(x)); }
__device__ __forceinline__ float logsigmoidf_(float x) { return -softplusf_(-x); }

namespace pg8 {
#define PG8_LAS __attribute__((address_space(3)))
typedef unsigned short bf16_t;
typedef short bf16x8 __attribute__((ext_vector_type(8)));
typedef float f32x4 __attribute__((ext_vector_type(4)));
typedef unsigned u32x4 __attribute__((ext_vector_type(4)));
constexpr int BM = 256, BK = 64, HALF = 128, HTB = HALF * BK * 2  , STAGE_BYTES = 8 * HTB, NXCD = 8, WGM = 8;

__host__ __device__ __forceinline__ int lds_byte(int r, int c) { const int st = (r >> 4) * 2 + (c >> 5), rr = r & 15, cc = c & 31, ob = rr * 64 + cc * 2; return st * 1024 + (ob ^ (((ob >> 9) & 1) << 5)); }
__host__ __device__ __forceinline__ void stage_rc(int b, int& R, int& C) { const int st = b / 1024, sb = b % 1024, swz = sb ^ (((sb >> 9) & 1) << 5); R = (st >> 1) * 16 + swz / 64; C = (st & 1) * 32 + (swz % 64) / 2; }
__host__ __device__ __forceinline__ int perm32(int rho) { const int n = rho >> 4, i = rho & 15; return 8 * (i >> 2) + 4 * n + (i & 3); }

struct Unit { int pm, pn; };
struct Gemm { const bf16_t* A; const bf16_t* Bt; int M, N, K; };

struct StaticOrder {
    int nM, nN, nwg, G, c;
    __host__ __device__ void init(int M, int N, int G_, int c_) { nM = M / BM; nN = N / BM; nwg = nM * nN; G = G_; c = c_; }
    __host__ __device__ bool next(int i, Unit& u) const {
        const long L = (long)i * G + c; if (L >= nwg) return false;
        int wgid = (int)L; { const int q = nwg / NXCD, r = nwg % NXCD, xcd = wgid % NXCD, off = wgid / NXCD; wgid = (xcd < r ? xcd * (q + 1) : r * (q + 1) + (xcd - r) * q) + off; }
        const int nig = WGM * nN, gid = wgid / nig, fm = gid * WGM, gsz = (nM - fm) < WGM ? (nM - fm) : WGM;
        u.pm = fm + ((wgid % nig) % gsz); u.pn = (wgid % nig) / gsz; return true;
    }
    __device__ __forceinline__ void a_ready(const Unit&) const {}
    __device__ __forceinline__ void done(const Unit&) const {}
};

__device__ __forceinline__ unsigned cvt_pk_bf16(float lo, float hi) { unsigned r; asm volatile("v_cvt_pk_bf16_f32 %0, %1, %2" : "=v"(r) : "v"(lo), "v"(hi)); return r; }
struct EpiIn {
    static constexpr bool PERM = true, AFTER_DRAIN = false;
    bf16_t* O; int ldc; const float* sump;
    __device__ __forceinline__ void operator()(const f32x4 (&acc)[2][2][4][2], const Unit& u, int wr, int wc, int fr, int fq) const {
        const int row0 = u.pm * BM + wr * 64 + fr, col0 = u.pn * BM + wc * 32 + 8 * fq;
#pragma unroll
        for (int ai = 0; ai < 2; ++ai)
#pragma unroll
            for (int m = 0; m < 4; ++m) { const int row = row0 + ai * HALF + m * 16;
                const f32x4 p0 = *(const f32x4*)(sump + (size_t)row * 8), p1 = *(const f32x4*)(sump + (size_t)row * 8 + 4);
                const float rs = __builtin_amdgcn_rsqf((((p0[0] + p0[1]) + (p0[2] + p0[3])) + ((p1[0] + p1[1]) + (p1[2] + p1[3]))) * (1.0f / 2048.0f) + 1e-6f);
                bf16_t* rowp = O + (size_t)row * ldc + col0;
#pragma unroll
                for (int bj = 0; bj < 2; ++bj) { const f32x4 v0 = acc[ai][bj][m][0] * rs, v1 = acc[ai][bj][m][1] * rs;
                    u32x4 w; w.x = cvt_pk_bf16(v0[0], v0[1]); w.y = cvt_pk_bf16(v0[2], v0[3]); w.z = cvt_pk_bf16(v1[0], v1[1]); w.w = cvt_pk_bf16(v1[2], v1[3]);
                    *(u32x4*)(rowp + bj * HALF) = w; } }
    }
};
struct EpiOut {
    static constexpr bool PERM = true, AFTER_DRAIN = false;
    bf16_t* x; float* sump_next; PG8_LAS float* xs;
    __device__ __forceinline__ void operator()(const f32x4 (&acc)[2][2][4][2], const Unit& u, int wr, int wc, int fr, int fq) const {
        const int row0 = u.pm * BM + wr * 64 + fr, col0 = u.pn * BM + wc * 32 + 8 * fq;
#pragma unroll
        for (int ai = 0; ai < 2; ++ai) {
            u32x4 xo[4][2];
#pragma unroll
            for (int m = 0; m < 4; ++m) { const size_t off = (size_t)(row0 + ai * HALF + m * 16) * 2048 + col0;
#pragma unroll
                for (int bj = 0; bj < 2; ++bj) xo[m][bj] = *(const u32x4*)(x + off + bj * HALF); }
            asm volatile("" ::: "memory");
#pragma unroll
            for (int m = 0; m < 4; ++m) { const size_t off = (size_t)(row0 + ai * HALF + m * 16) * 2048 + col0; float ss = 0.f;
#pragma unroll
                for (int bj = 0; bj < 2; ++bj) {
                    const u32x4 o = xo[m][bj]; u32x4 w;
#pragma unroll
                    for (int k = 0; k < 4; ++k) { const float lo = __uint_as_float(o[k] << 16) + acc[ai][bj][m][k >> 1][(k & 1) * 2], hi = __uint_as_float(o[k] & 0xffff0000u) + acc[ai][bj][m][k >> 1][(k & 1) * 2 + 1];
                        const unsigned p = cvt_pk_bf16(lo, hi); w[k] = p;
                        const float rl = __uint_as_float(p << 16), rh = __uint_as_float(p & 0xffff0000u); ss += rl * rl + rh * rh; }
                    *(u32x4*)(x + off + bj * HALF) = w; }
                ss += __shfl_xor(ss, 16); ss += __shfl_xor(ss, 32);
                if (fq == 0) xs[(ai * HALF + wr * 64 + m * 16 + fr) * 4 + wc] = ss; }
            asm volatile("" ::: "memory");
        }
        asm volatile("s_waitcnt lgkmcnt(0)" ::: "memory"); __builtin_amdgcn_s_barrier(); asm volatile("" ::: "memory");
        { const int t = threadIdx.x; if (t < 256) { const f32x4 p = *(const PG8_LAS f32x4*)(xs + 4 * t); sump_next[(size_t)(u.pm * BM + t) * 8 + u.pn] = (p[0] + p[1]) + (p[2] + p[3]); } }
    }
};
template <class Epi, class Sched, bool ALIGN_EPI = false, bool SP2 = false>
__device__ __forceinline__ void gemm_phase(PG8_LAS unsigned char* lds, const Gemm g, const Sched& S, const Epi& E) {
    int tid_op = threadIdx.x; asm volatile("" : "+v"(tid_op));
    const int tid = tid_op, wid = __builtin_amdgcn_readfirstlane(tid >> 6), lane = tid & 63, wr = wid >> 2, wc = wid & 3, fr = lane & 15, fq = lane >> 4;
    const int K = g.K, nt = K / BK;
    unsigned voffA[2], voffB[2];
#pragma unroll
    for (int i = 0; i < 2; ++i) { int R, C; stage_rc(tid * 16 + i * 8192, R, C); const int Rb = Epi::PERM ? ((R & ~31) + perm32(R & 31)) : R;
        voffA[i] = (unsigned)(R * K + C) * 2u; voffB[i] = (unsigned)(Rb * K + C) * 2u; }
    const size_t kstep = (size_t)(BK * 2);
    const size_t hstep = (size_t)HALF * K * 2;
    const size_t tstep = 2 * hstep;
    const unsigned ldsw = (unsigned)wid * 1024u;
    const int aoff = lds_byte(wr * 64 + fr, fq * 8), boff = lds_byte(wc * 32 + fr, fq * 8);
#define PG8_SA(b, h) (((b) * 2 + (h)) * HTB)
#define PG8_SB(b, h) ((4 + (b) * 2 + (h)) * HTB)
#define PG8_STAGE(bufoff, gbase, voff) do { _Pragma("unroll") for (int _i = 0; _i < 2; ++_i) \
        __builtin_amdgcn_global_load_lds((const unsigned*)((const char*)(gbase) + (voff)[_i]), (PG8_LAS unsigned*)(lds + (bufoff) + ldsw + _i * 8192), 16, 0, 0); } while (0)
#define PG8_LDA(dst, b, h) do { _Pragma("unroll") for (int m = 0; m < 4; ++m) _Pragma("unroll") for (int k = 0; k < 2; ++k) dst[m][k] = *(const PG8_LAS bf16x8*)(lds + PG8_SA(b, h) + aoff + m * 2048 + k * 1024); } while (0)
#define PG8_LDB(dst, b, h) do { _Pragma("unroll") for (int n = 0; n < 2; ++n) _Pragma("unroll") for (int k = 0; k < 2; ++k) dst[n][k] = *(const PG8_LAS bf16x8*)(lds + PG8_SB(b, h) + boff + n * 2048 + k * 1024); } while (0)
#define PG8_MMA(ai, bj, At, Bt) do { __builtin_amdgcn_s_setprio(1); _Pragma("unroll") for (int m = 0; m < 4; ++m) _Pragma("unroll") for (int n = 0; n < 2; ++n) _Pragma("unroll") for (int k = 0; k < 2; ++k) \
        acc[ai][bj][m][n] = __builtin_amdgcn_mfma_f32_16x16x32_bf16(Bt[n][k], At[m][k], acc[ai][bj][m][n], 0, 0, 0); __builtin_amdgcn_s_setprio(0); } while (0)
#define PG8_WAIT_V(n) asm volatile("s_waitcnt vmcnt(" #n ")" ::: "memory")
#define PG8_WAIT_L(n) asm volatile("s_waitcnt lgkmcnt(" #n ")" ::: "memory")
#define PG8_BAR __builtin_amdgcn_s_barrier()
#define PG8_SCHED __builtin_amdgcn_sched_barrier(0)
    Unit cur, nxt; int ui = 0;
    if (!S.next(0, cur)) return;
    f32x4 acc[2][2][4][2];
#pragma unroll
    for (int a = 0; a < 2; ++a)
#pragma unroll
        for (int b = 0; b < 2; ++b)
#pragma unroll
            for (int m = 0; m < 4; ++m)
#pragma unroll
                for (int n = 0; n < 2; ++n) acc[a][b][m][n] = (f32x4){0.f, 0.f, 0.f, 0.f};
    bf16x8 At[4][2], B0[2][2], B1[2][2];
    const char* cA = (const char*)g.A + (size_t)cur.pm * tstep; const char* cB = (const char*)g.Bt + (size_t)cur.pn * tstep;
    S.a_ready(cur);
    if constexpr (SP2) {
        PG8_STAGE(PG8_SB(0, 0), cB, voffB); PG8_STAGE(PG8_SB(0, 1), cB + hstep, voffB); PG8_STAGE(PG8_SA(0, 0), cA, voffA); PG8_STAGE(PG8_SA(0, 1), cA + hstep, voffA);
        if (wr == 1) PG8_BAR;
        PG8_WAIT_V(2); PG8_BAR;
        PG8_STAGE(PG8_SB(1, 0), cB + kstep, voffB); PG8_STAGE(PG8_SA(1, 0), cA + kstep, voffA); PG8_STAGE(PG8_SB(1, 1), cB + hstep + kstep, voffB);
        PG8_WAIT_V(6); PG8_BAR;
    } else {
        PG8_STAGE(PG8_SB(0, 0), cB, voffB); PG8_STAGE(PG8_SA(0, 0), cA, voffA); PG8_STAGE(PG8_SB(0, 1), cB + hstep, voffB); PG8_STAGE(PG8_SA(0, 1), cA + hstep, voffA);
        if (wr == 1) PG8_BAR;
        PG8_WAIT_V(4); PG8_BAR;
        PG8_STAGE(PG8_SB(1, 0), cB + kstep, voffB); PG8_STAGE(PG8_SA(1, 0), cA + kstep, voffA); PG8_STAGE(PG8_SB(1, 1), cB + hstep + kstep, voffB);
        PG8_WAIT_V(6); PG8_BAR;
    }
    for (;;) {
        const bool has_next = S.next(ui + 1, nxt);
        const char* nA = has_next ? (const char*)g.A + (size_t)nxt.pm * tstep : cA; const char* nB = has_next ? (const char*)g.Bt + (size_t)nxt.pn * tstep : cB;
        for (int t = 0; t < nt; t += 2) {
            const bool last = (t == nt - 2);
            const char* a1 = cA + (size_t)(t + 1) * kstep;
            const char* a2 = last ? nA : cA + (size_t)(t + 2) * kstep; const char* b2 = last ? nB : cB + (size_t)(t + 2) * kstep;
            const char* a3 = a2 + kstep; const char* b3 = b2 + kstep;
            if (last && has_next) S.a_ready(nxt);
            if constexpr (SP2) {
            PG8_LDB(B0, 0, 0); PG8_LDB(B1, 0, 1); PG8_SCHED; PG8_LDA(At, 0, 0); PG8_STAGE(PG8_SA(1, 1), a1 + hstep, voffA);
            PG8_WAIT_V(8); PG8_WAIT_L(0); PG8_BAR; PG8_MMA(0, 0, At, B0); PG8_MMA(0, 1, At, B1); PG8_BAR; PG8_SCHED;
            PG8_LDA(At, 0, 1); PG8_STAGE(PG8_SB(0, 0), b2, voffB); PG8_STAGE(PG8_SB(0, 1), b2 + hstep, voffB); PG8_STAGE(PG8_SA(0, 0), a2, voffA);
            PG8_WAIT_V(8); PG8_WAIT_L(0); PG8_BAR; PG8_MMA(1, 0, At, B0); PG8_MMA(1, 1, At, B1); PG8_BAR; PG8_SCHED;
            PG8_LDB(B0, 1, 0); PG8_LDB(B1, 1, 1); PG8_SCHED; PG8_LDA(At, 1, 0); PG8_STAGE(PG8_SA(0, 1), a2 + hstep, voffA);
            PG8_WAIT_V(8); PG8_WAIT_L(0); PG8_BAR; PG8_MMA(0, 0, At, B0); PG8_MMA(0, 1, At, B1); PG8_BAR; PG8_SCHED;
            PG8_LDA(At, 1, 1); PG8_STAGE(PG8_SB(1, 0), b3, voffB); PG8_STAGE(PG8_SB(1, 1), b3 + hstep, voffB); PG8_STAGE(PG8_SA(1, 0), a3, voffA);
            PG8_WAIT_V(8); PG8_WAIT_L(0); PG8_BAR; PG8_MMA(1, 0, At, B0); PG8_MMA(1, 1, At, B1); PG8_BAR; PG8_SCHED;
            } else {
            PG8_LDB(B0, 0, 0); PG8_SCHED; PG8_LDA(At, 0, 0); PG8_STAGE(PG8_SA(1, 1), a1 + hstep, voffA);
            PG8_WAIT_L(8); PG8_BAR; PG8_WAIT_L(0); PG8_MMA(0, 0, At, B0); PG8_BAR; PG8_SCHED;
            PG8_LDB(B1, 0, 1); PG8_STAGE(PG8_SB(0, 0), b2, voffB);
            PG8_BAR; PG8_WAIT_L(0); PG8_MMA(0, 1, At, B1); PG8_BAR;
            PG8_LDA(At, 0, 1); PG8_STAGE(PG8_SA(0, 0), a2, voffA);
            PG8_BAR; PG8_WAIT_L(0); PG8_MMA(1, 0, At, B0); PG8_BAR; PG8_SCHED;
            PG8_STAGE(PG8_SB(0, 1), b2 + hstep, voffB);
            PG8_WAIT_V(6); PG8_BAR; PG8_MMA(1, 1, At, B1); PG8_BAR;
            PG8_LDB(B0, 1, 0); PG8_SCHED; PG8_LDA(At, 1, 0); PG8_STAGE(PG8_SA(0, 1), a2 + hstep, voffA);
            PG8_WAIT_L(8); PG8_BAR; PG8_WAIT_L(0); PG8_MMA(0, 0, At, B0); PG8_BAR; PG8_SCHED;
            PG8_LDB(B1, 1, 1); PG8_STAGE(PG8_SB(1, 0), b3, voffB);
            PG8_BAR; PG8_WAIT_L(0); PG8_MMA(0, 1, At, B1); PG8_BAR;
            PG8_LDA(At, 1, 1); PG8_STAGE(PG8_SA(1, 0), a3, voffA);
            PG8_BAR; PG8_WAIT_L(0); PG8_MMA(1, 0, At, B0); PG8_BAR; PG8_SCHED;
            PG8_STAGE(PG8_SB(1, 1), b3 + hstep, voffB);
            PG8_WAIT_V(6); PG8_BAR; PG8_MMA(1, 1, At, B1); PG8_BAR;
            }
        }
        if constexpr (ALIGN_EPI) { if (wr == 0) PG8_BAR; }
        if constexpr (!Epi::AFTER_DRAIN) { E(acc, cur, wr, wc, fr, fq); S.done(cur); }
        if (!has_next) break;
#pragma unroll
        for (int a = 0; a < 2; ++a)
#pragma unroll
            for (int b = 0; b < 2; ++b)
#pragma unroll
                for (int m = 0; m < 4; ++m)
#pragma unroll
                    for (int n = 0; n < 2; ++n) acc[a][b][m][n] = (f32x4){0.f, 0.f, 0.f, 0.f};
        cur = nxt; cA = nA; cB = nB; ++ui;
        if constexpr (ALIGN_EPI) { if (wr == 1) PG8_BAR; }
    }
    PG8_WAIT_V(0);
    if constexpr (!ALIGN_EPI) { if (wr == 0) PG8_BAR; }
    PG8_BAR;
    if constexpr (Epi::AFTER_DRAIN) { E.fused(acc, cur, wr, wc, fr, fq, lds, wid, lane); S.done(cur); }
#undef PG8_SA
#undef PG8_SB
#undef PG8_STAGE
#undef PG8_LDA
#undef PG8_LDB
#undef PG8_MMA
#undef PG8_WAIT_V
#undef PG8_WAIT_L
#undef PG8_BAR
#undef PG8_SCHED
}
}
#define GAS __attribute__((address_space(1)))
#define LAS __attribute__((address_space(3)))
typedef unsigned v4u __attribute__((ext_vector_type(4)));
typedef float f32x4 __attribute__((ext_vector_type(4)));
typedef short bf16x8 __attribute__((ext_vector_type(8)));
typedef GAS unsigned gu32;
#define RLX_AGENT __ATOMIC_RELAXED, __HIP_MEMORY_SCOPE_AGENT
#define LDS_WAIT() asm volatile("s_waitcnt lgkmcnt(0)" ::: "memory")
#define VM_WAIT() asm volatile("s_waitcnt vmcnt(0)" ::: "memory")
#define XB_TMO      128
#define XB_XCNT(j)  (256  + 64 * (j))
#define XB_XSUB(j)  (1280 + 64 * (j))
#define XB_XGEN(j)  (2304 + 64 * (j))
#define XB_TOP      3328
#define XB_TOPGEN   3392
#define XCD_BAR_WORDS 3456
#define XB_SPIN_CAP (1u << 18)

__device__ __forceinline__ unsigned xb_ld(unsigned* p)              { return __hip_atomic_load(p, __ATOMIC_RELAXED, __HIP_MEMORY_SCOPE_AGENT); }
__device__ __forceinline__ unsigned xb_add(unsigned* p, unsigned v) { return __hip_atomic_fetch_add(p, v, __ATOMIC_RELAXED, __HIP_MEMORY_SCOPE_AGENT); }
__device__ __forceinline__ unsigned xb_xcc_id() { return (unsigned)__builtin_amdgcn_s_getreg((3 << 11) | 20) & 0xFu; }
#define XB_SPIN(cond, bar) do { unsigned _sp = 0; while (cond) { __builtin_amdgcn_s_sleep(1); \
    if ((++_sp & 255u) == 0u) { if (xb_ld(&(bar)[XB_TMO])) break; if (_sp > XB_SPIN_CAP) { atomicAdd(&(bar)[XB_TMO], 1u); break; } } } } while (0)

struct XcdBarrier {
    unsigned* bar; unsigned x;
    volatile LAS unsigned* st;
};

__device__ __forceinline__ XcdBarrier xcd_barrier_post(unsigned* bar, volatile LAS unsigned* st) {
    XcdBarrier b; b.bar = bar; b.x = xb_xcc_id(); b.st = st;
    if (threadIdx.x == 0) (void)xb_add(&bar[XB_XCNT(b.x)], 1u);
    return b;
}
__device__ __forceinline__ void xcd_barrier_complete(unsigned* bar, unsigned x, unsigned& nloc, unsigned& nx) {
    const unsigned G = gridDim.x * gridDim.y * gridDim.z;
    unsigned sum, cnt, mine, sp = 0u;
    for (;;) {
        sum = 0u; cnt = 0u; mine = 0u;
#pragma unroll
        for (unsigned j = 0; j < 16; ++j) { const unsigned c = xb_ld(&bar[XB_XCNT(j)]); sum += c; cnt += (c > 0u) ? 1u : 0u; mine = (j == x) ? c : mine; }
        if (sum == G) break;
        __builtin_amdgcn_s_sleep(1);
        if ((++sp & 255u) == 0u) { if (xb_ld(&bar[XB_TMO])) break; if (sp > XB_SPIN_CAP) { atomicAdd(&bar[XB_TMO], 1u); break; } }
    }
    nloc = mine > 0u ? mine : 1u; nx = cnt > 0u ? cnt : 1u;
}

__device__ __forceinline__ void xcd_barrier(const XcdBarrier& b) {
    asm volatile("s_waitcnt vmcnt(0)" ::: "memory");
    __syncthreads();
    if (threadIdx.x == 0) {
        unsigned* bar = b.bar;
        __builtin_amdgcn_s_waitcnt(0);
        unsigned nloc = b.st[0], nx = b.st[1];
        if (nloc == 0u) { xcd_barrier_complete(bar, b.x, nloc, nx); b.st[0] = nloc; b.st[1] = nx; }
        const unsigned old = xb_add(&bar[XB_XSUB(b.x)], 1u);
        const unsigned gen = old / nloc;
        if (old + 1u == (gen + 1u) * nloc) {
            __builtin_amdgcn_fence(__ATOMIC_RELEASE, "agent");
            asm volatile("s_waitcnt vmcnt(0)" ::: "memory");
            const unsigned og = xb_add(&bar[XB_TOP], 1u);
            const unsigned tg = og / nx;
            if (og + 1u == (tg + 1u) * nx) xb_add(&bar[XB_TOPGEN], 1u);
            else XB_SPIN(xb_ld(&bar[XB_TOPGEN]) == tg, bar);
            __builtin_amdgcn_fence(__ATOMIC_ACQUIRE, "agent");
            xb_add(&bar[XB_XGEN(b.x)], 1u);
            asm volatile("s_waitcnt vmcnt(0)" ::: "memory");
        } else {
            XB_SPIN(xb_ld(&bar[XB_XGEN(b.x)]) == gen, bar);
            __builtin_amdgcn_fence(__ATOMIC_ACQUIRE, "agent");
            asm volatile("s_waitcnt vmcnt(0)" ::: "memory");
        }
    }
    __syncthreads();
}

typedef short s16x4 __attribute__((ext_vector_type(4)));
typedef unsigned u32x2 __attribute__((ext_vector_type(2)));
__device__ __forceinline__ float fast_sigmoid(float x) { return __builtin_amdgcn_rcpf(1.f + __builtin_amdgcn_exp2f(-1.4426950408889634f * x)); }
__device__ __forceinline__ float fast_silu(float x) { return x * fast_sigmoid(x); }
__device__ __forceinline__ float fast_gelu(float x) { return x * fast_sigmoid(x * (1.5957691216057308f + 0.0713548162726f * x * x)); }
__device__ __forceinline__ float bflo(unsigned w) { return __uint_as_float(w << 16); }
__device__ __forceinline__ float bfhi(unsigned w) { return __uint_as_float(w & 0xffff0000u); }
typedef float f32x2_t __attribute__((ext_vector_type(2))); typedef __bf16 bf16x2_t __attribute__((ext_vector_type(2)));
__device__ __forceinline__ unsigned cvtpk(float lo, float hi) { const f32x2_t v = {lo, hi}; const bf16x2_t b = __builtin_convertvector(v, bf16x2_t); return __builtin_bit_cast(unsigned, b); }
__device__ __forceinline__ s16x4 tr_read(const LAS unsigned char* p) { return __builtin_bit_cast(s16x4, __builtin_amdgcn_ds_read_tr16_b64_v4i16((LAS s16x4*)p)); }
__device__ __forceinline__ bf16x8 frag_tr(const LAS unsigned char* base, int stride, int lane) {
    const int G = lane >> 4, q = (lane >> 2) & 3, p = lane & 3;
    const LAS unsigned char* a = base + (4 * G + q) * stride + 8 * p;
    const s16x4 lo = tr_read(a), hi = tr_read(a + 16 * stride);
    return (bf16x8){lo[0], lo[1], lo[2], lo[3], hi[0], hi[1], hi[2], hi[3]};
}
__device__ __forceinline__ bf16x8 frag_perm_row(const LAS unsigned char* rowbase, int stride, int lane) {
    const LAS unsigned char* a = rowbase + (lane & 15) * stride + 8 * (lane >> 4);
    const s16x4 lo = *(const LAS s16x4*)a, hi = *(const LAS s16x4*)(a + 32);
    return (bf16x8){lo[0], lo[1], lo[2], lo[3], hi[0], hi[1], hi[2], hi[3]};
}

constexpr int SGU_VF_STRIDE = 544, SGU_W_STRIDE = 272, SGU_VF_OFF = 0, SGU_W_OFF = 128 * SGU_VF_STRIDE;
__device__ __forceinline__ void sgu_item(LAS unsigned char* lds, int item, const bf16* Z, const float* v_norm, const float* w_s, const float* b_s, bf16* Y, int tid) {
    const int lane = tid & 63, wave = __builtin_amdgcn_readfirstlane(tid >> 6);
    const int g = item & 3, c = (item >> 2) & 15, b = item >> 6;
    const size_t tok0 = (size_t)b * SEQ + 128 * c;
    LAS unsigned char* VF = lds + SGU_VF_OFF; LAS unsigned char* WS = lds + SGU_W_OFF;
    {
        const int sub = lane >> 4, cl = lane & 15;
        float vn[16];
#pragma unroll
        for (int j = 0; j < 4; ++j) { const f32x4 t = *(const f32x4*)(v_norm + g * 256 + 16 * cl + 4 * j); vn[4 * j] = t[0]; vn[4 * j + 1] = t[1]; vn[4 * j + 2] = t[2]; vn[4 * j + 3] = t[3]; }
        v4u wv[4][2];
#pragma unroll
        for (int ps = 0; ps < 4; ++ps) { const v4u* src = (const v4u*)(Z + (tok0 + 16 * wave + 4 * ps + sub) * OD_Z + 4096 + 256 * g + 16 * cl); wv[ps][0] = src[0]; wv[ps][1] = src[1]; }
#pragma unroll
        for (int ps = 0; ps < 4; ++ps) {
            const int row = 16 * wave + 4 * ps + sub;
            const v4u w0 = wv[ps][0], w1 = wv[ps][1];
            float x[16];
#pragma unroll
            for (int j = 0; j < 4; ++j) { x[2 * j] = fast_gelu(bflo(w0[j])); x[2 * j + 1] = fast_gelu(bfhi(w0[j])); x[8 + 2 * j] = fast_gelu(bflo(w1[j])); x[9 + 2 * j] = fast_gelu(bfhi(w1[j])); }
            float s = 0.f;
#pragma unroll
            for (int j = 0; j < 16; ++j) s += x[j];
            s += __shfl_xor(s, 1); s += __shfl_xor(s, 2); s += __shfl_xor(s, 4); s += __shfl_xor(s, 8);
            const float mu = s * (1.f / 256.f);
            float q = 0.f;
#pragma unroll
            for (int j = 0; j < 16; ++j) { x[j] -= mu; q += x[j] * x[j]; }
            q += __shfl_xor(q, 1); q += __shfl_xor(q, 2); q += __shfl_xor(q, 4); q += __shfl_xor(q, 8);
            const float rstd = __builtin_amdgcn_rsqf(q * (1.f / 256.f) + 1e-6f);
            v4u o0, o1;
#pragma unroll
            for (int j = 0; j < 4; ++j) { o0[j] = cvtpk(x[2 * j] * rstd * vn[2 * j], x[2 * j + 1] * rstd * vn[2 * j + 1]); o1[j] = cvtpk(x[8 + 2 * j] * rstd * vn[8 + 2 * j], x[9 + 2 * j] * rstd * vn[9 + 2 * j]); }
            LAS v4u* dst = (LAS v4u*)(VF + row * SGU_VF_STRIDE + 32 * cl);
            dst[0] = o0; dst[1] = o1;
        }
    }
    {
        const int t = tid >> 2, s0 = (tid & 3) * 32;
        const f32x4* src = (const f32x4*)(w_s + ((size_t)g * 128 + t) * 128 + s0);
#pragma unroll
        for (int j = 0; j < 4; ++j) { const f32x4 a = src[2 * j], bb = src[2 * j + 1]; const int s = s0 + 8 * j;
            v4u o; o[0] = cvtpk(s + 0 <= t ? a[0] : 0.f, s + 1 <= t ? a[1] : 0.f); o[1] = cvtpk(s + 2 <= t ? a[2] : 0.f, s + 3 <= t ? a[3] : 0.f);
            o[2] = cvtpk(s + 4 <= t ? bb[0] : 0.f, s + 5 <= t ? bb[1] : 0.f); o[3] = cvtpk(s + 6 <= t ? bb[2] : 0.f, s + 7 <= t ? bb[3] : 0.f);
            *(LAS v4u*)(WS + t * SGU_W_STRIDE + 2 * s) = o; }
    }
    __syncthreads();
    u32x2 uv[8][2], gv[8][2];
    {
        const int G = lane >> 4, tl = lane & 15;
#pragma unroll
        for (int tb = 0; tb < 8; ++tb) { const bf16* zr = Z + (tok0 + 16 * tb + tl) * OD_Z + 256 * g;
#pragma unroll
            for (int eb = 0; eb < 2; ++eb) { const int e = 16 * (2 * wave + eb) + 4 * G; uv[tb][eb] = *(const u32x2*)(zr + 3072 + e); gv[tb][eb] = *(const u32x2*)(zr + 5120 + e); } }
    }
    f32x4 acc[2][8];
#pragma unroll
    for (int eb = 0; eb < 2; ++eb)
#pragma unroll
        for (int tb = 0; tb < 8; ++tb) acc[eb][tb] = (f32x4){0.f, 0.f, 0.f, 0.f};
#pragma unroll
    for (int ks = 0; ks < 4; ++ks) {
        bf16x8 af[2];
#pragma unroll
        for (int eb = 0; eb < 2; ++eb) af[eb] = frag_tr(VF + (32 * ks) * SGU_VF_STRIDE + (16 * (2 * wave + eb)) * 2, SGU_VF_STRIDE, lane);
#pragma unroll
        for (int tb = 2 * ks; tb < 8; ++tb) {
            const bf16x8 bfr = frag_perm_row(WS + (16 * tb) * SGU_W_STRIDE + (32 * ks) * 2, SGU_W_STRIDE, lane);
#pragma unroll
            for (int eb = 0; eb < 2; ++eb) acc[eb][tb] = __builtin_amdgcn_mfma_f32_16x16x32_bf16(af[eb], bfr, acc[eb][tb], 0, 0, 0);
        }
    }
    {
        const int G = lane >> 4, tl = lane & 15;
#pragma unroll
        for (int tb = 0; tb < 8; ++tb) {
            const int t = 16 * tb + tl; const float bs = b_s[g * 128 + t];
            bf16* yr = Y + (tok0 + t) * DM + 1024 + 256 * g;
#pragma unroll
            for (int eb = 0; eb < 2; ++eb) {
                const int e = 16 * (2 * wave + eb) + 4 * G;
                const u32x2 uu = uv[tb][eb], gg = gv[tb][eb];
                const f32x4 a = acc[eb][tb];
                const float y0 = fast_gelu(bflo(uu[0])) * (a[0] + bs) * fast_silu(bflo(gg[0])), y1 = fast_gelu(bfhi(uu[0])) * (a[1] + bs) * fast_silu(bfhi(gg[0]));
                const float y2 = fast_gelu(bflo(uu[1])) * (a[2] + bs) * fast_silu(bflo(gg[1])), y3 = fast_gelu(bfhi(uu[1])) * (a[3] + bs) * fast_silu(bfhi(gg[1]));
                u32x2 o; o[0] = cvtpk(y0, y1); o[1] = cvtpk(y2, y3);
                *(u32x2*)(yr + e) = o;
            }
        }
    }
    __syncthreads();
}

constexpr int AT_STRIDE = 288, AT_K_OFF = 0, AT_V_OFF = 256 * AT_STRIDE, AT_V_ROWS = 272, AT_LDS_END = AT_V_OFF + AT_V_ROWS * AT_STRIDE;
__device__ __forceinline__ void attn_item(LAS unsigned char* lds, int item, const bf16* Z, bf16* OG, float* LSE, int tid) {
    const int lane = tid & 63, wave = __builtin_amdgcn_readfirstlane(tid >> 6), G = lane >> 4, ql = lane & 15;
    const int g = item >> 8, rem = item & 255, j = rem & 3, rn = (rem >> 2) & 15, b = rem >> 6;
    const int d = 1 << (2 * g), nb = 16 >> (2 * g), n = rn % nb, r = rn / nb;
    const size_t tokb = (size_t)b * SEQ;
    LAS unsigned char* KT = lds + AT_K_OFF; LAS unsigned char* VT = lds + AT_V_OFF;
    const int q0 = 16 * wave;
    const size_t qtok = tokb + (size_t)(128 * n + q0 + ql) * d + r;
    bf16x8 qf[4];
    { const bf16* qp = Z + qtok * EV_IN + 3072 + g * 512 + j * 128 + 8 * G;
#pragma unroll
      for (int ks = 0; ks < 4; ++ks) qf[ks] = *(const bf16x8*)(qp + 32 * ks); }
    {
        const int c16 = tid & 15, rw = tid >> 4;
        const bf16* kb = Z + 4608 + g * 512 + j * 128 + 8 * c16;
        v4u kvs[8], vvs[8];
#pragma unroll
        for (int ps = 0; ps < 8; ++ps) {
            const int kk = 32 * ps + rw; const int l = 128 * (n - 1) + kk; const int lc = l < 0 ? 0 : l;
            const bf16* p = kb + (tokb + (size_t)lc * d + r) * EV_IN;
            kvs[ps] = *(const v4u*)p; vvs[ps] = *(const v4u*)(p + 1536);
            if (l < 0) { kvs[ps] = (v4u){0u, 0u, 0u, 0u}; vvs[ps] = (v4u){0u, 0u, 0u, 0u}; }
        }
#pragma unroll
        for (int ps = 0; ps < 8; ++ps) { const int kk = 32 * ps + rw; *(LAS v4u*)(KT + kk * AT_STRIDE + 16 * c16) = kvs[ps]; *(LAS v4u*)(VT + kk * AT_STRIDE + 16 * c16) = vvs[ps]; }
        if (tid < 16 * 18) *(LAS v4u*)(VT + 256 * AT_STRIDE + 16 * tid) = (v4u){0u, 0u, 0u, 0u};
    }
    __syncthreads();
    f32x4 sc[9];
#pragma unroll
    for (int t = 0; t < 9; ++t) {
        sc[t] = (f32x4){0.f, 0.f, 0.f, 0.f};
        const LAS unsigned char* kp = KT + (16 * wave + 16 * t + ql) * AT_STRIDE + 16 * G;
#pragma unroll
        for (int ks = 0; ks < 4; ++ks) sc[t] = __builtin_amdgcn_mfma_f32_16x16x32_bf16(*(const LAS bf16x8*)(kp + 64 * ks), qf[ks], sc[t], 0, 0, 0);
    }
    const float slope2 = exp2f(-8.0f * (float)(g + 3 * j + 1) / 12.0f) * (float)d * 1.4426950408889634f;
    const float scale2 = 0.08838834764831845f * 1.4426950408889634f;
    float mx = -INFINITY;
#pragma unroll
    for (int t = 0; t < 9; ++t)
#pragma unroll
        for (int rg = 0; rg < 4; ++rg) {
            const int rel = 16 * t + 4 * G + rg - ql;
            const bool ok = (rel >= 0) && (rel <= 128) && (n > 0 || (q0 + ql + rel) >= 128);
            const float s = sc[t][rg] * scale2 - slope2 * (float)(128 - rel);
            sc[t][rg] = ok ? s : -INFINITY;
            mx = fmaxf(mx, sc[t][rg]);
        }
    mx = fmaxf(mx, __shfl_xor(mx, 16)); mx = fmaxf(mx, __shfl_xor(mx, 32));
    float den = 0.f;
#pragma unroll
    for (int t = 0; t < 9; ++t)
#pragma unroll
        for (int rg = 0; rg < 4; ++rg) { const float p = __builtin_amdgcn_exp2f(sc[t][rg] - mx); sc[t][rg] = p; den += p; }
    den += __shfl_xor(den, 16); den += __shfl_xor(den, 32);
    f32x4 oc[8];
#pragma unroll
    for (int dvb = 0; dvb < 8; ++dvb) oc[dvb] = (f32x4){0.f, 0.f, 0.f, 0.f};
#pragma unroll
    for (int s = 0; s < 5; ++s) {
        const f32x4 plo = sc[2 * s], phi = (s < 4) ? sc[2 * s + 1] : (f32x4){0.f, 0.f, 0.f, 0.f};
        const unsigned w0 = cvtpk(plo[0], plo[1]), w1 = cvtpk(plo[2], plo[3]), w2 = cvtpk(phi[0], phi[1]), w3 = cvtpk(phi[2], phi[3]);
        const bf16x8 pf = __builtin_bit_cast(bf16x8, (v4u){w0, w1, w2, w3});
#pragma unroll
        for (int dvb = 0; dvb < 8; ++dvb) {
            const bf16x8 vf = frag_tr(VT + (16 * wave + 32 * s) * AT_STRIDE + (16 * dvb) * 2, AT_STRIDE, lane);
            oc[dvb] = __builtin_amdgcn_mfma_f32_16x16x32_bf16(vf, pf, oc[dvb], 0, 0, 0);
        }
    }
    const float rden = __builtin_amdgcn_rcpf(den);
    bf16* op = OG + ((size_t)g * MTOK + qtok) * 512 + j * 128 + 4 * G;
#pragma unroll
    for (int dvb = 0; dvb < 8; ++dvb) { u32x2 o; o[0] = cvtpk(oc[dvb][0] * rden, oc[dvb][1] * rden); o[1] = cvtpk(oc[dvb][2] * rden, oc[dvb][3] * rden); *(u32x2*)(op + 16 * dvb) = o; }
    if (G == 0) LSE[((size_t)g * MTOK + qtok) * 4 + j] = mx + __builtin_amdgcn_logf(den);
    __syncthreads();
}
__device__ __forceinline__ void attn_merge(const bf16* Z, const bf16* OG, const float* LSE, bf16* Y, int gtid, int gthreads) {
    for (int it = gtid; it < MTOK * 64; it += gthreads) {
        const int tok = it >> 6, c8 = it & 63, j = c8 >> 4;
        const float l0 = LSE[((size_t)0 * MTOK + tok) * 4 + j], l1 = LSE[((size_t)1 * MTOK + tok) * 4 + j], l2 = LSE[((size_t)2 * MTOK + tok) * 4 + j];
        const float m = fmaxf(l0, fmaxf(l1, l2));
        float w0 = __builtin_amdgcn_exp2f(l0 - m), w1 = __builtin_amdgcn_exp2f(l1 - m), w2 = __builtin_amdgcn_exp2f(l2 - m);
        const float rs = __builtin_amdgcn_rcpf(w0 + w1 + w2); w0 *= rs; w1 *= rs; w2 *= rs;
        const v4u a = *(const v4u*)(OG + ((size_t)0 * MTOK + tok) * 512 + 8 * c8), bb = *(const v4u*)(OG + ((size_t)1 * MTOK + tok) * 512 + 8 * c8), cc = *(const v4u*)(OG + ((size_t)2 * MTOK + tok) * 512 + 8 * c8);
        const v4u gt = *(const v4u*)(Z + (size_t)tok * EV_IN + 7680 + 8 * c8);
        v4u o;
#pragma unroll
        for (int k = 0; k < 4; ++k) {
            const float ylo = (w0 * bflo(a[k]) + w1 * bflo(bb[k]) + w2 * bflo(cc[k])) * fast_silu(bflo(gt[k]));
            const float yhi = (w0 * bfhi(a[k]) + w1 * bfhi(bb[k]) + w2 * bfhi(cc[k])) * fast_silu(bfhi(gt[k]));
            o[k] = cvtpk(ylo, yhi);
        }
        *(v4u*)(Y + (size_t)tok * DM + 1536 + 8 * c8) = o;
    }
}

constexpr int LR_XC_STRIDE = 272, LR_XC_OFF = 0, LR_F_STRIDE = 528  , LR_XCF_OFF = 128 * LR_XC_STRIDE, LR_A_OFF = LR_XCF_OFF + 32 * LR_F_STRIDE, LR_U_OFF = LR_A_OFF + 32 * LR_F_STRIDE, LR_LDS_END = LR_U_OFF + 32 * LR_F_STRIDE;
struct LruParams { const float *conv_w, *conv_b, *b_a, *b_i, *lam; const bf16* wg; };
__device__ __forceinline__ void lru_load_tile(v4u (&xa)[7], v4u& ga, const bf16* Z, size_t tokb, int t0, int h, int c4, int tid) {
    const int co = tid & 15, rg = tid >> 4;
#pragma unroll
    for (int k = 0; k < 7; ++k) { const int t = t0 + 4 * rg + k - 3; const int tc = t < 0 ? 0 : t;
        const v4u v = *(const v4u*)(Z + (tokb + tc) * EV_IN + h * 128 + 8 * co);
        xa[k] = (v4u){t >= 0 ? v[0] : 0u, t >= 0 ? v[1] : 0u, t >= 0 ? v[2] : 0u, t >= 0 ? v[3] : 0u}; }
    ga = *(const v4u*)(Z + (tokb + t0 + (tid >> 2)) * EV_IN + 1536 + h * 128 + 32 * c4 + 8 * (tid & 3));
}
__device__ __forceinline__ void lru_item(LAS unsigned char* lds, int item, const bf16* Z, const LruParams& P, bf16* Y, int tid) {
    const int lane = tid & 63, wave = __builtin_amdgcn_readfirstlane(tid >> 6), G = lane >> 4, ql = lane & 15;
    const int c4 = item & 3, h = (item >> 2) % 12, b = item / 48;
    const size_t tokb = (size_t)b * SEQ;
    LAS unsigned char* XC = lds + LR_XC_OFF; LAS unsigned char* XCF = lds + LR_XCF_OFF; LAS unsigned char* AL = lds + LR_A_OFF; LAS unsigned char* UL = lds + LR_U_OFF;
    bf16x8 wf[2][2][4];
#pragma unroll
    for (int gate = 0; gate < 2; ++gate)
#pragma unroll
        for (int cb = 0; cb < 2; ++cb)
#pragma unroll
            for (int ks = 0; ks < 4; ++ks) wf[gate][cb][ks] = *(const bf16x8*)(P.wg + ((size_t)(h * 2 + gate) * 128 + 32 * c4 + 16 * cb + ql) * 128 + 32 * ks + 8 * G);
    float ba[2], bi[2], sp8[2];
#pragma unroll
    for (int cb = 0; cb < 2; ++cb) { const int ch = h * 128 + 32 * c4 + 16 * cb + ql; ba[cb] = P.b_a[ch]; bi[cb] = P.b_i[ch];
        const float nl = -P.lam[ch]; sp8[cb] = 8.0f * (nl > 20.f ? nl : log1pf(__expf(nl))); }
    float hc = 0.f;
    v4u xa[7], ga;
    lru_load_tile(xa, ga, Z, tokb, 0, h, c4, tid);
    for (int sc = 0; sc < 16; ++sc) {
        const int t0 = 128 * sc;
        {
            const int co = tid & 15, rg = tid >> 4;
            v4u orow[4];
            const bool mine = (co >> 2) == c4;
#pragma unroll
            for (int e = 0; e < 4; ++e) {
                typedef float f32x2 __attribute__((ext_vector_type(2)));
                const int chn = h * 128 + 8 * co + 2 * e;
                const f32x2 w0 = *(const f32x2*)(P.conv_w + 0 * LRU_W + chn), w1 = *(const f32x2*)(P.conv_w + 1 * LRU_W + chn), w2 = *(const f32x2*)(P.conv_w + 2 * LRU_W + chn), w3 = *(const f32x2*)(P.conv_w + 3 * LRU_W + chn);
                const f32x2 cb2 = *(const f32x2*)(P.conv_b + chn);
                float lo[7], hi[7];
#pragma unroll
                for (int k = 0; k < 7; ++k) { lo[k] = bflo(xa[k][e]); hi[k] = bfhi(xa[k][e]); }
                f32x4 xlo, xhi;
#pragma unroll
                for (int r = 0; r < 4; ++r) { xlo[r] = cb2[0] + w0[0] * lo[r] + w1[0] * lo[r + 1] + w2[0] * lo[r + 2] + w3[0] * lo[r + 3];
                                              xhi[r] = cb2[1] + w0[1] * hi[r] + w1[1] * hi[r + 1] + w2[1] * hi[r + 2] + w3[1] * hi[r + 3]; orow[r][e] = cvtpk(xlo[r], xhi[r]); }
                if (mine) { *(LAS f32x4*)(XCF + (8 * (co & 3) + 2 * e) * LR_F_STRIDE + 16 * rg) = xlo; *(LAS f32x4*)(XCF + (8 * (co & 3) + 2 * e + 1) * LR_F_STRIDE + 16 * rg) = xhi; }
            }
#pragma unroll
            for (int r = 0; r < 4; ++r) *(LAS v4u*)(XC + (4 * rg + r) * LR_XC_STRIDE + 16 * co) = orow[r];
        }
        const v4u ga_cur = ga;
        if (sc < 15) lru_load_tile(xa, ga, Z, tokb, t0 + 128, h, c4, tid);
        __syncthreads();
        f32x4 acc[2][2];

#pragma unroll
        for (int gate = 0; gate < 2; ++gate)
#pragma unroll
            for (int cb = 0; cb < 2; ++cb) acc[gate][cb] = (f32x4){0.f, 0.f, 0.f, 0.f};
#pragma unroll
        for (int ks = 0; ks < 4; ++ks) {
            const bf16x8 af = *(const LAS bf16x8*)(XC + (16 * wave + ql) * LR_XC_STRIDE + 64 * ks + 16 * G);
#pragma unroll
            for (int gate = 0; gate < 2; ++gate)
#pragma unroll
                for (int cb = 0; cb < 2; ++cb) acc[gate][cb] = __builtin_amdgcn_mfma_f32_16x16x32_bf16(af, wf[gate][cb][ks], acc[gate][cb], 0, 0, 0);
        }
#pragma unroll
        for (int cb = 0; cb < 2; ++cb) {
            const int off = (16 * cb + ql) * LR_F_STRIDE + (16 * wave + 4 * G) * 4;
            const f32x4 xcv = *(const LAS f32x4*)(XCF + off);
            f32x4 av, uv;
#pragma unroll
            for (int rg2 = 0; rg2 < 4; ++rg2) {
                const float r = fast_sigmoid(acc[0][cb][rg2] + ba[cb]), ig = fast_sigmoid(acc[1][cb][rg2] + bi[cb]);
                const float la = -r * sp8[cb];
                const float a = __builtin_amdgcn_exp2f(la * 1.4426950408889634f);
                const float x2 = 2.f * la;
                const float om = (x2 > -0.05f) ? -x2 * (1.f + x2 * (0.5f + x2 * (0.16666667f + x2 * 0.041666667f))) : 1.f - a * a;
                av[rg2] = a; uv[rg2] = __builtin_amdgcn_sqrtf(om) * ig * xcv[rg2];
            }
            *(LAS f32x4*)(AL + off) = av; *(LAS f32x4*)(UL + off) = uv;
        }
        __syncthreads();
        {
            const int seg = ql, off = (4 * wave + G) * LR_F_STRIDE + 32 * seg;
            const f32x4 a0 = *(const LAS f32x4*)(AL + off), a1 = *(const LAS f32x4*)(AL + off + 16), u0 = *(const LAS f32x4*)(UL + off), u1 = *(const LAS f32x4*)(UL + off + 16);
            float Pp = 1.f, Hh = 0.f;
#pragma unroll
            for (int k = 0; k < 4; ++k) { Hh = a0[k] * Hh + u0[k]; Pp *= a0[k]; }
#pragma unroll
            for (int k = 0; k < 4; ++k) { Hh = a1[k] * Hh + u1[k]; Pp *= a1[k]; }
#pragma unroll
            for (int o = 1; o < 16; o <<= 1) { const float Pl = __shfl_up(Pp, o, 16), Hl = __shfl_up(Hh, o, 16); if (seg >= o) { Hh = Pp * Hl + Hh; Pp = Pp * Pl; } }
            float Pe = __shfl_up(Pp, 1, 16), He = __shfl_up(Hh, 1, 16);
            if (seg == 0) { Pe = 1.f; He = 0.f; }
            float hh = Pe * hc + He;
            f32x4 h0, h1;
#pragma unroll
            for (int k = 0; k < 4; ++k) { hh = a0[k] * hh + u0[k]; h0[k] = hh; }
#pragma unroll
            for (int k = 0; k < 4; ++k) { hh = a1[k] * hh + u1[k]; h1[k] = hh; }
            *(LAS f32x4*)(UL + off) = h0; *(LAS f32x4*)(UL + off + 16) = h1;
            hc = __shfl(hh, (lane & 48) + 15);
        }
        __syncthreads();
        {
            const int tk = tid >> 2, oc = tid & 3;
            float hv[8];
#pragma unroll
            for (int e = 0; e < 8; ++e) hv[e] = *(const LAS float*)(UL + (8 * oc + e) * LR_F_STRIDE + 4 * tk);
            v4u o;
#pragma unroll
            for (int e = 0; e < 4; ++e) o[e] = cvtpk(hv[2 * e] * fast_silu(bflo(ga_cur[e])), hv[2 * e + 1] * fast_silu(bfhi(ga_cur[e])));
            *(v4u*)(Y + (tokb + t0 + tk) * DM + h * 128 + 32 * c4 + 8 * oc) = o;
        }
    }
    __syncthreads();
}

constexpr int G1_ALR_OFF = 0, G1_TOT_OFF = 4096, G1_LDS_END = 6144;
__device__ __forceinline__ void gla1a_item(LAS unsigned char* lds, int item, const bf16* Z, const float* ALR, const float* w_alpha, const float* b_alpha, bf16* QT, bf16* KT, bf16* KD, float* DEC, int tid) {
    const int c = item & 31, h = (item >> 5) & 3, b = item >> 7;
    const size_t tok0 = (size_t)b * SEQ + 64 * c;
    LAS float* ALRs = (LAS float*)(lds + G1_ALR_OFF); LAS float* TOT = (LAS float*)(lds + G1_TOT_OFF);
    if (tid < 256) *(LAS f32x4*)(ALRs + 4 * tid) = *(const f32x4*)(ALR + tok0 * 16 + 4 * tid);
    const int e = tid & 127, tq = tid >> 7;
    float wa[16];
#pragma unroll
    for (int r = 0; r < 16; ++r) wa[r] = w_alpha[r * 512 + h * 128 + e];
    const float bal = b_alpha[h * 128 + e];
    float qv[16], kv[16];
#pragma unroll
    for (int t = 0; t < 16; ++t) { const bf16* zr = Z + (tok0 + 16 * tq + t) * OD_Z + h * 128 + e; qv[t] = bf2f(zr[0]); kv[t] = bf2f(zr[512]); }
    __syncthreads();
    float bc[16]; float run = 0.f;
#pragma unroll
    for (int t = 0; t < 16; ++t) {
        float s = bal;
#pragma unroll
        for (int r = 0; r < 16; ++r) s += ALRs[(16 * tq + t) * 16 + r] * wa[r];
        const float sp = (s < -20.f) ? -s : __builtin_amdgcn_logf(1.f + __builtin_amdgcn_exp2f(-s * 1.4426950408889634f)) * 0.6931471805599453f;
        run -= sp * 0.0625f; bc[t] = run;
    }
    TOT[tq * 128 + e] = run;
    __syncthreads();
    const float t0s = TOT[e], t1s = TOT[128 + e], t2s = TOT[256 + e], t3s = TOT[384 + e];
    const float offs = (tq > 0 ? t0s : 0.f) + (tq > 1 ? t1s : 0.f) + (tq > 2 ? t2s : 0.f), blast = (t0s + t1s) + (t2s + t3s);
    if (tq == 0) DEC[(size_t)item * 128 + e] = __builtin_amdgcn_exp2f(blast * 1.4426950408889634f);
#pragma unroll
    for (int t = 0; t < 16; ++t) {
        const float bb = bc[t] + offs;
        const float eb = __builtin_amdgcn_exp2f(bb * 1.4426950408889634f), enb = __builtin_amdgcn_exp2f(-bb * 1.4426950408889634f), edl = __builtin_amdgcn_exp2f((blast - bb) * 1.4426950408889634f);
        const size_t o = (tok0 + 16 * tq + t) * 512 + h * 128 + e;
        QT[o] = (bf16)f2bf(qv[t] * 0.08838834764831845f * eb); KT[o] = (bf16)f2bf(kv[t] * enb); KD[o] = (bf16)f2bf(kv[t] * edl);
    }
    __syncthreads();
}

constexpr int G2_KD_STRIDE = 288, G2_V_STRIDE = 160, G2_KD_OFF = 0, G2_V_OFF = 64 * G2_KD_STRIDE, G2_BUF = G2_V_OFF + 64 * G2_V_STRIDE, G2_DEC_OFF = 2 * G2_BUF, G2_SIMG_OFF = G2_DEC_OFF + 32 * 128 * 4,
              G2_SIMG_STRIDE = 272, G2_SIMG = 64 * G2_SIMG_STRIDE, G2_LDS_END = G2_SIMG_OFF + 2 * G2_SIMG;
struct Gla2Stage { v4u kd[2], v; };
__device__ __forceinline__ void gla2_load(Gla2Stage& st, const bf16* Z, const bf16* KD, size_t tok0, int h, int slice, int tid) {
    const int rw = tid >> 4, c16 = tid & 15;
#pragma unroll
    for (int ps = 0; ps < 2; ++ps) st.kd[ps] = *(const v4u*)(KD + (tok0 + 32 * ps + rw) * 512 + h * 128 + 8 * c16);
    st.v = *(const v4u*)(Z + (tok0 + (tid >> 3)) * OD_Z + 1024 + h * 256 + 64 * slice + 8 * (tid & 7));
}
__device__ __forceinline__ void gla2_store(const Gla2Stage& st, LAS unsigned char* buf, int tid) {
    const int rw = tid >> 4, c16 = tid & 15;
#pragma unroll
    for (int ps = 0; ps < 2; ++ps) *(LAS v4u*)(buf + G2_KD_OFF + (32 * ps + rw) * G2_KD_STRIDE + 16 * c16) = st.kd[ps];
    *(LAS v4u*)(buf + G2_V_OFF + (tid >> 3) * G2_V_STRIDE + 16 * (tid & 7)) = st.v;
}
__device__ __forceinline__ void gla2_flush(const LAS unsigned char* img, bf16* SST, int bh, int c, int slice, int tid) {
    const int rw = tid >> 4, c16 = tid & 15;
#pragma unroll
    for (int ps = 0; ps < 2; ++ps) *(v4u*)(SST + ((size_t)(bh * 32 + c) * 256 + 64 * slice + 32 * ps + rw) * 128 + 8 * c16) = *(const LAS v4u*)(img + (32 * ps + rw) * G2_SIMG_STRIDE + 16 * c16);
}
__device__ __forceinline__ void gla2s_item(LAS unsigned char* lds, int item, const bf16* Z, const bf16* KD, const float* DEC, bf16* SST, int tid) {
    const int lane = tid & 63, wave = __builtin_amdgcn_readfirstlane(tid >> 6), G = lane >> 4, ql = lane & 15;
    const int slice = item & 3, bh = item >> 2, h = bh & 3, b = bh >> 2;
    const size_t tokb = (size_t)b * SEQ;
    f32x4 sacc[4];
#pragma unroll
    for (int db = 0; db < 4; ++db) sacc[db] = (f32x4){0.f, 0.f, 0.f, 0.f};
    { Gla2Stage st; gla2_load(st, Z, KD, tokb, h, slice, tid); gla2_store(st, lds, tid);
#pragma unroll
      for (int k = 0; k < 2; ++k) *(LAS f32x4*)(lds + G2_DEC_OFF + 16 * (tid + 512 * k)) = *(const f32x4*)(DEC + (size_t)(bh * 32) * 128 + 4 * (tid + 512 * k)); }
    __syncthreads();
    for (int c = 0; c < 32; ++c) {
        LAS unsigned char* buf = lds + (c & 1) * G2_BUF;
        LAS unsigned char* img = lds + G2_SIMG_OFF + (c & 1) * G2_SIMG;
        Gla2Stage st;
        if (c < 31) gla2_load(st, Z, KD, tokb + 64 * (c + 1), h, slice, tid);
        if (c > 0) gla2_flush(lds + G2_SIMG_OFF + ((c - 1) & 1) * G2_SIMG, SST, bh, c - 1, slice, tid);
#pragma unroll
        for (int db = 0; db < 4; ++db) { u32x2 o; o[0] = cvtpk(sacc[db][0], sacc[db][1]); o[1] = cvtpk(sacc[db][2], sacc[db][3]); *(LAS u32x2*)(img + (16 * db + ql) * G2_SIMG_STRIDE + (16 * wave + 4 * G) * 2) = o; }
        const f32x4 dec = *(const LAS f32x4*)(lds + G2_DEC_OFF + (128 * c + 16 * wave + 4 * G) * 4);
#pragma unroll
        for (int db = 0; db < 4; ++db) sacc[db] *= dec;
#pragma unroll
        for (int s = 0; s < 2; ++s) {
            const bf16x8 kf = frag_tr(buf + G2_KD_OFF + (32 * s) * G2_KD_STRIDE + (16 * wave) * 2, G2_KD_STRIDE, lane);
#pragma unroll
            for (int db = 0; db < 4; ++db) {
                const bf16x8 vf = frag_tr(buf + G2_V_OFF + (32 * s) * G2_V_STRIDE + (16 * db) * 2, G2_V_STRIDE, lane);
                sacc[db] = __builtin_amdgcn_mfma_f32_16x16x32_bf16(kf, vf, sacc[db], 0, 0, 0);
            }
        }
        if (c < 31) gla2_store(st, lds + ((c + 1) & 1) * G2_BUF, tid);
        __syncthreads();
    }
    gla2_flush(lds + G2_SIMG_OFF + (31 & 1) * G2_SIMG, SST, bh, 31, slice, tid);
    __syncthreads();
}

constexpr int G3_QK_STRIDE = 272, G3_V_STRIDE = 544, G3_QT_OFF = 0, G3_KT_OFF = G3_QT_OFF + 64 * G3_QK_STRIDE, G3_V_OFF = G3_KT_OFF + 64 * G3_QK_STRIDE, G3_ST_OFF = G3_V_OFF + 64 * G3_V_STRIDE,
              G3_PART_OFF = G3_ST_OFF + 256 * G3_QK_STRIDE, G3_LDS_END = G3_PART_OFF + 8 * 16 * 4;
__device__ __forceinline__ void gla3_item(LAS unsigned char* lds, int item, const bf16* Z, const bf16* QT, const bf16* KT, const bf16* SST, const float* head_norm, bf16* Y, int tid) {
    const int lane = tid & 63, wave = __builtin_amdgcn_readfirstlane(tid >> 6), G = lane >> 4, ql = lane & 15;
    const int c = item & 31, h = (item >> 5) & 3, b = item >> 7;
    const size_t tok0 = (size_t)b * SEQ + 64 * c;
    LAS unsigned char* QTl = lds + G3_QT_OFF; LAS unsigned char* KTl = lds + G3_KT_OFF; LAS unsigned char* Vl = lds + G3_V_OFF; LAS unsigned char* STl = lds + G3_ST_OFF;
    LAS float* PART = (LAS float*)(lds + G3_PART_OFF);
    { const int rw = tid >> 4, c16 = tid & 15;
#pragma unroll
      for (int ps = 0; ps < 2; ++ps) { const size_t o = (tok0 + 32 * ps + rw) * 512 + h * 128 + 8 * c16;
          *(LAS v4u*)(QTl + (32 * ps + rw) * G3_QK_STRIDE + 16 * c16) = *(const v4u*)(QT + o); *(LAS v4u*)(KTl + (32 * ps + rw) * G3_QK_STRIDE + 16 * c16) = *(const v4u*)(KT + o); }
      const int rv = tid >> 5, c32 = tid & 31;
#pragma unroll
      for (int ps = 0; ps < 4; ++ps) *(LAS v4u*)(Vl + (16 * ps + rv) * G3_V_STRIDE + 16 * c32) = *(const v4u*)(Z + (tok0 + 16 * ps + rv) * OD_Z + 1024 + h * 256 + 8 * c32);
      const bf16* sp = SST + (size_t)item * 256 * 128;
#pragma unroll
      for (int ps = 0; ps < 8; ++ps) *(LAS v4u*)(STl + (32 * ps + rw) * G3_QK_STRIDE + 16 * c16) = *(const v4u*)(sp + (size_t)(32 * ps + rw) * 128 + 8 * c16); }
    const int ib = wave >> 1, dh = wave & 1;
    u32x2 gcv[8];
    { const bf16* gp = Z + (tok0 + 16 * ib + ql) * OD_Z + 2048 + h * 256 + 128 * dh + 4 * G;
#pragma unroll
      for (int dvb = 0; dvb < 8; ++dvb) gcv[dvb] = *(const u32x2*)(gp + 16 * dvb); }
    __syncthreads();
    bf16x8 qf[4];
#pragma unroll
    for (int ks = 0; ks < 4; ++ks) qf[ks] = *(const LAS bf16x8*)(QTl + (16 * ib + ql) * G3_QK_STRIDE + 64 * ks + 16 * G);
    f32x4 at[4];
#pragma unroll
    for (int jb = 0; jb < 4; ++jb) {
        at[jb] = (f32x4){0.f, 0.f, 0.f, 0.f};
        if (jb <= ib) {
#pragma unroll
            for (int ks = 0; ks < 4; ++ks) at[jb] = __builtin_amdgcn_mfma_f32_16x16x32_bf16(*(const LAS bf16x8*)(KTl + (16 * jb + ql) * G3_QK_STRIDE + 64 * ks + 16 * G), qf[ks], at[jb], 0, 0, 0);
#pragma unroll
            for (int rg = 0; rg < 4; ++rg) if (16 * jb + 4 * G + rg > 16 * ib + ql) at[jb][rg] = 0.f;
        }
    }
    f32x4 oc[8];
#pragma unroll
    for (int dvb = 0; dvb < 8; ++dvb) oc[dvb] = (f32x4){0.f, 0.f, 0.f, 0.f};
#pragma unroll
    for (int ks = 0; ks < 4; ++ks)
#pragma unroll
        for (int dvb = 0; dvb < 8; ++dvb)
            oc[dvb] = __builtin_amdgcn_mfma_f32_16x16x32_bf16(*(const LAS bf16x8*)(STl + (128 * dh + 16 * dvb + ql) * G3_QK_STRIDE + 64 * ks + 16 * G), qf[ks], oc[dvb], 0, 0, 0);
#pragma unroll
    for (int s = 0; s < 2; ++s) {
        if (2 * s <= ib) {
            const bf16x8 pf = __builtin_bit_cast(bf16x8, (v4u){cvtpk(at[2 * s][0], at[2 * s][1]), cvtpk(at[2 * s][2], at[2 * s][3]), cvtpk(at[2 * s + 1][0], at[2 * s + 1][1]), cvtpk(at[2 * s + 1][2], at[2 * s + 1][3])});
#pragma unroll
            for (int dvb = 0; dvb < 8; ++dvb) {
                const bf16x8 vf = frag_tr(Vl + (32 * s) * G3_V_STRIDE + (128 * dh + 16 * dvb) * 2, G3_V_STRIDE, lane);
                oc[dvb] = __builtin_amdgcn_mfma_f32_16x16x32_bf16(vf, pf, oc[dvb], 0, 0, 0);
            }
        }
    }
    float ss = 0.f;
#pragma unroll
    for (int dvb = 0; dvb < 8; ++dvb) ss += (oc[dvb][0] * oc[dvb][0] + oc[dvb][1] * oc[dvb][1]) + (oc[dvb][2] * oc[dvb][2] + oc[dvb][3] * oc[dvb][3]);
    ss += __shfl_xor(ss, 16); ss += __shfl_xor(ss, 32);
    if (G == 0) PART[wave * 16 + ql] = ss;
    __syncthreads();
    const float rs = __builtin_amdgcn_rsqf((PART[(wave & ~1) * 16 + ql] + PART[(wave | 1) * 16 + ql]) * (1.f / 256.f) + 1e-6f);
    bf16* yp = Y + (tok0 + 16 * ib + ql) * DM + h * 256 + 128 * dh + 4 * G;
    const float* hp = head_norm + h * 256 + 128 * dh + 4 * G;
#pragma unroll
    for (int dvb = 0; dvb < 8; ++dvb) {
        const f32x4 hn = *(const f32x4*)(hp + 16 * dvb); const f32x4 o = oc[dvb]; const u32x2 gc = gcv[dvb];
        u32x2 y; y[0] = cvtpk(o[0] * rs * hn[0] * fast_silu(bflo(gc[0])), o[1] * rs * hn[1] * fast_silu(bfhi(gc[0])));
        y[1] = cvtpk(o[2] * rs * hn[2] * fast_silu(bflo(gc[1])), o[3] * rs * hn[3] * fast_silu(bfhi(gc[1])));
        *(u32x2*)(yp + 16 * dvb) = y;
    }
    __syncthreads();
}
#define OPT_ATTN 1
#define OPT_LRU 1
#define OPT_GLA 1
constexpr int NWAVES = 8;
constexpr size_t MiB = 1u << 20;
constexpr size_t WS_CTL = 0, CTL_ZERO_BYTES = 1 * MiB;
constexpr size_t WS_WEVIN = 2 * MiB;
constexpr size_t WS_WEVOUT = 66 * MiB;
constexpr size_t WS_WODIN = 82 * MiB;
constexpr size_t WS_WODOUT = 130 * MiB;
constexpr size_t WS_WALR = 146 * MiB;
constexpr size_t WS_WGATE = 147 * MiB;
constexpr size_t WS_X = 150 * MiB;
constexpr size_t WS_XG = 214 * MiB;
constexpr size_t WS_Z = 246 * MiB;
constexpr size_t WS_Y = 374 * MiB;
constexpr size_t WS_ALR = 406 * MiB;
constexpr size_t WS_SUMP = 406 * MiB + 512 * 1024;
constexpr size_t WS_T0 = 408 * MiB;
constexpr size_t WS_T1 = 456 * MiB;
constexpr size_t WS_END = 504 * MiB;
constexpr int CW_BAR = 4096;
constexpr int MAX_LAUNCH = 8;
static_assert((CW_BAR + MAX_LAUNCH * XCD_BAR_WORDS) * 4 <= (int)CTL_ZERO_BYTES, "ctl map");
constexpr int RING_OFF = 0, RING_BYTES = 131072;
constexpr int LDSCTL_OFF = 152064, MISC_OFF = LDSCTL_OFF + 320;
constexpr int LDS_BYTES = 156160;
static_assert(G1_LDS_END <= LDSCTL_OFF && G2_LDS_END <= LDSCTL_OFF && G3_LDS_END <= LDSCTL_OFF && AT_LDS_END <= LDSCTL_OFF && LR_LDS_END <= LDSCTL_OFF && SGU_W_OFF + 128 * SGU_W_STRIDE <= LDSCTL_OFF, "LDS map");

constexpr int PH_PROLOGUE = 0, PH_FINAL = 21, N_PHASES = 22;

struct Args {
    const float* in[21]; float* out; unsigned char* ws;
    const float* gn[4];
    const float* xold[4];
    int ph_lo, ph_hi, li, pad;
};
#define CAS __attribute__((address_space(4)))
template <class T> __device__ __forceinline__ T* karg(const CAS char* ka, int byte_off) { T* p = *(T* const CAS*)(ka + byte_off); return (T*)(__attribute__((address_space(1))) T*)p; }
#define KIN(k) karg<const float>(ka_, 8 * (k))

__device__ __forceinline__ float wave_sum(float v) {
#pragma unroll
    for (int o = 1; o < 64; o <<= 1) v += __shfl_xor(v, o);
    return v;
}
__device__ __forceinline__ void p0_transpose_item(const float* W, int K, int ldw, int nblk, bf16* WT, int skip_at, int skip, const float* gk, LAS float* scr, int item, int lane) {
    const int kb = item / nblk, nb = item % nblk, k0 = 64 * kb, n0 = 64 * nb, s0 = n0 + (n0 >= skip_at ? skip : 0);
    const int c = lane & 7;
    f32x4 g0 = {1.f, 1.f, 1.f, 1.f}, g1 = {1.f, 1.f, 1.f, 1.f};
    if (gk) { g0 = *(const f32x4*)(gk + k0 + 8 * c); g1 = *(const f32x4*)(gk + k0 + 8 * c + 4); }
    { f32x4 wv[16];
#pragma unroll
      for (int i = 0; i < 16; ++i) wv[i] = *(const f32x4*)(W + (size_t)(k0 + 4 * i + (lane >> 4)) * ldw + s0 + 4 * (lane & 15));
#pragma unroll
      for (int i = 0; i < 16; ++i) *(LAS f32x4*)(scr + (4 * i + (lane >> 4)) * 68 + 4 * (lane & 15)) = wv[i]; }
    LDS_WAIT(); asm volatile("" ::: "memory");
#pragma unroll
    for (int j = 0; j < 8; ++j) { const int n = (lane >> 3) + 8 * j; const LAS float* s = scr + (8 * c) * 68 + n;
        v4u o; o.x = pk2(s[0 * 68] * g0[0], s[1 * 68] * g0[1]); o.y = pk2(s[2 * 68] * g0[2], s[3 * 68] * g0[3]); o.z = pk2(s[4 * 68] * g1[0], s[5 * 68] * g1[1]); o.w = pk2(s[6 * 68] * g1[2], s[7 * 68] * g1[3]);
        *(GAS v4u*)(WT + (size_t)(n0 + n) * K + k0 + 8 * c) = o; }
    LDS_WAIT(); asm volatile("" ::: "memory");
}

__global__ void __launch_bounds__(NWAVES * 64, 2) mk_fwd(Args args) {
    extern __shared__ __attribute__((aligned(16))) unsigned char lds_raw[];
    LAS unsigned char* lds = (LAS unsigned char*)lds_raw;
    volatile LAS unsigned* MISC = (volatile LAS unsigned*)(lds + MISC_OFF);
    const int G0 = gridDim.x;
    unsigned char* ws = args.ws;
    unsigned* ctl = (unsigned*)(ws + WS_CTL);
    float* SUMP = (float*)(ws + WS_SUMP);
    for (int u = threadIdx.x; u < (LDS_BYTES - LDSCTL_OFF) / 4; u += NWAVES * 64) ((LAS unsigned*)(lds + LDSCTL_OFF))[u] = 0u;
    __syncthreads();
    XcdBarrier bar = xcd_barrier_post(ctl + CW_BAR + args.li * XCD_BAR_WORDS, MISC + 8);

    float* X = (float*)(ws + WS_X); bf16* XG = (bf16*)(ws + WS_XG); bf16* Z = (bf16*)(ws + WS_Z); bf16* Y = (bf16*)(ws + WS_Y);
    float* ALR = (float*)(ws + WS_ALR);

#ifndef REP_COND
#define REP_COND(ph) false
#endif
    int rep_done = 0, first = 1;
    for (int ph = args.ph_lo; ph < args.ph_hi; ) {
        if (ph != PH_PROLOGUE && ph != PH_FINAL && ((ph - 1) % 5) == 3 && ((((ph - 1) / 5) & 1) == 0)) { ++ph; continue; }
        if (!first) xcd_barrier(bar);
        first = 0;
        int tid = threadIdx.x; asm volatile("" : "+v"(tid));
        int G = G0; asm volatile("" : "+s"(G));
        const int lane = tid & 63, wave = __builtin_amdgcn_readfirstlane(tid >> 6);
        const CAS char* ka_ = (const CAS char*)__builtin_amdgcn_kernarg_segment_ptr(); asm volatile("" : "+s"(ka_));
        const float* x_in = KIN(0);
        if (ph == PH_PROLOGUE) {
            LAS float* scr = (LAS float*)(lds + RING_OFF + wave * 17408);
            const int gw = blockIdx.x * NWAVES + wave, NGW = G * NWAVES;
            constexpr int I_EVIN = 32 * 128, I_EVOUT = 32 * 32, I_ODIN = 32 * 96, I_ODOUT = 32 * 32, I_GATE = 2 * 2;
            constexpr int NITEMS = 2 * (I_EVIN + I_EVOUT + I_ODIN + I_ODOUT) + 2 * 12 * 2 * I_GATE;
            for (int it = gw; it < NITEMS; it += NGW) {
                int r = it;
                if (r < 2 * I_EVIN) { const int i = r / I_EVIN; p0_transpose_item(KIN(2) + (size_t)i * DM * EV_IN, DM, EV_IN, 128, (bf16*)(ws + WS_WEVIN) + (size_t)i * EV_IN * DM, 1 << 30, 0, KIN(1) + (size_t)i * DM, scr, r % I_EVIN, lane); continue; } r -= 2 * I_EVIN;
                if (r < 2 * I_EVOUT) { const int i = r / I_EVOUT; p0_transpose_item(KIN(10) + (size_t)i * DM * DM, DM, DM, 32, (bf16*)(ws + WS_WEVOUT) + (size_t)i * DM * DM, 1 << 30, 0, nullptr, scr, r % I_EVOUT, lane); continue; } r -= 2 * I_EVOUT;
                if (r < 2 * I_ODIN) { const int i = r / I_ODIN; p0_transpose_item(KIN(12) + (size_t)i * DM * OD_IN, DM, OD_IN, 96, (bf16*)(ws + WS_WODIN) + (size_t)i * OD_Z * DM, 2048, 16, KIN(11) + (size_t)i * DM, scr, r % I_ODIN, lane); continue; } r -= 2 * I_ODIN;
                if (r < 2 * I_ODOUT) { const int i = r / I_ODOUT; p0_transpose_item(KIN(19) + (size_t)i * DM * DM, DM, DM, 32, (bf16*)(ws + WS_WODOUT) + (size_t)i * DM * DM, 1 << 30, 0, nullptr, scr, r % I_ODOUT, lane); continue; } r -= 2 * I_ODOUT;
                { const int mat = r / I_GATE, li2 = mat / 24, h = (mat % 24) >> 1, gate = mat & 1;
                  const float* src = KIN(gate ? 7 : 5) + ((size_t)li2 * 12 + h) * 128 * 128;
                  p0_transpose_item(src, 128, 128, 2, (bf16*)(ws + WS_WGATE) + (size_t)mat * 128 * 128, 1 << 30, 0, nullptr, scr, r % I_GATE, lane); }
            }
            for (int e = blockIdx.x * 512 + tid; e < 2 * 16 * 2048; e += G * 512) { const int i = e >> 15, j = (e >> 11) & 15, k = e & 2047;
                ((bf16*)(ws + WS_WALR))[e] = (bf16)f2bf(KIN(12)[(size_t)i * DM * OD_IN + (size_t)k * OD_IN + 2048 + j] * KIN(11)[(size_t)i * DM + k]); }
            for (int m = gw; m < MTOK; m += NGW) {
                const f32x4* xr = (const f32x4*)(x_in + (size_t)m * DM) + lane; float s = 0.f;
                unsigned long long* o8 = (unsigned long long*)(XG + (size_t)m * DM) + lane;
#pragma unroll
                for (int j = 0; j < 8; ++j) { const f32x4 v = xr[64 * j]; const unsigned p0 = pk2(v[0], v[1]), p1 = pk2(v[2], v[3]);
                    const float r0 = __uint_as_float(p0 << 16), r1 = __uint_as_float(p0 & 0xffff0000u), r2 = __uint_as_float(p1 << 16), r3 = __uint_as_float(p1 & 0xffff0000u);
                    s += (r0 * r0 + r1 * r1) + (r2 * r2 + r3 * r3);
                    o8[64 * j] = (unsigned long long)p0 | ((unsigned long long)p1 << 32); }
                s = wave_sum(s);
                if (lane < 8) SUMP[(size_t)m * 8 + lane] = (lane == 0) ? s : 0.f;
            }
        } else if (ph == PH_FINAL) {
            const int gw = blockIdx.x * NWAVES + wave, NGW = G * NWAVES;
            const float* gf = KIN(20);
            for (int m = gw; m < MTOK; m += NGW) {
                const f32x4 p0 = *(const f32x4*)(SUMP + ((size_t)4 * 8192 + m) * 8), p1 = *(const f32x4*)(SUMP + ((size_t)4 * 8192 + m) * 8 + 4);
                const float rs = __builtin_amdgcn_rsqf((((p0[0] + p0[1]) + (p0[2] + p0[3])) + ((p1[0] + p1[1]) + (p1[2] + p1[3]))) * (1.0f / 2048.0f) + 1e-6f);
                const unsigned long long* xr = (const unsigned long long*)(XG + (size_t)m * DM) + lane; f32x4* o = (f32x4*)(args.out + (size_t)m * DM) + lane;
#pragma unroll
                for (int j = 0; j < 8; ++j) { const unsigned long long w = xr[64 * j]; const unsigned w0 = (unsigned)w, w1 = (unsigned)(w >> 32); const f32x4 gg = ((const f32x4*)gf)[lane + 64 * j];
                    o[64 * j] = (f32x4){__uint_as_float(w0 << 16) * gg[0] * rs, __uint_as_float(w0 & 0xffff0000u) * gg[1] * rs, __uint_as_float(w1 << 16) * gg[2] * rs, __uint_as_float(w1 & 0xffff0000u) * gg[3] * rs}; }
            }
        } else {
            const int L = (ph - 1) / 5, sub = (ph - 1) % 5, i = L >> 1, odd = L & 1;
            if (sub == 0) {
                const int N = odd ? OD_Z : EV_IN;
                const bf16* Wt = (const bf16*)(ws + (odd ? WS_WODIN : WS_WEVIN)) + (size_t)i * N * DM;
                pg8::Gemm g{XG, Wt, MTOK, N, DM}; pg8::StaticOrder S; S.init(MTOK, N, G, (int)blockIdx.x);
                pg8::EpiIn E{Z, N, SUMP + (size_t)L * 8192 * 8};
                pg8::gemm_phase<pg8::EpiIn, pg8::StaticOrder, true, true>(lds + RING_OFF, g, S, E);
                if (odd) {
                    const bf16* WA = (const bf16*)(ws + WS_WALR) + (size_t)i * 16 * 2048;
                    for (int rb0 = blockIdx.x * 32; rb0 < MTOK; rb0 += G * 32) {
                        const int rb = wave & 1, kq = wave >> 1, fr = lane & 15, fq = lane >> 4;
                        const bf16* ap = XG + (size_t)(rb0 + 16 * rb + fr) * DM + kq * 512 + 8 * fq;
                        const bf16* bp = WA + (size_t)fr * DM + kq * 512 + 8 * fq;
                        f32x4 acc = {0.f, 0.f, 0.f, 0.f};
#pragma unroll 8
                        for (int ks = 0; ks < 16; ++ks) { const bf16x8 a = *(const bf16x8*)(ap + ks * 32), b = *(const bf16x8*)(bp + ks * 32);
                            acc = __builtin_amdgcn_mfma_f32_16x16x32_bf16(a, b, acc, 0, 0, 0); }
                        LAS float* part = (LAS float*)(lds + RING_OFF);
#pragma unroll
                        for (int r = 0; r < 4; ++r) part[(kq * 32 + 16 * rb + 4 * fq + r) * 16 + fr] = acc[r];
                        __syncthreads();
                        { const int row = tid >> 4, j = tid & 15;
                          const float s = (part[(0 * 32 + row) * 16 + j] + part[(1 * 32 + row) * 16 + j]) + (part[(2 * 32 + row) * 16 + j] + part[(3 * 32 + row) * 16 + j]);
                          const float* sp_ = SUMP + ((size_t)L * 8192 + rb0 + row) * 8; const f32x4 p0 = *(const f32x4*)sp_, p1 = *(const f32x4*)(sp_ + 4);
                          const float rs = __builtin_amdgcn_rsqf((((p0[0] + p0[1]) + (p0[2] + p0[3])) + ((p1[0] + p1[1]) + (p1[2] + p1[3]))) * (1.0f / 2048.0f) + 1e-6f);
                          ALR[(size_t)(rb0 + row) * 16 + j] = s * rs; }
                        __syncthreads();
                    }
                }
            } else if (sub == 4) {
                const bf16* Wt = (const bf16*)(ws + (odd ? WS_WODOUT : WS_WEVOUT)) + (size_t)i * DM * DM;
                pg8::Gemm g{Y, Wt, MTOK, DM, DM}; pg8::StaticOrder S; S.init(MTOK, DM, G, (int)blockIdx.x);
                pg8::EpiOut E{XG, SUMP + (size_t)(L + 1) * 8192 * 8, (LAS float*)(lds + RING_BYTES)};
                pg8::gemm_phase<pg8::EpiOut, pg8::StaticOrder, true, true>(lds + RING_OFF, g, S, E);
            }
            else if (sub == 1 && !odd) {
#ifdef OPT_LRU
                { LruParams P{KIN(3) + (size_t)i * 4 * LRU_W, KIN(4) + (size_t)i * LRU_W, KIN(6) + (size_t)i * LRU_W, KIN(8) + (size_t)i * LRU_W, KIN(9) + (size_t)i * LRU_W,
                              (const bf16*)(ws + WS_WGATE) + (size_t)i * 12 * 2 * 128 * 128};
                  for (int item = blockIdx.x; item < 192; item += G) lru_item(lds, item, Z, P, Y, tid); }
#endif
#ifdef OPT_ATTN
                { const bool bal = (G == 256); const int bx = blockIdx.x;
                  const int first = bal ? (bx < 192 ? bx : 192 + (bx - 192) * 9) : bx, cnt = bal ? (bx < 192 ? 1 : 9) : (768 - bx + G - 1) / G, step = bal ? 1 : G;
                  for (int k = 0; k < cnt; ++k) attn_item(lds, first + k * step, Z, (bf16*)(ws + WS_T0), (float*)(ws + WS_T1), tid); }
#endif
            } else if (sub == 2 && !odd) {
#ifdef OPT_ATTN
                attn_merge(Z, (const bf16*)(ws + WS_T0), (const float*)(ws + WS_T1), Y, blockIdx.x * 512 + tid, G * 512);
#endif
            }
            else if (sub == 1 && odd) {
                const float* wal = KIN(13) + (size_t)i * 16 * 512; const float* bal = KIN(14) + (size_t)i * 512;
                for (int item = blockIdx.x; item < 512; item += G)
                    gla1a_item(lds, item, Z, ALR, wal, bal, (bf16*)(ws + WS_T0), (bf16*)(ws + WS_T0 + 8 * MiB), (bf16*)(ws + WS_T0 + 16 * MiB), (float*)(ws + WS_T0 + 24 * MiB), tid);
            }
            else if (sub == 2 && odd) {
                const int nscan = (G >= 128) ? 64 : 0;
                if ((int)blockIdx.x < nscan || nscan == 0) {
                    for (int item = blockIdx.x; item < 64; item += (nscan ? nscan : G))
                        gla2s_item(lds, item, Z, (const bf16*)(ws + WS_T0 + 16 * MiB), (const float*)(ws + WS_T0 + 24 * MiB), (bf16*)(ws + WS_T1), tid);
                }
                if ((int)blockIdx.x >= nscan) {
                    const float* vn = KIN(16) + (size_t)i * 1024; const float* wsg = KIN(17) + (size_t)i * 4 * 128 * 128; const float* bsg = KIN(18) + (size_t)i * 4 * 128;
                    for (int item = blockIdx.x - nscan; item < 256; item += G - nscan) sgu_item(lds, item, Z, vn, wsg, bsg, Y, tid);
                }
            }
            else if (sub == 3 && odd) {
                for (int item = blockIdx.x; item < 512; item += G)
                    gla3_item(lds, item, Z, (const bf16*)(ws + WS_T0), (const bf16*)(ws + WS_T0 + 8 * MiB), (const bf16*)(ws + WS_T1), KIN(15) + (size_t)i * 1024, Y, tid);
            }
        }
        if (REP_COND(ph) && !rep_done) rep_done = 1; else { rep_done = 0; ++ph; }
    }
}

static void launch_mk(Args& a, int lo, int hi, int li, int grid, hipStream_t stream) {
    a.ph_lo = lo; a.ph_hi = hi; a.li = li;
    hipLaunchKernelGGL(mk_fwd, dim3(grid), dim3(NWAVES * 64), LDS_BYTES, stream, a);
}
extern "C" void kernel_launch(void* const* d_in, const int* in_sizes, int n_in, void* d_out, int out_size, void* d_ws, size_t ws_size, hipStream_t stream) {
    static int grid = 0;
    if (grid == 0) {
        if (n_in != 21 || ws_size < WS_END) { fprintf(stderr, "kernel_launch: unexpected n_in %d / ws_size %zu\n", n_in, ws_size); grid = -1; return; }
        int dev = 0, cus = 0, per_cu = 0;
        if (hipGetDevice(&dev) != hipSuccess || hipDeviceGetAttribute(&cus, hipDeviceAttributeMultiprocessorCount, dev) != hipSuccess) { grid = -1; return; }
        if (hipFuncSetAttribute((const void*)mk_fwd, hipFuncAttributeMaxDynamicSharedMemorySize, LDS_BYTES) != hipSuccess) { fprintf(stderr, "kernel_launch: hipFuncSetAttribute failed\n"); grid = -1; return; }
        if (hipOccupancyMaxActiveBlocksPerMultiprocessor(&per_cu, (const void*)mk_fwd, NWAVES * 64, LDS_BYTES) != hipSuccess || per_cu < 1) { fprintf(stderr, "kernel_launch: occupancy query says %d\n", per_cu); }
        (void)hipGetLastError();
        grid = cus;
    }
    if (grid < 0) return;
    hipMemsetAsync((char*)d_ws + WS_CTL, 0, CTL_ZERO_BYTES, stream);
    Args a{};
    for (int i = 0; i < 21; ++i) a.in[i] = (const float*)d_in[i];
    a.out = (float*)d_out; a.ws = (unsigned char*)d_ws;
    a.gn[0] = a.in[11]; a.gn[1] = a.in[1] + DM; a.gn[2] = a.in[11] + DM; a.gn[3] = a.in[20];
    a.xold[0] = a.in[0]; a.xold[1] = a.xold[2] = a.xold[3] = (const float*)((char*)d_ws + WS_X);
    launch_mk(a, 0, N_PHASES, 0, grid, stream);
}
```

```cpp
#include <hip/hip_runtime.h>
#include <cstdio>
#include <cstdint>

constexpr int DM = 2048, NB = 4, SEQ = 2048, MTOK = NB * SEQ;
constexpr int LRU_W = 1536, EV_IN = 8192;
constexpr int OD_IN = 6160, OD_Z = 6144;
constexpr float EPS = 1e-6f;

typedef unsigned short bf16;
typedef bf16 AT;

__device__ __forceinline__ float bf2f(bf16 v) { return __uint_as_float((unsigned)v << 16); }
__device__ __forceinline__ unsigned f2bf(float f) { unsigned u = __builtin_bit_cast(unsigned, f); return (u + 0x7fffu + ((u >> 16) & 1u)) >> 16; }
__device__ __forceinline__ unsigned pk2(float lo, float hi) { return f2bf(lo) | (f2bf(hi) << 16); }
__device__ __forceinline__ float ldA(const bf16* p, size_t i) { return bf2f(p[i]); }
__device__ __forceinline__ void stA(bf16* p, size_t i, float v) { p[i] = (bf16)f2bf(v); }

__device__ __forceinline__ float sigmoidf_(float x) { return 1.f / (1.f + __expf(-x)); }
__device__ __forceinline__ float siluf_(float x) { return x * sigmoidf_(x); }
__device__ __forceinline__ float geluf_(float x) { return 0.5f * x * (1.f + tanhf(0.7978845608028654f * (x + 0.044715f * x * x * x))); }
__device__ __forceinline__ float softplusf_(float x) { return x > 20.f ? x : log1pf(__expf(x)); }
__device__ __forceinline__ float logsigmoidf_(float x) { return -softplusf_(-x); }

namespace pg8 {
#define PG8_LAS __attribute__((address_space(3)))
typedef unsigned short bf16_t;
typedef short bf16x8 __attribute__((ext_vector_type(8)));
typedef float f32x4 __attribute__((ext_vector_type(4)));
typedef unsigned u32x4 __attribute__((ext_vector_type(4)));
constexpr int BM = 256, BK = 64, HALF = 128, HTB = HALF * BK * 2  , STAGE_BYTES = 8 * HTB, NXCD = 8, WGM = 8;

__host__ __device__ __forceinline__ int lds_byte(int r, int c) { const int st = (r >> 4) * 2 + (c >> 5), rr = r & 15, cc = c & 31, ob = rr * 64 + cc * 2; return st * 1024 + (ob ^ (((ob >> 9) & 1) << 5)); }
__host__ __device__ __forceinline__ void stage_rc(int b, int& R, int& C) { const int st = b / 1024, sb = b % 1024, swz = sb ^ (((sb >> 9) & 1) << 5); R = (st >> 1) * 16 + swz / 64; C = (st & 1) * 32 + (swz % 64) / 2; }
__host__ __device__ __forceinline__ int perm32(int rho) { const int n = rho >> 4, i = rho & 15; return 8 * (i >> 2) + 4 * n + (i & 3); }

struct Unit { int pm, pn; };
struct Gemm { const bf16_t* A; const bf16_t* Bt; int M, N, K; };

struct StaticOrder {
    int nM, nN, nwg, G, c;
    __host__ __device__ void init(int M, int N, int G_, int c_) { nM = M / BM; nN = N / BM; nwg = nM * nN; G = G_; c = c_; }
    __host__ __device__ bool next(int i, Unit& u) const {
        const long L = (long)i * G + c; if (L >= nwg) return false;
        int wgid = (int)L; { const int q = nwg / NXCD, r = nwg % NXCD, xcd = wgid % NXCD, off = wgid / NXCD; wgid = (xcd < r ? xcd * (q + 1) : r * (q + 1) + (xcd - r) * q) + off; }
        const int nig = WGM * nN, gid = wgid / nig, fm = gid * WGM, gsz = (nM - fm) < WGM ? (nM - fm) : WGM;
        u.pm = fm + ((wgid % nig) % gsz); u.pn = (wgid % nig) / gsz; return true;
    }
    __device__ __forceinline__ void a_ready(const Unit&) const {}
    __device__ __forceinline__ void done(const Unit&) const {}
};

__device__ __forceinline__ unsigned cvt_pk_bf16(float lo, float hi) { unsigned r; asm volatile("v_cvt_pk_bf16_f32 %0, %1, %2" : "=v"(r) : "v"(lo), "v"(hi)); return r; }
struct EpiIn {
    static constexpr bool PERM = true, AFTER_DRAIN = false;
    bf16_t* O; int ldc; const float* sump;
    __device__ __forceinline__ void operator()(const f32x4 (&acc)[2][2][4][2], const Unit& u, int wr, int wc, int fr, int fq) const {
        const int row0 = u.pm * BM + wr * 64 + fr, col0 = u.pn * BM + wc * 32 + 8 * fq;
#pragma unroll
        for (int ai = 0; ai < 2; ++ai)
#pragma unroll
            for (int m = 0; m < 4; ++m) { const int row = row0 + ai * HALF + m * 16;
                const f32x4 p0 = *(const f32x4*)(sump + (size_t)row * 8), p1 = *(const f32x4*)(sump + (size_t)row * 8 + 4);
                const float rs = __builtin_amdgcn_rsqf((((p0[0] + p0[1]) + (p0[2] + p0[3])) + ((p1[0] + p1[1]) + (p1[2] + p1[3]))) * (1.0f / 2048.0f) + 1e-6f);
                bf16_t* rowp = O + (size_t)row * ldc + col0;
#pragma unroll
                for (int bj = 0; bj < 2; ++bj) { const f32x4 v0 = acc[ai][bj][m][0] * rs, v1 = acc[ai][bj][m][1] * rs;
                    u32x4 w; w.x = cvt_pk_bf16(v0[0], v0[1]); w.y = cvt_pk_bf16(v0[2], v0[3]); w.z = cvt_pk_bf16(v1[0], v1[1]); w.w = cvt_pk_bf16(v1[2], v1[3]);
                    *(u32x4*)(rowp + bj * HALF) = w; } }
    }
};
struct EpiOut {
    static constexpr bool PERM = true, AFTER_DRAIN = false;
    bf16_t* x; float* sump_next; PG8_LAS float* xs;
    __device__ __forceinline__ void operator()(const f32x4 (&acc)[2][2][4][2], const Unit& u, int wr, int wc, int fr, int fq) const {
        const int row0 = u.pm * BM + wr * 64 + fr, col0 = u.pn * BM + wc * 32 + 8 * fq;
#pragma unroll
        for (int ai = 0; ai < 2; ++ai) {
            u32x4 xo[4][2];
#pragma unroll
            for (int m = 0; m < 4; ++m) { const size_t off = (size_t)(row0 + ai * HALF + m * 16) * 2048 + col0;
#pragma unroll
                for (int bj = 0; bj < 2; ++bj) xo[m][bj] = *(const u32x4*)(x + off + bj * HALF); }
            asm volatile("" ::: "memory");
#pragma unroll
            for (int m = 0; m < 4; ++m) { const size_t off = (size_t)(row0 + ai * HALF + m * 16) * 2048 + col0; float ss = 0.f;
#pragma unroll
                for (int bj = 0; bj < 2; ++bj) {
                    const u32x4 o = xo[m][bj]; u32x4 w;
#pragma unroll
                    for (int k = 0; k < 4; ++k) { const float lo = __uint_as_float(o[k] << 16) + acc[ai][bj][m][k >> 1][(k & 1) * 2], hi = __uint_as_float(o[k] & 0xffff0000u) + acc[ai][bj][m][k >> 1][(k & 1) * 2 + 1];
                        const unsigned p = cvt_pk_bf16(lo, hi); w[k] = p;
                        const float rl = __uint_as_float(p << 16), rh = __uint_as_float(p & 0xffff0000u); ss += rl * rl + rh * rh; }
                    *(u32x4*)(x + off + bj * HALF) = w; }
                ss += __shfl_xor(ss, 16); ss += __shfl_xor(ss, 32);
                if (fq == 0) xs[(ai * HALF + wr * 64 + m * 16 + fr) * 4 + wc] = ss; }
            asm volatile("" ::: "memory");
        }
        asm volatile("s_waitcnt lgkmcnt(0)" ::: "memory"); __builtin_amdgcn_s_barrier(); asm volatile("" ::: "memory");
        { const int t = threadIdx.x; if (t < 256) { const f32x4 p = *(const PG8_LAS f32x4*)(xs + 4 * t); sump_next[(size_t)(u.pm * BM + t) * 8 + u.pn] = (p[0] + p[1]) + (p[2] + p[3]); } }
    }
};
template <class Epi, class Sched, bool ALIGN_EPI = false, bool SP2 = false>
__device__ __forceinline__ void gemm_phase(PG8_LAS unsigned char* lds, const Gemm g, const Sched& S, const Epi& E) {
    int tid_op = threadIdx.x; asm volatile("" : "+v"(tid_op));
    const int tid = tid_op, wid = __builtin_amdgcn_readfirstlane(tid >> 6), lane = tid & 63, wr = wid >> 2, wc = wid & 3, fr = lane & 15, fq = lane >> 4;
    const int K = g.K, nt = K / BK;
    unsigned voffA[2], voffB[2];
#pragma unroll
    for (int i = 0; i < 2; ++i) { int R, C; stage_rc(tid * 16 + i * 8192, R, C); const int Rb = Epi::PERM ? ((R & ~31) + perm32(R & 31)) : R;
        voffA[i] = (unsigned)(R * K + C) * 2u; voffB[i] = (unsigned)(Rb * K + C) * 2u; }
    const size_t kstep = (size_t)(BK * 2);
    const size_t hstep = (size_t)HALF * K * 2;
    const size_t tstep = 2 * hstep;
    const unsigned ldsw = (unsigned)wid * 1024u;
    const int aoff = lds_byte(wr * 64 + fr, fq * 8), boff = lds_byte(wc * 32 + fr, fq * 8);
#define PG8_SA(b, h) (((b) * 2 + (h)) * HTB)
#define PG8_SB(b, h) ((4 + (b) * 2 + (h)) * HTB)
#define PG8_STAGE(bufoff, gbase, voff) do { _Pragma("unroll") for (int _i = 0; _i < 2; ++_i) \
        __builtin_amdgcn_global_load_lds((const unsigned*)((const char*)(gbase) + (voff)[_i]), (PG8_LAS unsigned*)(lds + (bufoff) + ldsw + _i * 8192), 16, 0, 0); } while (0)
#define PG8_LDA(dst, b, h) do { _Pragma("unroll") for (int m = 0; m < 4; ++m) _Pragma("unroll") for (int k = 0; k < 2; ++k) dst[m][k] = *(const PG8_LAS bf16x8*)(lds + PG8_SA(b, h) + aoff + m * 2048 + k * 1024); } while (0)
#define PG8_LDB(dst, b, h) do { _Pragma("unroll") for (int n = 0; n < 2; ++n) _Pragma("unroll") for (int k = 0; k < 2; ++k) dst[n][k] = *(const PG8_LAS bf16x8*)(lds + PG8_SB(b, h) + boff + n * 2048 + k * 1024); } while (0)
#define PG8_MMA(ai, bj, At, Bt) do { __builtin_amdgcn_s_setprio(1); _Pragma("unroll") for (int m = 0; m < 4; ++m) _Pragma("unroll") for (int n = 0; n < 2; ++n) _Pragma("unroll") for (int k = 0; k < 2; ++k) \
        acc[ai][bj][m][n] = __builtin_amdgcn_mfma_f32_16x16x32_bf16(Bt[n][k], At[m][k], acc[ai][bj][m][n], 0, 0, 0); __builtin_amdgcn_s_setprio(0); } while (0)
#define PG8_WAIT_V(n) asm volatile("s_waitcnt vmcnt(" #n ")" ::: "memory")
#define PG8_WAIT_L(n) asm volatile("s_waitcnt lgkmcnt(" #n ")" ::: "memory")
#define PG8_BAR __builtin_amdgcn_s_barrier()
#define PG8_SCHED __builtin_amdgcn_sched_barrier(0)
    Unit cur, nxt; int ui = 0;
    if (!S.next(0, cur)) return;
    f32x4 acc[2][2][4][2];
#pragma unroll
    for (int a = 0; a < 2; ++a)
#pragma unroll
        for (int b = 0; b < 2; ++b)
#pragma unroll
            for (int m = 0; m < 4; ++m)
#pragma unroll
                for (int n = 0; n < 2; ++n) acc[a][b][m][n] = (f32x4){0.f, 0.f, 0.f, 0.f};
    bf16x8 At[4][2], B0[2][2], B1[2][2];
    const char* cA = (const char*)g.A + (size_t)cur.pm * tstep; const char* cB = (const char*)g.Bt + (size_t)cur.pn * tstep;
    S.a_ready(cur);
    if constexpr (SP2) {
        PG8_STAGE(PG8_SB(0, 0), cB, voffB); PG8_STAGE(PG8_SB(0, 1), cB + hstep, voffB); PG8_STAGE(PG8_SA(0, 0), cA, voffA); PG8_STAGE(PG8_SA(0, 1), cA + hstep, voffA);
        if (wr == 1) PG8_BAR;
        PG8_WAIT_V(2); PG8_BAR;
        PG8_STAGE(PG8_SB(1, 0), cB + kstep, voffB); PG8_STAGE(PG8_SA(1, 0), cA + kstep, voffA); PG8_STAGE(PG8_SB(1, 1), cB + hstep + kstep, voffB);
        PG8_WAIT_V(6); PG8_BAR;
    } else {
        PG8_STAGE(PG8_SB(0, 0), cB, voffB); PG8_STAGE(PG8_SA(0, 0), cA, voffA); PG8_STAGE(PG8_SB(0, 1), cB + hstep, voffB); PG8_STAGE(PG8_SA(0, 1), cA + hstep, voffA);
        if (wr == 1) PG8_BAR;
        PG8_WAIT_V(4); PG8_BAR;
        PG8_STAGE(PG8_SB(1, 0), cB + kstep, voffB); PG8_STAGE(PG8_SA(1, 0), cA + kstep, voffA); PG8_STAGE(PG8_SB(1, 1), cB + hstep + kstep, voffB);
        PG8_WAIT_V(6); PG8_BAR;
    }
    for (;;) {
        const bool has_next = S.next(ui + 1, nxt);
        const char* nA = has_next ? (const char*)g.A + (size_t)nxt.pm * tstep : cA; const char* nB = has_next ? (const char*)g.Bt + (size_t)nxt.pn * tstep : cB;
        for (int t = 0; t < nt; t += 2) {
            const bool last = (t == nt - 2);
            const char* a1 = cA + (size_t)(t + 1) * kstep;
            const char* a2 = last ? nA : cA + (size_t)(t + 2) * kstep; const char* b2 = last ? nB : cB + (size_t)(t + 2) * kstep;
            const char* a3 = a2 + kstep; const char* b3 = b2 + kstep;
            if (last && has_next) S.a_ready(nxt);
            if constexpr (SP2) {
            PG8_LDB(B0, 0, 0); PG8_LDB(B1, 0, 1); PG8_SCHED; PG8_LDA(At, 0, 0); PG8_STAGE(PG8_SA(1, 1), a1 + hstep, voffA);
            PG8_WAIT_V(8); PG8_WAIT_L(0); PG8_BAR; PG8_MMA(0, 0, At, B0); PG8_MMA(0, 1, At, B1); PG8_BAR; PG8_SCHED;
            PG8_LDA(At, 0, 1); PG8_STAGE(PG8_SB(0, 0), b2, voffB); PG8_STAGE(PG8_SB(0, 1), b2 + hstep, voffB); PG8_STAGE(PG8_SA(0, 0), a2, voffA);
            PG8_WAIT_V(8); PG8_WAIT_L(0); PG8_BAR; PG8_MMA(1, 0, At, B0); PG8_MMA(1, 1, At, B1); PG8_BAR; PG8_SCHED;
            PG8_LDB(B0, 1, 0); PG8_LDB(B1, 1, 1); PG8_SCHED; PG8_LDA(At, 1, 0); PG8_STAGE(PG8_SA(0, 1), a2 + hstep, voffA);
            PG8_WAIT_V(8); PG8_WAIT_L(0); PG8_BAR; PG8_MMA(0, 0, At, B0); PG8_MMA(0, 1, At, B1); PG8_BAR; PG8_SCHED;
            PG8_LDA(At, 1, 1); PG8_STAGE(PG8_SB(1, 0), b3, voffB); PG8_STAGE(PG8_SB(1, 1), b3 + hstep, voffB); PG8_STAGE(PG8_SA(1, 0), a3, voffA);
            PG8_WAIT_V(8); PG8_WAIT_L(0); PG8_BAR; PG8_MMA(1, 0, At, B0); PG8_MMA(1, 1, At, B1); PG8_BAR; PG8_SCHED;
            } else {
            PG8_LDB(B0, 0, 0); PG8_SCHED; PG8_LDA(At, 0, 0); PG8_STAGE(PG8_SA(1, 1), a1 + hstep, voffA);
            PG8_WAIT_L(8); PG8_BAR; PG8_WAIT_L(0); PG8_MMA(0, 0, At, B0); PG8_BAR; PG8_SCHED;
            PG8_LDB(B1, 0, 1); PG8_STAGE(PG8_SB(0, 0), b2, voffB);
            PG8_BAR; PG8_WAIT_L(0); PG8_MMA(0, 1, At, B1); PG8_BAR;
            PG8_LDA(At, 0, 1); PG8_STAGE(PG8_SA(0, 0), a2, voffA);
            PG8_BAR; PG8_WAIT_L(0); PG8_MMA(1, 0, At, B0); PG8_BAR; PG8_SCHED;
            PG8_STAGE(PG8_SB(0, 1), b2 + hstep, voffB);
            PG8_WAIT_V(6); PG8_BAR; PG8_MMA(1, 1, At, B1); PG8_BAR;
            PG8_LDB(B0, 1, 0); PG8_SCHED; PG8_LDA(At, 1, 0); PG8_STAGE(PG8_SA(0, 1), a2 + hstep, voffA);
            PG8_WAIT_L(8); PG8_BAR; PG8_WAIT_L(0); PG8_MMA(0, 0, At, B0); PG8_BAR; PG8_SCHED;
            PG8_LDB(B1, 1, 1); PG8_STAGE(PG8_SB(1, 0), b3, voffB);
            PG8_BAR; PG8_WAIT_L(0); PG8_MMA(0, 1, At, B1); PG8_BAR;
            PG8_LDA(At, 1, 1); PG8_STAGE(PG8_SA(1, 0), a3, voffA);
            PG8_BAR; PG8_WAIT_L(0); PG8_MMA(1, 0, At, B0); PG8_BAR; PG8_SCHED;
            PG8_STAGE(PG8_SB(1, 1), b3 + hstep, voffB);
            PG8_WAIT_V(6); PG8_BAR; PG8_MMA(1, 1, At, B1); PG8_BAR;
            }
        }
        if constexpr (ALIGN_EPI) { if (wr == 0) PG8_BAR; }
        if constexpr (!Epi::AFTER_DRAIN) { E(acc, cur, wr, wc, fr, fq); S.done(cur); }
        if (!has_next) break;
#pragma unroll
        for (int a = 0; a < 2; ++a)
#pragma unroll
            for (int b = 0; b < 2; ++b)
#pragma unroll
                for (int m = 0; m < 4; ++m)
#pragma unroll
                    for (int n = 0; n < 2; ++n) acc[a][b][m][n] = (f32x4){0.f, 0.f, 0.f, 0.f};
        cur = nxt; cA = nA; cB = nB; ++ui;
        if constexpr (ALIGN_EPI) { if (wr == 1) PG8_BAR; }
    }
    PG8_WAIT_V(0);
    if constexpr (!ALIGN_EPI) { if (wr == 0) PG8_BAR; }
    PG8_BAR;
    if constexpr (Epi::AFTER_DRAIN) { E.fused(acc, cur, wr, wc, fr, fq, lds, wid, lane); S.done(cur); }
#undef PG8_SA
#undef PG8_SB
#undef PG8_STAGE
#undef PG8_LDA
#undef PG8_LDB
#undef PG8_MMA
#undef PG8_WAIT_V
#undef PG8_WAIT_L
#undef PG8_BAR
#undef PG8_SCHED
}
}
#define GAS __attribute__((address_space(1)))
#define LAS __attribute__((address_space(3)))
typedef unsigned v4u __attribute__((ext_vector_type(4)));
typedef float f32x4 __attribute__((ext_vector_type(4)));
typedef short bf16x8 __attribute__((ext_vector_type(8)));
typedef GAS unsigned gu32;
#define RLX_AGENT __ATOMIC_RELAXED, __HIP_MEMORY_SCOPE_AGENT
#define LDS_WAIT() asm volatile("s_waitcnt lgkmcnt(0)" ::: "memory")
#define VM_WAIT() asm volatile("s_waitcnt vmcnt(0)" ::: "memory")
#define XB_TMO      128
#define XB_XCNT(j)  (256  + 64 * (j))
#define XB_XSUB(j)  (1280 + 64 * (j))
#define XB_XGEN(j)  (2304 + 64 * (j))
#define XB_TOP      3328
#define XB_TOPGEN   3392
#define XCD_BAR_WORDS 3456
#define XB_SPIN_CAP (1u << 18)

__device__ __forceinline__ unsigned xb_ld(unsigned* p)              { return __hip_atomic_load(p, __ATOMIC_RELAXED, __HIP_MEMORY_SCOPE_AGENT); }
__device__ __forceinline__ unsigned xb_add(unsigned* p, unsigned v) { return __hip_atomic_fetch_add(p, v, __ATOMIC_RELAXED, __HIP_MEMORY_SCOPE_AGENT); }
__device__ __forceinline__ unsigned xb_xcc_id() { return (unsigned)__builtin_amdgcn_s_getreg((3 << 11) | 20) & 0xFu; }
#define XB_SPIN(cond, bar) do { unsigned _sp = 0; while (cond) { __builtin_amdgcn_s_sleep(1); \
    if ((++_sp & 255u) == 0u) { if (xb_ld(&(bar)[XB_TMO])) break; if (_sp > XB_SPIN_CAP) { atomicAdd(&(bar)[XB_TMO], 1u); break; } } } } while (0)

struct XcdBarrier {
    unsigned* bar; unsigned x;
    volatile LAS unsigned* st;
};

__device__ __forceinline__ XcdBarrier xcd_barrier_post(unsigned* bar, volatile LAS unsigned* st) {
    XcdBarrier b; b.bar = bar; b.x = xb_xcc_id(); b.st = st;
    if (threadIdx.x == 0) (void)xb_add(&bar[XB_XCNT(b.x)], 1u);
    return b;
}
__device__ __forceinline__ void xcd_barrier_complete(unsigned* bar, unsigned x, unsigned& nloc, unsigned& nx) {
    const unsigned G = gridDim.x * gridDim.y * gridDim.z;
    unsigned sum, cnt, mine, sp = 0u;
    for (;;) {
        sum = 0u; cnt = 0u; mine = 0u;
#pragma unroll
        for (unsigned j = 0; j < 16; ++j) { const unsigned c = xb_ld(&bar[XB_XCNT(j)]); sum += c; cnt += (c > 0u) ? 1u : 0u; mine = (j == x) ? c : mine; }
        if (sum == G) break;
        __builtin_amdgcn_s_sleep(1);
        if ((++sp & 255u) == 0u) { if (xb_ld(&bar[XB_TMO])) break; if (sp > XB_SPIN_CAP) { atomicAdd(&bar[XB_TMO], 1u); break; } }
    }
    nloc = mine > 0u ? mine : 1u; nx = cnt > 0u ? cnt : 1u;
}

__device__ __forceinline__ void xcd_barrier(const XcdBarrier& b) {
    asm volatile("s_waitcnt vmcnt(0)" ::: "memory");
    __syncthreads();
    if (threadIdx.x == 0) {
        unsigned* bar = b.bar;
        __builtin_amdgcn_s_waitcnt(0);
        unsigned nloc = b.st[0], nx = b.st[1];
        if (nloc == 0u) { xcd_barrier_complete(bar, b.x, nloc, nx); b.st[0] = nloc; b.st[1] = nx; }
        const unsigned old = xb_add(&bar[XB_XSUB(b.x)], 1u);
        const unsigned gen = old / nloc;
        if (old + 1u == (gen + 1u) * nloc) {
            __builtin_amdgcn_fence(__ATOMIC_RELEASE, "agent");
            asm volatile("s_waitcnt vmcnt(0)" ::: "memory");
            const unsigned og = xb_add(&bar[XB_TOP], 1u);
            const unsigned tg = og / nx;
            if (og + 1u == (tg + 1u) * nx) xb_add(&bar[XB_TOPGEN], 1u);
            else XB_SPIN(xb_ld(&bar[XB_TOPGEN]) == tg, bar);
            __builtin_amdgcn_fence(__ATOMIC_ACQUIRE, "agent");
            xb_add(&bar[XB_XGEN(b.x)], 1u);
            asm volatile("s_waitcnt vmcnt(0)" ::: "memory");
        } else {
            XB_SPIN(xb_ld(&bar[XB_XGEN(b.x)]) == gen, bar);
            __builtin_amdgcn_fence(__ATOMIC_ACQUIRE, "agent");
            asm volatile("s_waitcnt vmcnt(0)" ::: "memory");
        }
    }
    __syncthreads();
}

typedef short s16x4 __attribute__((ext_vector_type(4)));
typedef unsigned u32x2 __attribute__((ext_vector_type(2)));
__device__ __forceinline__ float fast_sigmoid(float x) { return __builtin_amdgcn_rcpf(1.f + __builtin_amdgcn_exp2f(-1.4426950408889634f * x)); }
__device__ __forceinline__ float fast_silu(float x) { return x * fast_sigmoid(x); }
__device__ __forceinline__ float fast_gelu(float x) { return x * fast_sigmoid(x * (1.5957691216057308f + 0.0713548162726f * x * x)); }
__device__ __forceinline__ float bflo(unsigned w) { return __uint_as_float(w << 16); }
__device__ __forceinline__ float bfhi(unsigned w) { return __uint_as_float(w & 0xffff0000u); }
typedef float f32x2_t __attribute__((ext_vector_type(2))); typedef __bf16 bf16x2_t __attribute__((ext_vector_type(2)));
__device__ __forceinline__ unsigned cvtpk(float lo, float hi) { const f32x2_t v = {lo, hi}; const bf16x2_t b = __builtin_convertvector(v, bf16x2_t); return __builtin_bit_cast(unsigned, b); }
__device__ __forceinline__ s16x4 tr_read(const LAS unsigned char* p) { return __builtin_bit_cast(s16x4, __builtin_amdgcn_ds_read_tr16_b64_v4i16((LAS s16x4*)p)); }
__device__ __forceinline__ bf16x8 frag_tr(const LAS unsigned char* base, int stride, int lane) {
    const int G = lane >> 4, q = (lane >> 2) & 3, p = lane & 3;
    const LAS unsigned char* a = base + (4 * G + q) * stride + 8 * p;
    const s16x4 lo = tr_read(a), hi = tr_read(a + 16 * stride);
    return (bf16x8){lo[0], lo[1], lo[2], lo[3], hi[0], hi[1], hi[2], hi[3]};
}
__device__ __forceinline__ bf16x8 frag_perm_row(const LAS unsigned char* rowbase, int stride, int lane) {
    const LAS unsigned char* a = rowbase + (lane & 15) * stride + 8 * (lane >> 4);
    const s16x4 lo = *(const LAS s16x4*)a, hi = *(const LAS s16x4*)(a + 32);
    return (bf16x8){lo[0], lo[1], lo[2], lo[3], hi[0], hi[1], hi[2], hi[3]};
}

constexpr int SGU_VF_STRIDE = 544, SGU_W_STRIDE = 272, SGU_VF_OFF = 0, SGU_W_OFF = 128 * SGU_VF_STRIDE;
__device__ __forceinline__ void sgu_item(LAS unsigned char* lds, int item, const bf16* Z, const float* v_norm, const float* w_s, const float* b_s, bf16* Y, int tid) {
    const int lane = tid & 63, wave = __builtin_amdgcn_readfirstlane(tid >> 6);
    const int g = item & 3, c = (item >> 2) & 15, b = item >> 6;
    const size_t tok0 = (size_t)b * SEQ + 128 * c;
    LAS unsigned char* VF = lds + SGU_VF_OFF; LAS unsigned char* WS = lds + SGU_W_OFF;
    {
        const int sub = lane >> 4, cl = lane & 15;
        float vn[16];
#pragma unroll
        for (int j = 0; j < 4; ++j) { const f32x4 t = *(const f32x4*)(v_norm + g * 256 + 16 * cl + 4 * j); vn[4 * j] = t[0]; vn[4 * j + 1] = t[1]; vn[4 * j + 2] = t[2]; vn[4 * j + 3] = t[3]; }
        v4u wv[4][2];
#pragma unroll
        for (int ps = 0; ps < 4; ++ps) { const v4u* src = (const v4u*)(Z + (tok0 + 16 * wave + 4 * ps + sub) * OD_Z + 4096 + 256 * g + 16 * cl); wv[ps][0] = src[0]; wv[ps][1] = src[1]; }
#pragma unroll
        for (int ps = 0; ps < 4; ++ps) {
            const int row = 16 * wave + 4 * ps + sub;
            const v4u w0 = wv[ps][0], w1 = wv[ps][1];
            float x[16];
#pragma unroll
            for (int j = 0; j < 4; ++j) { x[2 * j] = fast_gelu(bflo(w0[j])); x[2 * j + 1] = fast_gelu(bfhi(w0[j])); x[8 + 2 * j] = fast_gelu(bflo(w1[j])); x[9 + 2 * j] = fast_gelu(bfhi(w1[j])); }
            float s = 0.f;
#pragma unroll
            for (int j = 0; j < 16; ++j) s += x[j];
            s += __shfl_xor(s, 1); s += __shfl_xor(s, 2); s += __shfl_xor(s, 4); s += __shfl_xor(s, 8);
            const float mu = s * (1.f / 256.f);
            float q = 0.f;
#pragma unroll
            for (int j = 0; j < 16; ++j) { x[j] -= mu; q += x[j] * x[j]; }
            q += __shfl_xor(q, 1); q += __shfl_xor(q, 2); q += __shfl_xor(q, 4); q += __shfl_xor(q, 8);
            const float rstd = __builtin_amdgcn_rsqf(q * (1.f / 256.f) + 1e-6f);
            v4u o0, o1;
#pragma unroll
            for (int j = 0; j < 4; ++j) { o0[j] = cvtpk(x[2 * j] * rstd * vn[2 * j], x[2 * j + 1] * rstd * vn[2 * j + 1]); o1[j] = cvtpk(x[8 + 2 * j] * rstd * vn[8 + 2 * j], x[9 + 2 * j] * rstd * vn[9 + 2 * j]); }
            LAS v4u* dst = (LAS v4u*)(VF + row * SGU_VF_STRIDE + 32 * cl);
            dst[0] = o0; dst[1] = o1;
        }
    }
    {
        const int t = tid >> 2, s0 = (tid & 3) * 32;
        const f32x4* src = (const f32x4*)(w_s + ((size_t)g * 128 + t) * 128 + s0);
#pragma unroll
        for (int j = 0; j < 4; ++j) { const f32x4 a = src[2 * j], bb = src[2 * j + 1]; const int s = s0 + 8 * j;
            v4u o; o[0] = cvtpk(s + 0 <= t ? a[0] : 0.f, s + 1 <= t ? a[1] : 0.f); o[1] = cvtpk(s + 2 <= t ? a[2] : 0.f, s + 3 <= t ? a[3] : 0.f);
            o[2] = cvtpk(s + 4 <= t ? bb[0] : 0.f, s + 5 <= t ? bb[1] : 0.f); o[3] = cvtpk(s + 6 <= t ? bb[2] : 0.f, s + 7 <= t ? bb[3] : 0.f);
            *(LAS v4u*)(WS + t * SGU_W_STRIDE + 2 * s) = o; }
    }
    __syncthreads();
    u32x2 uv[8][2], gv[8][2];
    {
        const int G = lane >> 4, tl = lane & 15;
#pragma unroll
        for (int tb = 0; tb < 8; ++tb) { const bf16* zr = Z + (tok0 + 16 * tb + tl) * OD_Z + 256 * g;
#pragma unroll
            for (int eb = 0; eb < 2; ++eb) { const int e = 16 * (2 * wave + eb) + 4 * G; uv[tb][eb] = *(const u32x2*)(zr + 3072 + e); gv[tb][eb] = *(const u32x2*)(zr + 5120 + e); } }
    }
    f32x4 acc[2][8];
#pragma unroll
    for (int eb = 0; eb < 2; ++eb)
#pragma unroll
        for (int tb = 0; tb < 8; ++tb) acc[eb][tb] = (f32x4){0.f, 0.f, 0.f, 0.f};
#pragma unroll
    for (int ks = 0; ks < 4; ++ks) {
        bf16x8 af[2];
#pragma unroll
        for (int eb = 0; eb < 2; ++eb) af[eb] = frag_tr(VF + (32 * ks) * SGU_VF_STRIDE + (16 * (2 * wave + eb)) * 2, SGU_VF_STRIDE, lane);
#pragma unroll
        for (int tb = 2 * ks; tb < 8; ++tb) {
            const bf16x8 bfr = frag_perm_row(WS + (16 * tb) * SGU_W_STRIDE + (32 * ks) * 2, SGU_W_STRIDE, lane);
#pragma unroll
            for (int eb = 0; eb < 2; ++eb) acc[eb][tb] = __builtin_amdgcn_mfma_f32_16x16x32_bf16(af[eb], bfr, acc[eb][tb], 0, 0, 0);
        }
    }
    {
        const int G = lane >> 4, tl = lane & 15;
#pragma unroll
        for (int tb = 0; tb < 8; ++tb) {
            const int t = 16 * tb + tl; const float bs = b_s[g * 128 + t];
            bf16* yr = Y + (tok0 + t) * DM + 1024 + 256 * g;
#pragma unroll
            for (int eb = 0; eb < 2; ++eb) {
                const int e = 16 * (2 * wave + eb) + 4 * G;
                const u32x2 uu = uv[tb][eb], gg = gv[tb][eb];
                const f32x4 a = acc[eb][tb];
                const float y0 = fast_gelu(bflo(uu[0])) * (a[0] + bs) * fast_silu(bflo(gg[0])), y1 = fast_gelu(bfhi(uu[0])) * (a[1] + bs) * fast_silu(bfhi(gg[0]));
                const float y2 = fast_gelu(bflo(uu[1])) * (a[2] + bs) * fast_silu(bflo(gg[1])), y3 = fast_gelu(bfhi(uu[1])) * (a[3] + bs) * fast_silu(bfhi(gg[1]));
                u32x2 o; o[0] = cvtpk(y0, y1); o[1] = cvtpk(y2, y3);
                *(u32x2*)(yr + e) = o;
            }
        }
    }
    __syncthreads();
}

constexpr int AT_STRIDE = 288, AT_K_OFF = 0, AT_V_OFF = 256 * AT_STRIDE, AT_V_ROWS = 272, AT_LDS_END = AT_V_OFF + AT_V_ROWS * AT_STRIDE;
__device__ __forceinline__ void attn_item(LAS unsigned char* lds, int item, const bf16* Z, bf16* OG, float* LSE, int tid) {
    const int lane = tid & 63, wave = __builtin_amdgcn_readfirstlane(tid >> 6), G = lane >> 4, ql = lane & 15;
    const int g = item >> 8, rem = item & 255, j = rem & 3, rn = (rem >> 2) & 15, b = rem >> 6;
    const int d = 1 << (2 * g), nb = 16 >> (2 * g), n = rn % nb, r = rn / nb;
    const size_t tokb = (size_t)b * SEQ;
    LAS unsigned char* KT = lds + AT_K_OFF; LAS unsigned char* VT = lds + AT_V_OFF;
    const int q0 = 16 * wave;
    const size_t qtok = tokb + (size_t)(128 * n + q0 + ql) * d + r;
    bf16x8 qf[4];
    { const bf16* qp = Z + qtok * EV_IN + 3072 + g * 512 + j * 128 + 8 * G;
#pragma unroll
      for (int ks = 0; ks < 4; ++ks) qf[ks] = *(const bf16x8*)(qp + 32 * ks); }
    {
        const int c16 = tid & 15, rw = tid >> 4;
        const bf16* kb = Z + 4608 + g * 512 + j * 128 + 8 * c16;
        v4u kvs[8], vvs[8];
#pragma unroll
        for (int ps = 0; ps < 8; ++ps) {
            const int kk = 32 * ps + rw; const int l = 128 * (n - 1) + kk; const int lc = l < 0 ? 0 : l;
            const bf16* p = kb + (tokb + (size_t)lc * d + r) * EV_IN;
            kvs[ps] = *(const v4u*)p; vvs[ps] = *(const v4u*)(p + 1536);
            if (l < 0) { kvs[ps] = (v4u){0u, 0u, 0u, 0u}; vvs[ps] = (v4u){0u, 0u, 0u, 0u}; }
        }
#pragma unroll
        for (int ps = 0; ps < 8; ++ps) { const int kk = 32 * ps + rw; *(LAS v4u*)(KT + kk * AT_STRIDE + 16 * c16) = kvs[ps]; *(LAS v4u*)(VT + kk * AT_STRIDE + 16 * c16) = vvs[ps]; }
        if (tid < 16 * 18) *(LAS v4u*)(VT + 256 * AT_STRIDE + 16 * tid) = (v4u){0u, 0u, 0u, 0u};
    }
    __syncthreads();
    f32x4 sc[9];
#pragma unroll
    for (int t = 0; t < 9; ++t) {
        sc[t] = (f32x4){0.f, 0.f, 0.f, 0.f};
        const LAS unsigned char* kp = KT + (16 * wave + 16 * t + ql) * AT_STRIDE + 16 * G;
#pragma unroll
        for (int ks = 0; ks < 4; ++ks) sc[t] = __builtin_amdgcn_mfma_f32_16x16x32_bf16(*(const LAS bf16x8*)(kp + 64 * ks), qf[ks], sc[t], 0, 0, 0);
    }
    const float slope2 = exp2f(-8.0f * (float)(g + 3 * j + 1) / 12.0f) * (float)d * 1.4426950408889634f;
    const float scale2 = 0.08838834764831845f * 1.4426950408889634f;
    float mx = -INFINITY;
#pragma unroll
    for (int t = 0; t < 9; ++t)
#pragma unroll
        for (int rg = 0; rg < 4; ++rg) {
            const int rel = 16 * t + 4 * G + rg - ql;
            const bool ok = (rel >= 0) && (rel <= 128) && (n > 0 || (q0 + ql + rel) >= 128);
            const float s = sc[t][rg] * scale2 - slope2 * (float)(128 - rel);
            sc[t][rg] = ok ? s : -INFINITY;
            mx = fmaxf(mx, sc[t][rg]);
        }
    mx = fmaxf(mx, __shfl_xor(mx, 16)); mx = fmaxf(mx, __shfl_xor(mx, 32));
    float den = 0.f;
#pragma unroll
    for (int t = 0; t < 9; ++t)
#pragma unroll
        for (int rg = 0; rg < 4; ++rg) { const float p = __builtin_amdgcn_exp2f(sc[t][rg] - mx); sc[t][rg] = p; den += p; }
    den += __shfl_xor(den, 16); den += __shfl_xor(den, 32);
    f32x4 oc[8];
#pragma unroll
    for (int dvb = 0; dvb < 8; ++dvb) oc[dvb] = (f32x4){0.f, 0.f, 0.f, 0.f};
#pragma unroll
    for (int s = 0; s < 5; ++s) {
        const f32x4 plo = sc[2 * s], phi = (s < 4) ? sc[2 * s + 1] : (f32x4){0.f, 0.f, 0.f, 0.f};
        const unsigned w0 = cvtpk(plo[0], plo[1]), w1 = cvtpk(plo[2], plo[3]), w2 = cvtpk(phi[0], phi[1]), w3 = cvtpk(phi[2], phi[3]);
        const bf16x8 pf = __builtin_bit_cast(bf16x8, (v4u){w0, w1, w2, w3});
#pragma unroll
        for (int dvb = 0; dvb < 8; ++dvb) {
            const bf16x8 vf = frag_tr(VT + (16 * wave + 32 * s) * AT_STRIDE + (16 * dvb) * 2, AT_STRIDE, lane);
            oc[dvb] = __builtin_amdgcn_mfma_f32_16x16x32_bf16(vf, pf, oc[dvb], 0, 0, 0);
        }
    }
    const float rden = __builtin_amdgcn_rcpf(den);
    bf16* op = OG + ((size_t)g * MTOK + qtok) * 512 + j * 128 + 4 * G;
#pragma unroll
    for (int dvb = 0; dvb < 8; ++dvb) { u32x2 o; o[0] = cvtpk(oc[dvb][0] * rden, oc[dvb][1] * rden); o[1] = cvtpk(oc[dvb][2] * rden, oc[dvb][3] * rden); *(u32x2*)(op + 16 * dvb) = o; }
    if (G == 0) LSE[((size_t)g * MTOK + qtok) * 4 + j] = mx + __builtin_amdgcn_logf(den);
    __syncthreads();
}
__device__ __forceinline__ void attn_merge(const bf16* Z, const bf16* OG, const float* LSE, bf16* Y, int gtid, int gthreads) {
    for (int it = gtid; it < MTOK * 64; it += gthreads) {
        const int tok = it >> 6, c8 = it & 63, j = c8 >> 4;
        const float l0 = LSE[((size_t)0 * MTOK + tok) * 4 + j], l1 = LSE[((size_t)1 * MTOK + tok) * 4 + j], l2 = LSE[((size_t)2 * MTOK + tok) * 4 + j];
        const float m = fmaxf(l0, fmaxf(l1, l2));
        float w0 = __builtin_amdgcn_exp2f(l0 - m), w1 = __builtin_amdgcn_exp2f(l1 - m), w2 = __builtin_amdgcn_exp2f(l2 - m);
        const float rs = __builtin_amdgcn_rcpf(w0 + w1 + w2); w0 *= rs; w1 *= rs; w2 *= rs;
        const v4u a = *(const v4u*)(OG + ((size_t)0 * MTOK + tok) * 512 + 8 * c8), bb = *(const v4u*)(OG + ((size_t)1 * MTOK + tok) * 512 + 8 * c8), cc = *(const v4u*)(OG + ((size_t)2 * MTOK + tok) * 512 + 8 * c8);
        const v4u gt = *(const v4u*)(Z + (size_t)tok * EV_IN + 7680 + 8 * c8);
        v4u o;
#pragma unroll
        for (int k = 0; k < 4; ++k) {
            const float ylo = (w0 * bflo(a[k]) + w1 * bflo(bb[k]) + w2 * bflo(cc[k])) * fast_silu(bflo(gt[k]));
            const float yhi = (w0 * bfhi(a[k]) + w1 * bfhi(bb[k]) + w2 * bfhi(cc[k])) * fast_silu(bfhi(gt[k]));
            o[k] = cvtpk(ylo, yhi);
        }
        *(v4u*)(Y + (size_t)tok * DM + 1536 + 8 * c8) = o;
    }
}

constexpr int LR_XC_STRIDE = 272, LR_XC_OFF = 0, LR_F_STRIDE = 528  , LR_XCF_OFF = 128 * LR_XC_STRIDE, LR_A_OFF = LR_XCF_OFF + 32 * LR_F_STRIDE, LR_U_OFF = LR_A_OFF + 32 * LR_F_STRIDE, LR_CW_OFF = LR_U_OFF + 32 * LR_F_STRIDE  , LR_LDS_END = LR_CW_OFF + 5 * 128 * 4;
struct LruParams { const float *conv_w, *conv_b, *b_a, *b_i, *lam; const bf16* wg; };
__device__ __forceinline__ void lru_load_tile(v4u (&xa)[7], v4u& ga, const bf16* Z, size_t tokb, int t0, int h, int c4, int tid) {
    const int co = tid & 15, rg = tid >> 4;
#pragma unroll
    for (int k = 0; k < 7; ++k) { const int t = t0 + 4 * rg + k - 3; const int tc = t < 0 ? 0 : t;
        const v4u v = *(const v4u*)(Z + (tokb + tc) * EV_IN + h * 128 + 8 * co);
        xa[k] = (v4u){t >= 0 ? v[0] : 0u, t >= 0 ? v[1] : 0u, t >= 0 ? v[2] : 0u, t >= 0 ? v[3] : 0u}; }
    ga = *(const v4u*)(Z + (tokb + t0 + (tid >> 2)) * EV_IN + 1536 + h * 128 + 32 * c4 + 8 * (tid & 3));
}
__device__ __forceinline__ void lru_item(LAS unsigned char* lds, int item, const bf16* Z, const LruParams& P, bf16* Y, int tid) {
    const int lane = tid & 63, wave = __builtin_amdgcn_readfirstlane(tid >> 6), G = lane >> 4, ql = lane & 15;
    const int c4 = item & 3, h = (item >> 2) % 12, b = item / 48;
    const size_t tokb = (size_t)b * SEQ;
    LAS unsigned char* XC = lds + LR_XC_OFF; LAS unsigned char* XCF = lds + LR_XCF_OFF; LAS unsigned char* AL = lds + LR_A_OFF; LAS unsigned char* UL = lds + LR_U_OFF;
    bf16x8 wf[2][2][4];
#pragma unroll
    for (int gate = 0; gate < 2; ++gate)
#pragma unroll
        for (int cb = 0; cb < 2; ++cb)
#pragma unroll
            for (int ks = 0; ks < 4; ++ks) wf[gate][cb][ks] = *(const bf16x8*)(P.wg + ((size_t)(h * 2 + gate) * 128 + 32 * c4 + 16 * cb + ql) * 128 + 32 * ks + 8 * G);
    float ba[2], bi[2], sp8[2];
#pragma unroll
    for (int cb = 0; cb < 2; ++cb) { const int ch = h * 128 + 32 * c4 + 16 * cb + ql; ba[cb] = P.b_a[ch]; bi[cb] = P.b_i[ch];
        const float nl = -P.lam[ch]; sp8[cb] = 8.0f * (nl > 20.f ? nl : log1pf(__expf(nl))); }
    LAS float* CW = (LAS float*)(lds + LR_CW_OFF);
    if (tid < 128) {
#pragma unroll
        for (int q = 0; q < 4; ++q) CW[q * 128 + tid] = P.conv_w[q * LRU_W + h * 128 + tid];
        CW[4 * 128 + tid] = P.conv_b[h * 128 + tid];
    }
    __syncthreads();
    float hc = 0.f;
    v4u xa[7], ga;
    lru_load_tile(xa, ga, Z, tokb, 0, h, c4, tid);
    for (int sc = 0; sc < 16; ++sc) {
        const int t0 = 128 * sc;
        {
            const int co = tid & 15, rg = tid >> 4;
            v4u orow[4];
            const bool mine = (co >> 2) == c4;
#pragma unroll
            for (int e = 0; e < 4; ++e) {
                typedef float f32x2 __attribute__((ext_vector_type(2)));
                const int chn = 8 * co + 2 * e;
                const f32x2 w0 = *(const LAS f32x2*)(CW + 0 * 128 + chn), w1 = *(const LAS f32x2*)(CW + 1 * 128 + chn), w2 = *(const LAS f32x2*)(CW + 2 * 128 + chn), w3 = *(const LAS f32x2*)(CW + 3 * 128 + chn);
                const f32x2 cb2 = *(const LAS f32x2*)(CW + 4 * 128 + chn);
                float lo[7], hi[7];
#pragma unroll
                for (int k = 0; k < 7; ++k) { lo[k] = bflo(xa[k][e]); hi[k] = bfhi(xa[k][e]); }
                f32x4 xlo, xhi;
#pragma unroll
                for (int r = 0; r < 4; ++r) { xlo[r] = cb2[0] + w0[0] * lo[r] + w1[0] * lo[r + 1] + w2[0] * lo[r + 2] + w3[0] * lo[r + 3];
                                              xhi[r] = cb2[1] + w0[1] * hi[r] + w1[1] * hi[r + 1] + w2[1] * hi[r + 2] + w3[1] * hi[r + 3]; orow[r][e] = cvtpk(xlo[r], xhi[r]); }
                if (mine) { *(LAS f32x4*)(XCF + (8 * (co & 3) + 2 * e) * LR_F_STRIDE + 16 * rg) = xlo; *(LAS f32x4*)(XCF + (8 * (co & 3) + 2 * e + 1) * LR_F_STRIDE + 16 * rg) = xhi; }
            }
#pragma unroll
            for (int r = 0; r < 4; ++r) *(LAS v4u*)(XC + (4 * rg + r) * LR_XC_STRIDE + 16 * co) = orow[r];
        }
        const v4u ga_cur = ga;
        if (sc < 15) lru_load_tile(xa, ga, Z, tokb, t0 + 128, h, c4, tid);
        __syncthreads();
        f32x4 acc[2][2];

#pragma unroll
        for (int gate = 0; gate < 2; ++gate)
#pragma unroll
            for (int cb = 0; cb < 2; ++cb) acc[gate][cb] = (f32x4){0.f, 0.f, 0.f, 0.f};
#pragma unroll
        for (int ks = 0; ks < 4; ++ks) {
            const bf16x8 af = *(const LAS bf16x8*)(XC + (16 * wave + ql) * LR_XC_STRIDE + 64 * ks + 16 * G);
#pragma unroll
            for (int gate = 0; gate < 2; ++gate)
#pragma unroll
                for (int cb = 0; cb < 2; ++cb) acc[gate][cb] = __builtin_amdgcn_mfma_f32_16x16x32_bf16(af, wf[gate][cb][ks], acc[gate][cb], 0, 0, 0);
        }
#pragma unroll
        for (int cb = 0; cb < 2; ++cb) {
            const int off = (16 * cb + ql) * LR_F_STRIDE + (16 * wave + 4 * G) * 4;
            const f32x4 xcv = *(const LAS f32x4*)(XCF + off);
            f32x4 av, uv;
#pragma unroll
            for (int rg2 = 0; rg2 < 4; ++rg2) {
                const float r = fast_sigmoid(acc[0][cb][rg2] + ba[cb]), ig = fast_sigmoid(acc[1][cb][rg2] + bi[cb]);
                const float la = -r * sp8[cb];
                const float a = __builtin_amdgcn_exp2f(la * 1.4426950408889634f);
                const float x2 = 2.f * la;
                const float om = (x2 > -0.05f) ? -x2 * (1.f + x2 * (0.5f + x2 * (0.16666667f + x2 * 0.041666667f))) : 1.f - a * a;
                av[rg2] = a; uv[rg2] = __builtin_amdgcn_sqrtf(om) * ig * xcv[rg2];
            }
            *(LAS f32x4*)(AL + off) = av; *(LAS f32x4*)(UL + off) = uv;
        }
        __syncthreads();
        {
            const int seg = ql, off = (4 * wave + G) * LR_F_STRIDE + 32 * seg;
            const f32x4 a0 = *(const LAS f32x4*)(AL + off), a1 = *(const LAS f32x4*)(AL + off + 16), u0 = *(const LAS f32x4*)(UL + off), u1 = *(const LAS f32x4*)(UL + off + 16);
            float Pp = 1.f, Hh = 0.f;
#pragma unroll
            for (int k = 0; k < 4; ++k) { Hh = a0[k] * Hh + u0[k]; Pp *= a0[k]; }
#pragma unroll
            for (int k = 0; k < 4; ++k) { Hh = a1[k] * Hh + u1[k]; Pp *= a1[k]; }
#pragma unroll
            for (int o = 1; o < 16; o <<= 1) { const float Pl = __shfl_up(Pp, o, 16), Hl = __shfl_up(Hh, o, 16); if (seg >= o) { Hh = Pp * Hl + Hh; Pp = Pp * Pl; } }
            float Pe = __shfl_up(Pp, 1, 16), He = __shfl_up(Hh, 1, 16);
            if (seg == 0) { Pe = 1.f; He = 0.f; }
            float hh = Pe * hc + He;
            f32x4 h0, h1;
#pragma unroll
            for (int k = 0; k < 4; ++k) { hh = a0[k] * hh + u0[k]; h0[k] = hh; }
#pragma unroll
            for (int k = 0; k < 4; ++k) { hh = a1[k] * hh + u1[k]; h1[k] = hh; }
            *(LAS f32x4*)(UL + off) = h0; *(LAS f32x4*)(UL + off + 16) = h1;
            hc = __shfl(hh, (lane & 48) + 15);
        }
        __syncthreads();
        {
            const int tk = tid >> 2, oc = tid & 3;
            float hv[8];
#pragma unroll
            for (int e = 0; e < 8; ++e) hv[e] = *(const LAS float*)(UL + (8 * oc + e) * LR_F_STRIDE + 4 * tk);
            v4u o;
#pragma unroll
            for (int e = 0; e < 4; ++e) o[e] = cvtpk(hv[2 * e] * fast_silu(bflo(ga_cur[e])), hv[2 * e + 1] * fast_silu(bfhi(ga_cur[e])));
            *(v4u*)(Y + (tokb + t0 + tk) * DM + h * 128 + 32 * c4 + 8 * oc) = o;
        }
    }
    __syncthreads();
}

constexpr int G1_ALR_OFF = 0, G1_TOT_OFF = 4096, G1_LDS_END = 6144;
__device__ __forceinline__ void gla1a_item(LAS unsigned char* lds, int item, const bf16* Z, const float* ALR, const float* w_alpha, const float* b_alpha, bf16* QT, bf16* KT, bf16* KD, float* DEC, int tid) {
    const int c = item & 31, h = (item >> 5) & 3, b = item >> 7;
    const size_t tok0 = (size_t)b * SEQ + 64 * c;
    LAS float* ALRs = (LAS float*)(lds + G1_ALR_OFF); LAS float* TOT = (LAS float*)(lds + G1_TOT_OFF);
    if (tid < 256) *(LAS f32x4*)(ALRs + 4 * tid) = *(const f32x4*)(ALR + tok0 * 16 + 4 * tid);
    const int e = tid & 127, tq = tid >> 7;
    float wa[16];
#pragma unroll
    for (int r = 0; r < 16; ++r) wa[r] = w_alpha[r * 512 + h * 128 + e];
    const float bal = b_alpha[h * 128 + e];
    float qv[16], kv[16];
#pragma unroll
    for (int t = 0; t < 16; ++t) { const bf16* zr = Z + (tok0 + 16 * tq + t) * OD_Z + h * 128 + e; qv[t] = bf2f(zr[0]); kv[t] = bf2f(zr[512]); }
    __syncthreads();
    float bc[16]; float run = 0.f;
#pragma unroll
    for (int t = 0; t < 16; ++t) {
        float s = bal;
#pragma unroll
        for (int r = 0; r < 16; ++r) s += ALRs[(16 * tq + t) * 16 + r] * wa[r];
        const float sp = (s < -20.f) ? -s : __builtin_amdgcn_logf(1.f + __builtin_amdgcn_exp2f(-s * 1.4426950408889634f)) * 0.6931471805599453f;
        run -= sp * 0.0625f; bc[t] = run;
    }
    TOT[tq * 128 + e] = run;
    __syncthreads();
    const float t0s = TOT[e], t1s = TOT[128 + e], t2s = TOT[256 + e], t3s = TOT[384 + e];
    const float offs = (tq > 0 ? t0s : 0.f) + (tq > 1 ? t1s : 0.f) + (tq > 2 ? t2s : 0.f), blast = (t0s + t1s) + (t2s + t3s);
    if (tq == 0) DEC[(size_t)item * 128 + e] = __builtin_amdgcn_exp2f(blast * 1.4426950408889634f);
#pragma unroll
    for (int t = 0; t < 16; ++t) {
        const float bb = bc[t] + offs;
        const float eb = __builtin_amdgcn_exp2f(bb * 1.4426950408889634f), enb = __builtin_amdgcn_exp2f(-bb * 1.4426950408889634f), edl = __builtin_amdgcn_exp2f((blast - bb) * 1.4426950408889634f);
        const size_t o = (tok0 + 16 * tq + t) * 512 + h * 128 + e;
        QT[o] = (bf16)f2bf(qv[t] * 0.08838834764831845f * eb); KT[o] = (bf16)f2bf(kv[t] * enb); KD[o] = (bf16)f2bf(kv[t] * edl);
    }
    __syncthreads();
}

constexpr int G2_KD_STRIDE = 288, G2_V_STRIDE = 160, G2_KD_OFF = 0, G2_V_OFF = 64 * G2_KD_STRIDE, G2_BUF = G2_V_OFF + 64 * G2_V_STRIDE, G2_DEC_OFF = 2 * G2_BUF, G2_SIMG_OFF = G2_DEC_OFF + 32 * 128 * 4,
              G2_SIMG_STRIDE = 272, G2_SIMG = 64 * G2_SIMG_STRIDE, G2_LDS_END = G2_SIMG_OFF + 2 * G2_SIMG;
struct Gla2Stage { v4u kd[2], v; };
__device__ __forceinline__ void gla2_load(Gla2Stage& st, const bf16* Z, const bf16* KD, size_t tok0, int h, int slice, int tid) {
    const int rw = tid >> 4, c16 = tid & 15;
#pragma unroll
    for (int ps = 0; ps < 2; ++ps) st.kd[ps] = *(const v4u*)(KD + (tok0 + 32 * ps + rw) * 512 + h * 128 + 8 * c16);
    st.v = *(const v4u*)(Z + (tok0 + (tid >> 3)) * OD_Z + 1024 + h * 256 + 64 * slice + 8 * (tid & 7));
}
__device__ __forceinline__ void gla2_store(const Gla2Stage& st, LAS unsigned char* buf, int tid) {
    const int rw = tid >> 4, c16 = tid & 15;
#pragma unroll
    for (int ps = 0; ps < 2; ++ps) *(LAS v4u*)(buf + G2_KD_OFF + (32 * ps + rw) * G2_KD_STRIDE + 16 * c16) = st.kd[ps];
    *(LAS v4u*)(buf + G2_V_OFF + (tid >> 3) * G2_V_STRIDE + 16 * (tid & 7)) = st.v;
}
__device__ __forceinline__ void gla2_flush(const LAS unsigned char* img, bf16* SST, int bh, int c, int slice, int tid) {
    const int rw = tid >> 4, c16 = tid & 15;
#pragma unroll
    for (int ps = 0; ps < 2; ++ps) *(v4u*)(SST + ((size_t)(bh * 32 + c) * 256 + 64 * slice + 32 * ps + rw) * 128 + 8 * c16) = *(const LAS v4u*)(img + (32 * ps + rw) * G2_SIMG_STRIDE + 16 * c16);
}
__device__ __forceinline__ void gla2s_item(LAS unsigned char* lds, int item, const bf16* Z, const bf16* KD, const float* DEC, bf16* SST, int tid) {
    const int lane = tid & 63, wave = __builtin_amdgcn_readfirstlane(tid >> 6), G = lane >> 4, ql = lane & 15;
    const int slice = item & 3, bh = item >> 2, h = bh & 3, b = bh >> 2;
    const size_t tokb = (size_t)b * SEQ;
    f32x4 sacc[4];
#pragma unroll
    for (int db = 0; db < 4; ++db) sacc[db] = (f32x4){0.f, 0.f, 0.f, 0.f};
    { Gla2Stage st; gla2_load(st, Z, KD, tokb, h, slice, tid); gla2_store(st, lds, tid);
#pragma unroll
      for (int k = 0; k < 2; ++k) *(LAS f32x4*)(lds + G2_DEC_OFF + 16 * (tid + 512 * k)) = *(const f32x4*)(DEC + (size_t)(bh * 32) * 128 + 4 * (tid + 512 * k)); }
    __syncthreads();
    for (int c = 0; c < 32; ++c) {
        LAS unsigned char* buf = lds + (c & 1) * G2_BUF;
        LAS unsigned char* img = lds + G2_SIMG_OFF + (c & 1) * G2_SIMG;
        Gla2Stage st;
        if (c < 31) gla2_load(st, Z, KD, tokb + 64 * (c + 1), h, slice, tid);
        if (c > 0) gla2_flush(lds + G2_SIMG_OFF + ((c - 1) & 1) * G2_SIMG, SST, bh, c - 1, slice, tid);
#pragma unroll
        for (int db = 0; db < 4; ++db) { u32x2 o; o[0] = cvtpk(sacc[db][0], sacc[db][1]); o[1] = cvtpk(sacc[db][2], sacc[db][3]); *(LAS u32x2*)(img + (16 * db + ql) * G2_SIMG_STRIDE + (16 * wave + 4 * G) * 2) = o; }
        const f32x4 dec = *(const LAS f32x4*)(lds + G2_DEC_OFF + (128 * c + 16 * wave + 4 * G) * 4);
#pragma unroll
        for (int db = 0; db < 4; ++db) sacc[db] *= dec;
#pragma unroll
        for (int s = 0; s < 2; ++s) {
            const bf16x8 kf = frag_tr(buf + G2_KD_OFF + (32 * s) * G2_KD_STRIDE + (16 * wave) * 2, G2_KD_STRIDE, lane);
#pragma unroll
            for (int db = 0; db < 4; ++db) {
                const bf16x8 vf = frag_tr(buf + G2_V_OFF + (32 * s) * G2_V_STRIDE + (16 * db) * 2, G2_V_STRIDE, lane);
                sacc[db] = __builtin_amdgcn_mfma_f32_16x16x32_bf16(kf, vf, sacc[db], 0, 0, 0);
            }
        }
        if (c < 31) gla2_store(st, lds + ((c + 1) & 1) * G2_BUF, tid);
        __syncthreads();
    }
    gla2_flush(lds + G2_SIMG_OFF + (31 & 1) * G2_SIMG, SST, bh, 31, slice, tid);
    __syncthreads();
}

constexpr int G3_QK_STRIDE = 272, G3_V_STRIDE = 544, G3_QT_OFF = 0, G3_KT_OFF = G3_QT_OFF + 64 * G3_QK_STRIDE, G3_V_OFF = G3_KT_OFF + 64 * G3_QK_STRIDE, G3_ST_OFF = G3_V_OFF + 64 * G3_V_STRIDE,
              G3_PART_OFF = G3_ST_OFF + 256 * G3_QK_STRIDE, G3_LDS_END = G3_PART_OFF + 8 * 16 * 4;
struct G3Stage { v4u qt[2], kt[2], v[4], st[8]; };
__device__ __forceinline__ void gla3_load(G3Stage& sg, int item, const bf16* Z, const bf16* QT, const bf16* KT, const bf16* SST, int tid) {
    const int c = item & 31, h = (item >> 5) & 3, b = item >> 7; const size_t tok0 = (size_t)b * SEQ + 64 * c;
    const int rw = tid >> 4, c16 = tid & 15, rv = tid >> 5, c32 = tid & 31;
#pragma unroll
    for (int ps = 0; ps < 2; ++ps) { const size_t o = (tok0 + 32 * ps + rw) * 512 + h * 128 + 8 * c16; sg.qt[ps] = *(const v4u*)(QT + o); sg.kt[ps] = *(const v4u*)(KT + o); }
#pragma unroll
    for (int ps = 0; ps < 4; ++ps) sg.v[ps] = *(const v4u*)(Z + (tok0 + 16 * ps + rv) * OD_Z + 1024 + h * 256 + 8 * c32);
    const bf16* sp = SST + (size_t)item * 256 * 128;
#pragma unroll
    for (int ps = 0; ps < 8; ++ps) sg.st[ps] = *(const v4u*)(sp + (size_t)(32 * ps + rw) * 128 + 8 * c16);
}
__device__ __forceinline__ void gla3_store(const G3Stage& sg, LAS unsigned char* lds, int tid) {
    const int rw = tid >> 4, c16 = tid & 15, rv = tid >> 5, c32 = tid & 31;
#pragma unroll
    for (int ps = 0; ps < 2; ++ps) { *(LAS v4u*)(lds + G3_QT_OFF + (32 * ps + rw) * G3_QK_STRIDE + 16 * c16) = sg.qt[ps]; *(LAS v4u*)(lds + G3_KT_OFF + (32 * ps + rw) * G3_QK_STRIDE + 16 * c16) = sg.kt[ps]; }
#pragma unroll
    for (int ps = 0; ps < 4; ++ps) *(LAS v4u*)(lds + G3_V_OFF + (16 * ps + rv) * G3_V_STRIDE + 16 * c32) = sg.v[ps];
#pragma unroll
    for (int ps = 0; ps < 8; ++ps) *(LAS v4u*)(lds + G3_ST_OFF + (32 * ps + rw) * G3_QK_STRIDE + 16 * c16) = sg.st[ps];
}
__device__ __forceinline__ void gla3_items(LAS unsigned char* lds, int first, int step, int last_excl, const bf16* Z, const bf16* QT, const bf16* KT, const bf16* SST, const float* head_norm, bf16* Y, int tid) {
    const int lane = tid & 63, wave = __builtin_amdgcn_readfirstlane(tid >> 6), G = lane >> 4, ql = lane & 15;
    LAS unsigned char* QTl = lds + G3_QT_OFF; LAS unsigned char* KTl = lds + G3_KT_OFF; LAS unsigned char* Vl = lds + G3_V_OFF; LAS unsigned char* STl = lds + G3_ST_OFF;
    LAS float* PART = (LAS float*)(lds + G3_PART_OFF);
    const int ib = wave >> 1, dh = wave & 1;
    if (first >= last_excl) return;
    G3Stage sg;
    gla3_load(sg, first, Z, QT, KT, SST, tid);
    for (int item = first; item < last_excl; item += step) {
        const int c = item & 31, h = (item >> 5) & 3, b = item >> 7;
        const size_t tok0 = (size_t)b * SEQ + 64 * c;
        gla3_store(sg, lds, tid);
        u32x2 gcv[8];
        { const bf16* gp = Z + (tok0 + 16 * ib + ql) * OD_Z + 2048 + h * 256 + 128 * dh + 4 * G;
#pragma unroll
          for (int dvb = 0; dvb < 8; ++dvb) gcv[dvb] = *(const u32x2*)(gp + 16 * dvb); }
        __syncthreads();
        bf16x8 qf[4];
#pragma unroll
        for (int ks = 0; ks < 4; ++ks) qf[ks] = *(const LAS bf16x8*)(QTl + (16 * ib + ql) * G3_QK_STRIDE + 64 * ks + 16 * G);
        f32x4 at[4];
#pragma unroll
        for (int jb = 0; jb < 4; ++jb) {
            at[jb] = (f32x4){0.f, 0.f, 0.f, 0.f};
            if (jb <= ib) {
#pragma unroll
                for (int ks = 0; ks < 4; ++ks) at[jb] = __builtin_amdgcn_mfma_f32_16x16x32_bf16(*(const LAS bf16x8*)(KTl + (16 * jb + ql) * G3_QK_STRIDE + 64 * ks + 16 * G), qf[ks], at[jb], 0, 0, 0);
#pragma unroll
                for (int rg = 0; rg < 4; ++rg) if (16 * jb + 4 * G + rg > 16 * ib + ql) at[jb][rg] = 0.f;
            }
        }
        f32x4 oc[8];
#pragma unroll
        for (int dvb = 0; dvb < 8; ++dvb) oc[dvb] = (f32x4){0.f, 0.f, 0.f, 0.f};
#pragma unroll
        for (int ks = 0; ks < 4; ++ks)
#pragma unroll
            for (int dvb = 0; dvb < 8; ++dvb)
                oc[dvb] = __builtin_amdgcn_mfma_f32_16x16x32_bf16(*(const LAS bf16x8*)(STl + (128 * dh + 16 * dvb + ql) * G3_QK_STRIDE + 64 * ks + 16 * G), qf[ks], oc[dvb], 0, 0, 0);
#pragma unroll
        for (int s = 0; s < 2; ++s) {
            if (2 * s <= ib) {
                const bf16x8 pf = __builtin_bit_cast(bf16x8, (v4u){cvtpk(at[2 * s][0], at[2 * s][1]), cvtpk(at[2 * s][2], at[2 * s][3]), cvtpk(at[2 * s + 1][0], at[2 * s + 1][1]), cvtpk(at[2 * s + 1][2], at[2 * s + 1][3])});
#pragma unroll
                for (int dvb = 0; dvb < 8; ++dvb) {
                    const bf16x8 vf = frag_tr(Vl + (32 * s) * G3_V_STRIDE + (128 * dh + 16 * dvb) * 2, G3_V_STRIDE, lane);
                    oc[dvb] = __builtin_amdgcn_mfma_f32_16x16x32_bf16(vf, pf, oc[dvb], 0, 0, 0);
                }
            }
        }
        float ss = 0.f;
#pragma unroll
        for (int dvb = 0; dvb < 8; ++dvb) ss += (oc[dvb][0] * oc[dvb][0] + oc[dvb][1] * oc[dvb][1]) + (oc[dvb][2] * oc[dvb][2] + oc[dvb][3] * oc[dvb][3]);
        ss += __shfl_xor(ss, 16); ss += __shfl_xor(ss, 32);
        if (G == 0) PART[wave * 16 + ql] = ss;
        __syncthreads();
        if (item + step < last_excl) gla3_load(sg, item + step, Z, QT, KT, SST, tid);
        const float rs = __builtin_amdgcn_rsqf((PART[(wave & ~1) * 16 + ql] + PART[(wave | 1) * 16 + ql]) * (1.f / 256.f) + 1e-6f);
        bf16* yp = Y + (tok0 + 16 * ib + ql) * DM + h * 256 + 128 * dh + 4 * G;
        const float* hp = head_norm + h * 256 + 128 * dh + 4 * G;
#pragma unroll
        for (int dvb = 0; dvb < 8; ++dvb) {
            const f32x4 hn = *(const f32x4*)(hp + 16 * dvb); const f32x4 o = oc[dvb]; const u32x2 gc = gcv[dvb];
            u32x2 y; y[0] = cvtpk(o[0] * rs * hn[0] * fast_silu(bflo(gc[0])), o[1] * rs * hn[1] * fast_silu(bfhi(gc[0])));
            y[1] = cvtpk(o[2] * rs * hn[2] * fast_silu(bflo(gc[1])), o[3] * rs * hn[3] * fast_silu(bfhi(gc[1])));
            *(u32x2*)(yp + 16 * dvb) = y;
        }
    }
    __syncthreads();
}
#define OPT_ATTN 1
#define OPT_LRU 1
#define OPT_GLA 1
constexpr int NWAVES = 8;
constexpr size_t MiB = 1u << 20;
constexpr size_t WS_CTL = 0, CTL_ZERO_BYTES = 1 * MiB;
constexpr size_t WS_WEVIN = 2 * MiB;
constexpr size_t WS_WEVOUT = 66 * MiB;
constexpr size_t WS_WODIN = 82 * MiB;
constexpr size_t WS_WODOUT = 130 * MiB;
constexpr size_t WS_WALR = 146 * MiB;
constexpr size_t WS_WGATE = 147 * MiB;
constexpr size_t WS_X = 150 * MiB;
constexpr size_t WS_XG = 214 * MiB;
constexpr size_t WS_Z = 246 * MiB;
constexpr size_t WS_Y = 374 * MiB;
constexpr size_t WS_ALR = 406 * MiB;
constexpr size_t WS_SUMP = 406 * MiB + 512 * 1024;
constexpr size_t WS_T0 = 408 * MiB;
constexpr size_t WS_T1 = 456 * MiB;
constexpr size_t WS_END = 504 * MiB;
constexpr int CW_BAR = 4096;
constexpr int MAX_LAUNCH = 8;
static_assert((CW_BAR + MAX_LAUNCH * XCD_BAR_WORDS) * 4 <= (int)CTL_ZERO_BYTES, "ctl map");
constexpr int RING_OFF = 0, RING_BYTES = 131072;
constexpr int LDSCTL_OFF = 152064, MISC_OFF = LDSCTL_OFF + 320;
constexpr int LDS_BYTES = 156160;
static_assert(G1_LDS_END <= LDSCTL_OFF && G2_LDS_END <= LDSCTL_OFF && G3_LDS_END <= LDSCTL_OFF && AT_LDS_END <= LDSCTL_OFF && LR_LDS_END <= LDSCTL_OFF && SGU_W_OFF + 128 * SGU_W_STRIDE <= LDSCTL_OFF, "LDS map");

constexpr int PH_PROLOGUE = 0, PH_FINAL = 21, N_PHASES = 22;

struct Args {
    const float* in[21]; float* out; unsigned char* ws;
    const float* gn[4];
    const float* xold[4];
    int ph_lo, ph_hi, li, pad;
};
#define CAS __attribute__((address_space(4)))
template <class T> __device__ __forceinline__ T* karg(const CAS char* ka, int byte_off) { T* p = *(T* const CAS*)(ka + byte_off); return (T*)(__attribute__((address_space(1))) T*)p; }
#define KIN(k) karg<const float>(ka_, 8 * (k))

__device__ __forceinline__ float wave_sum(float v) {
#pragma unroll
    for (int o = 1; o < 64; o <<= 1) v += __shfl_xor(v, o);
    return v;
}
__device__ __forceinline__ void p0_transpose_item(const float* W, int K, int ldw, int nblk, bf16* WT, int skip_at, int skip, const float* gk, LAS float* scr, int item, int lane) {
    const int kb = item / nblk, nb = item % nblk, k0 = 64 * kb, n0 = 64 * nb, s0 = n0 + (n0 >= skip_at ? skip : 0);
    const int c = lane & 7;
    f32x4 g0 = {1.f, 1.f, 1.f, 1.f}, g1 = {1.f, 1.f, 1.f, 1.f};
    if (gk) { g0 = *(const f32x4*)(gk + k0 + 8 * c); g1 = *(const f32x4*)(gk + k0 + 8 * c + 4); }
    { f32x4 wv[16];
#pragma unroll
      for (int i = 0; i < 16; ++i) wv[i] = *(const f32x4*)(W + (size_t)(k0 + 4 * i + (lane >> 4)) * ldw + s0 + 4 * (lane & 15));
#pragma unroll
      for (int i = 0; i < 16; ++i) *(LAS f32x4*)(scr + (4 * i + (lane >> 4)) * 68 + 4 * (lane & 15)) = wv[i]; }
    LDS_WAIT(); asm volatile("" ::: "memory");
#pragma unroll
    for (int j = 0; j < 8; ++j) { const int n = (lane >> 3) + 8 * j; const LAS float* s = scr + (8 * c) * 68 + n;
        v4u o; o.x = pk2(s[0 * 68] * g0[0], s[1 * 68] * g0[1]); o.y = pk2(s[2 * 68] * g0[2], s[3 * 68] * g0[3]); o.z = pk2(s[4 * 68] * g1[0], s[5 * 68] * g1[1]); o.w = pk2(s[6 * 68] * g1[2], s[7 * 68] * g1[3]);
        *(GAS v4u*)(WT + (size_t)(n0 + n) * K + k0 + 8 * c) = o; }
    LDS_WAIT(); asm volatile("" ::: "memory");
}

__global__ void __launch_bounds__(NWAVES * 64, 2) mk_fwd(Args args) {
    extern __shared__ __attribute__((aligned(16))) unsigned char lds_raw[];
    LAS unsigned char* lds = (LAS unsigned char*)lds_raw;
    volatile LAS unsigned* MISC = (volatile LAS unsigned*)(lds + MISC_OFF);
    const int G0 = gridDim.x;
    unsigned char* ws = args.ws;
    unsigned* ctl = (unsigned*)(ws + WS_CTL);
    float* SUMP = (float*)(ws + WS_SUMP);
    for (int u = threadIdx.x; u < (LDS_BYTES - LDSCTL_OFF) / 4; u += NWAVES * 64) ((LAS unsigned*)(lds + LDSCTL_OFF))[u] = 0u;
    __syncthreads();
    XcdBarrier bar = xcd_barrier_post(ctl + CW_BAR + args.li * XCD_BAR_WORDS, MISC + 8);

    float* X = (float*)(ws + WS_X); bf16* XG = (bf16*)(ws + WS_XG); bf16* Z = (bf16*)(ws + WS_Z); bf16* Y = (bf16*)(ws + WS_Y);
    float* ALR = (float*)(ws + WS_ALR);

#ifndef REP_COND
#define REP_COND(ph) false
#endif
    int rep_done = 0, first = 1;
    for (int ph = args.ph_lo; ph < args.ph_hi; ) {
        if (ph != PH_PROLOGUE && ph != PH_FINAL && ((ph - 1) % 5) == 3 && ((((ph - 1) / 5) & 1) == 0)) { ++ph; continue; }
        if (!first) xcd_barrier(bar);
        first = 0;
        int tid = threadIdx.x; asm volatile("" : "+v"(tid));
        int G = G0; asm volatile("" : "+s"(G));
        const int lane = tid & 63, wave = __builtin_amdgcn_readfirstlane(tid >> 6);
        const CAS char* ka_ = (const CAS char*)__builtin_amdgcn_kernarg_segment_ptr(); asm volatile("" : "+s"(ka_));
        const float* x_in = KIN(0);
        if (ph == PH_PROLOGUE) {
            LAS float* scr = (LAS float*)(lds + RING_OFF + wave * 17408);
            const int gw = blockIdx.x * NWAVES + wave, NGW = G * NWAVES;
            constexpr int I_EVIN = 32 * 128, I_EVOUT = 32 * 32, I_ODIN = 32 * 96, I_ODOUT = 32 * 32, I_GATE = 2 * 2;
            constexpr int NITEMS = 2 * (I_EVIN + I_EVOUT + I_ODIN + I_ODOUT) + 2 * 12 * 2 * I_GATE;
            for (int it = gw; it < NITEMS; it += NGW) {
                int r = it;
                if (r < 2 * I_EVIN) { const int i = r / I_EVIN; p0_transpose_item(KIN(2) + (size_t)i * DM * EV_IN, DM, EV_IN, 128, (bf16*)(ws + WS_WEVIN) + (size_t)i * EV_IN * DM, 1 << 30, 0, KIN(1) + (size_t)i * DM, scr, r % I_EVIN, lane); continue; } r -= 2 * I_EVIN;
                if (r < 2 * I_EVOUT) { const int i = r / I_EVOUT; p0_transpose_item(KIN(10) + (size_t)i * DM * DM, DM, DM, 32, (bf16*)(ws + WS_WEVOUT) + (size_t)i * DM * DM, 1 << 30, 0, nullptr, scr, r % I_EVOUT, lane); continue; } r -= 2 * I_EVOUT;
                if (r < 2 * I_ODIN) { const int i = r / I_ODIN; p0_transpose_item(KIN(12) + (size_t)i * DM * OD_IN, DM, OD_IN, 96, (bf16*)(ws + WS_WODIN) + (size_t)i * OD_Z * DM, 2048, 16, KIN(11) + (size_t)i * DM, scr, r % I_ODIN, lane); continue; } r -= 2 * I_ODIN;
                if (r < 2 * I_ODOUT) { const int i = r / I_ODOUT; p0_transpose_item(KIN(19) + (size_t)i * DM * DM, DM, DM, 32, (bf16*)(ws + WS_WODOUT) + (size_t)i * DM * DM, 1 << 30, 0, nullptr, scr, r % I_ODOUT, lane); continue; } r -= 2 * I_ODOUT;
                { const int mat = r / I_GATE, li2 = mat / 24, h = (mat % 24) >> 1, gate = mat & 1;
                  const float* src = KIN(gate ? 7 : 5) + ((size_t)li2 * 12 + h) * 128 * 128;
                  p0_transpose_item(src, 128, 128, 2, (bf16*)(ws + WS_WGATE) + (size_t)mat * 128 * 128, 1 << 30, 0, nullptr, scr, r % I_GATE, lane); }
            }
            for (int e = blockIdx.x * 512 + tid; e < 2 * 16 * 2048; e += G * 512) { const int i = e >> 15, j = (e >> 11) & 15, k = e & 2047;
                ((bf16*)(ws + WS_WALR))[e] = (bf16)f2bf(KIN(12)[(size_t)i * DM * OD_IN + (size_t)k * OD_IN + 2048 + j] * KIN(11)[(size_t)i * DM + k]); }
            for (int m = gw; m < MTOK; m += NGW) {
                const f32x4* xr = (const f32x4*)(x_in + (size_t)m * DM) + lane; float s = 0.f;
                unsigned long long* o8 = (unsigned long long*)(XG + (size_t)m * DM) + lane;
#pragma unroll
                for (int j = 0; j < 8; ++j) { const f32x4 v = xr[64 * j]; const unsigned p0 = pk2(v[0], v[1]), p1 = pk2(v[2], v[3]);
                    const float r0 = __uint_as_float(p0 << 16), r1 = __uint_as_float(p0 & 0xffff0000u), r2 = __uint_as_float(p1 << 16), r3 = __uint_as_float(p1 & 0xffff0000u);
                    s += (r0 * r0 + r1 * r1) + (r2 * r2 + r3 * r3);
                    o8[64 * j] = (unsigned long long)p0 | ((unsigned long long)p1 << 32); }
                s = wave_sum(s);
                if (lane < 8) SUMP[(size_t)m * 8 + lane] = (lane == 0) ? s : 0.f;
            }
        } else if (ph == PH_FINAL) {
            const int gw = blockIdx.x * NWAVES + wave, NGW = G * NWAVES;
            const float* gf = KIN(20);
            for (int m = gw; m < MTOK; m += NGW) {
                const f32x4 p0 = *(const f32x4*)(SUMP + ((size_t)4 * 8192 + m) * 8), p1 = *(const f32x4*)(SUMP + ((size_t)4 * 8192 + m) * 8 + 4);
                const float rs = __builtin_amdgcn_rsqf((((p0[0] + p0[1]) + (p0[2] + p0[3])) + ((p1[0] + p1[1]) + (p1[2] + p1[3]))) * (1.0f / 2048.0f) + 1e-6f);
                const unsigned long long* xr = (const unsigned long long*)(XG + (size_t)m * DM) + lane; f32x4* o = (f32x4*)(args.out + (size_t)m * DM) + lane;
#pragma unroll
                for (int j = 0; j < 8; ++j) { const unsigned long long w = xr[64 * j]; const unsigned w0 = (unsigned)w, w1 = (unsigned)(w >> 32); const f32x4 gg = ((const f32x4*)gf)[lane + 64 * j];
                    o[64 * j] = (f32x4){__uint_as_float(w0 << 16) * gg[0] * rs, __uint_as_float(w0 & 0xffff0000u) * gg[1] * rs, __uint_as_float(w1 << 16) * gg[2] * rs, __uint_as_float(w1 & 0xffff0000u) * gg[3] * rs}; }
            }
        } else {
            const int L = (ph - 1) / 5, sub = (ph - 1) % 5, i = L >> 1, odd = L & 1;
            if (sub == 0) {
                const int N = odd ? OD_Z : EV_IN;
                const bf16* Wt = (const bf16*)(ws + (odd ? WS_WODIN : WS_WEVIN)) + (size_t)i * N * DM;
                pg8::Gemm g{XG, Wt, MTOK, N, DM}; pg8::StaticOrder S; S.init(MTOK, N, G, (int)blockIdx.x);
                pg8::EpiIn E{Z, N, SUMP + (size_t)L * 8192 * 8};
                pg8::gemm_phase<pg8::EpiIn, pg8::StaticOrder, true, true>(lds + RING_OFF, g, S, E);
                if (odd) {
                    const bf16* WA = (const bf16*)(ws + WS_WALR) + (size_t)i * 16 * 2048;
                    for (int rb0 = blockIdx.x * 32; rb0 < MTOK; rb0 += G * 32) {
                        const int rb = wave & 1, kq = wave >> 1, fr = lane & 15, fq = lane >> 4;
                        const bf16* ap = XG + (size_t)(rb0 + 16 * rb + fr) * DM + kq * 512 + 8 * fq;
                        const bf16* bp = WA + (size_t)fr * DM + kq * 512 + 8 * fq;
                        f32x4 acc = {0.f, 0.f, 0.f, 0.f};
#pragma unroll 8
                        for (int ks = 0; ks < 16; ++ks) { const bf16x8 a = *(const bf16x8*)(ap + ks * 32), b = *(const bf16x8*)(bp + ks * 32);
                            acc = __builtin_amdgcn_mfma_f32_16x16x32_bf16(a, b, acc, 0, 0, 0); }
                        LAS float* part = (LAS float*)(lds + RING_OFF);
#pragma unroll
                        for (int r = 0; r < 4; ++r) part[(kq * 32 + 16 * rb + 4 * fq + r) * 16 + fr] = acc[r];
                        __syncthreads();
                        { const int row = tid >> 4, j = tid & 15;
                          const float s = (part[(0 * 32 + row) * 16 + j] + part[(1 * 32 + row) * 16 + j]) + (part[(2 * 32 + row) * 16 + j] + part[(3 * 32 + row) * 16 + j]);
                          const float* sp_ = SUMP + ((size_t)L * 8192 + rb0 + row) * 8; const f32x4 p0 = *(const f32x4*)sp_, p1 = *(const f32x4*)(sp_ + 4);
                          const float rs = __builtin_amdgcn_rsqf((((p0[0] + p0[1]) + (p0[2] + p0[3])) + ((p1[0] + p1[1]) + (p1[2] + p1[3]))) * (1.0f / 2048.0f) + 1e-6f);
                          ALR[(size_t)(rb0 + row) * 16 + j] = s * rs; }
                        __syncthreads();
                    }
                }
            } else if (sub == 4) {
                const bf16* Wt = (const bf16*)(ws + (odd ? WS_WODOUT : WS_WEVOUT)) + (size_t)i * DM * DM;
                pg8::Gemm g{Y, Wt, MTOK, DM, DM}; pg8::StaticOrder S; S.init(MTOK, DM, G, (int)blockIdx.x);
                pg8::EpiOut E{XG, SUMP + (size_t)(L + 1) * 8192 * 8, (LAS float*)(lds + RING_BYTES)};
                pg8::gemm_phase<pg8::EpiOut, pg8::StaticOrder, true, true>(lds + RING_OFF, g, S, E);
            }
            else if (sub == 1 && !odd) {
#ifdef OPT_LRU
                { LruParams P{KIN(3) + (size_t)i * 4 * LRU_W, KIN(4) + (size_t)i * LRU_W, KIN(6) + (size_t)i * LRU_W, KIN(8) + (size_t)i * LRU_W, KIN(9) + (size_t)i * LRU_W,
                              (const bf16*)(ws + WS_WGATE) + (size_t)i * 12 * 2 * 128 * 128};
                  for (int item = blockIdx.x; item < 192; item += G) lru_item(lds, item, Z, P, Y, tid); }
#endif
#ifdef OPT_ATTN
                { const bool bal = (G == 256); const int bx = blockIdx.x;
                  const int first = bal ? (bx < 192 ? bx : 192 + (bx - 192) * 9) : bx, cnt = bal ? (bx < 192 ? 1 : 9) : (768 - bx + G - 1) / G, step = bal ? 1 : G;
                  for (int k = 0; k < cnt; ++k) attn_item(lds, first + k * step, Z, (bf16*)(ws + WS_T0), (float*)(ws + WS_T1), tid); }
#endif
            } else if (sub == 2 && !odd) {
#ifdef OPT_ATTN
                attn_merge(Z, (const bf16*)(ws + WS_T0), (const float*)(ws + WS_T1), Y, blockIdx.x * 512 + tid, G * 512);
#endif
            }
            else if (sub == 1 && odd) {
                const float* wal = KIN(13) + (size_t)i * 16 * 512; const float* bal = KIN(14) + (size_t)i * 512;
                for (int item = blockIdx.x; item < 512; item += G)
                    gla1a_item(lds, item, Z, ALR, wal, bal, (bf16*)(ws + WS_T0), (bf16*)(ws + WS_T0 + 8 * MiB), (bf16*)(ws + WS_T0 + 16 * MiB), (float*)(ws + WS_T0 + 24 * MiB), tid);
            }
            else if (sub == 2 && odd) {
                const int nscan = (G >= 128) ? 64 : 0;
                if ((int)blockIdx.x < nscan || nscan == 0) {
                    for (int item = blockIdx.x; item < 64; item += (nscan ? nscan : G))
                        gla2s_item(lds, item, Z, (const bf16*)(ws + WS_T0 + 16 * MiB), (const float*)(ws + WS_T0 + 24 * MiB), (bf16*)(ws + WS_T1), tid);
                }
                if ((int)blockIdx.x >= nscan) {
                    const float* vn = KIN(16) + (size_t)i * 1024; const float* wsg = KIN(17) + (size_t)i * 4 * 128 * 128; const float* bsg = KIN(18) + (size_t)i * 4 * 128;
                    for (int item = blockIdx.x - nscan; item < 256; item += G - nscan) sgu_item(lds, item, Z, vn, wsg, bsg, Y, tid);
                }
            }
            else if (sub == 3 && odd) {
                gla3_items(lds, blockIdx.x, G, 512, Z, (const bf16*)(ws + WS_T0), (const bf16*)(ws + WS_T0 + 8 * MiB), (const bf16*)(ws + WS_T1), KIN(15) + (size_t)i * 1024, Y, tid);
            }
        }
        if (REP_COND(ph) && !rep_done) rep_done = 1; else { rep_done = 0; ++ph; }
    }
}

static void launch_mk(Args& a, int lo, int hi, int li, int grid, hipStream_t stream) {
    a.ph_lo = lo; a.ph_hi = hi; a.li = li;
    hipLaunchKernelGGL(mk_fwd, dim3(grid), dim3(NWAVES * 64), LDS_BYTES, stream, a);
}
extern "C" void kernel_launch(void* const* d_in, const int* in_sizes, int n_in, void* d_out, int out_size, void* d_ws, size_t ws_size, hipStream_t stream) {
    static int grid = 0;
    if (grid == 0) {
        if (n_in != 21 || ws_size < WS_END) { fprintf(stderr, "kernel_launch: unexpected n_in %d / ws_size %zu\n", n_in, ws_size); grid = -1; return; }
        int dev = 0, cus = 0, per_cu = 0;
        if (hipGetDevice(&dev) != hipSuccess || hipDeviceGetAttribute(&cus, hipDeviceAttributeMultiprocessorCount, dev) != hipSuccess) { grid = -1; return; }
        if (hipFuncSetAttribute((const void*)mk_fwd, hipFuncAttributeMaxDynamicSharedMemorySize, LDS_BYTES) != hipSuccess) { fprintf(stderr, "kernel_launch: hipFuncSetAttribute failed\n"); grid = -1; return; }
        if (hipOccupancyMaxActiveBlocksPerMultiprocessor(&per_cu, (const void*)mk_fwd, NWAVES * 64, LDS_BYTES) != hipSuccess || per_cu < 1) { fprintf(stderr, "kernel_launch: occupancy query says %d\n", per_cu); }
        (void)hipGetLastError();
        grid = cus;
    }
    if (grid < 0) return;
    hipMemsetAsync((char*)d_ws + WS_CTL, 0, CTL_ZERO_BYTES, stream);
    Args a{};
    for (int i = 0; i < 21; ++i) a.in[i] = (const float*)d_in[i];
    a.out = (float*)d_out; a.ws = (unsigned char*)d_ws;
    a.gn[0] = a.in[11]; a.gn[1] = a.in[1] + DM; a.gn[2] = a.in[11] + DM; a.gn[3] = a.in[20];
    a.xold[0] = a.in[0]; a.xold[1] = a.xold[2] = a.xold[3] = (const float*)((char*)d_ws + WS_X);
    launch_mk(a, 0, N_PHASES, 0, grid, stream);
}
```

```cpp
#include <hip/hip_runtime.h>
#include <cstdio>
#include <cstdint>

constexpr int DM = 2048, NB = 4, SEQ = 2048, MTOK = NB * SEQ;
constexpr int LRU_W = 1536, EV_IN = 8192;
constexpr int OD_IN = 6160, OD_Z = 6144;
constexpr float EPS = 1e-6f;

typedef unsigned short bf16;
typedef bf16 AT;

__device__ __forceinline__ float bf2f(bf16 v) { return __uint_as_float((unsigned)v << 16); }
__device__ __forceinline__ unsigned f2bf(float f) { unsigned u = __builtin_bit_cast(unsigned, f); return (u + 0x7fffu + ((u >> 16) & 1u)) >> 16; }
__device__ __forceinline__ unsigned pk2(float lo, float hi) { return f2bf(lo) | (f2bf(hi) << 16); }
__device__ __forceinline__ float ldA(const bf16* p, size_t i) { return bf2f(p[i]); }
__device__ __forceinline__ void stA(bf16* p, size_t i, float v) { p[i] = (bf16)f2bf(v); }

__device__ __forceinline__ float sigmoidf_(float x) { return 1.f / (1.f + __expf(-x)); }
__device__ __forceinline__ float siluf_(float x) { return x * sigmoidf_(x); }
__device__ __forceinline__ float geluf_(float x) { return 0.5f * x * (1.f + tanhf(0.7978845608028654f * (x + 0.044715f * x * x * x))); }
__device__ __forceinline__ float softplusf_(float x) { return x > 20.f ? x : log1pf(__expf(x)); }
__device__ __forceinline__ float logsigmoidf_(float x) { return -softplusf_(-x); }

namespace pg8 {
#define PG8_LAS __attribute__((address_space(3)))
typedef unsigned short bf16_t;
typedef short bf16x8 __attribute__((ext_vector_type(8)));
typedef float f32x4 __attribute__((ext_vector_type(4)));
typedef unsigned u32x4 __attribute__((ext_vector_type(4)));
constexpr int BM = 256, BK = 64, HALF = 128, HTB = HALF * BK * 2  , STAGE_BYTES = 8 * HTB, NXCD = 8, WGM = 8;

__host__ __device__ __forceinline__ int lds_byte(int r, int c) { const int st = (r >> 4) * 2 + (c >> 5), rr = r & 15, cc = c & 31, ob = rr * 64 + cc * 2; return st * 1024 + (ob ^ (((ob >> 9) & 1) << 5)); }
__host__ __device__ __forceinline__ void stage_rc(int b, int& R, int& C) { const int st = b / 1024, sb = b % 1024, swz = sb ^ (((sb >> 9) & 1) << 5); R = (st >> 1) * 16 + swz / 64; C = (st & 1) * 32 + (swz % 64) / 2; }
__host__ __device__ __forceinline__ int perm32(int rho) { const int n = rho >> 4, i = rho & 15; return 8 * (i >> 2) + 4 * n + (i & 3); }

struct Unit { int pm, pn; };
struct Gemm { const bf16_t* A; const bf16_t* Bt; int M, N, K; };

struct StaticOrder {
    int nM, nN, nwg, G, c;
    __host__ __device__ void init(int M, int N, int G_, int c_) { nM = M / BM; nN = N / BM; nwg = nM * nN; G = G_; c = c_; }
    __host__ __device__ bool next(int i, Unit& u) const {
        const long L = (long)i * G + c; if (L >= nwg) return false;
        int wgid = (int)L; { const int q = nwg / NXCD, r = nwg % NXCD, xcd = wgid % NXCD, off = wgid / NXCD; wgid = (xcd < r ? xcd * (q + 1) : r * (q + 1) + (xcd - r) * q) + off; }
        const int nig = WGM * nN, gid = wgid / nig, fm = gid * WGM, gsz = (nM - fm) < WGM ? (nM - fm) : WGM;
        u.pm = fm + ((wgid % nig) % gsz); u.pn = (wgid % nig) / gsz; return true;
    }
    __device__ __forceinline__ void a_ready(const Unit&) const {}
    __device__ __forceinline__ void done(const Unit&) const {}
};

__device__ __forceinline__ unsigned cvt_pk_bf16(float lo, float hi) { unsigned r; asm volatile("v_cvt_pk_bf16_f32 %0, %1, %2" : "=v"(r) : "v"(lo), "v"(hi)); return r; }
struct EpiIn {
    static constexpr bool PERM = true, AFTER_DRAIN = false;
    bf16_t* O; int ldc; const float* sump;
    const PG8_LAS float* rtab; int tab_pm;
    __device__ __forceinline__ void operator()(const f32x4 (&acc)[2][2][4][2], const Unit& u, int wr, int wc, int fr, int fq) const {
        const int row0 = u.pm * BM + wr * 64 + fr, col0 = u.pn * BM + wc * 32 + 8 * fq;
        const bool tab = (u.pm == tab_pm);
#pragma unroll
        for (int ai = 0; ai < 2; ++ai)
#pragma unroll
            for (int m = 0; m < 4; ++m) { const int row = row0 + ai * HALF + m * 16;
                float rs;
                if (tab) rs = rtab[wr * 64 + fr + ai * HALF + m * 16];
                else { const f32x4 p0 = *(const f32x4*)(sump + (size_t)row * 8), p1 = *(const f32x4*)(sump + (size_t)row * 8 + 4);
                       rs = __builtin_amdgcn_rsqf((((p0[0] + p0[1]) + (p0[2] + p0[3])) + ((p1[0] + p1[1]) + (p1[2] + p1[3]))) * (1.0f / 2048.0f) + 1e-6f); }
                bf16_t* rowp = O + (size_t)row * ldc + col0;
#pragma unroll
                for (int bj = 0; bj < 2; ++bj) { const f32x4 v0 = acc[ai][bj][m][0] * rs, v1 = acc[ai][bj][m][1] * rs;
                    u32x4 w; w.x = cvt_pk_bf16(v0[0], v0[1]); w.y = cvt_pk_bf16(v0[2], v0[3]); w.z = cvt_pk_bf16(v1[0], v1[1]); w.w = cvt_pk_bf16(v1[2], v1[3]);
                    *(u32x4*)(rowp + bj * HALF) = w; } }
    }
};
struct EpiOut {
    static constexpr bool PERM = true, AFTER_DRAIN = false;
    bf16_t* x; float* sump_next; PG8_LAS float* xs;
    __device__ __forceinline__ void operator()(const f32x4 (&acc)[2][2][4][2], const Unit& u, int wr, int wc, int fr, int fq) const {
        const int row0 = u.pm * BM + wr * 64 + fr, col0 = u.pn * BM + wc * 32 + 8 * fq;
#pragma unroll
        for (int ai = 0; ai < 2; ++ai) {
            u32x4 xo[4][2];
#pragma unroll
            for (int m = 0; m < 4; ++m) { const size_t off = (size_t)(row0 + ai * HALF + m * 16) * 2048 + col0;
#pragma unroll
                for (int bj = 0; bj < 2; ++bj) xo[m][bj] = *(const u32x4*)(x + off + bj * HALF); }
            asm volatile("" ::: "memory");
#pragma unroll
            for (int m = 0; m < 4; ++m) { const size_t off = (size_t)(row0 + ai * HALF + m * 16) * 2048 + col0; float ss = 0.f;
#pragma unroll
                for (int bj = 0; bj < 2; ++bj) {
                    const u32x4 o = xo[m][bj]; u32x4 w;
#pragma unroll
                    for (int k = 0; k < 4; ++k) { const float lo = __uint_as_float(o[k] << 16) + acc[ai][bj][m][k >> 1][(k & 1) * 2], hi = __uint_as_float(o[k] & 0xffff0000u) + acc[ai][bj][m][k >> 1][(k & 1) * 2 + 1];
                        const unsigned p = cvt_pk_bf16(lo, hi); w[k] = p;
                        const float rl = __uint_as_float(p << 16), rh = __uint_as_float(p & 0xffff0000u); ss += rl * rl + rh * rh; }
                    *(u32x4*)(x + off + bj * HALF) = w; }
                ss += __shfl_xor(ss, 16); ss += __shfl_xor(ss, 32);
                if (fq == 0) xs[(ai * HALF + wr * 64 + m * 16 + fr) * 4 + wc] = ss; }
            asm volatile("" ::: "memory");
        }
        asm volatile("s_waitcnt lgkmcnt(0)" ::: "memory"); __builtin_amdgcn_s_barrier(); asm volatile("" ::: "memory");
        { const int t = threadIdx.x; if (t < 256) { const f32x4 p = *(const PG8_LAS f32x4*)(xs + 4 * t); sump_next[(size_t)(u.pm * BM + t) * 8 + u.pn] = (p[0] + p[1]) + (p[2] + p[3]); } }
    }
};
template <class Epi, class Sched, bool ALIGN_EPI = false, bool SP2 = false>
__device__ __forceinline__ void gemm_phase(PG8_LAS unsigned char* lds, const Gemm g, const Sched& S, const Epi& E) {
    int tid_op = threadIdx.x; asm volatile("" : "+v"(tid_op));
    const int tid = tid_op, wid = __builtin_amdgcn_readfirstlane(tid >> 6), lane = tid & 63, wr = wid >> 2, wc = wid & 3, fr = lane & 15, fq = lane >> 4;
    const int K = g.K, nt = K / BK;
    unsigned voffA[2], voffB[2];
#pragma unroll
    for (int i = 0; i < 2; ++i) { int R, C; stage_rc(tid * 16 + i * 8192, R, C); const int Rb = Epi::PERM ? ((R & ~31) + perm32(R & 31)) : R;
        voffA[i] = (unsigned)(R * K + C) * 2u; voffB[i] = (unsigned)(Rb * K + C) * 2u; }
    const size_t kstep = (size_t)(BK * 2);
    const size_t hstep = (size_t)HALF * K * 2;
    const size_t tstep = 2 * hstep;
    const unsigned ldsw = (unsigned)wid * 1024u;
    const int aoff = lds_byte(wr * 64 + fr, fq * 8), boff = lds_byte(wc * 32 + fr, fq * 8);
#define PG8_SA(b, h) (((b) * 2 + (h)) * HTB)
#define PG8_SB(b, h) ((4 + (b) * 2 + (h)) * HTB)
#define PG8_STAGE(bufoff, gbase, voff) do { _Pragma("unroll") for (int _i = 0; _i < 2; ++_i) \
        __builtin_amdgcn_global_load_lds((const unsigned*)((const char*)(gbase) + (voff)[_i]), (PG8_LAS unsigned*)(lds + (bufoff) + ldsw + _i * 8192), 16, 0, 0); } while (0)
#define PG8_LDA(dst, b, h) do { _Pragma("unroll") for (int m = 0; m < 4; ++m) _Pragma("unroll") for (int k = 0; k < 2; ++k) dst[m][k] = *(const PG8_LAS bf16x8*)(lds + PG8_SA(b, h) + aoff + m * 2048 + k * 1024); } while (0)
#define PG8_LDB(dst, b, h) do { _Pragma("unroll") for (int n = 0; n < 2; ++n) _Pragma("unroll") for (int k = 0; k < 2; ++k) dst[n][k] = *(const PG8_LAS bf16x8*)(lds + PG8_SB(b, h) + boff + n * 2048 + k * 1024); } while (0)
#define PG8_MMA(ai, bj, At, Bt) do { __builtin_amdgcn_s_setprio(1); _Pragma("unroll") for (int m = 0; m < 4; ++m) _Pragma("unroll") for (int n = 0; n < 2; ++n) _Pragma("unroll") for (int k = 0; k < 2; ++k) \
        acc[ai][bj][m][n] = __builtin_amdgcn_mfma_f32_16x16x32_bf16(Bt[n][k], At[m][k], acc[ai][bj][m][n], 0, 0, 0); __builtin_amdgcn_s_setprio(0); } while (0)
#define PG8_WAIT_V(n) asm volatile("s_waitcnt vmcnt(" #n ")" ::: "memory")
#define PG8_WAIT_L(n) asm volatile("s_waitcnt lgkmcnt(" #n ")" ::: "memory")
#define PG8_BAR __builtin_amdgcn_s_barrier()
#define PG8_SCHED __builtin_amdgcn_sched_barrier(0)
    Unit cur, nxt; int ui = 0;
    if (!S.next(0, cur)) return;
    f32x4 acc[2][2][4][2];
#pragma unroll
    for (int a = 0; a < 2; ++a)
#pragma unroll
        for (int b = 0; b < 2; ++b)
#pragma unroll
            for (int m = 0; m < 4; ++m)
#pragma unroll
                for (int n = 0; n < 2; ++n) acc[a][b][m][n] = (f32x4){0.f, 0.f, 0.f, 0.f};
    bf16x8 At[4][2], B0[2][2], B1[2][2];
    const char* cA = (const char*)g.A + (size_t)cur.pm * tstep; const char* cB = (const char*)g.Bt + (size_t)cur.pn * tstep;
    S.a_ready(cur);
    if constexpr (SP2) {
        PG8_STAGE(PG8_SB(0, 0), cB, voffB); PG8_STAGE(PG8_SB(0, 1), cB + hstep, voffB); PG8_STAGE(PG8_SA(0, 0), cA, voffA); PG8_STAGE(PG8_SA(0, 1), cA + hstep, voffA);
        if (wr == 1) PG8_BAR;
        PG8_WAIT_V(2); PG8_BAR;
        PG8_STAGE(PG8_SB(1, 0), cB + kstep, voffB); PG8_STAGE(PG8_SA(1, 0), cA + kstep, voffA); PG8_STAGE(PG8_SB(1, 1), cB + hstep + kstep, voffB);
        PG8_WAIT_V(6); PG8_BAR;
    } else {
        PG8_STAGE(PG8_SB(0, 0), cB, voffB); PG8_STAGE(PG8_SA(0, 0), cA, voffA); PG8_STAGE(PG8_SB(0, 1), cB + hstep, voffB); PG8_STAGE(PG8_SA(0, 1), cA + hstep, voffA);
        if (wr == 1) PG8_BAR;
        PG8_WAIT_V(4); PG8_BAR;
        PG8_STAGE(PG8_SB(1, 0), cB + kstep, voffB); PG8_STAGE(PG8_SA(1, 0), cA + kstep, voffA); PG8_STAGE(PG8_SB(1, 1), cB + hstep + kstep, voffB);
        PG8_WAIT_V(6); PG8_BAR;
    }
    for (;;) {
        const bool has_next = S.next(ui + 1, nxt);
        const char* nA = has_next ? (const char*)g.A + (size_t)nxt.pm * tstep : cA; const char* nB = has_next ? (const char*)g.Bt + (size_t)nxt.pn * tstep : cB;
        for (int t = 0; t < nt; t += 2) {
            const bool last = (t == nt - 2);
            const char* a1 = cA + (size_t)(t + 1) * kstep;
            const char* a2 = last ? nA : cA + (size_t)(t + 2) * kstep; const char* b2 = last ? nB : cB + (size_t)(t + 2) * kstep;
            const char* a3 = a2 + kstep; const char* b3 = b2 + kstep;
            if (last && has_next) S.a_ready(nxt);
            if constexpr (SP2) {
            PG8_LDB(B0, 0, 0); PG8_LDB(B1, 0, 1); PG8_SCHED; PG8_LDA(At, 0, 0); PG8_STAGE(PG8_SA(1, 1), a1 + hstep, voffA);
            PG8_WAIT_V(8); PG8_WAIT_L(0); PG8_BAR; PG8_MMA(0, 0, At, B0); PG8_MMA(0, 1, At, B1); PG8_BAR; PG8_SCHED;
            PG8_LDA(At, 0, 1); PG8_STAGE(PG8_SB(0, 0), b2, voffB); PG8_STAGE(PG8_SB(0, 1), b2 + hstep, voffB); PG8_STAGE(PG8_SA(0, 0), a2, voffA);
            PG8_WAIT_V(8); PG8_WAIT_L(0); PG8_BAR; PG8_MMA(1, 0, At, B0); PG8_MMA(1, 1, At, B1); PG8_BAR; PG8_SCHED;
            PG8_LDB(B0, 1, 0); PG8_LDB(B1, 1, 1); PG8_SCHED; PG8_LDA(At, 1, 0); PG8_STAGE(PG8_SA(0, 1), a2 + hstep, voffA);
            PG8_WAIT_V(8); PG8_WAIT_L(0); PG8_BAR; PG8_MMA(0, 0, At, B0); PG8_MMA(0, 1, At, B1); PG8_BAR; PG8_SCHED;
            PG8_LDA(At, 1, 1); PG8_STAGE(PG8_SB(1, 0), b3, voffB); PG8_STAGE(PG8_SB(1, 1), b3 + hstep, voffB); PG8_STAGE(PG8_SA(1, 0), a3, voffA);
            PG8_WAIT_V(8); PG8_WAIT_L(0); PG8_BAR; PG8_MMA(1, 0, At, B0); PG8_MMA(1, 1, At, B1); PG8_BAR; PG8_SCHED;
            } else {
            PG8_LDB(B0, 0, 0); PG8_SCHED; PG8_LDA(At, 0, 0); PG8_STAGE(PG8_SA(1, 1), a1 + hstep, voffA);
            PG8_WAIT_L(8); PG8_BAR; PG8_WAIT_L(0); PG8_MMA(0, 0, At, B0); PG8_BAR; PG8_SCHED;
            PG8_LDB(B1, 0, 1); PG8_STAGE(PG8_SB(0, 0), b2, voffB);
            PG8_BAR; PG8_WAIT_L(0); PG8_MMA(0, 1, At, B1); PG8_BAR;
            PG8_LDA(At, 0, 1); PG8_STAGE(PG8_SA(0, 0), a2, voffA);
            PG8_BAR; PG8_WAIT_L(0); PG8_MMA(1, 0, At, B0); PG8_BAR; PG8_SCHED;
            PG8_STAGE(PG8_SB(0, 1), b2 + hstep, voffB);
            PG8_WAIT_V(6); PG8_BAR; PG8_MMA(1, 1, At, B1); PG8_BAR;
            PG8_LDB(B0, 1, 0); PG8_SCHED; PG8_LDA(At, 1, 0); PG8_STAGE(PG8_SA(0, 1), a2 + hstep, voffA);
            PG8_WAIT_L(8); PG8_BAR; PG8_WAIT_L(0); PG8_MMA(0, 0, At, B0); PG8_BAR; PG8_SCHED;
            PG8_LDB(B1, 1, 1); PG8_STAGE(PG8_SB(1, 0), b3, voffB);
            PG8_BAR; PG8_WAIT_L(0); PG8_MMA(0, 1, At, B1); PG8_BAR;
            PG8_LDA(At, 1, 1); PG8_STAGE(PG8_SA(1, 0), a3, voffA);
            PG8_BAR; PG8_WAIT_L(0); PG8_MMA(1, 0, At, B0); PG8_BAR; PG8_SCHED;
            PG8_STAGE(PG8_SB(1, 1), b3 + hstep, voffB);
            PG8_WAIT_V(6); PG8_BAR; PG8_MMA(1, 1, At, B1); PG8_BAR;
            }
        }
        if constexpr (ALIGN_EPI) { if (wr == 0) PG8_BAR; }
        if constexpr (!Epi::AFTER_DRAIN) { E(acc, cur, wr, wc, fr, fq); S.done(cur); }
        if (!has_next) break;
#pragma unroll
        for (int a = 0; a < 2; ++a)
#pragma unroll
            for (int b = 0; b < 2; ++b)
#pragma unroll
                for (int m = 0; m < 4; ++m)
#pragma unroll
                    for (int n = 0; n < 2; ++n) acc[a][b][m][n] = (f32x4){0.f, 0.f, 0.f, 0.f};
        cur = nxt; cA = nA; cB = nB; ++ui;
        if constexpr (ALIGN_EPI) { if (wr == 1) PG8_BAR; }
    }
    PG8_WAIT_V(0);
    if constexpr (!ALIGN_EPI) { if (wr == 0) PG8_BAR; }
    PG8_BAR;
    if constexpr (Epi::AFTER_DRAIN) { E.fused(acc, cur, wr, wc, fr, fq, lds, wid, lane); S.done(cur); }
#undef PG8_SA
#undef PG8_SB
#undef PG8_STAGE
#undef PG8_LDA
#undef PG8_LDB
#undef PG8_MMA
#undef PG8_WAIT_V
#undef PG8_WAIT_L
#undef PG8_BAR
#undef PG8_SCHED
}
}
#define GAS __attribute__((address_space(1)))
#define LAS __attribute__((address_space(3)))
typedef unsigned v4u __attribute__((ext_vector_type(4)));
typedef float f32x4 __attribute__((ext_vector_type(4)));
typedef short bf16x8 __attribute__((ext_vector_type(8)));
typedef GAS unsigned gu32;
#define RLX_AGENT __ATOMIC_RELAXED, __HIP_MEMORY_SCOPE_AGENT
#define LDS_WAIT() asm volatile("s_waitcnt lgkmcnt(0)" ::: "memory")
#define VM_WAIT() asm volatile("s_waitcnt vmcnt(0)" ::: "memory")
#define XB_TMO      128
#define XB_XCNT(j)  (256  + 64 * (j))
#define XB_XSUB(j)  (1280 + 64 * (j))
#define XB_XGEN(j)  (2304 + 64 * (j))
#define XB_TOP      3328
#define XB_TOPGEN   3392
#define XCD_BAR_WORDS 3456
#define XB_SPIN_CAP (1u << 18)

__device__ __forceinline__ unsigned xb_ld(unsigned* p)              { return __hip_atomic_load(p, __ATOMIC_RELAXED, __HIP_MEMORY_SCOPE_AGENT); }
__device__ __forceinline__ unsigned xb_add(unsigned* p, unsigned v) { return __hip_atomic_fetch_add(p, v, __ATOMIC_RELAXED, __HIP_MEMORY_SCOPE_AGENT); }
__device__ __forceinline__ unsigned xb_xcc_id() { return (unsigned)__builtin_amdgcn_s_getreg((3 << 11) | 20) & 0xFu; }
#define XB_SPIN(cond, bar) do { unsigned _sp = 0; while (cond) { __builtin_amdgcn_s_sleep(1); \
    if ((++_sp & 255u) == 0u) { if (xb_ld(&(bar)[XB_TMO])) break; if (_sp > XB_SPIN_CAP) { atomicAdd(&(bar)[XB_TMO], 1u); break; } } } } while (0)

struct XcdBarrier {
    unsigned* bar; unsigned x;
    volatile LAS unsigned* st;
};

__device__ __forceinline__ XcdBarrier xcd_barrier_post(unsigned* bar, volatile LAS unsigned* st) {
    XcdBarrier b; b.bar = bar; b.x = xb_xcc_id(); b.st = st;
    if (threadIdx.x == 0) (void)xb_add(&bar[XB_XCNT(b.x)], 1u);
    return b;
}
__device__ __forceinline__ void xcd_barrier_complete(unsigned* bar, unsigned x, unsigned& nloc, unsigned& nx) {
    const unsigned G = gridDim.x * gridDim.y * gridDim.z;
    unsigned sum, cnt, mine, sp = 0u;
    for (;;) {
        sum = 0u; cnt = 0u; mine = 0u;
#pragma unroll
        for (unsigned j = 0; j < 16; ++j) { const unsigned c = xb_ld(&bar[XB_XCNT(j)]); sum += c; cnt += (c > 0u) ? 1u : 0u; mine = (j == x) ? c : mine; }
        if (sum == G) break;
        __builtin_amdgcn_s_sleep(1);
        if ((++sp & 255u) == 0u) { if (xb_ld(&bar[XB_TMO])) break; if (sp > XB_SPIN_CAP) { atomicAdd(&bar[XB_TMO], 1u); break; } }
    }
    nloc = mine > 0u ? mine : 1u; nx = cnt > 0u ? cnt : 1u;
}

__device__ __forceinline__ void xcd_barrier(const XcdBarrier& b) {
    asm volatile("s_waitcnt vmcnt(0)" ::: "memory");
    __syncthreads();
    if (threadIdx.x == 0) {
        unsigned* bar = b.bar;
        __builtin_amdgcn_s_waitcnt(0);
        unsigned nloc = b.st[0], nx = b.st[1];
        if (nloc == 0u) { xcd_barrier_complete(bar, b.x, nloc, nx); b.st[0] = nloc; b.st[1] = nx; }
        const unsigned old = xb_add(&bar[XB_XSUB(b.x)], 1u);
        const unsigned gen = old / nloc;
        if (old + 1u == (gen + 1u) * nloc) {
            __builtin_amdgcn_fence(__ATOMIC_RELEASE, "agent");
            asm volatile("s_waitcnt vmcnt(0)" ::: "memory");
            const unsigned og = xb_add(&bar[XB_TOP], 1u);
            const unsigned tg = og / nx;
            if (og + 1u == (tg + 1u) * nx) xb_add(&bar[XB_TOPGEN], 1u);
            else XB_SPIN(xb_ld(&bar[XB_TOPGEN]) == tg, bar);
            __builtin_amdgcn_fence(__ATOMIC_ACQUIRE, "agent");
            xb_add(&bar[XB_XGEN(b.x)], 1u);
            asm volatile("s_waitcnt vmcnt(0)" ::: "memory");
        } else {
            XB_SPIN(xb_ld(&bar[XB_XGEN(b.x)]) == gen, bar);
            __builtin_amdgcn_fence(__ATOMIC_ACQUIRE, "agent");
            asm volatile("s_waitcnt vmcnt(0)" ::: "memory");
        }
    }
    __syncthreads();
}

typedef short s16x4 __attribute__((ext_vector_type(4)));
typedef unsigned u32x2 __attribute__((ext_vector_type(2)));
__device__ __forceinline__ float fast_sigmoid(float x) { return __builtin_amdgcn_rcpf(1.f + __builtin_amdgcn_exp2f(-1.4426950408889634f * x)); }
__device__ __forceinline__ float fast_silu(float x) { return x * fast_sigmoid(x); }
__device__ __forceinline__ float fast_gelu(float x) { return x * fast_sigmoid(x * (1.5957691216057308f + 0.0713548162726f * x * x)); }
__device__ __forceinline__ float bflo(unsigned w) { return __uint_as_float(w << 16); }
__device__ __forceinline__ float bfhi(unsigned w) { return __uint_as_float(w & 0xffff0000u); }
typedef float f32x2_t __attribute__((ext_vector_type(2))); typedef __bf16 bf16x2_t __attribute__((ext_vector_type(2)));
__device__ __forceinline__ unsigned cvtpk(float lo, float hi) { const f32x2_t v = {lo, hi}; const bf16x2_t b = __builtin_convertvector(v, bf16x2_t); return __builtin_bit_cast(unsigned, b); }
__device__ __forceinline__ s16x4 tr_read(const LAS unsigned char* p) { return __builtin_bit_cast(s16x4, __builtin_amdgcn_ds_read_tr16_b64_v4i16((LAS s16x4*)p)); }
__device__ __forceinline__ bf16x8 frag_tr(const LAS unsigned char* base, int stride, int lane) {
    const int G = lane >> 4, q = (lane >> 2) & 3, p = lane & 3;
    const LAS unsigned char* a = base + (4 * G + q) * stride + 8 * p;
    const s16x4 lo = tr_read(a), hi = tr_read(a + 16 * stride);
    return (bf16x8){lo[0], lo[1], lo[2], lo[3], hi[0], hi[1], hi[2], hi[3]};
}
__device__ __forceinline__ bf16x8 frag_perm_row(const LAS unsigned char* rowbase, int stride, int lane) {
    const LAS unsigned char* a = rowbase + (lane & 15) * stride + 8 * (lane >> 4);
    const s16x4 lo = *(const LAS s16x4*)a, hi = *(const LAS s16x4*)(a + 32);
    return (bf16x8){lo[0], lo[1], lo[2], lo[3], hi[0], hi[1], hi[2], hi[3]};
}

constexpr int SGU_VF_STRIDE = 544, SGU_W_STRIDE = 272, SGU_VF_OFF = 0, SGU_W_OFF = 128 * SGU_VF_STRIDE;
__device__ __forceinline__ void sgu_item(LAS unsigned char* lds, int item, const bf16* Z, const float* v_norm, const float* w_s, const float* b_s, bf16* Y, int tid) {
    const int lane = tid & 63, wave = __builtin_amdgcn_readfirstlane(tid >> 6);
    const int g = item & 3, c = (item >> 2) & 15, b = item >> 6;
    const size_t tok0 = (size_t)b * SEQ + 128 * c;
    LAS unsigned char* VF = lds + SGU_VF_OFF; LAS unsigned char* WS = lds + SGU_W_OFF;
    {
        const int sub = lane >> 4, cl = lane & 15;
        float vn[16];
#pragma unroll
        for (int j = 0; j < 4; ++j) { const f32x4 t = *(const f32x4*)(v_norm + g * 256 + 16 * cl + 4 * j); vn[4 * j] = t[0]; vn[4 * j + 1] = t[1]; vn[4 * j + 2] = t[2]; vn[4 * j + 3] = t[3]; }
        v4u wv[4][2];
#pragma unroll
        for (int ps = 0; ps < 4; ++ps) { const v4u* src = (const v4u*)(Z + (tok0 + 16 * wave + 4 * ps + sub) * OD_Z + 4096 + 256 * g + 16 * cl); wv[ps][0] = src[0]; wv[ps][1] = src[1]; }
#pragma unroll
        for (int ps = 0; ps < 4; ++ps) {
            const int row = 16 * wave + 4 * ps + sub;
            const v4u w0 = wv[ps][0], w1 = wv[ps][1];
            float x[16];
#pragma unroll
            for (int j = 0; j < 4; ++j) { x[2 * j] = fast_gelu(bflo(w0[j])); x[2 * j + 1] = fast_gelu(bfhi(w0[j])); x[8 + 2 * j] = fast_gelu(bflo(w1[j])); x[9 + 2 * j] = fast_gelu(bfhi(w1[j])); }
            float s = 0.f;
#pragma unroll
            for (int j = 0; j < 16; ++j) s += x[j];
            s += __shfl_xor(s, 1); s += __shfl_xor(s, 2); s += __shfl_xor(s, 4); s += __shfl_xor(s, 8);
            const float mu = s * (1.f / 256.f);
            float q = 0.f;
#pragma unroll
            for (int j = 0; j < 16; ++j) { x[j] -= mu; q += x[j] * x[j]; }
            q += __shfl_xor(q, 1); q += __shfl_xor(q, 2); q += __shfl_xor(q, 4); q += __shfl_xor(q, 8);
            const float rstd = __builtin_amdgcn_rsqf(q * (1.f / 256.f) + 1e-6f);
            v4u o0, o1;
#pragma unroll
            for (int j = 0; j < 4; ++j) { o0[j] = cvtpk(x[2 * j] * rstd * vn[2 * j], x[2 * j + 1] * rstd * vn[2 * j + 1]); o1[j] = cvtpk(x[8 + 2 * j] * rstd * vn[8 + 2 * j], x[9 + 2 * j] * rstd * vn[9 + 2 * j]); }
            LAS v4u* dst = (LAS v4u*)(VF + row * SGU_VF_STRIDE + 32 * cl);
            dst[0] = o0; dst[1] = o1;
        }
    }
    {
        const int t = tid >> 2, s0 = (tid & 3) * 32;
        const f32x4* src = (const f32x4*)(w_s + ((size_t)g * 128 + t) * 128 + s0);
#pragma unroll
        for (int j = 0; j < 4; ++j) { const f32x4 a = src[2 * j], bb = src[2 * j + 1]; const int s = s0 + 8 * j;
            v4u o; o[0] = cvtpk(s + 0 <= t ? a[0] : 0.f, s + 1 <= t ? a[1] : 0.f); o[1] = cvtpk(s + 2 <= t ? a[2] : 0.f, s + 3 <= t ? a[3] : 0.f);
            o[2] = cvtpk(s + 4 <= t ? bb[0] : 0.f, s + 5 <= t ? bb[1] : 0.f); o[3] = cvtpk(s + 6 <= t ? bb[2] : 0.f, s + 7 <= t ? bb[3] : 0.f);
            *(LAS v4u*)(WS + t * SGU_W_STRIDE + 2 * s) = o; }
    }
    __syncthreads();
    u32x2 uv[8][2], gv[8][2];
    {
        const int G = lane >> 4, tl = lane & 15;
#pragma unroll
        for (int tb = 0; tb < 8; ++tb) { const bf16* zr = Z + (tok0 + 16 * tb + tl) * OD_Z + 256 * g;
#pragma unroll
            for (int eb = 0; eb < 2; ++eb) { const int e = 16 * (2 * wave + eb) + 4 * G; uv[tb][eb] = *(const u32x2*)(zr + 3072 + e); gv[tb][eb] = *(const u32x2*)(zr + 5120 + e); } }
    }
    f32x4 acc[2][8];
#pragma unroll
    for (int eb = 0; eb < 2; ++eb)
#pragma unroll
        for (int tb = 0; tb < 8; ++tb) acc[eb][tb] = (f32x4){0.f, 0.f, 0.f, 0.f};
#pragma unroll
    for (int ks = 0; ks < 4; ++ks) {
        bf16x8 af[2];
#pragma unroll
        for (int eb = 0; eb < 2; ++eb) af[eb] = frag_tr(VF + (32 * ks) * SGU_VF_STRIDE + (16 * (2 * wave + eb)) * 2, SGU_VF_STRIDE, lane);
#pragma unroll
        for (int tb = 2 * ks; tb < 8; ++tb) {
            const bf16x8 bfr = frag_perm_row(WS + (16 * tb) * SGU_W_STRIDE + (32 * ks) * 2, SGU_W_STRIDE, lane);
#pragma unroll
            for (int eb = 0; eb < 2; ++eb) acc[eb][tb] = __builtin_amdgcn_mfma_f32_16x16x32_bf16(af[eb], bfr, acc[eb][tb], 0, 0, 0);
        }
    }
    {
        const int G = lane >> 4, tl = lane & 15;
#pragma unroll
        for (int tb = 0; tb < 8; ++tb) {
            const int t = 16 * tb + tl; const float bs = b_s[g * 128 + t];
            bf16* yr = Y + (tok0 + t) * DM + 1024 + 256 * g;
#pragma unroll
            for (int eb = 0; eb < 2; ++eb) {
                const int e = 16 * (2 * wave + eb) + 4 * G;
                const u32x2 uu = uv[tb][eb], gg = gv[tb][eb];
                const f32x4 a = acc[eb][tb];
                const float y0 = fast_gelu(bflo(uu[0])) * (a[0] + bs) * fast_silu(bflo(gg[0])), y1 = fast_gelu(bfhi(uu[0])) * (a[1] + bs) * fast_silu(bfhi(gg[0]));
                const float y2 = fast_gelu(bflo(uu[1])) * (a[2] + bs) * fast_silu(bflo(gg[1])), y3 = fast_gelu(bfhi(uu[1])) * (a[3] + bs) * fast_silu(bfhi(gg[1]));
                u32x2 o; o[0] = cvtpk(y0, y1); o[1] = cvtpk(y2, y3);
                *(u32x2*)(yr + e) = o;
            }
        }
    }
    __syncthreads();
}

constexpr int AT_STRIDE = 288, AT_K_OFF = 0, AT_V_OFF = 256 * AT_STRIDE, AT_V_ROWS = 272, AT_LDS_END = AT_V_OFF + AT_V_ROWS * AT_STRIDE;
struct AtStage { v4u k[8], v[8]; bf16x8 q[4]; };
__device__ __forceinline__ void attn_load(AtStage& sg, int item, const bf16* Z, int tid) {
    const int lane = tid & 63, wave = __builtin_amdgcn_readfirstlane(tid >> 6), G = lane >> 4, ql = lane & 15;
    const int g = item >> 8, rem = item & 255, j = rem & 3, rn = (rem >> 2) & 15, b = rem >> 6;
    const int d = 1 << (2 * g), nb = 16 >> (2 * g), n = rn % nb, r = rn / nb;
    const size_t tokb = (size_t)b * SEQ;
    { const size_t qtok = tokb + (size_t)(128 * n + 16 * wave + ql) * d + r; const bf16* qp = Z + qtok * EV_IN + 3072 + g * 512 + j * 128 + 8 * G;
#pragma unroll
      for (int ks = 0; ks < 4; ++ks) sg.q[ks] = *(const bf16x8*)(qp + 32 * ks); }
    const int c16 = tid & 15, rw = tid >> 4;
    const bf16* kb = Z + 4608 + g * 512 + j * 128 + 8 * c16;
#pragma unroll
    for (int ps = 0; ps < 8; ++ps) {
        const int kk = 32 * ps + rw; const int l = 128 * (n - 1) + kk; const int lc = l < 0 ? 0 : l;
        const bf16* p = kb + (tokb + (size_t)lc * d + r) * EV_IN;
        sg.k[ps] = *(const v4u*)p; sg.v[ps] = *(const v4u*)(p + 1536);
        if (l < 0) { sg.k[ps] = (v4u){0u, 0u, 0u, 0u}; sg.v[ps] = (v4u){0u, 0u, 0u, 0u}; }
    }
}
__device__ __forceinline__ void attn_items(LAS unsigned char* lds, int first, int step, int cnt, const bf16* Z, bf16* OG, float* LSE, int tid) {
    const int lane = tid & 63, wave = __builtin_amdgcn_readfirstlane(tid >> 6), G = lane >> 4, ql = lane & 15;
    LAS unsigned char* KT = lds + AT_K_OFF; LAS unsigned char* VT = lds + AT_V_OFF;
    if (cnt <= 0) return;
    AtStage sg;
    attn_load(sg, first, Z, tid);
    for (int it = 0; it < cnt; ++it) {
    const int item = first + it * step;
    const int g = item >> 8, rem = item & 255, j = rem & 3, rn = (rem >> 2) & 15, b = rem >> 6;
    const int d = 1 << (2 * g), nb = 16 >> (2 * g), n = rn % nb, r = rn / nb;
    const size_t tokb = (size_t)b * SEQ;
    const int q0 = 16 * wave;
    const size_t qtok = tokb + (size_t)(128 * n + q0 + ql) * d + r;
    bf16x8 qf[4];
#pragma unroll
    for (int ks = 0; ks < 4; ++ks) qf[ks] = sg.q[ks];
    {
        const int c16 = tid & 15, rw = tid >> 4;
#pragma unroll
        for (int ps = 0; ps < 8; ++ps) { const int kk = 32 * ps + rw; *(LAS v4u*)(KT + kk * AT_STRIDE + 16 * c16) = sg.k[ps]; *(LAS v4u*)(VT + kk * AT_STRIDE + 16 * c16) = sg.v[ps]; }
        { unsigned z = 0u; asm volatile("" : "+v"(z));
          if (tid < 16 * 18) *(LAS v4u*)(VT + 256 * AT_STRIDE + 16 * tid) = (v4u){z, z, z, z}; }
    }
    __syncthreads();
    f32x4 sc[9];
#pragma unroll
    for (int t = 0; t < 9; ++t) {
        sc[t] = (f32x4){0.f, 0.f, 0.f, 0.f};
        const LAS unsigned char* kp = KT + (16 * wave + 16 * t + ql) * AT_STRIDE + 16 * G;
#pragma unroll
        for (int ks = 0; ks < 4; ++ks) sc[t] = __builtin_amdgcn_mfma_f32_16x16x32_bf16(*(const LAS bf16x8*)(kp + 64 * ks), qf[ks], sc[t], 0, 0, 0);
    }
    const float slope2 = exp2f(-8.0f * (float)(g + 3 * j + 1) / 12.0f) * (float)d * 1.4426950408889634f;
    const float scale2 = 0.08838834764831845f * 1.4426950408889634f;
    float mx = -INFINITY;
#pragma unroll
    for (int t = 0; t < 9; ++t)
#pragma unroll
        for (int rg = 0; rg < 4; ++rg) {
            const int rel = 16 * t + 4 * G + rg - ql;
            const bool ok = (rel >= 0) && (rel <= 128) && (n > 0 || (q0 + ql + rel) >= 128);
            const float s = sc[t][rg] * scale2 - slope2 * (float)(128 - rel);
            sc[t][rg] = ok ? s : -INFINITY;
            mx = fmaxf(mx, sc[t][rg]);
        }
    mx = fmaxf(mx, __shfl_xor(mx, 16)); mx = fmaxf(mx, __shfl_xor(mx, 32));
    float den = 0.f;
#pragma unroll
    for (int t = 0; t < 9; ++t)
#pragma unroll
        for (int rg = 0; rg < 4; ++rg) { const float p = __builtin_amdgcn_exp2f(sc[t][rg] - mx); sc[t][rg] = p; den += p; }
    den += __shfl_xor(den, 16); den += __shfl_xor(den, 32);
    if (it + 1 < cnt) attn_load(sg, item + step, Z, tid);
    f32x4 oc[8];
#pragma unroll
    for (int dvb = 0; dvb < 8; ++dvb) oc[dvb] = (f32x4){0.f, 0.f, 0.f, 0.f};
#pragma unroll
    for (int s = 0; s < 5; ++s) {
        const f32x4 plo = sc[2 * s], phi = (s < 4) ? sc[2 * s + 1] : (f32x4){0.f, 0.f, 0.f, 0.f};
        const unsigned w0 = cvtpk(plo[0], plo[1]), w1 = cvtpk(plo[2], plo[3]), w2 = cvtpk(phi[0], phi[1]), w3 = cvtpk(phi[2], phi[3]);
        const bf16x8 pf = __builtin_bit_cast(bf16x8, (v4u){w0, w1, w2, w3});
#pragma unroll
        for (int dvb = 0; dvb < 8; ++dvb) {
            const bf16x8 vf = frag_tr(VT + (16 * wave + 32 * s) * AT_STRIDE + (16 * dvb) * 2, AT_STRIDE, lane);
            oc[dvb] = __builtin_amdgcn_mfma_f32_16x16x32_bf16(vf, pf, oc[dvb], 0, 0, 0);
        }
    }
    const float rden = __builtin_amdgcn_rcpf(den);
    bf16* op = OG + ((size_t)g * MTOK + qtok) * 512 + j * 128 + 4 * G;
#pragma unroll
    for (int dvb = 0; dvb < 8; ++dvb) { u32x2 o; o[0] = cvtpk(oc[dvb][0] * rden, oc[dvb][1] * rden); o[1] = cvtpk(oc[dvb][2] * rden, oc[dvb][3] * rden); *(u32x2*)(op + 16 * dvb) = o; }
    if (G == 0) LSE[((size_t)g * MTOK + qtok) * 4 + j] = mx + __builtin_amdgcn_logf(den);
    __syncthreads();
    }
}
__device__ __forceinline__ void attn_merge(const bf16* Z, const bf16* OG, const float* LSE, bf16* Y, int gtid, int gthreads) {
    for (int it = gtid; it < MTOK * 64; it += gthreads) {
        const int tok = it >> 6, c8 = it & 63, j = c8 >> 4;
        const float l0 = LSE[((size_t)0 * MTOK + tok) * 4 + j], l1 = LSE[((size_t)1 * MTOK + tok) * 4 + j], l2 = LSE[((size_t)2 * MTOK + tok) * 4 + j];
        const float m = fmaxf(l0, fmaxf(l1, l2));
        float w0 = __builtin_amdgcn_exp2f(l0 - m), w1 = __builtin_amdgcn_exp2f(l1 - m), w2 = __builtin_amdgcn_exp2f(l2 - m);
        const float rs = __builtin_amdgcn_rcpf(w0 + w1 + w2); w0 *= rs; w1 *= rs; w2 *= rs;
        const v4u a = *(const v4u*)(OG + ((size_t)0 * MTOK + tok) * 512 + 8 * c8), bb = *(const v4u*)(OG + ((size_t)1 * MTOK + tok) * 512 + 8 * c8), cc = *(const v4u*)(OG + ((size_t)2 * MTOK + tok) * 512 + 8 * c8);
        const v4u gt = *(const v4u*)(Z + (size_t)tok * EV_IN + 7680 + 8 * c8);
        v4u o;
#pragma unroll
        for (int k = 0; k < 4; ++k) {
            const float ylo = (w0 * bflo(a[k]) + w1 * bflo(bb[k]) + w2 * bflo(cc[k])) * fast_silu(bflo(gt[k]));
            const float yhi = (w0 * bfhi(a[k]) + w1 * bfhi(bb[k]) + w2 * bfhi(cc[k])) * fast_silu(bfhi(gt[k]));
            o[k] = cvtpk(ylo, yhi);
        }
        *(v4u*)(Y + (size_t)tok * DM + 1536 + 8 * c8) = o;
    }
}

constexpr int LR_XC_STRIDE = 272, LR_XC_OFF = 0, LR_F_STRIDE = 528  , LR_XCF_OFF = 128 * LR_XC_STRIDE, LR_A_OFF = LR_XCF_OFF + 32 * LR_F_STRIDE, LR_U_OFF = LR_A_OFF + 32 * LR_F_STRIDE, LR_CW_OFF = LR_U_OFF + 32 * LR_F_STRIDE  , LR_LDS_END = LR_CW_OFF + 5 * 128 * 4;
struct LruParams { const float *conv_w, *conv_b, *b_a, *b_i, *lam; const bf16* wg; };
__device__ __forceinline__ void lru_load_tile(v4u (&xa)[7], v4u& ga, const bf16* Z, size_t tokb, int t0, int h, int c4, int tid) {
    const int co = tid & 15, rg = tid >> 4;
#pragma unroll
    for (int k = 0; k < 7; ++k) { const int t = t0 + 4 * rg + k - 3; const int tc = t < 0 ? 0 : t;
        const v4u v = *(const v4u*)(Z + (tokb + tc) * EV_IN + h * 128 + 8 * co);
        xa[k] = (v4u){t >= 0 ? v[0] : 0u, t >= 0 ? v[1] : 0u, t >= 0 ? v[2] : 0u, t >= 0 ? v[3] : 0u}; }
    ga = *(const v4u*)(Z + (tokb + t0 + (tid >> 2)) * EV_IN + 1536 + h * 128 + 32 * c4 + 8 * (tid & 3));
}
__device__ __forceinline__ void lru_item(LAS unsigned char* lds, int item, const bf16* Z, const LruParams& P, bf16* Y, int tid) {
    const int lane = tid & 63, wave = __builtin_amdgcn_readfirstlane(tid >> 6), G = lane >> 4, ql = lane & 15;
    const int c4 = item & 3, h = (item >> 2) % 12, b = item / 48;
    const size_t tokb = (size_t)b * SEQ;
    LAS unsigned char* XC = lds + LR_XC_OFF; LAS unsigned char* XCF = lds + LR_XCF_OFF; LAS unsigned char* AL = lds + LR_A_OFF; LAS unsigned char* UL = lds + LR_U_OFF;
    bf16x8 wf[2][2][4];
#pragma unroll
    for (int gate = 0; gate < 2; ++gate)
#pragma unroll
        for (int cb = 0; cb < 2; ++cb)
#pragma unroll
            for (int ks = 0; ks < 4; ++ks) wf[gate][cb][ks] = *(const bf16x8*)(P.wg + ((size_t)(h * 2 + gate) * 128 + 32 * c4 + 16 * cb + ql) * 128 + 32 * ks + 8 * G);
    float ba[2], bi[2], sp8[2];
#pragma unroll
    for (int cb = 0; cb < 2; ++cb) { const int ch = h * 128 + 32 * c4 + 16 * cb + ql; ba[cb] = P.b_a[ch]; bi[cb] = P.b_i[ch];
        const float nl = -P.lam[ch]; sp8[cb] = 8.0f * (nl > 20.f ? nl : log1pf(__expf(nl))); }
    LAS float* CW = (LAS float*)(lds + LR_CW_OFF);
    if (tid < 128) {
#pragma unroll
        for (int q = 0; q < 4; ++q) CW[q * 128 + tid] = P.conv_w[q * LRU_W + h * 128 + tid];
        CW[4 * 128 + tid] = P.conv_b[h * 128 + tid];
    }
    __syncthreads();
    float hc = 0.f;
    v4u xa[7], ga;
    lru_load_tile(xa, ga, Z, tokb, 0, h, c4, tid);
    for (int sc = 0; sc < 16; ++sc) {
        const int t0 = 128 * sc;
        {
            const int co = tid & 15, rg = tid >> 4;
            v4u orow[4];
            const bool mine = (co >> 2) == c4;
#pragma unroll
            for (int e = 0; e < 4; ++e) {
                typedef float f32x2 __attribute__((ext_vector_type(2)));
                const int chn = 8 * co + 2 * e;
                const f32x2 w0 = *(const LAS f32x2*)(CW + 0 * 128 + chn), w1 = *(const LAS f32x2*)(CW + 1 * 128 + chn), w2 = *(const LAS f32x2*)(CW + 2 * 128 + chn), w3 = *(const LAS f32x2*)(CW + 3 * 128 + chn);
                const f32x2 cb2 = *(const LAS f32x2*)(CW + 4 * 128 + chn);
                float lo[7], hi[7];
#pragma unroll
                for (int k = 0; k < 7; ++k) { lo[k] = bflo(xa[k][e]); hi[k] = bfhi(xa[k][e]); }
                f32x4 xlo, xhi;
#pragma unroll
                for (int r = 0; r < 4; ++r) { xlo[r] = cb2[0] + w0[0] * lo[r] + w1[0] * lo[r + 1] + w2[0] * lo[r + 2] + w3[0] * lo[r + 3];
                                              xhi[r] = cb2[1] + w0[1] * hi[r] + w1[1] * hi[r + 1] + w2[1] * hi[r + 2] + w3[1] * hi[r + 3]; orow[r][e] = cvtpk(xlo[r], xhi[r]); }
                if (mine) { *(LAS f32x4*)(XCF + (8 * (co & 3) + 2 * e) * LR_F_STRIDE + 16 * rg) = xlo; *(LAS f32x4*)(XCF + (8 * (co & 3) + 2 * e + 1) * LR_F_STRIDE + 16 * rg) = xhi; }
            }
#pragma unroll
            for (int r = 0; r < 4; ++r) *(LAS v4u*)(XC + (4 * rg + r) * LR_XC_STRIDE + 16 * co) = orow[r];
        }
        const v4u ga_cur = ga;
        if (sc < 15) lru_load_tile(xa, ga, Z, tokb, t0 + 128, h, c4, tid);
        __syncthreads();
        f32x4 acc[2][2];

#pragma unroll
        for (int gate = 0; gate < 2; ++gate)
#pragma unroll
            for (int cb = 0; cb < 2; ++cb) acc[gate][cb] = (f32x4){0.f, 0.f, 0.f, 0.f};
#pragma unroll
        for (int ks = 0; ks < 4; ++ks) {
            const bf16x8 af = *(const LAS bf16x8*)(XC + (16 * wave + ql) * LR_XC_STRIDE + 64 * ks + 16 * G);
#pragma unroll
            for (int gate = 0; gate < 2; ++gate)
#pragma unroll
                for (int cb = 0; cb < 2; ++cb) acc[gate][cb] = __builtin_amdgcn_mfma_f32_16x16x32_bf16(af, wf[gate][cb][ks], acc[gate][cb], 0, 0, 0);
        }
#pragma unroll
        for (int cb = 0; cb < 2; ++cb) {
            const int off = (16 * cb + ql) * LR_F_STRIDE + (16 * wave + 4 * G) * 4;
            const f32x4 xcv = *(const LAS f32x4*)(XCF + off);
            f32x4 av, uv;
#pragma unroll
            for (int rg2 = 0; rg2 < 4; ++rg2) {
                const float r = fast_sigmoid(acc[0][cb][rg2] + ba[cb]), ig = fast_sigmoid(acc[1][cb][rg2] + bi[cb]);
                const float la = -r * sp8[cb];
                const float a = __builtin_amdgcn_exp2f(la * 1.4426950408889634f);
                const float x2 = 2.f * la;
                const float om = (x2 > -0.05f) ? -x2 * (1.f + x2 * (0.5f + x2 * (0.16666667f + x2 * 0.041666667f))) : 1.f - a * a;
                av[rg2] = a; uv[rg2] = __builtin_amdgcn_sqrtf(om) * ig * xcv[rg2];
            }
            *(LAS f32x4*)(AL + off) = av; *(LAS f32x4*)(UL + off) = uv;
        }
        __syncthreads();
        {
            const int seg = ql, off = (4 * wave + G) * LR_F_STRIDE + 32 * seg;
            const f32x4 a0 = *(const LAS f32x4*)(AL + off), a1 = *(const LAS f32x4*)(AL + off + 16), u0 = *(const LAS f32x4*)(UL + off), u1 = *(const LAS f32x4*)(UL + off + 16);
            float Pp = 1.f, Hh = 0.f;
#pragma unroll
            for (int k = 0; k < 4; ++k) { Hh = a0[k] * Hh + u0[k]; Pp *= a0[k]; }
#pragma unroll
            for (int k = 0; k < 4; ++k) { Hh = a1[k] * Hh + u1[k]; Pp *= a1[k]; }
#pragma unroll
            for (int o = 1; o < 16; o <<= 1) { const float Pl = __shfl_up(Pp, o, 16), Hl = __shfl_up(Hh, o, 16); if (seg >= o) { Hh = Pp * Hl + Hh; Pp = Pp * Pl; } }
            float Pe = __shfl_up(Pp, 1, 16), He = __shfl_up(Hh, 1, 16);
            if (seg == 0) { Pe = 1.f; He = 0.f; }
            float hh = Pe * hc + He;
            f32x4 h0, h1;
#pragma unroll
            for (int k = 0; k < 4; ++k) { hh = a0[k] * hh + u0[k]; h0[k] = hh; }
#pragma unroll
            for (int k = 0; k < 4; ++k) { hh = a1[k] * hh + u1[k]; h1[k] = hh; }
            *(LAS f32x4*)(UL + off) = h0; *(LAS f32x4*)(UL + off + 16) = h1;
            hc = __shfl(hh, (lane & 48) + 15);
        }
        __syncthreads();
        {
            const int tk = tid >> 2, oc = tid & 3;
            float hv[8];
#pragma unroll
            for (int e = 0; e < 8; ++e) hv[e] = *(const LAS float*)(UL + (8 * oc + e) * LR_F_STRIDE + 4 * tk);
            v4u o;
#pragma unroll
            for (int e = 0; e < 4; ++e) o[e] = cvtpk(hv[2 * e] * fast_silu(bflo(ga_cur[e])), hv[2 * e + 1] * fast_silu(bfhi(ga_cur[e])));
            *(v4u*)(Y + (tokb + t0 + tk) * DM + h * 128 + 32 * c4 + 8 * oc) = o;
        }
    }
    __syncthreads();
}

constexpr int G1_ALR_OFF = 0, G1_TOT_OFF = 4096, G1_LDS_END = 6144;
__device__ __forceinline__ void gla1a_item(LAS unsigned char* lds, int item, const bf16* Z, const float* ALR, const float* w_alpha, const float* b_alpha, bf16* QT, bf16* KT, bf16* KD, float* DEC, int tid) {
    const int c = item & 31, h = (item >> 5) & 3, b = item >> 7;
    const size_t tok0 = (size_t)b * SEQ + 64 * c;
    LAS float* ALRs = (LAS float*)(lds + G1_ALR_OFF); LAS float* TOT = (LAS float*)(lds + G1_TOT_OFF);
    if (tid < 256) *(LAS f32x4*)(ALRs + 4 * tid) = *(const f32x4*)(ALR + tok0 * 16 + 4 * tid);
    const int e = tid & 127, tq = tid >> 7;
    float wa[16];
#pragma unroll
    for (int r = 0; r < 16; ++r) wa[r] = w_alpha[r * 512 + h * 128 + e];
    const float bal = b_alpha[h * 128 + e];
    float qv[16], kv[16];
#pragma unroll
    for (int t = 0; t < 16; ++t) { const bf16* zr = Z + (tok0 + 16 * tq + t) * OD_Z + h * 128 + e; qv[t] = bf2f(zr[0]); kv[t] = bf2f(zr[512]); }
    __syncthreads();
    float bc[16]; float run = 0.f;
#pragma unroll
    for (int t = 0; t < 16; ++t) {
        float s = bal;
#pragma unroll
        for (int r = 0; r < 16; ++r) s += ALRs[(16 * tq + t) * 16 + r] * wa[r];
        const float sp = (s < -20.f) ? -s : __builtin_amdgcn_logf(1.f + __builtin_amdgcn_exp2f(-s * 1.4426950408889634f)) * 0.6931471805599453f;
        run -= sp * 0.0625f; bc[t] = run;
    }
    TOT[tq * 128 + e] = run;
    __syncthreads();
    const float t0s = TOT[e], t1s = TOT[128 + e], t2s = TOT[256 + e], t3s = TOT[384 + e];
    const float offs = (tq > 0 ? t0s : 0.f) + (tq > 1 ? t1s : 0.f) + (tq > 2 ? t2s : 0.f), blast = (t0s + t1s) + (t2s + t3s);
    if (tq == 0) DEC[(size_t)item * 128 + e] = __builtin_amdgcn_exp2f(blast * 1.4426950408889634f);
#pragma unroll
    for (int t = 0; t < 16; ++t) {
        const float bb = bc[t] + offs;
        const float eb = __builtin_amdgcn_exp2f(bb * 1.4426950408889634f), enb = __builtin_amdgcn_exp2f(-bb * 1.4426950408889634f), edl = __builtin_amdgcn_exp2f((blast - bb) * 1.4426950408889634f);
        const size_t o = (tok0 + 16 * tq + t) * 512 + h * 128 + e;
        QT[o] = (bf16)f2bf(qv[t] * 0.08838834764831845f * eb); KT[o] = (bf16)f2bf(kv[t] * enb); KD[o] = (bf16)f2bf(kv[t] * edl);
    }
    __syncthreads();
}

constexpr int G2_KD_STRIDE = 288, G2_V_STRIDE = 160, G2_KD_OFF = 0, G2_V_OFF = 64 * G2_KD_STRIDE, G2_BUF = G2_V_OFF + 64 * G2_V_STRIDE, G2_DEC_OFF = 2 * G2_BUF, G2_SIMG_OFF = G2_DEC_OFF + 32 * 128 * 4,
              G2_SIMG_STRIDE = 272, G2_SIMG = 64 * G2_SIMG_STRIDE, G2_LDS_END = G2_SIMG_OFF + 2 * G2_SIMG;
struct Gla2Stage { v4u kd[2], v; };
__device__ __forceinline__ void gla2_load(Gla2Stage& st, const bf16* Z, const bf16* KD, size_t tok0, int h, int slice, int tid) {
    const int rw = tid >> 4, c16 = tid & 15;
#pragma unroll
    for (int ps = 0; ps < 2; ++ps) st.kd[ps] = *(const v4u*)(KD + (tok0 + 32 * ps + rw) * 512 + h * 128 + 8 * c16);
    st.v = *(const v4u*)(Z + (tok0 + (tid >> 3)) * OD_Z + 1024 + h * 256 + 64 * slice + 8 * (tid & 7));
}
__device__ __forceinline__ void gla2_store(const Gla2Stage& st, LAS unsigned char* buf, int tid) {
    const int rw = tid >> 4, c16 = tid & 15;
#pragma unroll
    for (int ps = 0; ps < 2; ++ps) *(LAS v4u*)(buf + G2_KD_OFF + (32 * ps + rw) * G2_KD_STRIDE + 16 * c16) = st.kd[ps];
    *(LAS v4u*)(buf + G2_V_OFF + (tid >> 3) * G2_V_STRIDE + 16 * (tid & 7)) = st.v;
}
__device__ __forceinline__ void gla2_flush(const LAS unsigned char* img, bf16* SST, int bh, int c, int slice, int tid) {
    const int rw = tid >> 4, c16 = tid & 15;
#pragma unroll
    for (int ps = 0; ps < 2; ++ps) *(v4u*)(SST + ((size_t)(bh * 32 + c) * 256 + 64 * slice + 32 * ps + rw) * 128 + 8 * c16) = *(const LAS v4u*)(img + (32 * ps + rw) * G2_SIMG_STRIDE + 16 * c16);
}
__device__ __forceinline__ void gla2s_item(LAS unsigned char* lds, int item, const bf16* Z, const bf16* KD, const float* DEC, bf16* SST, int tid) {
    const int lane = tid & 63, wave = __builtin_amdgcn_readfirstlane(tid >> 6), G = lane >> 4, ql = lane & 15;
    const int slice = item & 3, bh = item >> 2, h = bh & 3, b = bh >> 2;
    const size_t tokb = (size_t)b * SEQ;
    f32x4 sacc[4];
#pragma unroll
    for (int db = 0; db < 4; ++db) sacc[db] = (f32x4){0.f, 0.f, 0.f, 0.f};
    { Gla2Stage st; gla2_load(st, Z, KD, tokb, h, slice, tid); gla2_store(st, lds, tid);
#pragma unroll
      for (int k = 0; k < 2; ++k) *(LAS f32x4*)(lds + G2_DEC_OFF + 16 * (tid + 512 * k)) = *(const f32x4*)(DEC + (size_t)(bh * 32) * 128 + 4 * (tid + 512 * k)); }
    __syncthreads();
    for (int c = 0; c < 32; ++c) {
        LAS unsigned char* buf = lds + (c & 1) * G2_BUF;
        LAS unsigned char* img = lds + G2_SIMG_OFF + (c & 1) * G2_SIMG;
        Gla2Stage st;
        if (c < 31) gla2_load(st, Z, KD, tokb + 64 * (c + 1), h, slice, tid);
        if (c > 0) gla2_flush(lds + G2_SIMG_OFF + ((c - 1) & 1) * G2_SIMG, SST, bh, c - 1, slice, tid);
#pragma unroll
        for (int db = 0; db < 4; ++db) { u32x2 o; o[0] = cvtpk(sacc[db][0], sacc[db][1]); o[1] = cvtpk(sacc[db][2], sacc[db][3]); *(LAS u32x2*)(img + (16 * db + ql) * G2_SIMG_STRIDE + (16 * wave + 4 * G) * 2) = o; }
        const f32x4 dec = *(const LAS f32x4*)(lds + G2_DEC_OFF + (128 * c + 16 * wave + 4 * G) * 4);
#pragma unroll
        for (int db = 0; db < 4; ++db) sacc[db] *= dec;
#pragma unroll
        for (int s = 0; s < 2; ++s) {
            const bf16x8 kf = frag_tr(buf + G2_KD_OFF + (32 * s) * G2_KD_STRIDE + (16 * wave) * 2, G2_KD_STRIDE, lane);
#pragma unroll
            for (int db = 0; db < 4; ++db) {
                const bf16x8 vf = frag_tr(buf + G2_V_OFF + (32 * s) * G2_V_STRIDE + (16 * db) * 2, G2_V_STRIDE, lane);
                sacc[db] = __builtin_amdgcn_mfma_f32_16x16x32_bf16(kf, vf, sacc[db], 0, 0, 0);
            }
        }
        if (c < 31) gla2_store(st, lds + ((c + 1) & 1) * G2_BUF, tid);
        __syncthreads();
    }
    gla2_flush(lds + G2_SIMG_OFF + (31 & 1) * G2_SIMG, SST, bh, 31, slice, tid);
    __syncthreads();
}

constexpr int G3_QK_STRIDE = 272, G3_V_STRIDE = 544, G3_QT_OFF = 0, G3_KT_OFF = G3_QT_OFF + 64 * G3_QK_STRIDE, G3_V_OFF = G3_KT_OFF + 64 * G3_QK_STRIDE, G3_ST_OFF = G3_V_OFF + 64 * G3_V_STRIDE,
              G3_PART_OFF = G3_ST_OFF + 256 * G3_QK_STRIDE, G3_LDS_END = G3_PART_OFF + 8 * 16 * 4;
struct G3Stage { v4u qt[2], kt[2], v[4], st[8]; };
__device__ __forceinline__ void gla3_load(G3Stage& sg, int item, const bf16* Z, const bf16* QT, const bf16* KT, const bf16* SST, int tid) {
    const int c = item & 31, h = (item >> 5) & 3, b = item >> 7; const size_t tok0 = (size_t)b * SEQ + 64 * c;
    const int rw = tid >> 4, c16 = tid & 15, rv = tid >> 5, c32 = tid & 31;
#pragma unroll
    for (int ps = 0; ps < 2; ++ps) { const size_t o = (tok0 + 32 * ps + rw) * 512 + h * 128 + 8 * c16; sg.qt[ps] = *(const v4u*)(QT + o); sg.kt[ps] = *(const v4u*)(KT + o); }
#pragma unroll
    for (int ps = 0; ps < 4; ++ps) sg.v[ps] = *(const v4u*)(Z + (tok0 + 16 * ps + rv) * OD_Z + 1024 + h * 256 + 8 * c32);
    const bf16* sp = SST + (size_t)item * 256 * 128;
#pragma unroll
    for (int ps = 0; ps < 8; ++ps) sg.st[ps] = *(const v4u*)(sp + (size_t)(32 * ps + rw) * 128 + 8 * c16);
}
__device__ __forceinline__ void gla3_store(const G3Stage& sg, LAS unsigned char* lds, int tid) {
    const int rw = tid >> 4, c16 = tid & 15, rv = tid >> 5, c32 = tid & 31;
#pragma unroll
    for (int ps = 0; ps < 2; ++ps) { *(LAS v4u*)(lds + G3_QT_OFF + (32 * ps + rw) * G3_QK_STRIDE + 16 * c16) = sg.qt[ps]; *(LAS v4u*)(lds + G3_KT_OFF + (32 * ps + rw) * G3_QK_STRIDE + 16 * c16) = sg.kt[ps]; }
#pragma unroll
    for (int ps = 0; ps < 4; ++ps) *(LAS v4u*)(lds + G3_V_OFF + (16 * ps + rv) * G3_V_STRIDE + 16 * c32) = sg.v[ps];
#pragma unroll
    for (int ps = 0; ps < 8; ++ps) *(LAS v4u*)(lds + G3_ST_OFF + (32 * ps + rw) * G3_QK_STRIDE + 16 * c16) = sg.st[ps];
}
__device__ __forceinline__ void gla3_items(LAS unsigned char* lds, int first, int step, int last_excl, const bf16* Z, const bf16* QT, const bf16* KT, const bf16* SST, const float* head_norm, bf16* Y, int tid) {
    const int lane = tid & 63, wave = __builtin_amdgcn_readfirstlane(tid >> 6), G = lane >> 4, ql = lane & 15;
    LAS unsigned char* QTl = lds + G3_QT_OFF; LAS unsigned char* KTl = lds + G3_KT_OFF; LAS unsigned char* Vl = lds + G3_V_OFF; LAS unsigned char* STl = lds + G3_ST_OFF;
    LAS float* PART = (LAS float*)(lds + G3_PART_OFF);
    const int ib = wave >> 1, dh = wave & 1;
    if (first >= last_excl) return;
    G3Stage sg;
    gla3_load(sg, first, Z, QT, KT, SST, tid);
    for (int item = first; item < last_excl; item += step) {
        const int c = item & 31, h = (item >> 5) & 3, b = item >> 7;
        const size_t tok0 = (size_t)b * SEQ + 64 * c;
        gla3_store(sg, lds, tid);
        u32x2 gcv[8];
        { const bf16* gp = Z + (tok0 + 16 * ib + ql) * OD_Z + 2048 + h * 256 + 128 * dh + 4 * G;
#pragma unroll
          for (int dvb = 0; dvb < 8; ++dvb) gcv[dvb] = *(const u32x2*)(gp + 16 * dvb); }
        __syncthreads();
        bf16x8 qf[4];
#pragma unroll
        for (int ks = 0; ks < 4; ++ks) qf[ks] = *(const LAS bf16x8*)(QTl + (16 * ib + ql) * G3_QK_STRIDE + 64 * ks + 16 * G);
        f32x4 at[4];
#pragma unroll
        for (int jb = 0; jb < 4; ++jb) {
            at[jb] = (f32x4){0.f, 0.f, 0.f, 0.f};
            if (jb <= ib) {
#pragma unroll
                for (int ks = 0; ks < 4; ++ks) at[jb] = __builtin_amdgcn_mfma_f32_16x16x32_bf16(*(const LAS bf16x8*)(KTl + (16 * jb + ql) * G3_QK_STRIDE + 64 * ks + 16 * G), qf[ks], at[jb], 0, 0, 0);
#pragma unroll
                for (int rg = 0; rg < 4; ++rg) if (16 * jb + 4 * G + rg > 16 * ib + ql) at[jb][rg] = 0.f;
            }
        }
        f32x4 oc[8];
#pragma unroll
        for (int dvb = 0; dvb < 8; ++dvb) oc[dvb] = (f32x4){0.f, 0.f, 0.f, 0.f};
#pragma unroll
        for (int ks = 0; ks < 4; ++ks)
#pragma unroll
            for (int dvb = 0; dvb < 8; ++dvb)
                oc[dvb] = __builtin_amdgcn_mfma_f32_16x16x32_bf16(*(const LAS bf16x8*)(STl + (128 * dh + 16 * dvb + ql) * G3_QK_STRIDE + 64 * ks + 16 * G), qf[ks], oc[dvb], 0, 0, 0);
#pragma unroll
        for (int s = 0; s < 2; ++s) {
            if (2 * s <= ib) {
                const bf16x8 pf = __builtin_bit_cast(bf16x8, (v4u){cvtpk(at[2 * s][0], at[2 * s][1]), cvtpk(at[2 * s][2], at[2 * s][3]), cvtpk(at[2 * s + 1][0], at[2 * s + 1][1]), cvtpk(at[2 * s + 1][2], at[2 * s + 1][3])});
#pragma unroll
                for (int dvb = 0; dvb < 8; ++dvb) {
                    const bf16x8 vf = frag_tr(Vl + (32 * s) * G3_V_STRIDE + (128 * dh + 16 * dvb) * 2, G3_V_STRIDE, lane);
                    oc[dvb] = __builtin_amdgcn_mfma_f32_16x16x32_bf16(vf, pf, oc[dvb], 0, 0, 0);
                }
            }
        }
        float ss = 0.f;
#pragma unroll
        for (int dvb = 0; dvb < 8; ++dvb) ss += (oc[dvb][0] * oc[dvb][0] + oc[dvb][1] * oc[dvb][1]) + (oc[dvb][2] * oc[dvb][2] + oc[dvb][3] * oc[dvb][3]);
        ss += __shfl_xor(ss, 16); ss += __shfl_xor(ss, 32);
        if (G == 0) PART[wave * 16 + ql] = ss;
        __syncthreads();
        if (item + step < last_excl) gla3_load(sg, item + step, Z, QT, KT, SST, tid);
        const float rs = __builtin_amdgcn_rsqf((PART[(wave & ~1) * 16 + ql] + PART[(wave | 1) * 16 + ql]) * (1.f / 256.f) + 1e-6f);
        bf16* yp = Y + (tok0 + 16 * ib + ql) * DM + h * 256 + 128 * dh + 4 * G;
        const float* hp = head_norm + h * 256 + 128 * dh + 4 * G;
#pragma unroll
        for (int dvb = 0; dvb < 8; ++dvb) {
            const f32x4 hn = *(const f32x4*)(hp + 16 * dvb); const f32x4 o = oc[dvb]; const u32x2 gc = gcv[dvb];
            u32x2 y; y[0] = cvtpk(o[0] * rs * hn[0] * fast_silu(bflo(gc[0])), o[1] * rs * hn[1] * fast_silu(bfhi(gc[0])));
            y[1] = cvtpk(o[2] * rs * hn[2] * fast_silu(bflo(gc[1])), o[3] * rs * hn[3] * fast_silu(bfhi(gc[1])));
            *(u32x2*)(yp + 16 * dvb) = y;
        }
    }
    __syncthreads();
}
#define OPT_ATTN 1
#define OPT_LRU 1
#define OPT_GLA 1
constexpr int NWAVES = 8;
constexpr size_t MiB = 1u << 20;
constexpr size_t WS_CTL = 0, CTL_ZERO_BYTES = 1 * MiB;
constexpr size_t WS_WEVIN = 2 * MiB;
constexpr size_t WS_WEVOUT = 66 * MiB;
constexpr size_t WS_WODIN = 82 * MiB;
constexpr size_t WS_WODOUT = 130 * MiB;
constexpr size_t WS_WALR = 146 * MiB;
constexpr size_t WS_WGATE = 147 * MiB;
constexpr size_t WS_X = 150 * MiB;
constexpr size_t WS_XG = 214 * MiB;
constexpr size_t WS_Z = 246 * MiB;
constexpr size_t WS_Y = 374 * MiB;
constexpr size_t WS_ALR = 406 * MiB;
constexpr size_t WS_SUMP = 406 * MiB + 512 * 1024;
constexpr size_t WS_T0 = 408 * MiB;
constexpr size_t WS_T1 = 456 * MiB;
constexpr size_t WS_END = 504 * MiB;
constexpr int CW_BAR = 4096;
constexpr int MAX_LAUNCH = 8;
static_assert((CW_BAR + MAX_LAUNCH * XCD_BAR_WORDS) * 4 <= (int)CTL_ZERO_BYTES, "ctl map");
constexpr int RING_OFF = 0, RING_BYTES = 131072;
constexpr int LDSCTL_OFF = 152064, MISC_OFF = LDSCTL_OFF + 320;
constexpr int LDS_BYTES = 156160;
static_assert(G1_LDS_END <= LDSCTL_OFF && G2_LDS_END <= LDSCTL_OFF && G3_LDS_END <= LDSCTL_OFF && AT_LDS_END <= LDSCTL_OFF && LR_LDS_END <= LDSCTL_OFF && SGU_W_OFF + 128 * SGU_W_STRIDE <= LDSCTL_OFF, "LDS map");

constexpr int PH_PROLOGUE = 0, PH_FINAL = 21, N_PHASES = 22;

struct Args {
    const float* in[21]; float* out; unsigned char* ws;
    const float* gn[4];
    const float* xold[4];
    int ph_lo, ph_hi, li, pad;
};
#define CAS __attribute__((address_space(4)))
template <class T> __device__ __forceinline__ T* karg(const CAS char* ka, int byte_off) { T* p = *(T* const CAS*)(ka + byte_off); return (T*)(__attribute__((address_space(1))) T*)p; }
#define KIN(k) karg<const float>(ka_, 8 * (k))

__device__ __forceinline__ float wave_sum(float v) {
#pragma unroll
    for (int o = 1; o < 64; o <<= 1) v += __shfl_xor(v, o);
    return v;
}
__device__ __forceinline__ void p0_transpose_item(const float* W, int K, int ldw, int nblk, bf16* WT, int skip_at, int skip, const float* gk, LAS float* scr, int item, int lane) {
    const int kb = item / nblk, nb = item % nblk, k0 = 64 * kb, n0 = 64 * nb, s0 = n0 + (n0 >= skip_at ? skip : 0);
    const int c = lane & 7;
    f32x4 g0 = {1.f, 1.f, 1.f, 1.f}, g1 = {1.f, 1.f, 1.f, 1.f};
    if (gk) { g0 = *(const f32x4*)(gk + k0 + 8 * c); g1 = *(const f32x4*)(gk + k0 + 8 * c + 4); }
    { f32x4 wv[16];
#pragma unroll
      for (int i = 0; i < 16; ++i) wv[i] = __builtin_nontemporal_load((const f32x4*)(W + (size_t)(k0 + 4 * i + (lane >> 4)) * ldw + s0 + 4 * (lane & 15)));
#pragma unroll
      for (int i = 0; i < 16; ++i) *(LAS f32x4*)(scr + (4 * i + (lane >> 4)) * 68 + 4 * (lane & 15)) = wv[i]; }
    LDS_WAIT(); asm volatile("" ::: "memory");
#pragma unroll
    for (int j = 0; j < 8; ++j) { const int n = (lane >> 3) + 8 * j; const LAS float* s = scr + (8 * c) * 68 + n;
        v4u o; o.x = pk2(s[0 * 68] * g0[0], s[1 * 68] * g0[1]); o.y = pk2(s[2 * 68] * g0[2], s[3 * 68] * g0[3]); o.z = pk2(s[4 * 68] * g1[0], s[5 * 68] * g1[1]); o.w = pk2(s[6 * 68] * g1[2], s[7 * 68] * g1[3]);
        *(GAS v4u*)(WT + (size_t)(n0 + n) * K + k0 + 8 * c) = o; }
    LDS_WAIT(); asm volatile("" ::: "memory");
}

__global__ void __launch_bounds__(NWAVES * 64, 2) mk_fwd(Args args) {
    extern __shared__ __attribute__((aligned(16))) unsigned char lds_raw[];
    LAS unsigned char* lds = (LAS unsigned char*)lds_raw;
    volatile LAS unsigned* MISC = (volatile LAS unsigned*)(lds + MISC_OFF);
    const int G0 = gridDim.x;
    unsigned char* ws = args.ws;
    unsigned* ctl = (unsigned*)(ws + WS_CTL);
    float* SUMP = (float*)(ws + WS_SUMP);
    for (int u = threadIdx.x; u < (LDS_BYTES - LDSCTL_OFF) / 4; u += NWAVES * 64) ((LAS unsigned*)(lds + LDSCTL_OFF))[u] = 0u;
    __syncthreads();
    XcdBarrier bar = xcd_barrier_post(ctl + CW_BAR + args.li * XCD_BAR_WORDS, MISC + 8);

    float* X = (float*)(ws + WS_X); bf16* XG = (bf16*)(ws + WS_XG); bf16* Z = (bf16*)(ws + WS_Z); bf16* Y = (bf16*)(ws + WS_Y);
    float* ALR = (float*)(ws + WS_ALR);

#ifndef REP_COND
#define REP_COND(ph) false
#endif
    int rep_done = 0, first = 1;
    for (int ph = args.ph_lo; ph < args.ph_hi; ) {
        if (ph != PH_PROLOGUE && ph != PH_FINAL && ((ph - 1) % 5) == 3 && ((((ph - 1) / 5) & 1) == 0)) { ++ph; continue; }
        if (!first) xcd_barrier(bar);
        first = 0;
        int tid = threadIdx.x; asm volatile("" : "+v"(tid));
        int G = G0; asm volatile("" : "+s"(G));
        const int lane = tid & 63, wave = __builtin_amdgcn_readfirstlane(tid >> 6);
        const CAS char* ka_ = (const CAS char*)__builtin_amdgcn_kernarg_segment_ptr(); asm volatile("" : "+s"(ka_));
        const float* x_in = KIN(0);
        if (ph == PH_PROLOGUE) {
            LAS float* scr = (LAS float*)(lds + RING_OFF + wave * 17408);
            const int gw = blockIdx.x * NWAVES + wave, NGW = G * NWAVES;
            constexpr int I_EVIN = 32 * 128, I_EVOUT = 32 * 32, I_ODIN = 32 * 96, I_ODOUT = 32 * 32, I_GATE = 2 * 2;
            constexpr int NITEMS = 2 * (I_EVIN + I_EVOUT + I_ODIN + I_ODOUT) + 2 * 12 * 2 * I_GATE;
            for (int it = gw; it < NITEMS; it += NGW) {
                int r = it;
                if (r < 2 * I_EVIN) { const int i = r / I_EVIN; p0_transpose_item(KIN(2) + (size_t)i * DM * EV_IN, DM, EV_IN, 128, (bf16*)(ws + WS_WEVIN) + (size_t)i * EV_IN * DM, 1 << 30, 0, KIN(1) + (size_t)i * DM, scr, r % I_EVIN, lane); continue; } r -= 2 * I_EVIN;
                if (r < 2 * I_EVOUT) { const int i = r / I_EVOUT; p0_transpose_item(KIN(10) + (size_t)i * DM * DM, DM, DM, 32, (bf16*)(ws + WS_WEVOUT) + (size_t)i * DM * DM, 1 << 30, 0, nullptr, scr, r % I_EVOUT, lane); continue; } r -= 2 * I_EVOUT;
                if (r < 2 * I_ODIN) { const int i = r / I_ODIN; p0_transpose_item(KIN(12) + (size_t)i * DM * OD_IN, DM, OD_IN, 96, (bf16*)(ws + WS_WODIN) + (size_t)i * OD_Z * DM, 2048, 16, KIN(11) + (size_t)i * DM, scr, r % I_ODIN, lane); continue; } r -= 2 * I_ODIN;
                if (r < 2 * I_ODOUT) { const int i = r / I_ODOUT; p0_transpose_item(KIN(19) + (size_t)i * DM * DM, DM, DM, 32, (bf16*)(ws + WS_WODOUT) + (size_t)i * DM * DM, 1 << 30, 0, nullptr, scr, r % I_ODOUT, lane); continue; } r -= 2 * I_ODOUT;
                { const int mat = r / I_GATE, li2 = mat / 24, h = (mat % 24) >> 1, gate = mat & 1;
                  const float* src = KIN(gate ? 7 : 5) + ((size_t)li2 * 12 + h) * 128 * 128;
                  p0_transpose_item(src, 128, 128, 2, (bf16*)(ws + WS_WGATE) + (size_t)mat * 128 * 128, 1 << 30, 0, nullptr, scr, r % I_GATE, lane); }
            }
            for (int e = blockIdx.x * 512 + tid; e < 2 * 16 * 2048; e += G * 512) { const int i = e >> 15, j = (e >> 11) & 15, k = e & 2047;
                ((bf16*)(ws + WS_WALR))[e] = (bf16)f2bf(KIN(12)[(size_t)i * DM * OD_IN + (size_t)k * OD_IN + 2048 + j] * KIN(11)[(size_t)i * DM + k]); }
            for (int m = gw; m < MTOK; m += NGW) {
                const f32x4* xr = (const f32x4*)(x_in + (size_t)m * DM) + lane; float s = 0.f;
                unsigned long long* o8 = (unsigned long long*)(XG + (size_t)m * DM) + lane;
#pragma unroll
                for (int j = 0; j < 8; ++j) { const f32x4 v = __builtin_nontemporal_load(xr + 64 * j); const unsigned p0 = pk2(v[0], v[1]), p1 = pk2(v[2], v[3]);
                    const float r0 = __uint_as_float(p0 << 16), r1 = __uint_as_float(p0 & 0xffff0000u), r2 = __uint_as_float(p1 << 16), r3 = __uint_as_float(p1 & 0xffff0000u);
                    s += (r0 * r0 + r1 * r1) + (r2 * r2 + r3 * r3);
                    o8[64 * j] = (unsigned long long)p0 | ((unsigned long long)p1 << 32); }
                s = wave_sum(s);
                if (lane < 8) SUMP[(size_t)m * 8 + lane] = (lane == 0) ? s : 0.f;
            }
        } else if (ph == PH_FINAL) {
            const int gw = blockIdx.x * NWAVES + wave, NGW = G * NWAVES;
            const float* gf = KIN(20);
            for (int m = gw; m < MTOK; m += NGW) {
                const f32x4 p0 = *(const f32x4*)(SUMP + ((size_t)4 * 8192 + m) * 8), p1 = *(const f32x4*)(SUMP + ((size_t)4 * 8192 + m) * 8 + 4);
                const float rs = __builtin_amdgcn_rsqf((((p0[0] + p0[1]) + (p0[2] + p0[3])) + ((p1[0] + p1[1]) + (p1[2] + p1[3]))) * (1.0f / 2048.0f) + 1e-6f);
                const unsigned long long* xr = (const unsigned long long*)(XG + (size_t)m * DM) + lane; f32x4* o = (f32x4*)(args.out + (size_t)m * DM) + lane;
#pragma unroll
                for (int j = 0; j < 8; ++j) { const unsigned long long w = xr[64 * j]; const unsigned w0 = (unsigned)w, w1 = (unsigned)(w >> 32); const f32x4 gg = ((const f32x4*)gf)[lane + 64 * j];
                    __builtin_nontemporal_store((f32x4){__uint_as_float(w0 << 16) * gg[0] * rs, __uint_as_float(w0 & 0xffff0000u) * gg[1] * rs, __uint_as_float(w1 << 16) * gg[2] * rs, __uint_as_float(w1 & 0xffff0000u) * gg[3] * rs}, o + 64 * j); }
            }
        } else {
            const int L = (ph - 1) / 5, sub = (ph - 1) % 5, i = L >> 1, odd = L & 1;
            if (sub == 0) {
                const int N = odd ? OD_Z : EV_IN;
                const bf16* Wt = (const bf16*)(ws + (odd ? WS_WODIN : WS_WEVIN)) + (size_t)i * N * DM;
                pg8::Gemm g{XG, Wt, MTOK, N, DM}; pg8::StaticOrder S; S.init(MTOK, N, G, (int)blockIdx.x);
                LAS float* rtab = (LAS float*)(lds + RING_BYTES + 4096);
                pg8::Unit u0; u0.pm = 0; u0.pn = 0; (void)S.next(0, u0);
                if (tid < 256) { const float* sp_ = SUMP + ((size_t)L * 8192 + u0.pm * 256 + tid) * 8; const f32x4 p0 = *(const f32x4*)sp_, p1 = *(const f32x4*)(sp_ + 4);
                    rtab[tid] = __builtin_amdgcn_rsqf((((p0[0] + p0[1]) + (p0[2] + p0[3])) + ((p1[0] + p1[1]) + (p1[2] + p1[3]))) * (1.0f / 2048.0f) + 1e-6f); }
                __syncthreads();
                pg8::EpiIn E{Z, N, SUMP + (size_t)L * 8192 * 8, rtab, u0.pm};
                pg8::gemm_phase<pg8::EpiIn, pg8::StaticOrder, true, true>(lds + RING_OFF, g, S, E);
                if (odd) {
                    const bf16* WA = (const bf16*)(ws + WS_WALR) + (size_t)i * 16 * 2048;
                    for (int rb0 = blockIdx.x * 32; rb0 < MTOK; rb0 += G * 32) {
                        const int rb = wave & 1, kq = wave >> 1, fr = lane & 15, fq = lane >> 4;
                        const bf16* ap = XG + (size_t)(rb0 + 16 * rb + fr) * DM + kq * 512 + 8 * fq;
                        const bf16* bp = WA + (size_t)fr * DM + kq * 512 + 8 * fq;
                        f32x4 acc = {0.f, 0.f, 0.f, 0.f};
#pragma unroll 8
                        for (int ks = 0; ks < 16; ++ks) { const bf16x8 a = *(const bf16x8*)(ap + ks * 32), b = *(const bf16x8*)(bp + ks * 32);
                            acc = __builtin_amdgcn_mfma_f32_16x16x32_bf16(a, b, acc, 0, 0, 0); }
                        LAS float* part = (LAS float*)(lds + RING_OFF);
#pragma unroll
                        for (int r = 0; r < 4; ++r) part[(kq * 32 + 16 * rb + 4 * fq + r) * 16 + fr] = acc[r];
                        __syncthreads();
                        { const int row = tid >> 4, j = tid & 15;
                          const float s = (part[(0 * 32 + row) * 16 + j] + part[(1 * 32 + row) * 16 + j]) + (part[(2 * 32 + row) * 16 + j] + part[(3 * 32 + row) * 16 + j]);
                          const float* sp_ = SUMP + ((size_t)L * 8192 + rb0 + row) * 8; const f32x4 p0 = *(const f32x4*)sp_, p1 = *(const f32x4*)(sp_ + 4);
                          const float rs = __builtin_amdgcn_rsqf((((p0[0] + p0[1]) + (p0[2] + p0[3])) + ((p1[0] + p1[1]) + (p1[2] + p1[3]))) * (1.0f / 2048.0f) + 1e-6f);
                          ALR[(size_t)(rb0 + row) * 16 + j] = s * rs; }
                        __syncthreads();
                    }
                }
            } else if (sub == 4) {
                const bf16* Wt = (const bf16*)(ws + (odd ? WS_WODOUT : WS_WEVOUT)) + (size_t)i * DM * DM;
                pg8::Gemm g{Y, Wt, MTOK, DM, DM}; pg8::StaticOrder S; S.init(MTOK, DM, G, (int)blockIdx.x);
                pg8::EpiOut E{XG, SUMP + (size_t)(L + 1) * 8192 * 8, (LAS float*)(lds + RING_BYTES)};
                pg8::gemm_phase<pg8::EpiOut, pg8::StaticOrder, true, true>(lds + RING_OFF, g, S, E);
            }
            else if (sub == 1 && !odd) {
#ifdef OPT_LRU
                { LruParams P{KIN(3) + (size_t)i * 4 * LRU_W, KIN(4) + (size_t)i * LRU_W, KIN(6) + (size_t)i * LRU_W, KIN(8) + (size_t)i * LRU_W, KIN(9) + (size_t)i * LRU_W,
                              (const bf16*)(ws + WS_WGATE) + (size_t)i * 12 * 2 * 128 * 128};
                  for (int item = blockIdx.x; item < 192; item += G) lru_item(lds, item, Z, P, Y, tid); }
#endif
#ifdef OPT_ATTN
                { const bool bal = (G == 256); const int bx = blockIdx.x;
                  const int first = bal ? (bx < 192 ? bx : 192 + (bx - 192) * 9) : bx, cnt = bal ? (bx < 192 ? 1 : 9) : (768 - bx + G - 1) / G, step = bal ? 1 : G;
                  attn_items(lds, first, step, cnt, Z, (bf16*)(ws + WS_T0), (float*)(ws + WS_T1), tid); }
#endif
            } else if (sub == 2 && !odd) {
#ifdef OPT_ATTN
                attn_merge(Z, (const bf16*)(ws + WS_T0), (const float*)(ws + WS_T1), Y, blockIdx.x * 512 + tid, G * 512);
#endif
            }
            else if (sub == 1 && odd) {
                const float* wal = KIN(13) + (size_t)i * 16 * 512; const float* bal = KIN(14) + (size_t)i * 512;
                for (int item = blockIdx.x; item < 512; item += G)
                    gla1a_item(lds, item, Z, ALR, wal, bal, (bf16*)(ws + WS_T0), (bf16*)(ws + WS_T0 + 8 * MiB), (bf16*)(ws + WS_T0 + 16 * MiB), (float*)(ws + WS_T0 + 24 * MiB), tid);
            }
            else if (sub == 2 && odd) {
                const int nscan = (G >= 128) ? 64 : 0;
                if ((int)blockIdx.x < nscan || nscan == 0) {
                    for (int item = blockIdx.x; item < 64; item += (nscan ? nscan : G))
                        gla2s_item(lds, item, Z, (const bf16*)(ws + WS_T0 + 16 * MiB), (const float*)(ws + WS_T0 + 24 * MiB), (bf16*)(ws + WS_T1), tid);
                }
                if ((int)blockIdx.x >= nscan) {
                    const float* vn = KIN(16) + (size_t)i * 1024; const float* wsg = KIN(17) + (size_t)i * 4 * 128 * 128; const float* bsg = KIN(18) + (size_t)i * 4 * 128;
                    for (int item = blockIdx.x - nscan; item < 256; item += G - nscan) sgu_item(lds, item, Z, vn, wsg, bsg, Y, tid);
                }
            }
            else if (sub == 3 && odd) {
                gla3_items(lds, blockIdx.x, G, 512, Z, (const bf16*)(ws + WS_T0), (const bf16*)(ws + WS_T0 + 8 * MiB), (const bf16*)(ws + WS_T1), KIN(15) + (size_t)i * 1024, Y, tid);
            }
        }
        if (REP_COND(ph) && !rep_done) rep_done = 1; else { rep_done = 0; ++ph; }
    }
}

static void launch_mk(Args& a, int lo, int hi, int li, int grid, hipStream_t stream) {
    a.ph_lo = lo; a.ph_hi = hi; a.li = li;
    hipLaunchKernelGGL(mk_fwd, dim3(grid), dim3(NWAVES * 64), LDS_BYTES, stream, a);
}
extern "C" void kernel_launch(void* const* d_in, const int* in_sizes, int n_in, void* d_out, int out_size, void* d_ws, size_t ws_size, hipStream_t stream) {
    static int grid = 0;
    if (grid == 0) {
        if (n_in != 21 || ws_size < WS_END) { fprintf(stderr, "kernel_launch: unexpected n_in %d / ws_size %zu\n", n_in, ws_size); grid = -1; return; }
        int dev = 0, cus = 0, per_cu = 0;
        if (hipGetDevice(&dev) != hipSuccess || hipDeviceGetAttribute(&cus, hipDeviceAttributeMultiprocessorCount, dev) != hipSuccess) { grid = -1; return; }
        if (hipFuncSetAttribute((const void*)mk_fwd, hipFuncAttributeMaxDynamicSharedMemorySize, LDS_BYTES) != hipSuccess) { fprintf(stderr, "kernel_launch: hipFuncSetAttribute failed\n"); grid = -1; return; }
        if (hipOccupancyMaxActiveBlocksPerMultiprocessor(&per_cu, (const void*)mk_fwd, NWAVES * 64, LDS_BYTES) != hipSuccess || per_cu < 1) { fprintf(stderr, "kernel_launch: occupancy query says %d\n", per_cu); }
        (void)hipGetLastError();
        grid = cus;
    }
    if (grid < 0) return;
    hipMemsetAsync((char*)d_ws + WS_CTL, 0, CTL_ZERO_BYTES, stream);
    Args a{};
    for (int i = 0; i < 21; ++i) a.in[i] = (const float*)d_in[i];
    a.out = (float*)d_out; a.ws = (unsigned char*)d_ws;
    a.gn[0] = a.in[11]; a.gn[1] = a.in[1] + DM; a.gn[2] = a.in[11] + DM; a.gn[3] = a.in[20];
    a.xold[0] = a.in[0]; a.xold[1] = a.xold[2] = a.xold[3] = (const float*)((char*)d_ws + WS_X);
    launch_mk(a, 0, N_PHASES, 0, grid, stream);
}
```

```cpp
#include <hip/hip_runtime.h>
#include <cstdio>
#include <cstdint>

constexpr int DM = 2048, NB = 4, SEQ = 2048, MTOK = NB * SEQ;
constexpr int LRU_W = 1536, EV_IN = 8192;
constexpr int OD_IN = 6160, OD_Z = 6144;
constexpr float EPS = 1e-6f;

typedef unsigned short bf16;
typedef bf16 AT;

__device__ __forceinline__ float bf2f(bf16 v) { return __uint_as_float((unsigned)v << 16); }
__device__ __forceinline__ unsigned f2bf(float f) { unsigned u = __builtin_bit_cast(unsigned, f); return (u + 0x7fffu + ((u >> 16) & 1u)) >> 16; }
__device__ __forceinline__ unsigned pk2(float lo, float hi) { return f2bf(lo) | (f2bf(hi) << 16); }
__device__ __forceinline__ float ldA(const bf16* p, size_t i) { return bf2f(p[i]); }
__device__ __forceinline__ void stA(bf16* p, size_t i, float v) { p[i] = (bf16)f2bf(v); }

__device__ __forceinline__ float sigmoidf_(float x) { return 1.f / (1.f + __expf(-x)); }
__device__ __forceinline__ float siluf_(float x) { return x * sigmoidf_(x); }
__device__ __forceinline__ float geluf_(float x) { return 0.5f * x * (1.f + tanhf(0.7978845608028654f * (x + 0.044715f * x * x * x))); }
__device__ __forceinline__ float softplusf_(float x) { return x > 20.f ? x : log1pf(__expf(x)); }
__device__ __forceinline__ float logsigmoidf_(float x) { return -softplusf_(-x); }

namespace pg8 {
#define PG8_LAS __attribute__((address_space(3)))
typedef unsigned short bf16_t;
typedef short bf16x8 __attribute__((ext_vector_type(8)));
typedef float f32x4 __attribute__((ext_vector_type(4)));
typedef unsigned u32x4 __attribute__((ext_vector_type(4)));
constexpr int BM = 256, BK = 64, HALF = 128, HTB = HALF * BK * 2  , STAGE_BYTES = 8 * HTB, NXCD = 8, WGM = 8;

__host__ __device__ __forceinline__ int lds_byte(int r, int c) { const int st = (r >> 4) * 2 + (c >> 5), rr = r & 15, cc = c & 31, ob = rr * 64 + cc * 2; return st * 1024 + (ob ^ (((ob >> 9) & 1) << 5)); }
__host__ __device__ __forceinline__ void stage_rc(int b, int& R, int& C) { const int st = b / 1024, sb = b % 1024, swz = sb ^ (((sb >> 9) & 1) << 5); R = (st >> 1) * 16 + swz / 64; C = (st & 1) * 32 + (swz % 64) / 2; }
__host__ __device__ __forceinline__ int perm32(int rho) { const int n = rho >> 4, i = rho & 15; return 8 * (i >> 2) + 4 * n + (i & 3); }

struct Unit { int pm, pn; };
struct Gemm { const bf16_t* A; const bf16_t* Bt; int M, N, K; };

struct StaticOrder {
    int nM, nN, nwg, G, c;
    __host__ __device__ void init(int M, int N, int G_, int c_) { nM = M / BM; nN = N / BM; nwg = nM * nN; G = G_; c = c_; }
    __host__ __device__ bool next(int i, Unit& u) const {
        const long L = (long)i * G + c; if (L >= nwg) return false;
        int wgid = (int)L; { const int q = nwg / NXCD, r = nwg % NXCD, xcd = wgid % NXCD, off = wgid / NXCD; wgid = (xcd < r ? xcd * (q + 1) : r * (q + 1) + (xcd - r) * q) + off; }
        const int nig = WGM * nN, gid = wgid / nig, fm = gid * WGM, gsz = (nM - fm) < WGM ? (nM - fm) : WGM;
        u.pm = fm + ((wgid % nig) % gsz); u.pn = (wgid % nig) / gsz; return true;
    }
    __device__ __forceinline__ void a_ready(const Unit&) const {}
    __device__ __forceinline__ void done(const Unit&) const {}
};

__device__ __forceinline__ unsigned cvt_pk_bf16(float lo, float hi) { unsigned r; asm volatile("v_cvt_pk_bf16_f32 %0, %1, %2" : "=v"(r) : "v"(lo), "v"(hi)); return r; }
struct EpiIn {
    static constexpr bool PERM = true, AFTER_DRAIN = false;
    bf16_t* O; int ldc; const float* sump;
    const PG8_LAS float* rtab; int tab_pm;
    __device__ __forceinline__ void operator()(const f32x4 (&acc)[2][2][4][2], const Unit& u, int wr, int wc, int fr, int fq) const {
        const int row0 = u.pm * BM + wr * 64 + fr, col0 = u.pn * BM + wc * 32 + 8 * fq;
        const bool tab = (u.pm == tab_pm);
#pragma unroll
        for (int ai = 0; ai < 2; ++ai)
#pragma unroll
            for (int m = 0; m < 4; ++m) { const int row = row0 + ai * HALF + m * 16;
                float rs;
                if (tab) rs = rtab[wr * 64 + fr + ai * HALF + m * 16];
                else { const f32x4 p0 = *(const f32x4*)(sump + (size_t)row * 8), p1 = *(const f32x4*)(sump + (size_t)row * 8 + 4);
                       rs = __builtin_amdgcn_rsqf((((p0[0] + p0[1]) + (p0[2] + p0[3])) + ((p1[0] + p1[1]) + (p1[2] + p1[3]))) * (1.0f / 2048.0f) + 1e-6f); }
                bf16_t* rowp = O + (size_t)row * ldc + col0;
#pragma unroll
                for (int bj = 0; bj < 2; ++bj) { const f32x4 v0 = acc[ai][bj][m][0] * rs, v1 = acc[ai][bj][m][1] * rs;
                    u32x4 w; w.x = cvt_pk_bf16(v0[0], v0[1]); w.y = cvt_pk_bf16(v0[2], v0[3]); w.z = cvt_pk_bf16(v1[0], v1[1]); w.w = cvt_pk_bf16(v1[2], v1[3]);
                    *(u32x4*)(rowp + bj * HALF) = w; } }
    }
};
struct EpiOut {
    static constexpr bool PERM = true, AFTER_DRAIN = false;
    bf16_t* x; float* sump_next; PG8_LAS float* xs;
    __device__ __forceinline__ void operator()(const f32x4 (&acc)[2][2][4][2], const Unit& u, int wr, int wc, int fr, int fq) const {
        const int row0 = u.pm * BM + wr * 64 + fr, col0 = u.pn * BM + wc * 32 + 8 * fq;
#pragma unroll
        for (int ai = 0; ai < 2; ++ai) {
            u32x4 xo[4][2];
#pragma unroll
            for (int m = 0; m < 4; ++m) { const size_t off = (size_t)(row0 + ai * HALF + m * 16) * 2048 + col0;
#pragma unroll
                for (int bj = 0; bj < 2; ++bj) xo[m][bj] = *(const u32x4*)(x + off + bj * HALF); }
            asm volatile("" ::: "memory");
#pragma unroll
            for (int m = 0; m < 4; ++m) { const size_t off = (size_t)(row0 + ai * HALF + m * 16) * 2048 + col0; float ss = 0.f;
#pragma unroll
                for (int bj = 0; bj < 2; ++bj) {
                    const u32x4 o = xo[m][bj]; u32x4 w;
#pragma unroll
                    for (int k = 0; k < 4; ++k) { const float lo = __uint_as_float(o[k] << 16) + acc[ai][bj][m][k >> 1][(k & 1) * 2], hi = __uint_as_float(o[k] & 0xffff0000u) + acc[ai][bj][m][k >> 1][(k & 1) * 2 + 1];
                        const unsigned p = cvt_pk_bf16(lo, hi); w[k] = p;
                        const float rl = __uint_as_float(p << 16), rh = __uint_as_float(p & 0xffff0000u); ss += rl * rl + rh * rh; }
                    *(u32x4*)(x + off + bj * HALF) = w; }
                ss += __shfl_xor(ss, 16); ss += __shfl_xor(ss, 32);
                if (fq == 0) xs[(ai * HALF + wr * 64 + m * 16 + fr) * 4 + wc] = ss; }
            asm volatile("" ::: "memory");
        }
        asm volatile("s_waitcnt lgkmcnt(0)" ::: "memory"); __builtin_amdgcn_s_barrier(); asm volatile("" ::: "memory");
        { const int t = threadIdx.x; if (t < 256) { const f32x4 p = *(const PG8_LAS f32x4*)(xs + 4 * t); sump_next[(size_t)(u.pm * BM + t) * 8 + u.pn] = (p[0] + p[1]) + (p[2] + p[3]); } }
    }
};
template <class Epi, class Sched, bool ALIGN_EPI = false, bool SP2 = false>
__device__ __forceinline__ void gemm_phase(PG8_LAS unsigned char* lds, const Gemm g, const Sched& S, const Epi& E) {
    int tid_op = threadIdx.x; asm volatile("" : "+v"(tid_op));
    const int tid = tid_op, wid = __builtin_amdgcn_readfirstlane(tid >> 6), lane = tid & 63, wr = wid >> 2, wc = wid & 3, fr = lane & 15, fq = lane >> 4;
    const int K = g.K, nt = K / BK;
    unsigned voffA[2], voffB[2];
#pragma unroll
    for (int i = 0; i < 2; ++i) { int R, C; stage_rc(tid * 16 + i * 8192, R, C); const int Rb = Epi::PERM ? ((R & ~31) + perm32(R & 31)) : R;
        voffA[i] = (unsigned)(R * K + C) * 2u; voffB[i] = (unsigned)(Rb * K + C) * 2u; }
    const size_t kstep = (size_t)(BK * 2);
    const size_t hstep = (size_t)HALF * K * 2;
    const size_t tstep = 2 * hstep;
    const unsigned ldsw = (unsigned)wid * 1024u;
    const int aoff = lds_byte(wr * 64 + fr, fq * 8), boff = lds_byte(wc * 32 + fr, fq * 8);
#define PG8_SA(b, h) (((b) * 2 + (h)) * HTB)
#define PG8_SB(b, h) ((4 + (b) * 2 + (h)) * HTB)
#define PG8_STAGE(bufoff, gbase, voff) do { _Pragma("unroll") for (int _i = 0; _i < 2; ++_i) \
        __builtin_amdgcn_global_load_lds((const unsigned*)((const char*)(gbase) + (voff)[_i]), (PG8_LAS unsigned*)(lds + (bufoff) + ldsw + _i * 8192), 16, 0, 0); } while (0)
#define PG8_LDA(dst, b, h) do { _Pragma("unroll") for (int m = 0; m < 4; ++m) _Pragma("unroll") for (int k = 0; k < 2; ++k) dst[m][k] = *(const PG8_LAS bf16x8*)(lds + PG8_SA(b, h) + aoff + m * 2048 + k * 1024); } while (0)
#define PG8_LDB(dst, b, h) do { _Pragma("unroll") for (int n = 0; n < 2; ++n) _Pragma("unroll") for (int k = 0; k < 2; ++k) dst[n][k] = *(const PG8_LAS bf16x8*)(lds + PG8_SB(b, h) + boff + n * 2048 + k * 1024); } while (0)
#define PG8_MMA(ai, bj, At, Bt) do { __builtin_amdgcn_s_setprio(1); _Pragma("unroll") for (int m = 0; m < 4; ++m) _Pragma("unroll") for (int n = 0; n < 2; ++n) _Pragma("unroll") for (int k = 0; k < 2; ++k) \
        acc[ai][bj][m][n] = __builtin_amdgcn_mfma_f32_16x16x32_bf16(Bt[n][k], At[m][k], acc[ai][bj][m][n], 0, 0, 0); __builtin_amdgcn_s_setprio(0); } while (0)
#define PG8_WAIT_V(n) asm volatile("s_waitcnt vmcnt(" #n ")" ::: "memory")
#define PG8_WAIT_L(n) asm volatile("s_waitcnt lgkmcnt(" #n ")" ::: "memory")
#define PG8_BAR __builtin_amdgcn_s_barrier()
#define PG8_SCHED __builtin_amdgcn_sched_barrier(0)
    Unit cur, nxt; int ui = 0;
    if (!S.next(0, cur)) return;
    f32x4 acc[2][2][4][2];
#pragma unroll
    for (int a = 0; a < 2; ++a)
#pragma unroll
        for (int b = 0; b < 2; ++b)
#pragma unroll
            for (int m = 0; m < 4; ++m)
#pragma unroll
                for (int n = 0; n < 2; ++n) acc[a][b][m][n] = (f32x4){0.f, 0.f, 0.f, 0.f};
    bf16x8 At[4][2], B0[2][2], B1[2][2];
    const char* cA = (const char*)g.A + (size_t)cur.pm * tstep; const char* cB = (const char*)g.Bt + (size_t)cur.pn * tstep;
    S.a_ready(cur);
    if constexpr (SP2) {
        PG8_STAGE(PG8_SB(0, 0), cB, voffB); PG8_STAGE(PG8_SB(0, 1), cB + hstep, voffB); PG8_STAGE(PG8_SA(0, 0), cA, voffA); PG8_STAGE(PG8_SA(0, 1), cA + hstep, voffA);
        if (wr == 1) PG8_BAR;
        PG8_WAIT_V(2); PG8_BAR;
        PG8_STAGE(PG8_SB(1, 0), cB + kstep, voffB); PG8_STAGE(PG8_SA(1, 0), cA + kstep, voffA); PG8_STAGE(PG8_SB(1, 1), cB + hstep + kstep, voffB);
        PG8_WAIT_V(6); PG8_BAR;
    } else {
        PG8_STAGE(PG8_SB(0, 0), cB, voffB); PG8_STAGE(PG8_SA(0, 0), cA, voffA); PG8_STAGE(PG8_SB(0, 1), cB + hstep, voffB); PG8_STAGE(PG8_SA(0, 1), cA + hstep, voffA);
        if (wr == 1) PG8_BAR;
        PG8_WAIT_V(4); PG8_BAR;
        PG8_STAGE(PG8_SB(1, 0), cB + kstep, voffB); PG8_STAGE(PG8_SA(1, 0), cA + kstep, voffA); PG8_STAGE(PG8_SB(1, 1), cB + hstep + kstep, voffB);
        PG8_WAIT_V(6); PG8_BAR;
    }
    for (;;) {
        const bool has_next = S.next(ui + 1, nxt);
        const char* nA = has_next ? (const char*)g.A + (size_t)nxt.pm * tstep : cA; const char* nB = has_next ? (const char*)g.Bt + (size_t)nxt.pn * tstep : cB;
        for (int t = 0; t < nt; t += 2) {
            const bool last = (t == nt - 2);
            const char* a1 = cA + (size_t)(t + 1) * kstep;
            const char* a2 = last ? nA : cA + (size_t)(t + 2) * kstep; const char* b2 = last ? nB : cB + (size_t)(t + 2) * kstep;
            const char* a3 = a2 + kstep; const char* b3 = b2 + kstep;
            if (last && has_next) S.a_ready(nxt);
            if constexpr (SP2) {
            PG8_LDB(B0, 0, 0); PG8_LDB(B1, 0, 1); PG8_SCHED; PG8_LDA(At, 0, 0); PG8_STAGE(PG8_SA(1, 1), a1 + hstep, voffA);
            PG8_WAIT_V(8); PG8_WAIT_L(0); PG8_BAR; PG8_MMA(0, 0, At, B0); PG8_MMA(0, 1, At, B1); PG8_BAR; PG8_SCHED;
            PG8_LDA(At, 0, 1); PG8_STAGE(PG8_SB(0, 0), b2, voffB); PG8_STAGE(PG8_SB(0, 1), b2 + hstep, voffB); PG8_STAGE(PG8_SA(0, 0), a2, voffA);
            PG8_WAIT_V(8); PG8_WAIT_L(0); PG8_BAR; PG8_MMA(1, 0, At, B0); PG8_MMA(1, 1, At, B1); PG8_BAR; PG8_SCHED;
            PG8_LDB(B0, 1, 0); PG8_LDB(B1, 1, 1); PG8_SCHED; PG8_LDA(At, 1, 0); PG8_STAGE(PG8_SA(0, 1), a2 + hstep, voffA);
            PG8_WAIT_V(8); PG8_WAIT_L(0); PG8_BAR; PG8_MMA(0, 0, At, B0); PG8_MMA(0, 1, At, B1); PG8_BAR; PG8_SCHED;
            PG8_LDA(At, 1, 1); PG8_STAGE(PG8_SB(1, 0), b3, voffB); PG8_STAGE(PG8_SB(1, 1), b3 + hstep, voffB); PG8_STAGE(PG8_SA(1, 0), a3, voffA);
            PG8_WAIT_V(8); PG8_WAIT_L(0); PG8_BAR; PG8_MMA(1, 0, At, B0); PG8_MMA(1, 1, At, B1); PG8_BAR; PG8_SCHED;
            } else {
            PG8_LDB(B0, 0, 0); PG8_SCHED; PG8_LDA(At, 0, 0); PG8_STAGE(PG8_SA(1, 1), a1 + hstep, voffA);
            PG8_WAIT_L(8); PG8_BAR; PG8_WAIT_L(0); PG8_MMA(0, 0, At, B0); PG8_BAR; PG8_SCHED;
            PG8_LDB(B1, 0, 1); PG8_STAGE(PG8_SB(0, 0), b2, voffB);
            PG8_BAR; PG8_WAIT_L(0); PG8_MMA(0, 1, At, B1); PG8_BAR;
            PG8_LDA(At, 0, 1); PG8_STAGE(PG8_SA(0, 0), a2, voffA);
            PG8_BAR; PG8_WAIT_L(0); PG8_MMA(1, 0, At, B0); PG8_BAR; PG8_SCHED;
            PG8_STAGE(PG8_SB(0, 1), b2 + hstep, voffB);
            PG8_WAIT_V(6); PG8_BAR; PG8_MMA(1, 1, At, B1); PG8_BAR;
            PG8_LDB(B0, 1, 0); PG8_SCHED; PG8_LDA(At, 1, 0); PG8_STAGE(PG8_SA(0, 1), a2 + hstep, voffA);
            PG8_WAIT_L(8); PG8_BAR; PG8_WAIT_L(0); PG8_MMA(0, 0, At, B0); PG8_BAR; PG8_SCHED;
            PG8_LDB(B1, 1, 1); PG8_STAGE(PG8_SB(1, 0), b3, voffB);
            PG8_BAR; PG8_WAIT_L(0); PG8_MMA(0, 1, At, B1); PG8_BAR;
            PG8_LDA(At, 1, 1); PG8_STAGE(PG8_SA(1, 0), a3, voffA);
            PG8_BAR; PG8_WAIT_L(0); PG8_MMA(1, 0, At, B0); PG8_BAR; PG8_SCHED;
            PG8_STAGE(PG8_SB(1, 1), b3 + hstep, voffB);
            PG8_WAIT_V(6); PG8_BAR; PG8_MMA(1, 1, At, B1); PG8_BAR;
            }
        }
        if constexpr (ALIGN_EPI) { if (wr == 0) PG8_BAR; }
        if constexpr (!Epi::AFTER_DRAIN) { E(acc, cur, wr, wc, fr, fq); S.done(cur); }
        if (!has_next) break;
#pragma unroll
        for (int a = 0; a < 2; ++a)
#pragma unroll
            for (int b = 0; b < 2; ++b)
#pragma unroll
                for (int m = 0; m < 4; ++m)
#pragma unroll
                    for (int n = 0; n < 2; ++n) acc[a][b][m][n] = (f32x4){0.f, 0.f, 0.f, 0.f};
        cur = nxt; cA = nA; cB = nB; ++ui;
        if constexpr (ALIGN_EPI) { if (wr == 1) PG8_BAR; }
    }
    PG8_WAIT_V(0);
    if constexpr (!ALIGN_EPI) { if (wr == 0) PG8_BAR; }
    PG8_BAR;
    if constexpr (Epi::AFTER_DRAIN) { E.fused(acc, cur, wr, wc, fr, fq, lds, wid, lane); S.done(cur); }
#undef PG8_SA
#undef PG8_SB
#undef PG8_STAGE
#undef PG8_LDA
#undef PG8_LDB
#undef PG8_MMA
#undef PG8_WAIT_V
#undef PG8_WAIT_L
#undef PG8_BAR
#undef PG8_SCHED
}
}
#define GAS __attribute__((address_space(1)))
#define LAS __attribute__((address_space(3)))
typedef unsigned v4u __attribute__((ext_vector_type(4)));
typedef float f32x4 __attribute__((ext_vector_type(4)));
typedef short bf16x8 __attribute__((ext_vector_type(8)));
typedef GAS unsigned gu32;
#define RLX_AGENT __ATOMIC_RELAXED, __HIP_MEMORY_SCOPE_AGENT
#define LDS_WAIT() asm volatile("s_waitcnt lgkmcnt(0)" ::: "memory")
#define VM_WAIT() asm volatile("s_waitcnt vmcnt(0)" ::: "memory")
#define XB_TMO      128
#define XB_XCNT(j)  (256  + 64 * (j))
#define XB_XSUB(j)  (1280 + 64 * (j))
#define XB_XGEN(j)  (2304 + 64 * (j))
#define XB_TOP      3328
#define XB_TOPGEN   3392
#define XCD_BAR_WORDS 3456
#define XB_SPIN_CAP (1u << 18)

__device__ __forceinline__ unsigned xb_ld(unsigned* p)              { return __hip_atomic_load(p, __ATOMIC_RELAXED, __HIP_MEMORY_SCOPE_AGENT); }
__device__ __forceinline__ unsigned xb_add(unsigned* p, unsigned v) { return __hip_atomic_fetch_add(p, v, __ATOMIC_RELAXED, __HIP_MEMORY_SCOPE_AGENT); }
__device__ __forceinline__ unsigned xb_xcc_id() { return (unsigned)__builtin_amdgcn_s_getreg((3 << 11) | 20) & 0xFu; }
#define XB_SPIN(cond, bar) do { unsigned _sp = 0; while (cond) { __builtin_amdgcn_s_sleep(1); \
    if ((++_sp & 255u) == 0u) { if (xb_ld(&(bar)[XB_TMO])) break; if (_sp > XB_SPIN_CAP) { atomicAdd(&(bar)[XB_TMO], 1u); break; } } } } while (0)

struct XcdBarrier {
    unsigned* bar; unsigned x;
    volatile LAS unsigned* st;
};

__device__ __forceinline__ XcdBarrier xcd_barrier_post(unsigned* bar, volatile LAS unsigned* st) {
    XcdBarrier b; b.bar = bar; b.x = xb_xcc_id(); b.st = st;
    if (threadIdx.x == 0) (void)xb_add(&bar[XB_XCNT(b.x)], 1u);
    return b;
}
__device__ __forceinline__ void xcd_barrier_complete(unsigned* bar, unsigned x, unsigned& nloc, unsigned& nx) {
    const unsigned G = gridDim.x * gridDim.y * gridDim.z;
    unsigned sum, cnt, mine, sp = 0u;
    for (;;) {
        sum = 0u; cnt = 0u; mine = 0u;
#pragma unroll
        for (unsigned j = 0; j < 16; ++j) { const unsigned c = xb_ld(&bar[XB_XCNT(j)]); sum += c; cnt += (c > 0u) ? 1u : 0u; mine = (j == x) ? c : mine; }
        if (sum == G) break;
        __builtin_amdgcn_s_sleep(1);
        if ((++sp & 255u) == 0u) { if (xb_ld(&bar[XB_TMO])) break; if (sp > XB_SPIN_CAP) { atomicAdd(&bar[XB_TMO], 1u); break; } }
    }
    nloc = mine > 0u ? mine : 1u; nx = cnt > 0u ? cnt : 1u;
}

__device__ __forceinline__ void xcd_barrier(const XcdBarrier& b) {
    asm volatile("s_waitcnt vmcnt(0)" ::: "memory");
    __syncthreads();
    if (threadIdx.x == 0) {
        unsigned* bar = b.bar;
        __builtin_amdgcn_s_waitcnt(0);
        unsigned nloc = b.st[0], nx = b.st[1];
        if (nloc == 0u) { xcd_barrier_complete(bar, b.x, nloc, nx); b.st[0] = nloc; b.st[1] = nx; }
        const unsigned old = xb_add(&bar[XB_XSUB(b.x)], 1u);
        const unsigned gen = old / nloc;
        if (old + 1u == (gen + 1u) * nloc) {
            __builtin_amdgcn_fence(__ATOMIC_RELEASE, "agent");
            asm volatile("s_waitcnt vmcnt(0)" ::: "memory");
            const unsigned og = xb_add(&bar[XB_TOP], 1u);
            const unsigned tg = og / nx;
            if (og + 1u == (tg + 1u) * nx) xb_add(&bar[XB_TOPGEN], 1u);
            else XB_SPIN(xb_ld(&bar[XB_TOPGEN]) == tg, bar);
            __builtin_amdgcn_fence(__ATOMIC_ACQUIRE, "agent");
            xb_add(&bar[XB_XGEN(b.x)], 1u);
            asm volatile("s_waitcnt vmcnt(0)" ::: "memory");
        } else {
            XB_SPIN(xb_ld(&bar[XB_XGEN(b.x)]) == gen, bar);
            __builtin_amdgcn_fence(__ATOMIC_ACQUIRE, "agent");
            asm volatile("s_waitcnt vmcnt(0)" ::: "memory");
        }
    }
    __syncthreads();
}

typedef short s16x4 __attribute__((ext_vector_type(4)));
typedef unsigned u32x2 __attribute__((ext_vector_type(2)));
__device__ __forceinline__ float fast_sigmoid(float x) { return __builtin_amdgcn_rcpf(1.f + __builtin_amdgcn_exp2f(-1.4426950408889634f * x)); }
__device__ __forceinline__ float fast_silu(float x) { return x * fast_sigmoid(x); }
__device__ __forceinline__ float fast_gelu(float x) { return x * fast_sigmoid(x * (1.5957691216057308f + 0.0713548162726f * x * x)); }
__device__ __forceinline__ float bflo(unsigned w) { return __uint_as_float(w << 16); }
__device__ __forceinline__ float bfhi(unsigned w) { return __uint_as_float(w & 0xffff0000u); }
typedef float f32x2_t __attribute__((ext_vector_type(2))); typedef __bf16 bf16x2_t __attribute__((ext_vector_type(2)));
__device__ __forceinline__ unsigned cvtpk(float lo, float hi) { const f32x2_t v = {lo, hi}; const bf16x2_t b = __builtin_convertvector(v, bf16x2_t); return __builtin_bit_cast(unsigned, b); }
__device__ __forceinline__ s16x4 tr_read(const LAS unsigned char* p) { return __builtin_bit_cast(s16x4, __builtin_amdgcn_ds_read_tr16_b64_v4i16((LAS s16x4*)p)); }
__device__ __forceinline__ bf16x8 frag_tr(const LAS unsigned char* base, int stride, int lane) {
    const int G = lane >> 4, q = (lane >> 2) & 3, p = lane & 3;
    const LAS unsigned char* a = base + (4 * G + q) * stride + 8 * p;
    const s16x4 lo = tr_read(a), hi = tr_read(a + 16 * stride);
    return (bf16x8){lo[0], lo[1], lo[2], lo[3], hi[0], hi[1], hi[2], hi[3]};
}
__device__ __forceinline__ bf16x8 frag_perm_row(const LAS unsigned char* rowbase, int stride, int lane) {
    const LAS unsigned char* a = rowbase + (lane & 15) * stride + 8 * (lane >> 4);
    const s16x4 lo = *(const LAS s16x4*)a, hi = *(const LAS s16x4*)(a + 32);
    return (bf16x8){lo[0], lo[1], lo[2], lo[3], hi[0], hi[1], hi[2], hi[3]};
}

constexpr int SGU_VF_STRIDE = 544, SGU_W_STRIDE = 272, SGU_VF_OFF = 0, SGU_W_OFF = 128 * SGU_VF_STRIDE;
__device__ __forceinline__ void sgu_item(LAS unsigned char* lds, int item, const bf16* Z, const float* v_norm, const float* w_s, const float* b_s, bf16* Y, int tid) {
    const int lane = tid & 63, wave = __builtin_amdgcn_readfirstlane(tid >> 6);
    const int g = item & 3, c = (item >> 2) & 15, b = item >> 6;
    const size_t tok0 = (size_t)b * SEQ + 128 * c;
    LAS unsigned char* VF = lds + SGU_VF_OFF; LAS unsigned char* WS = lds + SGU_W_OFF;
    {
        const int sub = lane >> 4, cl = lane & 15;
        float vn[16];
#pragma unroll
        for (int j = 0; j < 4; ++j) { const f32x4 t = *(const f32x4*)(v_norm + g * 256 + 16 * cl + 4 * j); vn[4 * j] = t[0]; vn[4 * j + 1] = t[1]; vn[4 * j + 2] = t[2]; vn[4 * j + 3] = t[3]; }
        v4u wv[4][2];
#pragma unroll
        for (int ps = 0; ps < 4; ++ps) { const v4u* src = (const v4u*)(Z + (tok0 + 16 * wave + 4 * ps + sub) * OD_Z + 4096 + 256 * g + 16 * cl); wv[ps][0] = src[0]; wv[ps][1] = src[1]; }
#pragma unroll
        for (int ps = 0; ps < 4; ++ps) {
            const int row = 16 * wave + 4 * ps + sub;
            const v4u w0 = wv[ps][0], w1 = wv[ps][1];
            float x[16];
#pragma unroll
            for (int j = 0; j < 4; ++j) { x[2 * j] = fast_gelu(bflo(w0[j])); x[2 * j + 1] = fast_gelu(bfhi(w0[j])); x[8 + 2 * j] = fast_gelu(bflo(w1[j])); x[9 + 2 * j] = fast_gelu(bfhi(w1[j])); }
            float s = 0.f;
#pragma unroll
            for (int j = 0; j < 16; ++j) s += x[j];
            s += __shfl_xor(s, 1); s += __shfl_xor(s, 2); s += __shfl_xor(s, 4); s += __shfl_xor(s, 8);
            const float mu = s * (1.f / 256.f);
            float q = 0.f;
#pragma unroll
            for (int j = 0; j < 16; ++j) { x[j] -= mu; q += x[j] * x[j]; }
            q += __shfl_xor(q, 1); q += __shfl_xor(q, 2); q += __shfl_xor(q, 4); q += __shfl_xor(q, 8);
            const float rstd = __builtin_amdgcn_rsqf(q * (1.f / 256.f) + 1e-6f);
            v4u o0, o1;
#pragma unroll
            for (int j = 0; j < 4; ++j) { o0[j] = cvtpk(x[2 * j] * rstd * vn[2 * j], x[2 * j + 1] * rstd * vn[2 * j + 1]); o1[j] = cvtpk(x[8 + 2 * j] * rstd * vn[8 + 2 * j], x[9 + 2 * j] * rstd * vn[9 + 2 * j]); }
            LAS v4u* dst = (LAS v4u*)(VF + row * SGU_VF_STRIDE + 32 * cl);
            dst[0] = o0; dst[1] = o1;
        }
    }
    {
        const int t = tid >> 2, s0 = (tid & 3) * 32;
        const f32x4* src = (const f32x4*)(w_s + ((size_t)g * 128 + t) * 128 + s0);
#pragma unroll
        for (int j = 0; j < 4; ++j) { const f32x4 a = src[2 * j], bb = src[2 * j + 1]; const int s = s0 + 8 * j;
            v4u o; o[0] = cvtpk(s + 0 <= t ? a[0] : 0.f, s + 1 <= t ? a[1] : 0.f); o[1] = cvtpk(s + 2 <= t ? a[2] : 0.f, s + 3 <= t ? a[3] : 0.f);
            o[2] = cvtpk(s + 4 <= t ? bb[0] : 0.f, s + 5 <= t ? bb[1] : 0.f); o[3] = cvtpk(s + 6 <= t ? bb[2] : 0.f, s + 7 <= t ? bb[3] : 0.f);
            *(LAS v4u*)(WS + t * SGU_W_STRIDE + 2 * s) = o; }
    }
    __syncthreads();
    u32x2 uv[8][2], gv[8][2];
    {
        const int G = lane >> 4, tl = lane & 15;
#pragma unroll
        for (int tb = 0; tb < 8; ++tb) { const bf16* zr = Z + (tok0 + 16 * tb + tl) * OD_Z + 256 * g;
#pragma unroll
            for (int eb = 0; eb < 2; ++eb) { const int e = 16 * (2 * wave + eb) + 4 * G; uv[tb][eb] = *(const u32x2*)(zr + 3072 + e); gv[tb][eb] = *(const u32x2*)(zr + 5120 + e); } }
    }
    f32x4 acc[2][8];
#pragma unroll
    for (int eb = 0; eb < 2; ++eb)
#pragma unroll
        for (int tb = 0; tb < 8; ++tb) acc[eb][tb] = (f32x4){0.f, 0.f, 0.f, 0.f};
#pragma unroll
    for (int ks = 0; ks < 4; ++ks) {
        bf16x8 af[2];
#pragma unroll
        for (int eb = 0; eb < 2; ++eb) af[eb] = frag_tr(VF + (32 * ks) * SGU_VF_STRIDE + (16 * (2 * wave + eb)) * 2, SGU_VF_STRIDE, lane);
#pragma unroll
        for (int tb = 2 * ks; tb < 8; ++tb) {
            const bf16x8 bfr = frag_perm_row(WS + (16 * tb) * SGU_W_STRIDE + (32 * ks) * 2, SGU_W_STRIDE, lane);
#pragma unroll
            for (int eb = 0; eb < 2; ++eb) acc[eb][tb] = __builtin_amdgcn_mfma_f32_16x16x32_bf16(af[eb], bfr, acc[eb][tb], 0, 0, 0);
        }
    }
    {
        const int G = lane >> 4, tl = lane & 15;
#pragma unroll
        for (int tb = 0; tb < 8; ++tb) {
            const int t = 16 * tb + tl; const float bs = b_s[g * 128 + t];
            bf16* yr = Y + (tok0 + t) * DM + 1024 + 256 * g;
#pragma unroll
            for (int eb = 0; eb < 2; ++eb) {
                const int e = 16 * (2 * wave + eb) + 4 * G;
                const u32x2 uu = uv[tb][eb], gg = gv[tb][eb];
                const f32x4 a = acc[eb][tb];
                const float y0 = fast_gelu(bflo(uu[0])) * (a[0] + bs) * fast_silu(bflo(gg[0])), y1 = fast_gelu(bfhi(uu[0])) * (a[1] + bs) * fast_silu(bfhi(gg[0]));
                const float y2 = fast_gelu(bflo(uu[1])) * (a[2] + bs) * fast_silu(bflo(gg[1])), y3 = fast_gelu(bfhi(uu[1])) * (a[3] + bs) * fast_silu(bfhi(gg[1]));
                u32x2 o; o[0] = cvtpk(y0, y1); o[1] = cvtpk(y2, y3);
                *(u32x2*)(yr + e) = o;
            }
        }
    }
    __syncthreads();
}

constexpr int AT_STRIDE = 288, AT_K_OFF = 0, AT_V_OFF = 256 * AT_STRIDE, AT_V_ROWS = 272, AT_LDS_END = AT_V_OFF + AT_V_ROWS * AT_STRIDE;
struct AtStage { v4u k[8], v[8]; bf16x8 q[4]; };
__device__ __forceinline__ void attn_load(AtStage& sg, int item, const bf16* Z, int tid) {
    const int lane = tid & 63, wave = __builtin_amdgcn_readfirstlane(tid >> 6), G = lane >> 4, ql = lane & 15;
    const int g = item >> 8, rem = item & 255, j = rem & 3, rn = (rem >> 2) & 15, b = rem >> 6;
    const int d = 1 << (2 * g), nb = 16 >> (2 * g), n = rn % nb, r = rn / nb;
    const size_t tokb = (size_t)b * SEQ;
    { const size_t qtok = tokb + (size_t)(128 * n + 16 * wave + ql) * d + r; const bf16* qp = Z + qtok * EV_IN + 3072 + g * 512 + j * 128 + 8 * G;
#pragma unroll
      for (int ks = 0; ks < 4; ++ks) sg.q[ks] = *(const bf16x8*)(qp + 32 * ks); }
    const int c16 = tid & 15, rw = tid >> 4;
    const bf16* kb = Z + 4608 + g * 512 + j * 128 + 8 * c16;
#pragma unroll
    for (int ps = 0; ps < 8; ++ps) {
        const int kk = 32 * ps + rw; const int l = 128 * (n - 1) + kk; const int lc = l < 0 ? 0 : l;
        const bf16* p = kb + (tokb + (size_t)lc * d + r) * EV_IN;
        sg.k[ps] = *(const v4u*)p; sg.v[ps] = *(const v4u*)(p + 1536);
        if (l < 0) { sg.k[ps] = (v4u){0u, 0u, 0u, 0u}; sg.v[ps] = (v4u){0u, 0u, 0u, 0u}; }
    }
}
__device__ __forceinline__ void attn_items(LAS unsigned char* lds, int first, int step, int cnt, const bf16* Z, bf16* OG, float* LSE, int tid) {
    const int lane = tid & 63, wave = __builtin_amdgcn_readfirstlane(tid >> 6), G = lane >> 4, ql = lane & 15;
    LAS unsigned char* KT = lds + AT_K_OFF; LAS unsigned char* VT = lds + AT_V_OFF;
    if (cnt <= 0) return;
    AtStage sg;
    attn_load(sg, first, Z, tid);
    for (int it = 0; it < cnt; ++it) {
    const int item = first + it * step;
    const int g = item >> 8, rem = item & 255, j = rem & 3, rn = (rem >> 2) & 15, b = rem >> 6;
    const int d = 1 << (2 * g), nb = 16 >> (2 * g), n = rn % nb, r = rn / nb;
    const size_t tokb = (size_t)b * SEQ;
    const int q0 = 16 * wave;
    const size_t qtok = tokb + (size_t)(128 * n + q0 + ql) * d + r;
    bf16x8 qf[4];
#pragma unroll
    for (int ks = 0; ks < 4; ++ks) qf[ks] = sg.q[ks];
    {
        const int c16 = tid & 15, rw = tid >> 4;
#pragma unroll
        for (int ps = 0; ps < 8; ++ps) { const int kk = 32 * ps + rw; *(LAS v4u*)(KT + kk * AT_STRIDE + 16 * c16) = sg.k[ps]; *(LAS v4u*)(VT + kk * AT_STRIDE + 16 * c16) = sg.v[ps]; }
        { unsigned z = 0u; asm volatile("" : "+v"(z));
          if (tid < 16 * 18) *(LAS v4u*)(VT + 256 * AT_STRIDE + 16 * tid) = (v4u){z, z, z, z}; }
    }
    __syncthreads();
    f32x4 sc[9];
#pragma unroll
    for (int t = 0; t < 9; ++t) {
        sc[t] = (f32x4){0.f, 0.f, 0.f, 0.f};
        const LAS unsigned char* kp = KT + (16 * wave + 16 * t + ql) * AT_STRIDE + 16 * G;
#pragma unroll
        for (int ks = 0; ks < 4; ++ks) sc[t] = __builtin_amdgcn_mfma_f32_16x16x32_bf16(*(const LAS bf16x8*)(kp + 64 * ks), qf[ks], sc[t], 0, 0, 0);
    }
    const float slope2 = exp2f(-8.0f * (float)(g + 3 * j + 1) / 12.0f) * (float)d * 1.4426950408889634f;
    const float scale2 = 0.08838834764831845f * 1.4426950408889634f;
    float mx = -INFINITY;
#pragma unroll
    for (int t = 0; t < 9; ++t)
#pragma unroll
        for (int rg = 0; rg < 4; ++rg) {
            const int rel = 16 * t + 4 * G + rg - ql;
            const bool ok = (rel >= 0) && (rel <= 128) && (n > 0 || (q0 + ql + rel) >= 128);
            const float s = sc[t][rg] * scale2 - slope2 * (float)(128 - rel);
            sc[t][rg] = ok ? s : -INFINITY;
            mx = fmaxf(mx, sc[t][rg]);
        }
    mx = fmaxf(mx, __shfl_xor(mx, 16)); mx = fmaxf(mx, __shfl_xor(mx, 32));
    float den = 0.f;
#pragma unroll
    for (int t = 0; t < 9; ++t)
#pragma unroll
        for (int rg = 0; rg < 4; ++rg) { const float p = __builtin_amdgcn_exp2f(sc[t][rg] - mx); sc[t][rg] = p; den += p; }
    den += __shfl_xor(den, 16); den += __shfl_xor(den, 32);
    if (it + 1 < cnt) attn_load(sg, item + step, Z, tid);
    f32x4 oc[8];
#pragma unroll
    for (int dvb = 0; dvb < 8; ++dvb) oc[dvb] = (f32x4){0.f, 0.f, 0.f, 0.f};
#pragma unroll
    for (int s = 0; s < 5; ++s) {
        const f32x4 plo = sc[2 * s], phi = (s < 4) ? sc[2 * s + 1] : (f32x4){0.f, 0.f, 0.f, 0.f};
        const unsigned w0 = cvtpk(plo[0], plo[1]), w1 = cvtpk(plo[2], plo[3]), w2 = cvtpk(phi[0], phi[1]), w3 = cvtpk(phi[2], phi[3]);
        const bf16x8 pf = __builtin_bit_cast(bf16x8, (v4u){w0, w1, w2, w3});
#pragma unroll
        for (int dvb = 0; dvb < 8; ++dvb) {
            const bf16x8 vf = frag_tr(VT + (16 * wave + 32 * s) * AT_STRIDE + (16 * dvb) * 2, AT_STRIDE, lane);
            oc[dvb] = __builtin_amdgcn_mfma_f32_16x16x32_bf16(vf, pf, oc[dvb], 0, 0, 0);
        }
    }
    const float rden = __builtin_amdgcn_rcpf(den);
    bf16* op = OG + ((size_t)g * MTOK + qtok) * 512 + j * 128 + 4 * G;
#pragma unroll
    for (int dvb = 0; dvb < 8; ++dvb) { u32x2 o; o[0] = cvtpk(oc[dvb][0] * rden, oc[dvb][1] * rden); o[1] = cvtpk(oc[dvb][2] * rden, oc[dvb][3] * rden); *(u32x2*)(op + 16 * dvb) = o; }
    if (G == 0) LSE[((size_t)g * MTOK + qtok) * 4 + j] = mx + __builtin_amdgcn_logf(den);
    __syncthreads();
    }
}
__device__ __forceinline__ void attn_merge(const bf16* Z, const bf16* OG, const float* LSE, bf16* Y, int gtid, int gthreads) {
    for (int it = gtid; it < MTOK * 64; it += gthreads) {
        const int tok = it >> 6, c8 = it & 63, j = c8 >> 4;
        const float l0 = LSE[((size_t)0 * MTOK + tok) * 4 + j], l1 = LSE[((size_t)1 * MTOK + tok) * 4 + j], l2 = LSE[((size_t)2 * MTOK + tok) * 4 + j];
        const float m = fmaxf(l0, fmaxf(l1, l2));
        float w0 = __builtin_amdgcn_exp2f(l0 - m), w1 = __builtin_amdgcn_exp2f(l1 - m), w2 = __builtin_amdgcn_exp2f(l2 - m);
        const float rs = __builtin_amdgcn_rcpf(w0 + w1 + w2); w0 *= rs; w1 *= rs; w2 *= rs;
        const v4u a = *(const v4u*)(OG + ((size_t)0 * MTOK + tok) * 512 + 8 * c8), bb = *(const v4u*)(OG + ((size_t)1 * MTOK + tok) * 512 + 8 * c8), cc = *(const v4u*)(OG + ((size_t)2 * MTOK + tok) * 512 + 8 * c8);
        const v4u gt = *(const v4u*)(Z + (size_t)tok * EV_IN + 7680 + 8 * c8);
        v4u o;
#pragma unroll
        for (int k = 0; k < 4; ++k) {
            const float ylo = (w0 * bflo(a[k]) + w1 * bflo(bb[k]) + w2 * bflo(cc[k])) * fast_silu(bflo(gt[k]));
            const float yhi = (w0 * bfhi(a[k]) + w1 * bfhi(bb[k]) + w2 * bfhi(cc[k])) * fast_silu(bfhi(gt[k]));
            o[k] = cvtpk(ylo, yhi);
        }
        *(v4u*)(Y + (size_t)tok * DM + 1536 + 8 * c8) = o;
    }
}

constexpr int LR_XC_STRIDE = 272, LR_XC_OFF = 0, LR_F_STRIDE = 528  , LR_XCF_OFF = 128 * LR_XC_STRIDE, LR_A_OFF = LR_XCF_OFF + 32 * LR_F_STRIDE, LR_U_OFF = LR_A_OFF + 32 * LR_F_STRIDE, LR_CW_OFF = LR_U_OFF + 32 * LR_F_STRIDE  , LR_LDS_END = LR_CW_OFF + 5 * 128 * 4;
struct LruParams { const float *conv_w, *conv_b, *b_a, *b_i, *lam; const bf16* wg; };
__device__ __forceinline__ void lru_load_tile(v4u (&xa)[7], v4u& ga, const bf16* Z, size_t tokb, int t0, int h, int c4, int tid) {
    const int co = tid & 15, rg = tid >> 4;
#pragma unroll
    for (int k = 0; k < 7; ++k) { const int t = t0 + 4 * rg + k - 3; const int tc = t < 0 ? 0 : t;
        const v4u v = *(const v4u*)(Z + (tokb + tc) * EV_IN + h * 128 + 8 * co);
        xa[k] = (v4u){t >= 0 ? v[0] : 0u, t >= 0 ? v[1] : 0u, t >= 0 ? v[2] : 0u, t >= 0 ? v[3] : 0u}; }
    ga = *(const v4u*)(Z + (tokb + t0 + (tid >> 2)) * EV_IN + 1536 + h * 128 + 32 * c4 + 8 * (tid & 3));
}
__device__ __forceinline__ void lru_item(LAS unsigned char* lds, int item, const bf16* Z, const LruParams& P, bf16* Y, int tid) {
    const int lane = tid & 63, wave = __builtin_amdgcn_readfirstlane(tid >> 6), G = lane >> 4, ql = lane & 15;
    const int c4 = item & 3, h = (item >> 2) % 12, b = item / 48;
    const size_t tokb = (size_t)b * SEQ;
    LAS unsigned char* XC = lds + LR_XC_OFF; LAS unsigned char* XCF = lds + LR_XCF_OFF; LAS unsigned char* AL = lds + LR_A_OFF; LAS unsigned char* UL = lds + LR_U_OFF;
    bf16x8 wf[2][2][4];
#pragma unroll
    for (int gate = 0; gate < 2; ++gate)
#pragma unroll
        for (int cb = 0; cb < 2; ++cb)
#pragma unroll
            for (int ks = 0; ks < 4; ++ks) wf[gate][cb][ks] = *(const bf16x8*)(P.wg + ((size_t)(h * 2 + gate) * 128 + 32 * c4 + 16 * cb + ql) * 128 + 32 * ks + 8 * G);
    float ba[2], bi[2], sp8[2];
#pragma unroll
    for (int cb = 0; cb < 2; ++cb) { const int ch = h * 128 + 32 * c4 + 16 * cb + ql; ba[cb] = P.b_a[ch]; bi[cb] = P.b_i[ch];
        const float nl = -P.lam[ch]; sp8[cb] = 8.0f * (nl > 20.f ? nl : log1pf(__expf(nl))); }
    LAS float* CW = (LAS float*)(lds + LR_CW_OFF);
    if (tid < 128) {
#pragma unroll
        for (int q = 0; q < 4; ++q) CW[q * 128 + tid] = P.conv_w[q * LRU_W + h * 128 + tid];
        CW[4 * 128 + tid] = P.conv_b[h * 128 + tid];
    }
    __syncthreads();
    float hc = 0.f;
    v4u xa[7], ga;
    lru_load_tile(xa, ga, Z, tokb, 0, h, c4, tid);
    for (int sc = 0; sc < 16; ++sc) {
        const int t0 = 128 * sc;
        {
            const int co = tid & 15, rg = tid >> 4;
            v4u orow[4];
            const bool mine = (co >> 2) == c4;
#pragma unroll
            for (int e = 0; e < 4; ++e) {
                typedef float f32x2 __attribute__((ext_vector_type(2)));
                const int chn = 8 * co + 2 * e;
                const f32x2 w0 = *(const LAS f32x2*)(CW + 0 * 128 + chn), w1 = *(const LAS f32x2*)(CW + 1 * 128 + chn), w2 = *(const LAS f32x2*)(CW + 2 * 128 + chn), w3 = *(const LAS f32x2*)(CW + 3 * 128 + chn);
                const f32x2 cb2 = *(const LAS f32x2*)(CW + 4 * 128 + chn);
                float lo[7], hi[7];
#pragma unroll
                for (int k = 0; k < 7; ++k) { lo[k] = bflo(xa[k][e]); hi[k] = bfhi(xa[k][e]); }
                f32x4 xlo, xhi;
#pragma unroll
                for (int r = 0; r < 4; ++r) { xlo[r] = cb2[0] + w0[0] * lo[r] + w1[0] * lo[r + 1] + w2[0] * lo[r + 2] + w3[0] * lo[r + 3];
                                              xhi[r] = cb2[1] + w0[1] * hi[r] + w1[1] * hi[r + 1] + w2[1] * hi[r + 2] + w3[1] * hi[r + 3]; orow[r][e] = cvtpk(xlo[r], xhi[r]); }
                if (mine) { *(LAS f32x4*)(XCF + (8 * (co & 3) + 2 * e) * LR_F_STRIDE + 16 * rg) = xlo; *(LAS f32x4*)(XCF + (8 * (co & 3) + 2 * e + 1) * LR_F_STRIDE + 16 * rg) = xhi; }
            }
#pragma unroll
            for (int r = 0; r < 4; ++r) *(LAS v4u*)(XC + (4 * rg + r) * LR_XC_STRIDE + 16 * co) = orow[r];
        }
        const v4u ga_cur = ga;
        if (sc < 15) lru_load_tile(xa, ga, Z, tokb, t0 + 128, h, c4, tid);
        __syncthreads();
        f32x4 acc[2][2];

#pragma unroll
        for (int gate = 0; gate < 2; ++gate)
#pragma unroll
            for (int cb = 0; cb < 2; ++cb) acc[gate][cb] = (f32x4){0.f, 0.f, 0.f, 0.f};
#pragma unroll
        for (int ks = 0; ks < 4; ++ks) {
            const bf16x8 af = *(const LAS bf16x8*)(XC + (16 * wave + ql) * LR_XC_STRIDE + 64 * ks + 16 * G);
#pragma unroll
            for (int gate = 0; gate < 2; ++gate)
#pragma unroll
                for (int cb = 0; cb < 2; ++cb) acc[gate][cb] = __builtin_amdgcn_mfma_f32_16x16x32_bf16(af, wf[gate][cb][ks], acc[gate][cb], 0, 0, 0);
        }
#pragma unroll
        for (int cb = 0; cb < 2; ++cb) {
            const int off = (16 * cb + ql) * LR_F_STRIDE + (16 * wave + 4 * G) * 4;
            const f32x4 xcv = *(const LAS f32x4*)(XCF + off);
            f32x4 av, uv;
#pragma unroll
            for (int rg2 = 0; rg2 < 4; ++rg2) {
                const float r = fast_sigmoid(acc[0][cb][rg2] + ba[cb]), ig = fast_sigmoid(acc[1][cb][rg2] + bi[cb]);
                const float la = -r * sp8[cb];
                const float a = __builtin_amdgcn_exp2f(la * 1.4426950408889634f);
                const float x2 = 2.f * la;
                const float om = (x2 > -0.05f) ? -x2 * (1.f + x2 * (0.5f + x2 * (0.16666667f + x2 * 0.041666667f))) : 1.f - a * a;
                av[rg2] = a; uv[rg2] = __builtin_amdgcn_sqrtf(om) * ig * xcv[rg2];
            }
            *(LAS f32x4*)(AL + off) = av; *(LAS f32x4*)(UL + off) = uv;
        }
        __syncthreads();
        {
            const int seg = ql, off = (4 * wave + G) * LR_F_STRIDE + 32 * seg;
            const f32x4 a0 = *(const LAS f32x4*)(AL + off), a1 = *(const LAS f32x4*)(AL + off + 16), u0 = *(const LAS f32x4*)(UL + off), u1 = *(const LAS f32x4*)(UL + off + 16);
            float Pp = 1.f, Hh = 0.f;
#pragma unroll
            for (int k = 0; k < 4; ++k) { Hh = a0[k] * Hh + u0[k]; Pp *= a0[k]; }
#pragma unroll
            for (int k = 0; k < 4; ++k) { Hh = a1[k] * Hh + u1[k]; Pp *= a1[k]; }
#pragma unroll
            for (int o = 1; o < 16; o <<= 1) { const float Pl = __shfl_up(Pp, o, 16), Hl = __shfl_up(Hh, o, 16); if (seg >= o) { Hh = Pp * Hl + Hh; Pp = Pp * Pl; } }
            float Pe = __shfl_up(Pp, 1, 16), He = __shfl_up(Hh, 1, 16);
            if (seg == 0) { Pe = 1.f; He = 0.f; }
            float hh = Pe * hc + He;
            f32x4 h0, h1;
#pragma unroll
            for (int k = 0; k < 4; ++k) { hh = a0[k] * hh + u0[k]; h0[k] = hh; }
#pragma unroll
            for (int k = 0; k < 4; ++k) { hh = a1[k] * hh + u1[k]; h1[k] = hh; }
            *(LAS f32x4*)(UL + off) = h0; *(LAS f32x4*)(UL + off + 16) = h1;
            hc = __shfl(hh, (lane & 48) + 15);
        }
        __syncthreads();
        {
            const int tk = tid >> 2, oc = tid & 3;
            float hv[8];
#pragma unroll
            for (int e = 0; e < 8; ++e) hv[e] = *(const LAS float*)(UL + (8 * oc + e) * LR_F_STRIDE + 4 * tk);
            v4u o;
#pragma unroll
            for (int e = 0; e < 4; ++e) o[e] = cvtpk(hv[2 * e] * fast_silu(bflo(ga_cur[e])), hv[2 * e + 1] * fast_silu(bfhi(ga_cur[e])));
            *(v4u*)(Y + (tokb + t0 + tk) * DM + h * 128 + 32 * c4 + 8 * oc) = o;
        }
    }
    __syncthreads();
}

constexpr int G1_ALR_OFF = 0, G1_TOT_OFF = 4096, G1_LDS_END = 6144;
__device__ __forceinline__ void gla1a_item(LAS unsigned char* lds, int item, const bf16* Z, const float* ALR, const float* w_alpha, const float* b_alpha, bf16* QT, bf16* KT, bf16* KD, float* DEC, int tid) {
    const int c = item & 31, h = (item >> 5) & 3, b = item >> 7;
    const size_t tok0 = (size_t)b * SEQ + 64 * c;
    LAS float* ALRs = (LAS float*)(lds + G1_ALR_OFF); LAS float* TOT = (LAS float*)(lds + G1_TOT_OFF);
    if (tid < 256) *(LAS f32x4*)(ALRs + 4 * tid) = *(const f32x4*)(ALR + tok0 * 16 + 4 * tid);
    const int e = tid & 127, tq = tid >> 7;
    float wa[16];
#pragma unroll
    for (int r = 0; r < 16; ++r) wa[r] = w_alpha[r * 512 + h * 128 + e];
    const float bal = b_alpha[h * 128 + e];
    float qv[16], kv[16];
#pragma unroll
    for (int t = 0; t < 16; ++t) { const bf16* zr = Z + (tok0 + 16 * tq + t) * OD_Z + h * 128 + e; qv[t] = bf2f(zr[0]); kv[t] = bf2f(zr[512]); }
    __syncthreads();
    float bc[16]; float run = 0.f;
#pragma unroll
    for (int t = 0; t < 16; ++t) {
        float s = bal;
#pragma unroll
        for (int r = 0; r < 16; ++r) s += ALRs[(16 * tq + t) * 16 + r] * wa[r];
        const float sp = (s < -20.f) ? -s : __builtin_amdgcn_logf(1.f + __builtin_amdgcn_exp2f(-s * 1.4426950408889634f)) * 0.6931471805599453f;
        run -= sp * 0.0625f; bc[t] = run;
    }
    TOT[tq * 128 + e] = run;
    __syncthreads();
    const float t0s = TOT[e], t1s = TOT[128 + e], t2s = TOT[256 + e], t3s = TOT[384 + e];
    const float offs = (tq > 0 ? t0s : 0.f) + (tq > 1 ? t1s : 0.f) + (tq > 2 ? t2s : 0.f), blast = (t0s + t1s) + (t2s + t3s);
    if (tq == 0) DEC[(size_t)item * 128 + e] = __builtin_amdgcn_exp2f(blast * 1.4426950408889634f);
#pragma unroll
    for (int t = 0; t < 16; ++t) {
        const float bb = bc[t] + offs;
        const float eb = __builtin_amdgcn_exp2f(bb * 1.4426950408889634f), enb = __builtin_amdgcn_exp2f(-bb * 1.4426950408889634f), edl = __builtin_amdgcn_exp2f((blast - bb) * 1.4426950408889634f);
        const size_t o = (tok0 + 16 * tq + t) * 512 + h * 128 + e;
        QT[o] = (bf16)f2bf(qv[t] * 0.08838834764831845f * eb); KT[o] = (bf16)f2bf(kv[t] * enb); KD[o] = (bf16)f2bf(kv[t] * edl);
    }
    __syncthreads();
}

constexpr int G2_KD_STRIDE = 288, G2_V_STRIDE = 160, G2_KD_OFF = 0, G2_V_OFF = 64 * G2_KD_STRIDE, G2_BUF = G2_V_OFF + 64 * G2_V_STRIDE, G2_DEC_OFF = 2 * G2_BUF, G2_SIMG_OFF = G2_DEC_OFF + 32 * 128 * 4,
              G2_SIMG_STRIDE = 272, G2_SIMG = 64 * G2_SIMG_STRIDE, G2_LDS_END = G2_SIMG_OFF + 2 * G2_SIMG;
struct Gla2Stage { v4u kd[2], v; };
__device__ __forceinline__ void gla2_load(Gla2Stage& st, const bf16* Z, const bf16* KD, size_t tok0, int h, int slice, int tid) {
    const int rw = tid >> 4, c16 = tid & 15;
#pragma unroll
    for (int ps = 0; ps < 2; ++ps) st.kd[ps] = *(const v4u*)(KD + (tok0 + 32 * ps + rw) * 512 + h * 128 + 8 * c16);
    st.v = *(const v4u*)(Z + (tok0 + (tid >> 3)) * OD_Z + 1024 + h * 256 + 64 * slice + 8 * (tid & 7));
}
__device__ __forceinline__ void gla2_store(const Gla2Stage& st, LAS unsigned char* buf, int tid) {
    const int rw = tid >> 4, c16 = tid & 15;
#pragma unroll
    for (int ps = 0; ps < 2; ++ps) *(LAS v4u*)(buf + G2_KD_OFF + (32 * ps + rw) * G2_KD_STRIDE + 16 * c16) = st.kd[ps];
    *(LAS v4u*)(buf + G2_V_OFF + (tid >> 3) * G2_V_STRIDE + 16 * (tid & 7)) = st.v;
}
__device__ __forceinline__ void gla2_flush(const LAS unsigned char* img, bf16* SST, int bh, int c, int slice, int tid) {
    const int rw = tid >> 4, c16 = tid & 15;
#pragma unroll
    for (int ps = 0; ps < 2; ++ps) *(v4u*)(SST + ((size_t)(bh * 32 + c) * 256 + 64 * slice + 32 * ps + rw) * 128 + 8 * c16) = *(const LAS v4u*)(img + (32 * ps + rw) * G2_SIMG_STRIDE + 16 * c16);
}
__device__ __forceinline__ void gla2s_item(LAS unsigned char* lds, int item, const bf16* Z, const bf16* KD, const float* DEC, bf16* SST, int tid) {
    const int lane = tid & 63, wave = __builtin_amdgcn_readfirstlane(tid >> 6), G = lane >> 4, ql = lane & 15;
    const int slice = item & 3, bh = item >> 2, h = bh & 3, b = bh >> 2;
    const size_t tokb = (size_t)b * SEQ;
    f32x4 sacc[4];
#pragma unroll
    for (int db = 0; db < 4; ++db) sacc[db] = (f32x4){0.f, 0.f, 0.f, 0.f};
    { Gla2Stage st; gla2_load(st, Z, KD, tokb, h, slice, tid); gla2_store(st, lds, tid);
#pragma unroll
      for (int k = 0; k < 2; ++k) *(LAS f32x4*)(lds + G2_DEC_OFF + 16 * (tid + 512 * k)) = *(const f32x4*)(DEC + (size_t)(bh * 32) * 128 + 4 * (tid + 512 * k)); }
    __syncthreads();
    for (int c = 0; c < 32; ++c) {
        LAS unsigned char* buf = lds + (c & 1) * G2_BUF;
        LAS unsigned char* img = lds + G2_SIMG_OFF + (c & 1) * G2_SIMG;
        Gla2Stage st;
        if (c < 31) gla2_load(st, Z, KD, tokb + 64 * (c + 1), h, slice, tid);
        if (c > 0) gla2_flush(lds + G2_SIMG_OFF + ((c - 1) & 1) * G2_SIMG, SST, bh, c - 1, slice, tid);
#pragma unroll
        for (int db = 0; db < 4; ++db) { u32x2 o; o[0] = cvtpk(sacc[db][0], sacc[db][1]); o[1] = cvtpk(sacc[db][2], sacc[db][3]); *(LAS u32x2*)(img + (16 * db + ql) * G2_SIMG_STRIDE + (16 * wave + 4 * G) * 2) = o; }
        const f32x4 dec = *(const LAS f32x4*)(lds + G2_DEC_OFF + (128 * c + 16 * wave + 4 * G) * 4);
#pragma unroll
        for (int db = 0; db < 4; ++db) sacc[db] *= dec;
#pragma unroll
        for (int s = 0; s < 2; ++s) {
            const bf16x8 kf = frag_tr(buf + G2_KD_OFF + (32 * s) * G2_KD_STRIDE + (16 * wave) * 2, G2_KD_STRIDE, lane);
#pragma unroll
            for (int db = 0; db < 4; ++db) {
                const bf16x8 vf = frag_tr(buf + G2_V_OFF + (32 * s) * G2_V_STRIDE + (16 * db) * 2, G2_V_STRIDE, lane);
                sacc[db] = __builtin_amdgcn_mfma_f32_16x16x32_bf16(kf, vf, sacc[db], 0, 0, 0);
            }
        }
        if (c < 31) gla2_store(st, lds + ((c + 1) & 1) * G2_BUF, tid);
        __syncthreads();
    }
    gla2_flush(lds + G2_SIMG_OFF + (31 & 1) * G2_SIMG, SST, bh, 31, slice, tid);
    __syncthreads();
}

constexpr int G3_QK_STRIDE = 272, G3_V_STRIDE = 544, G3_QT_OFF = 0, G3_KT_OFF = G3_QT_OFF + 64 * G3_QK_STRIDE, G3_V_OFF = G3_KT_OFF + 64 * G3_QK_STRIDE, G3_ST_OFF = G3_V_OFF + 64 * G3_V_STRIDE,
              G3_PART_OFF = G3_ST_OFF + 256 * G3_QK_STRIDE, G3_LDS_END = G3_PART_OFF + 8 * 16 * 4;
struct G3Stage { v4u qt[2], kt[2], v[4], st[8]; };
__device__ __forceinline__ void gla3_load(G3Stage& sg, int item, const bf16* Z, const bf16* QT, const bf16* KT, const bf16* SST, int tid) {
    const int c = item & 31, h = (item >> 5) & 3, b = item >> 7; const size_t tok0 = (size_t)b * SEQ + 64 * c;
    const int rw = tid >> 4, c16 = tid & 15, rv = tid >> 5, c32 = tid & 31;
#pragma unroll
    for (int ps = 0; ps < 2; ++ps) { const size_t o = (tok0 + 32 * ps + rw) * 512 + h * 128 + 8 * c16; sg.qt[ps] = *(const v4u*)(QT + o); sg.kt[ps] = *(const v4u*)(KT + o); }
#pragma unroll
    for (int ps = 0; ps < 4; ++ps) sg.v[ps] = *(const v4u*)(Z + (tok0 + 16 * ps + rv) * OD_Z + 1024 + h * 256 + 8 * c32);
    const bf16* sp = SST + (size_t)item * 256 * 128;
#pragma unroll
    for (int ps = 0; ps < 8; ++ps) sg.st[ps] = *(const v4u*)(sp + (size_t)(32 * ps + rw) * 128 + 8 * c16);
}
__device__ __forceinline__ void gla3_store(const G3Stage& sg, LAS unsigned char* lds, int tid) {
    const int rw = tid >> 4, c16 = tid & 15, rv = tid >> 5, c32 = tid & 31;
#pragma unroll
    for (int ps = 0; ps < 2; ++ps) { *(LAS v4u*)(lds + G3_QT_OFF + (32 * ps + rw) * G3_QK_STRIDE + 16 * c16) = sg.qt[ps]; *(LAS v4u*)(lds + G3_KT_OFF + (32 * ps + rw) * G3_QK_STRIDE + 16 * c16) = sg.kt[ps]; }
#pragma unroll
    for (int ps = 0; ps < 4; ++ps) *(LAS v4u*)(lds + G3_V_OFF + (16 * ps + rv) * G3_V_STRIDE + 16 * c32) = sg.v[ps];
#pragma unroll
    for (int ps = 0; ps < 8; ++ps) *(LAS v4u*)(lds + G3_ST_OFF + (32 * ps + rw) * G3_QK_STRIDE + 16 * c16) = sg.st[ps];
}
__device__ __forceinline__ void gla3_items(LAS unsigned char* lds, int first, int step, int last_excl, const bf16* Z, const bf16* QT, const bf16* KT, const bf16* SST, const float* head_norm, bf16* Y, int tid) {
    const int lane = tid & 63, wave = __builtin_amdgcn_readfirstlane(tid >> 6), G = lane >> 4, ql = lane & 15;
    LAS unsigned char* QTl = lds + G3_QT_OFF; LAS unsigned char* KTl = lds + G3_KT_OFF; LAS unsigned char* Vl = lds + G3_V_OFF; LAS unsigned char* STl = lds + G3_ST_OFF;
    LAS float* PART = (LAS float*)(lds + G3_PART_OFF);
    const int ib = wave >> 1, dh = wave & 1;
    if (first >= last_excl) return;
    G3Stage sg;
    gla3_load(sg, first, Z, QT, KT, SST, tid);
    for (int item = first; item < last_excl; item += step) {
        const int c = item & 31, h = (item >> 5) & 3, b = item >> 7;
        const size_t tok0 = (size_t)b * SEQ + 64 * c;
        gla3_store(sg, lds, tid);
        u32x2 gcv[8];
        { const bf16* gp = Z + (tok0 + 16 * ib + ql) * OD_Z + 2048 + h * 256 + 128 * dh + 4 * G;
#pragma unroll
          for (int dvb = 0; dvb < 8; ++dvb) gcv[dvb] = *(const u32x2*)(gp + 16 * dvb); }
        __syncthreads();
        bf16x8 qf[4];
#pragma unroll
        for (int ks = 0; ks < 4; ++ks) qf[ks] = *(const LAS bf16x8*)(QTl + (16 * ib + ql) * G3_QK_STRIDE + 64 * ks + 16 * G);
        f32x4 at[4];
#pragma unroll
        for (int jb = 0; jb < 4; ++jb) {
            at[jb] = (f32x4){0.f, 0.f, 0.f, 0.f};
            if (jb <= ib) {
#pragma unroll
                for (int ks = 0; ks < 4; ++ks) at[jb] = __builtin_amdgcn_mfma_f32_16x16x32_bf16(*(const LAS bf16x8*)(KTl + (16 * jb + ql) * G3_QK_STRIDE + 64 * ks + 16 * G), qf[ks], at[jb], 0, 0, 0);
#pragma unroll
                for (int rg = 0; rg < 4; ++rg) if (16 * jb + 4 * G + rg > 16 * ib + ql) at[jb][rg] = 0.f;
            }
        }
        f32x4 oc[8];
#pragma unroll
        for (int dvb = 0; dvb < 8; ++dvb) oc[dvb] = (f32x4){0.f, 0.f, 0.f, 0.f};
#pragma unroll
        for (int ks = 0; ks < 4; ++ks)
#pragma unroll
            for (int dvb = 0; dvb < 8; ++dvb)
                oc[dvb] = __builtin_amdgcn_mfma_f32_16x16x32_bf16(*(const LAS bf16x8*)(STl + (128 * dh + 16 * dvb + ql) * G3_QK_STRIDE + 64 * ks + 16 * G), qf[ks], oc[dvb], 0, 0, 0);
#pragma unroll
        for (int s = 0; s < 2; ++s) {
            if (2 * s <= ib) {
                const bf16x8 pf = __builtin_bit_cast(bf16x8, (v4u){cvtpk(at[2 * s][0], at[2 * s][1]), cvtpk(at[2 * s][2], at[2 * s][3]), cvtpk(at[2 * s + 1][0], at[2 * s + 1][1]), cvtpk(at[2 * s + 1][2], at[2 * s + 1][3])});
#pragma unroll
                for (int dvb = 0; dvb < 8; ++dvb) {
                    const bf16x8 vf = frag_tr(Vl + (32 * s) * G3_V_STRIDE + (128 * dh + 16 * dvb) * 2, G3_V_STRIDE, lane);
                    oc[dvb] = __builtin_amdgcn_mfma_f32_16x16x32_bf16(vf, pf, oc[dvb], 0, 0, 0);
                }
            }
        }
        float ss = 0.f;
#pragma unroll
        for (int dvb = 0; dvb < 8; ++dvb) ss += (oc[dvb][0] * oc[dvb][0] + oc[dvb][1] * oc[dvb][1]) + (oc[dvb][2] * oc[dvb][2] + oc[dvb][3] * oc[dvb][3]);
        ss += __shfl_xor(ss, 16); ss += __shfl_xor(ss, 32);
        if (G == 0) PART[wave * 16 + ql] = ss;
        __syncthreads();
        if (item + step < last_excl) gla3_load(sg, item + step, Z, QT, KT, SST, tid);
        const float rs = __builtin_amdgcn_rsqf((PART[(wave & ~1) * 16 + ql] + PART[(wave | 1) * 16 + ql]) * (1.f / 256.f) + 1e-6f);
        bf16* yp = Y + (tok0 + 16 * ib + ql) * DM + h * 256 + 128 * dh + 4 * G;
        const float* hp = head_norm + h * 256 + 128 * dh + 4 * G;
#pragma unroll
        for (int dvb = 0; dvb < 8; ++dvb) {
            const f32x4 hn = *(const f32x4*)(hp + 16 * dvb); const f32x4 o = oc[dvb]; const u32x2 gc = gcv[dvb];
            u32x2 y; y[0] = cvtpk(o[0] * rs * hn[0] * fast_silu(bflo(gc[0])), o[1] * rs * hn[1] * fast_silu(bfhi(gc[0])));
            y[1] = cvtpk(o[2] * rs * hn[2] * fast_silu(bflo(gc[1])), o[3] * rs * hn[3] * fast_silu(bfhi(gc[1])));
            *(u32x2*)(yp + 16 * dvb) = y;
        }
    }
    __syncthreads();
}
#define OPT_ATTN 1
#define OPT_LRU 1
#define OPT_GLA 1
constexpr int NWAVES = 8;
constexpr size_t MiB = 1u << 20;
constexpr size_t WS_CTL = 0, CTL_ZERO_BYTES = 1 * MiB;
constexpr size_t WS_WEVIN = 2 * MiB;
constexpr size_t WS_WEVOUT = 66 * MiB;
constexpr size_t WS_WODIN = 82 * MiB;
constexpr size_t WS_WODOUT = 130 * MiB;
constexpr size_t WS_WALR = 146 * MiB;
constexpr size_t WS_WGATE = 147 * MiB;
constexpr size_t WS_X = 150 * MiB;
constexpr size_t WS_XG = 214 * MiB;
constexpr size_t WS_Z = 246 * MiB;
constexpr size_t WS_Y = 374 * MiB;
constexpr size_t WS_ALR = 406 * MiB;
constexpr size_t WS_SUMP = 406 * MiB + 512 * 1024;
constexpr size_t WS_T0 = 408 * MiB;
constexpr size_t WS_T1 = 456 * MiB;
constexpr size_t WS_END = 504 * MiB;
constexpr int CW_BAR = 4096;
constexpr int MAX_LAUNCH = 8;
static_assert((CW_BAR + MAX_LAUNCH * XCD_BAR_WORDS) * 4 <= (int)CTL_ZERO_BYTES, "ctl map");
constexpr int RING_OFF = 0, RING_BYTES = 131072;
constexpr int LDSCTL_OFF = 152064, MISC_OFF = LDSCTL_OFF + 320;
constexpr int LDS_BYTES = 156160;
static_assert(G1_LDS_END <= LDSCTL_OFF && G2_LDS_END <= LDSCTL_OFF && G3_LDS_END <= LDSCTL_OFF && AT_LDS_END <= LDSCTL_OFF && LR_LDS_END <= LDSCTL_OFF && SGU_W_OFF + 128 * SGU_W_STRIDE <= LDSCTL_OFF, "LDS map");

constexpr int PH_PROLOGUE = 0, PH_FINAL = 21, N_PHASES = 22;

struct Args {
    const float* in[21]; float* out; unsigned char* ws;
    const float* gn[4];
    const float* xold[4];
    int ph_lo, ph_hi, li, pad;
};
#define CAS __attribute__((address_space(4)))
template <class T> __device__ __forceinline__ T* karg(const CAS char* ka, int byte_off) { T* p = *(T* const CAS*)(ka + byte_off); return (T*)(__attribute__((address_space(1))) T*)p; }
#define KIN(k) karg<const float>(ka_, 8 * (k))

__device__ __forceinline__ float wave_sum(float v) {
#pragma unroll
    for (int o = 1; o < 64; o <<= 1) v += __shfl_xor(v, o);
    return v;
}
__device__ __forceinline__ void p0_transpose_item(const float* W, int K, int ldw, int nblk, bf16* WT, int skip_at, int skip, const float* gk, LAS float* scr, int item, int lane, bool nt_out) {
    const int kb = item / nblk, nb = item % nblk, k0 = 64 * kb, n0 = 64 * nb, s0 = n0 + (n0 >= skip_at ? skip : 0);
    const int c = lane & 7;
    f32x4 g0 = {1.f, 1.f, 1.f, 1.f}, g1 = {1.f, 1.f, 1.f, 1.f};
    if (gk) { g0 = *(const f32x4*)(gk + k0 + 8 * c); g1 = *(const f32x4*)(gk + k0 + 8 * c + 4); }
    { f32x4 wv[16];
#pragma unroll
      for (int i = 0; i < 16; ++i) wv[i] = __builtin_nontemporal_load((const f32x4*)(W + (size_t)(k0 + 4 * i + (lane >> 4)) * ldw + s0 + 4 * (lane & 15)));
#pragma unroll
      for (int i = 0; i < 16; ++i) *(LAS f32x4*)(scr + (4 * i + (lane >> 4)) * 68 + 4 * (lane & 15)) = wv[i]; }
    LDS_WAIT(); asm volatile("" ::: "memory");
#pragma unroll
    for (int j = 0; j < 8; ++j) { const int n = (lane >> 3) + 8 * j; const LAS float* s = scr + (8 * c) * 68 + n;
        v4u o; o.x = pk2(s[0 * 68] * g0[0], s[1 * 68] * g0[1]); o.y = pk2(s[2 * 68] * g0[2], s[3 * 68] * g0[3]); o.z = pk2(s[4 * 68] * g1[0], s[5 * 68] * g1[1]); o.w = pk2(s[6 * 68] * g1[2], s[7 * 68] * g1[3]);
        if (nt_out) __builtin_nontemporal_store(o, (GAS v4u*)(WT + (size_t)(n0 + n) * K + k0 + 8 * c)); else *(GAS v4u*)(WT + (size_t)(n0 + n) * K + k0 + 8 * c) = o; }
    LDS_WAIT(); asm volatile("" ::: "memory");
}

__global__ void __launch_bounds__(NWAVES * 64, 2) mk_fwd(Args args) {
    extern __shared__ __attribute__((aligned(16))) unsigned char lds_raw[];
    LAS unsigned char* lds = (LAS unsigned char*)lds_raw;
    volatile LAS unsigned* MISC = (volatile LAS unsigned*)(lds + MISC_OFF);
    const int G0 = gridDim.x;
    unsigned char* ws = args.ws;
    unsigned* ctl = (unsigned*)(ws + WS_CTL);
    float* SUMP = (float*)(ws + WS_SUMP);
    for (int u = threadIdx.x; u < (LDS_BYTES - LDSCTL_OFF) / 4; u += NWAVES * 64) ((LAS unsigned*)(lds + LDSCTL_OFF))[u] = 0u;
    __syncthreads();
    XcdBarrier bar = xcd_barrier_post(ctl + CW_BAR + args.li * XCD_BAR_WORDS, MISC + 8);

    float* X = (float*)(ws + WS_X); bf16* XG = (bf16*)(ws + WS_XG); bf16* Z = (bf16*)(ws + WS_Z); bf16* Y = (bf16*)(ws + WS_Y);
    float* ALR = (float*)(ws + WS_ALR);

#ifndef REP_COND
#define REP_COND(ph) false
#endif
    int rep_done = 0, first = 1;
    for (int ph = args.ph_lo; ph < args.ph_hi; ) {
        if (ph != PH_PROLOGUE && ph != PH_FINAL && ((ph - 1) % 5) == 3 && ((((ph - 1) / 5) & 1) == 0)) { ++ph; continue; }
        if (!first) xcd_barrier(bar);
        first = 0;
        int tid = threadIdx.x; asm volatile("" : "+v"(tid));
        int G = G0; asm volatile("" : "+s"(G));
        const int lane = tid & 63, wave = __builtin_amdgcn_readfirstlane(tid >> 6);
        const CAS char* ka_ = (const CAS char*)__builtin_amdgcn_kernarg_segment_ptr(); asm volatile("" : "+s"(ka_));
        const float* x_in = KIN(0);
        if (ph == PH_PROLOGUE) {
            LAS float* scr = (LAS float*)(lds + RING_OFF + wave * 17408);
            const int gw = blockIdx.x * NWAVES + wave, NGW = G * NWAVES;
            constexpr int I_EVIN = 32 * 128, I_EVOUT = 32 * 32, I_ODIN = 32 * 96, I_ODOUT = 32 * 32, I_GATE = 2 * 2;
            constexpr int NITEMS = 2 * (I_EVIN + I_EVOUT + I_ODIN + I_ODOUT) + 2 * 12 * 2 * I_GATE;
            for (int it = gw; it < NITEMS; it += NGW) {
                int r = it;
                if (r < 2 * I_EVIN) { const int i = r / I_EVIN; p0_transpose_item(KIN(2) + (size_t)i * DM * EV_IN, DM, EV_IN, 128, (bf16*)(ws + WS_WEVIN) + (size_t)i * EV_IN * DM, 1 << 30, 0, KIN(1) + (size_t)i * DM, scr, r % I_EVIN, lane, i != 0); continue; } r -= 2 * I_EVIN;
                if (r < 2 * I_EVOUT) { const int i = r / I_EVOUT; p0_transpose_item(KIN(10) + (size_t)i * DM * DM, DM, DM, 32, (bf16*)(ws + WS_WEVOUT) + (size_t)i * DM * DM, 1 << 30, 0, nullptr, scr, r % I_EVOUT, lane, true); continue; } r -= 2 * I_EVOUT;
                if (r < 2 * I_ODIN) { const int i = r / I_ODIN; p0_transpose_item(KIN(12) + (size_t)i * DM * OD_IN, DM, OD_IN, 96, (bf16*)(ws + WS_WODIN) + (size_t)i * OD_Z * DM, 2048, 16, KIN(11) + (size_t)i * DM, scr, r % I_ODIN, lane, true); continue; } r -= 2 * I_ODIN;
                if (r < 2 * I_ODOUT) { const int i = r / I_ODOUT; p0_transpose_item(KIN(19) + (size_t)i * DM * DM, DM, DM, 32, (bf16*)(ws + WS_WODOUT) + (size_t)i * DM * DM, 1 << 30, 0, nullptr, scr, r % I_ODOUT, lane, true); continue; } r -= 2 * I_ODOUT;
                { const int mat = r / I_GATE, li2 = mat / 24, h = (mat % 24) >> 1, gate = mat & 1;
                  const float* src = KIN(gate ? 7 : 5) + ((size_t)li2 * 12 + h) * 128 * 128;
                  p0_transpose_item(src, 128, 128, 2, (bf16*)(ws + WS_WGATE) + (size_t)mat * 128 * 128, 1 << 30, 0, nullptr, scr, r % I_GATE, lane, false); }
            }
            for (int e = blockIdx.x * 512 + tid; e < 2 * 16 * 2048; e += G * 512) { const int i = e >> 15, j = (e >> 11) & 15, k = e & 2047;
                ((bf16*)(ws + WS_WALR))[e] = (bf16)f2bf(KIN(12)[(size_t)i * DM * OD_IN + (size_t)k * OD_IN + 2048 + j] * KIN(11)[(size_t)i * DM + k]); }
            for (int m = gw; m < MTOK; m += NGW) {
                const f32x4* xr = (const f32x4*)(x_in + (size_t)m * DM) + lane; float s = 0.f;
                unsigned long long* o8 = (unsigned long long*)(XG + (size_t)m * DM) + lane;
#pragma unroll
                for (int j = 0; j < 8; ++j) { const f32x4 v = __builtin_nontemporal_load(xr + 64 * j); const unsigned p0 = pk2(v[0], v[1]), p1 = pk2(v[2], v[3]);
                    const float r0 = __uint_as_float(p0 << 16), r1 = __uint_as_float(p0 & 0xffff0000u), r2 = __uint_as_float(p1 << 16), r3 = __uint_as_float(p1 & 0xffff0000u);
                    s += (r0 * r0 + r1 * r1) + (r2 * r2 + r3 * r3);
                    o8[64 * j] = (unsigned long long)p0 | ((unsigned long long)p1 << 32); }
                s = wave_sum(s);
                if (lane < 8) SUMP[(size_t)m * 8 + lane] = (lane == 0) ? s : 0.f;
            }
        } else if (ph == PH_FINAL) {
            const int gw = blockIdx.x * NWAVES + wave, NGW = G * NWAVES;
            const float* gf = KIN(20);
            for (int m = gw; m < MTOK; m += NGW) {
                const f32x4 p0 = *(const f32x4*)(SUMP + ((size_t)4 * 8192 + m) * 8), p1 = *(const f32x4*)(SUMP + ((size_t)4 * 8192 + m) * 8 + 4);
                const float rs = __builtin_amdgcn_rsqf((((p0[0] + p0[1]) + (p0[2] + p0[3])) + ((p1[0] + p1[1]) + (p1[2] + p1[3]))) * (1.0f / 2048.0f) + 1e-6f);
                const unsigned long long* xr = (const unsigned long long*)(XG + (size_t)m * DM) + lane; f32x4* o = (f32x4*)(args.out + (size_t)m * DM) + lane;
#pragma unroll
                for (int j = 0; j < 8; ++j) { const unsigned long long w = xr[64 * j]; const unsigned w0 = (unsigned)w, w1 = (unsigned)(w >> 32); const f32x4 gg = ((const f32x4*)gf)[lane + 64 * j];
                    __builtin_nontemporal_store((f32x4){__uint_as_float(w0 << 16) * gg[0] * rs, __uint_as_float(w0 & 0xffff0000u) * gg[1] * rs, __uint_as_float(w1 << 16) * gg[2] * rs, __uint_as_float(w1 & 0xffff0000u) * gg[3] * rs}, o + 64 * j); }
            }
        } else {
            const int L = (ph - 1) / 5, sub = (ph - 1) % 5, i = L >> 1, odd = L & 1;
            if (sub == 0) {
                const int N = odd ? OD_Z : EV_IN;
                const bf16* Wt = (const bf16*)(ws + (odd ? WS_WODIN : WS_WEVIN)) + (size_t)i * N * DM;
                pg8::Gemm g{XG, Wt, MTOK, N, DM}; pg8::StaticOrder S; S.init(MTOK, N, G, (int)blockIdx.x);
                LAS float* rtab = (LAS float*)(lds + RING_BYTES + 4096);
                pg8::Unit u0; u0.pm = 0; u0.pn = 0; (void)S.next(0, u0);
                if (tid < 256) { const float* sp_ = SUMP + ((size_t)L * 8192 + u0.pm * 256 + tid) * 8; const f32x4 p0 = *(const f32x4*)sp_, p1 = *(const f32x4*)(sp_ + 4);
                    rtab[tid] = __builtin_amdgcn_rsqf((((p0[0] + p0[1]) + (p0[2] + p0[3])) + ((p1[0] + p1[1]) + (p1[2] + p1[3]))) * (1.0f / 2048.0f) + 1e-6f); }
                __syncthreads();
                pg8::EpiIn E{Z, N, SUMP + (size_t)L * 8192 * 8, rtab, u0.pm};
                pg8::gemm_phase<pg8::EpiIn, pg8::StaticOrder, true, true>(lds + RING_OFF, g, S, E);
                if (odd) {
                    const bf16* WA = (const bf16*)(ws + WS_WALR) + (size_t)i * 16 * 2048;
                    for (int rb0 = blockIdx.x * 32; rb0 < MTOK; rb0 += G * 32) {
                        const int rb = wave & 1, kq = wave >> 1, fr = lane & 15, fq = lane >> 4;
                        const bf16* ap = XG + (size_t)(rb0 + 16 * rb + fr) * DM + kq * 512 + 8 * fq;
                        const bf16* bp = WA + (size_t)fr * DM + kq * 512 + 8 * fq;
                        f32x4 acc = {0.f, 0.f, 0.f, 0.f};
#pragma unroll 8
                        for (int ks = 0; ks < 16; ++ks) { const bf16x8 a = *(const bf16x8*)(ap + ks * 32), b = *(const bf16x8*)(bp + ks * 32);
                            acc = __builtin_amdgcn_mfma_f32_16x16x32_bf16(a, b, acc, 0, 0, 0); }
                        LAS float* part = (LAS float*)(lds + RING_OFF);
#pragma unroll
                        for (int r = 0; r < 4; ++r) part[(kq * 32 + 16 * rb + 4 * fq + r) * 16 + fr] = acc[r];
                        __syncthreads();
                        { const int row = tid >> 4, j = tid & 15;
                          const float s = (part[(0 * 32 + row) * 16 + j] + part[(1 * 32 + row) * 16 + j]) + (part[(2 * 32 + row) * 16 + j] + part[(3 * 32 + row) * 16 + j]);
                          const float* sp_ = SUMP + ((size_t)L * 8192 + rb0 + row) * 8; const f32x4 p0 = *(const f32x4*)sp_, p1 = *(const f32x4*)(sp_ + 4);
                          const float rs = __builtin_amdgcn_rsqf((((p0[0] + p0[1]) + (p0[2] + p0[3])) + ((p1[0] + p1[1]) + (p1[2] + p1[3]))) * (1.0f / 2048.0f) + 1e-6f);
                          ALR[(size_t)(rb0 + row) * 16 + j] = s * rs; }
                        __syncthreads();
                    }
                }
            } else if (sub == 4) {
                const bf16* Wt = (const bf16*)(ws + (odd ? WS_WODOUT : WS_WEVOUT)) + (size_t)i * DM * DM;
                pg8::Gemm g{Y, Wt, MTOK, DM, DM}; pg8::StaticOrder S; S.init(MTOK, DM, G, (int)blockIdx.x);
                pg8::EpiOut E{XG, SUMP + (size_t)(L + 1) * 8192 * 8, (LAS float*)(lds + RING_BYTES)};
                pg8::gemm_phase<pg8::EpiOut, pg8::StaticOrder, true, true>(lds + RING_OFF, g, S, E);
            }
            else if (sub == 1 && !odd) {
#ifdef OPT_LRU
                { LruParams P{KIN(3) + (size_t)i * 4 * LRU_W, KIN(4) + (size_t)i * LRU_W, KIN(6) + (size_t)i * LRU_W, KIN(8) + (size_t)i * LRU_W, KIN(9) + (size_t)i * LRU_W,
                              (const bf16*)(ws + WS_WGATE) + (size_t)i * 12 * 2 * 128 * 128};
                  for (int item = blockIdx.x; item < 192; item += G) lru_item(lds, item, Z, P, Y, tid); }
#endif
#ifdef OPT_ATTN
                { const bool bal = (G == 256); const int bx = blockIdx.x;
                  const int first = bal ? (bx < 192 ? bx : 192 + (bx - 192) * 9) : bx, cnt = bal ? (bx < 192 ? 1 : 9) : (768 - bx + G - 1) / G, step = bal ? 1 : G;
                  attn_items(lds, first, step, cnt, Z, (bf16*)(ws + WS_T0), (float*)(ws + WS_T1), tid); }
#endif
            } else if (sub == 2 && !odd) {
#ifdef OPT_ATTN
                attn_merge(Z, (const bf16*)(ws + WS_T0), (const float*)(ws + WS_T1), Y, blockIdx.x * 512 + tid, G * 512);
#endif
            }
            else if (sub == 1 && odd) {
                const float* wal = KIN(13) + (size_t)i * 16 * 512; const float* bal = KIN(14) + (size_t)i * 512;
                for (int item = blockIdx.x; item < 512; item += G)
                    gla1a_item(lds, item, Z, ALR, wal, bal, (bf16*)(ws + WS_T0), (bf16*)(ws + WS_T0 + 8 * MiB), (bf16*)(ws + WS_T0 + 16 * MiB), (float*)(ws + WS_T0 + 24 * MiB), tid);
            }
            else if (sub == 2 && odd) {
                const int nscan = (G >= 128) ? 64 : 0;
                if ((int)blockIdx.x < nscan || nscan == 0) {
                    for (int item = blockIdx.x; item < 64; item += (nscan ? nscan : G))
                        gla2s_item(lds, item, Z, (const bf16*)(ws + WS_T0 + 16 * MiB), (const float*)(ws + WS_T0 + 24 * MiB), (bf16*)(ws + WS_T1), tid);
                }
                if ((int)blockIdx.x >= nscan) {
                    const float* vn = KIN(16) + (size_t)i * 1024; const float* wsg = KIN(17) + (size_t)i * 4 * 128 * 128; const float* bsg = KIN(18) + (size_t)i * 4 * 128;
                    for (int item = blockIdx.x - nscan; item < 256; item += G - nscan) sgu_item(lds, item, Z, vn, wsg, bsg, Y, tid);
                }
            }
            else if (sub == 3 && odd) {
                gla3_items(lds, blockIdx.x, G, 512, Z, (const bf16*)(ws + WS_T0), (const bf16*)(ws + WS_T0 + 8 * MiB), (const bf16*)(ws + WS_T1), KIN(15) + (size_t)i * 1024, Y, tid);
            }
        }
        if (REP_COND(ph) && !rep_done) rep_done = 1; else { rep_done = 0; ++ph; }
    }
}

static void launch_mk(Args& a, int lo, int hi, int li, int grid, hipStream_t stream) {
    a.ph_lo = lo; a.ph_hi = hi; a.li = li;
    hipLaunchKernelGGL(mk_fwd, dim3(grid), dim3(NWAVES * 64), LDS_BYTES, stream, a);
}
extern "C" void kernel_launch(void* const* d_in, const int* in_sizes, int n_in, void* d_out, int out_size, void* d_ws, size_t ws_size, hipStream_t stream) {
    static int grid = 0;
    if (grid == 0) {
        if (n_in != 21 || ws_size < WS_END) { fprintf(stderr, "kernel_launch: unexpected n_in %d / ws_size %zu\n", n_in, ws_size); grid = -1; return; }
        int dev = 0, cus = 0, per_cu = 0;
        if (hipGetDevice(&dev) != hipSuccess || hipDeviceGetAttribute(&cus, hipDeviceAttributeMultiprocessorCount, dev) != hipSuccess) { grid = -1; return; }
        if (hipFuncSetAttribute((const void*)mk_fwd, hipFuncAttributeMaxDynamicSharedMemorySize, LDS_BYTES) != hipSuccess) { fprintf(stderr, "kernel_launch: hipFuncSetAttribute failed\n"); grid = -1; return; }
        if (hipOccupancyMaxActiveBlocksPerMultiprocessor(&per_cu, (const void*)mk_fwd, NWAVES * 64, LDS_BYTES) != hipSuccess || per_cu < 1) { fprintf(stderr, "kernel_launch: occupancy query says %d\n", per_cu); }
        (void)hipGetLastError();
        grid = cus;
    }
    if (grid < 0) return;
    hipMemsetAsync((char*)d_ws + WS_CTL, 0, CTL_ZERO_BYTES, stream);
    Args a{};
    for (int i = 0; i < 21; ++i) a.in[i] = (const float*)d_in[i];
    a.out = (float*)d_out; a.ws = (unsigned char*)d_ws;
    a.gn[0] = a.in[11]; a.gn[1] = a.in[1] + DM; a.gn[2] = a.in[11] + DM; a.gn[3] = a.in[20];
    a.xold[0] = a.in[0]; a.xold[1] = a.xold[2] = a.xold[3] = (const float*)((char*)d_ws + WS_X);
    launch_mk(a, 0, N_PHASES, 0, grid, stream);
}
```
